# Optimizing an MI355X kernel written in HIP

```python
import jax
import jax.numpy as jnp
from jax import lax
import numpy as np


D_MODEL = 1024
BATCH = 8
SEQ = 4096
DEPTH = 2

GRID_W = 64
CTX_LEN = 256
N_MOD = 6
LN_EPS = 1e-6
DEEPNORM_ALPHA = (2 * DEPTH) ** 0.25
DEEPNORM_BETA = (8 * DEPTH) ** -0.25

MLA_HEADS = 8
MLA_Q_RANK = 384
MLA_KV_RANK = 256
MLA_NOPE = 64
MLA_ROPE = 32
MLA_V = 64
MLA_SCALE = (MLA_NOPE + MLA_ROPE) ** -0.5
ROPE_BASE = 10000.0
ATTN_BLOCK = 128

GLA_HEADS = 4
GLA_DK = 64
GLA_DV = 128
GLA_GATE_RANK = 16
GLA_TAU = 16.0
GLA_CHUNK = 64

EV_WIDTHS = (MLA_Q_RANK, MLA_KV_RANK, MLA_ROPE,
             GLA_HEADS * GLA_DK, GLA_HEADS * GLA_DK, GLA_HEADS * GLA_DV, GLA_HEADS * GLA_DV,
             GLA_GATE_RANK, GLA_GATE_RANK)
EV_SPLITS = tuple(sum(EV_WIDTHS[:i + 1]) for i in range(len(EV_WIDTHS) - 1))
EV_IN = sum(EV_WIDTHS)
MIX_OUT = MLA_HEADS * MLA_V + GLA_HEADS * GLA_DV

RG_WIDTH = 1280
RG_BLOCKS = 10
RG_BW = RG_WIDTH // RG_BLOCKS
RG_CONV = 4
RG_CONV_LEFT = 2
RG_C = 8.0

PEER_HEADS = 8
PEER_NK = 128
PEER_N = PEER_NK * PEER_NK
PEER_TOPK = 16
PEER_QDIM = 256
PEER_HALF = PEER_QDIM // 2
PEER_BLOCK = 128

kernel_name = 'hybrid_mla_gla_rglru_peer_diffusion_block'


def layer_norm(x, g, b):
    xf = x.astype(jnp.float32)
    mu = jnp.mean(xf, axis=-1, keepdims=True)
    var = jnp.mean(jnp.square(xf - mu), axis=-1, keepdims=True)
    return ((xf - mu) * lax.rsqrt(var + LN_EPS) * g + b).astype(x.dtype)


def rms_norm(x, g):
    xf = x.astype(jnp.float32)
    y = xf * lax.rsqrt(jnp.mean(jnp.square(xf), axis=-1, keepdims=True) + LN_EPS)
    return (y * g).astype(x.dtype)


def modulate(h, shift, scale):
    return h * (1.0 + scale) + shift


def tflip(z):
    return jnp.flip(z, axis=1)


def axial_rope(seq_len):
    rows = seq_len // GRID_W
    row = jnp.repeat(jnp.arange(rows, dtype=jnp.float32), GRID_W)
    col = jnp.tile(jnp.arange(GRID_W, dtype=jnp.float32), rows)
    n_freq = MLA_ROPE // 4
    inv = jnp.power(ROPE_BASE, -jnp.arange(n_freq, dtype=jnp.float32) / n_freq)
    ang = jnp.concatenate([row[:, None] * inv, col[:, None] * inv], axis=-1)
    return jnp.cos(ang), jnp.sin(ang)


def apply_rope(x, cos, sin):
    half = x.shape[-1] // 2
    x1, x2 = x[..., :half], x[..., half:]
    return jnp.concatenate([x1 * cos - x2 * sin, x1 * sin + x2 * cos], axis=-1).astype(x.dtype)


def mla_queries(c_q, q_norm, w_uq, cos, sin):
    q = (rms_norm(c_q, q_norm) @ w_uq).reshape(c_q.shape[:-1] + (MLA_HEADS, MLA_NOPE + MLA_ROPE))
    q_nope, q_pe = q[..., :MLA_NOPE], q[..., MLA_NOPE:]
    if cos is not None:
        q_pe = apply_rope(q_pe, cos[:, None, :], sin[:, None, :])
    return jnp.concatenate([q_nope, q_pe], axis=-1)


def mla_keys_values(c_kv, k_pe, kv_norm, w_ukv, cos, sin):
    kv = (rms_norm(c_kv, kv_norm) @ w_ukv).reshape(c_kv.shape[:-1] + (MLA_HEADS, MLA_NOPE + MLA_V))
    k_nope, v = kv[..., :MLA_NOPE], kv[..., MLA_NOPE:]
    if cos is not None:
        k_pe = apply_rope(k_pe, cos, sin)
    k_pe = jnp.broadcast_to(k_pe[..., None, :], k_nope.shape[:-1] + (MLA_ROPE,))
    return jnp.concatenate([k_nope, k_pe], axis=-1), v


def softmax_attend(q, k, v):
    s = jnp.einsum('bqhd,bkhd->bhqk', q, k).astype(jnp.float32) * MLA_SCALE
    p = jax.nn.softmax(s, axis=-1).astype(v.dtype)
    return jnp.einsum('bhqk,bkhd->bqhd', p, v)


def blocked_attend(q, k, v):
    b, s, h, d = q.shape
    nb = s // ATTN_BLOCK
    qb = q.reshape(b, nb, ATTN_BLOCK, h, d).transpose(1, 0, 2, 3, 4)
    ob = lax.map(lambda qi: softmax_attend(qi, k, v), qb)
    return ob.transpose(1, 0, 2, 3, 4).reshape(b, s, h, v.shape[-1])


def gla_project(gq, gk, gv, gaf, gab, wa2, ba):
    lead = gq.shape[:-1]
    q = gq.reshape(lead + (GLA_HEADS, GLA_DK)) * (GLA_DK ** -0.5)
    k = gk.reshape(lead + (GLA_HEADS, GLA_DK))
    v = gv.reshape(lead + (GLA_HEADS, GLA_DV))

    def log_decay(ga, w, bias):
        z = (ga @ w + bias).astype(jnp.float32)
        return (jax.nn.log_sigmoid(z) / GLA_TAU).reshape(lead + (GLA_HEADS, GLA_DK))

    return q, k, v, log_decay(gaf, wa2[0], ba[0]), log_decay(gab, wa2[1], ba[1])


def gla_chunked(q, k, v, log_a, s0):
    b, t, h, dk = q.shape
    dv = v.shape[-1]
    n = t // GLA_CHUNK

    def chunks(z):
        return z.astype(jnp.float32).reshape(b, n, GLA_CHUNK, h, z.shape[-1]).transpose(1, 0, 3, 2, 4)

    lower = jnp.tril(jnp.ones((GLA_CHUNK, GLA_CHUNK), dtype=bool))[:, :, None]

    def step(state, inp):
        qc, kc, vc, ac = inp
        cum = jnp.cumsum(ac, axis=2)
        diff = cum[:, :, :, None, :] - cum[:, :, None, :, :]
        decay = jnp.exp(jnp.where(lower, diff, -jnp.inf))
        scores = jnp.einsum('bhid,bhjd,bhijd->bhij', qc, kc, decay)
        out = scores @ vc + jnp.einsum('bhid,bhde->bhie', qc * jnp.exp(cum), state)
        last = cum[:, :, -1:, :]
        state = (jnp.exp(last[:, :, 0, :])[..., None] * state
                 + jnp.einsum('bhjd,bhje->bhde', kc * jnp.exp(last - cum), vc))
        return state, out

    s_fin, o = lax.scan(step, s0, (chunks(q), chunks(k), chunks(v), chunks(log_a)))
    o = o.transpose(1, 0, 3, 2, 4).reshape(b, t, h, dv).astype(v.dtype)
    return o, s_fin


def gla_final_state(k, v, log_a):
    cum = jnp.cumsum(log_a, axis=1)
    w = jnp.exp(cum[:, -1:] - cum)
    return jnp.einsum('bthd,bthe->bhde', k.astype(jnp.float32) * w, v.astype(jnp.float32))


def gla_output(o, g, norm):
    lead = o.shape[:-2]
    y = rms_norm(o, norm.reshape(GLA_HEADS, GLA_DV)).reshape(lead + (GLA_HEADS * GLA_DV,))
    return y * jax.nn.silu(g)


def mla_gla_mixer(h_ctx, h_lat, cos, sin, w_in, q_norm, kv_norm, w_uq, w_ukv,
                  gla_wa2, gla_ba, gla_norm, w_out, with_ctx_out):
    b = h_lat.shape[0]
    pc = jnp.split(h_ctx @ w_in, EV_SPLITS, axis=-1)
    px = jnp.split(h_lat @ w_in, EV_SPLITS, axis=-1)
    k_c, v_c = mla_keys_values(pc[1], pc[2], kv_norm, w_ukv, None, None)
    k_x, v_x = mla_keys_values(px[1], px[2], kv_norm, w_ukv, cos, sin)
    q_x = mla_queries(px[0], q_norm, w_uq, cos, sin)
    att_x = blocked_attend(q_x, jnp.concatenate([k_c, k_x], axis=1), jnp.concatenate([v_c, v_x], axis=1))
    gq_c, gk_c, gv_c, laf_c, lab_c = gla_project(pc[3], pc[4], pc[5], pc[7], pc[8], gla_wa2, gla_ba)
    gq_x, gk_x, gv_x, laf_x, lab_x = gla_project(px[3], px[4], px[5], px[7], px[8], gla_wa2, gla_ba)
    zero = jnp.zeros((b, GLA_HEADS, GLA_DK, GLA_DV), jnp.float32)
    if with_ctx_out:
        o_cf, s_f = gla_chunked(gq_c, gk_c, gv_c, laf_c, zero)
        o_cb, s_b = gla_chunked(tflip(gq_c), tflip(gk_c), tflip(gv_c), tflip(lab_c), zero)
    else:
        s_f = gla_final_state(gk_c, gv_c, laf_c)
        s_b = gla_final_state(tflip(gk_c), tflip(gv_c), tflip(lab_c))
    o_xf, _ = gla_chunked(gq_x, gk_x, gv_x, laf_x, s_f)
    o_xb, _ = gla_chunked(tflip(gq_x), tflip(gk_x), tflip(gv_x), tflip(lab_x), s_b)
    gla_x = gla_output(o_xf + tflip(o_xb), px[6], gla_norm)
    out_x = jnp.concatenate([att_x.reshape(att_x.shape[:2] + (MLA_HEADS * MLA_V,)), gla_x], axis=-1) @ w_out
    out_c = None
    if with_ctx_out:
        q_c = mla_queries(pc[0], q_norm, w_uq, None, None)
        att_c = softmax_attend(q_c, k_c, v_c)
        gla_c = gla_output(o_cf + tflip(o_cb), pc[6], gla_norm)
        out_c = jnp.concatenate([att_c.reshape(att_c.shape[:2] + (MLA_HEADS * MLA_V,)), gla_c], axis=-1) @ w_out
    return out_c, out_x


def dwconv_centred(z, w, bias):
    t = z.shape[1]
    zp = jnp.pad(z, ((0, 0), (RG_CONV_LEFT, RG_CONV - 1 - RG_CONV_LEFT), (0, 0)))
    y = bias + zp[:, 0:t] * w[0]
    for tap in range(1, RG_CONV):
        y = y + zp[:, tap:tap + t] * w[tap]
    return y


def rg_gates(z, gw, gb, lam):
    zf = z.astype(jnp.float32)
    zb = zf.reshape(z.shape[:-1] + (RG_BLOCKS, RG_BW))

    def gate(w, bias):
        return jax.nn.sigmoid(jnp.einsum('btnc,ncd->btnd', zb, w.astype(jnp.float32)).reshape(zf.shape) + bias)

    r = gate(gw[0], gb[0])
    i = gate(gw[1], gb[1])
    log_a = -RG_C * jax.nn.softplus(-lam.astype(jnp.float32)) * r
    x_in = jnp.sqrt(-jnp.expm1(2.0 * log_a)) * (i * zf)
    return log_a, x_in


def linear_scan(log_a, x_in, h0, reverse):
    a = jnp.exp(log_a)
    if h0 is not None:
        edge = -1 if reverse else 0
        x_in = x_in.at[:, edge].add(a[:, edge] * h0)

    def combine(left, right):
        a_l, b_l = left
        a_r, b_r = right
        return a_l * a_r, a_r * b_l + b_r

    _, h = lax.associative_scan(combine, (a, x_in), reverse=reverse, axis=1)
    return h, (h[:, 0] if reverse else h[:, -1])


def rglru_mixer(h_ctx, h_lat, w_in, conv_w, conv_b, gate_w, gate_b, lam, w_out, with_ctx_out):
    proj_x = h_lat @ w_in
    branch_x, rnn_x = proj_x[..., :RG_WIDTH], proj_x[..., RG_WIDTH:]
    rnn_c = h_ctx @ w_in[:, RG_WIDTH:]
    rnn_x = dwconv_centred(rnn_x, conv_w, conv_b)
    rnn_c = dwconv_centred(rnn_c, conv_w, conv_b)
    ys_x = []
    ys_c = []
    for d, reverse in enumerate((False, True)):
        la_c, in_c = rg_gates(rnn_c, gate_w[d], gate_b[d], lam[d])
        la_x, in_x = rg_gates(rnn_x, gate_w[d], gate_b[d], lam[d])
        y_c, h_ctx_final = linear_scan(la_c, in_c, None, reverse)
        y_x, _ = linear_scan(la_x, in_x, h_ctx_final, reverse)
        ys_c.append(y_c)
        ys_x.append(y_x)
    out_x = (jax.nn.gelu(branch_x, approximate=False) * (ys_x[0] + ys_x[1]).astype(h_lat.dtype)) @ w_out
    out_c = None
    if with_ctx_out:
        branch_c = h_ctx @ w_in[:, :RG_WIDTH]
        out_c = (jax.nn.gelu(branch_c, approximate=False) * (ys_c[0] + ys_c[1]).astype(h_ctx.dtype)) @ w_out
    return out_c, out_x


def peer_ffn(h, wq, k1, k2, u, v):
    b, t, d = h.shape
    n_tok = b * t
    ht = h.reshape(n_tok, d)
    q = (ht @ wq).reshape(n_tok, PEER_HEADS, PEER_QDIM)
    s1 = jnp.einsum('thd,kd->thk', q[..., :PEER_HALF], k1).astype(jnp.float32)
    s2 = jnp.einsum('thd,kd->thk', q[..., PEER_HALF:], k2).astype(jnp.float32)
    t1, i1 = lax.top_k(s1, PEER_TOPK)
    t2, i2 = lax.top_k(s2, PEER_TOPK)
    cand_s = (t1[..., :, None] + t2[..., None, :]).reshape(n_tok, PEER_HEADS, PEER_TOPK * PEER_TOPK)
    cand_i = (i1[..., :, None] * PEER_NK + i2[..., None, :]).reshape(n_tok, PEER_HEADS, PEER_TOPK * PEER_TOPK)
    top_s, pos = lax.top_k(cand_s, PEER_TOPK)
    idx = jnp.take_along_axis(cand_i, pos, axis=-1)
    g = jax.nn.softmax(top_s, axis=-1).astype(h.dtype)
    nb = n_tok // PEER_BLOCK

    def block(args):
        hb, ib, gb = args
        ue = jnp.take(u, ib, axis=0)
        ve = jnp.take(v, ib, axis=0)
        act = jax.nn.gelu(jnp.einsum('td,thkd->thk', hb, ue), approximate=False)
        return jnp.einsum('thk,thkd->td', gb * act, ve)

    out = lax.map(block, (ht.reshape(nb, PEER_BLOCK, d),
                          idx.reshape(nb, PEER_BLOCK, PEER_HEADS, PEER_TOPK),
                          g.reshape(nb, PEER_BLOCK, PEER_HEADS, PEER_TOPK)))
    return out.reshape(b, t, d)


def setup_inputs(seed: int = 0) -> dict:
    key = jax.random.key(seed)
    ks = jax.random.split(key, 32)
    f32 = jnp.float32
    D = D_MODEL
    NE = (DEPTH + 1) // 2
    NO = DEPTH // 2

    def nrm(k, shape, scale):
        return jax.random.normal(k, shape, f32) * scale

    a_c = jax.random.uniform(ks[24], (NO, 2, RG_WIDTH), f32, minval=0.9, maxval=0.999)
    sig = jnp.power(a_c, 1.0 / RG_C)
    od_lambda = jnp.log(sig) - jnp.log1p(-sig)
    return {
        'x': nrm(ks[0], (BATCH, SEQ, D), 1.0),
        'c': nrm(ks[1], (BATCH, D), 1.0),
        'ctx': nrm(ks[2], (BATCH, CTX_LEN, D), 1.0),
        'c_ctx': nrm(ks[3], (D,), 1.0),
        'mod_w': nrm(ks[4], (DEPTH, D, N_MOD * D), D ** -0.5),
        'mod_b': nrm(ks[5], (DEPTH, N_MOD * D), 0.02),
        'ln_g': 1.0 + nrm(ks[6], (DEPTH, 2, D), 0.02),
        'ln_b': nrm(ks[7], (DEPTH, 2, D), 0.02),
        'ev_w_in': nrm(ks[8], (NE, D, EV_IN), D ** -0.5),
        'ev_q_norm': 1.0 + nrm(ks[9], (NE, MLA_Q_RANK), 0.02),
        'ev_kv_norm': 1.0 + nrm(ks[10], (NE, MLA_KV_RANK), 0.02),
        'ev_w_uq': nrm(ks[11], (NE, MLA_Q_RANK, MLA_HEADS * (MLA_NOPE + MLA_ROPE)), MLA_Q_RANK ** -0.5),
        'ev_w_ukv': nrm(ks[12], (NE, MLA_KV_RANK, MLA_HEADS * (MLA_NOPE + MLA_V)), MLA_KV_RANK ** -0.5),
        'ev_gla_wa2': nrm(ks[13], (NE, 2, GLA_GATE_RANK, GLA_HEADS * GLA_DK), GLA_GATE_RANK ** -0.5),
        'ev_gla_ba': nrm(ks[14], (NE, 2, GLA_HEADS * GLA_DK), 0.1),
        'ev_gla_norm': 1.0 + nrm(ks[15], (NE, GLA_HEADS * GLA_DV), 0.02),
        'ev_w_out': nrm(ks[16], (NE, MIX_OUT, D), (MIX_OUT ** -0.5) * DEEPNORM_BETA),
        'od_w_in': nrm(ks[17], (NO, D, 2 * RG_WIDTH), D ** -0.5),
        'od_conv_w': nrm(ks[18], (NO, RG_CONV, RG_WIDTH), RG_CONV ** -0.5),
        'od_conv_b': nrm(ks[19], (NO, RG_WIDTH), 0.02),
        'od_gate_w': nrm(ks[20], (NO, 2, 2, RG_BLOCKS, RG_BW, RG_BW), RG_BW ** -0.5),
        'od_gate_b': nrm(ks[21], (NO, 2, 2, RG_WIDTH), 0.02),
        'od_lambda': od_lambda,
        'od_w_out': nrm(ks[22], (NO, RG_WIDTH, D), (RG_WIDTH ** -0.5) * DEEPNORM_BETA),
        'peer_wq': nrm(ks[23], (DEPTH, D, PEER_HEADS * PEER_QDIM), D ** -0.5),
        'peer_k1': nrm(ks[25], (DEPTH, PEER_NK, PEER_HALF), PEER_HALF ** -0.5),
        'peer_k2': nrm(ks[26], (DEPTH, PEER_NK, PEER_HALF), PEER_HALF ** -0.5),
        'peer_u': nrm(ks[27], (DEPTH, PEER_N, D), D ** -0.5),
        'peer_v': nrm(ks[28], (DEPTH, PEER_N, D), DEEPNORM_BETA),
    }


def reference(x, c, ctx, c_ctx, mod_w, mod_b, ln_g, ln_b,
              ev_w_in, ev_q_norm, ev_kv_norm, ev_w_uq, ev_w_ukv, ev_gla_wa2, ev_gla_ba, ev_gla_norm, ev_w_out,
              od_w_in, od_conv_w, od_conv_b, od_gate_w, od_gate_b, od_lambda, od_w_out,
              peer_wq, peer_k1, peer_k2, peer_u, peer_v):
    seq_len = x.shape[1]
    cos, sin = axial_rope(seq_len)
    silu_c = jax.nn.silu(c)
    silu_cc = jax.nn.silu(c_ctx)
    h_lat, h_ctx = x, ctx
    for layer in range(DEPTH):
        last = layer == DEPTH - 1
        j = layer // 2
        mx = jnp.split((silu_c @ mod_w[layer] + mod_b[layer])[:, None, :], N_MOD, axis=-1)
        mc = jnp.split((silu_cc @ mod_w[layer] + mod_b[layer])[None, None, :], N_MOD, axis=-1)
        in_x = modulate(h_lat, mx[0], mx[1])
        in_c = modulate(h_ctx, mc[0], mc[1])
        if layer % 2 == 0:
            mix_c, mix_x = mla_gla_mixer(in_c, in_x, cos, sin, ev_w_in[j], ev_q_norm[j], ev_kv_norm[j],
                                         ev_w_uq[j], ev_w_ukv[j], ev_gla_wa2[j], ev_gla_ba[j],
                                         ev_gla_norm[j], ev_w_out[j], not last)
        else:
            mix_c, mix_x = rglru_mixer(in_c, in_x, od_w_in[j], od_conv_w[j], od_conv_b[j], od_gate_w[j],
                                       od_gate_b[j], od_lambda[j], od_w_out[j], not last)
        h_lat = layer_norm(DEEPNORM_ALPHA * h_lat + mx[2] * mix_x, ln_g[layer, 0], ln_b[layer, 0])
        f_x = peer_ffn(modulate(h_lat, mx[3], mx[4]), peer_wq[layer], peer_k1[layer], peer_k2[layer],
                       peer_u[layer], peer_v[layer])
        h_lat = layer_norm(DEEPNORM_ALPHA * h_lat + mx[5] * f_x, ln_g[layer, 1], ln_b[layer, 1])
        if not last:
            h_ctx = layer_norm(DEEPNORM_ALPHA * h_ctx + mc[2] * mix_c, ln_g[layer, 0], ln_b[layer, 0])
            f_c = peer_ffn(modulate(h_ctx, mc[3], mc[4]), peer_wq[layer], peer_k1[layer], peer_k2[layer],
                           peer_u[layer], peer_v[layer])
            h_ctx = layer_norm(DEEPNORM_ALPHA * h_ctx + mc[5] * f_c, ln_g[layer, 1], ln_b[layer, 1])
    return h_lat
```

```cpp
#include <hip/hip_runtime.h>
#include <cstdio>
#include <cstdint>

typedef unsigned short bf16_t;
typedef short bf16x8 __attribute__((ext_vector_type(8)));
typedef float f32x4 __attribute__((ext_vector_type(4)));
typedef unsigned u32x4 __attribute__((ext_vector_type(4)));
typedef unsigned u32x2 __attribute__((ext_vector_type(2)));

constexpr int D = 1024, NB = 8, SEQ = 4096, CTX = 256, PB = SEQ + CTX  , R = NB * PB  ;
constexpr int EV_IN = 2240, RGW = 1280;
constexpr int C_CQ = 0, C_CKV = 384, C_KPE = 640, C_GQ = 672, C_GK = 928, C_GV = 1184, C_GG = 1696, C_GAF = 2208;
constexpr float LN_EPS = 1e-6f, ALPHA = 1.41421356237f, MLA_SCALE = 0.10206207261596577f  ;
constexpr int PEER_N = 16384;

struct Params {
    const float *x, *c, *ctx, *c_ctx, *mod_w, *mod_b, *ln_g, *ln_b;
    const float *ev_w_in, *ev_q_norm, *ev_kv_norm, *ev_w_uq, *ev_w_ukv, *ev_gla_wa2, *ev_gla_ba, *ev_gla_norm, *ev_w_out;
    const float *od_w_in, *od_conv_w, *od_conv_b, *od_gate_w, *od_gate_b, *od_lambda, *od_w_out;
    const float *peer_wq, *peer_k1, *peer_k2, *peer_u, *peer_v;
    float* out;
    bf16_t *wt_ev_in, *wt_uq, *wt_ukv, *wt_ev_out, *wt_od_in, *wt_gate, *wt_od_out, *wt_pq, *wt_k;
    float *mod, *rope_cos, *rope_sin, *rsq;
    float* H; bf16_t *Q16, *K16, *V16;
    bf16_t* A16; bf16_t* P; unsigned char* G;
};

__device__ __forceinline__ bf16_t f2bf(float f) { unsigned u = __float_as_uint(f); u += 0x7fffu + ((u >> 16) & 1u); return (bf16_t)(u >> 16); }
__device__ __forceinline__ float bf2f(bf16_t h) { return __uint_as_float(((unsigned)h) << 16); }
__device__ __forceinline__ unsigned pack2(float a, float b) { return (unsigned)f2bf(a) | ((unsigned)f2bf(b) << 16); }
__device__ __forceinline__ float silu_f(float x) { return x / (1.0f + expf(-x)); }
__device__ __forceinline__ float sigmoid_f(float x) { return 1.0f / (1.0f + expf(-x)); }
__device__ __forceinline__ float gelu_f(float x) { return 0.5f * x * (1.0f + erff(x * 0.70710678118654752f)); }
__device__ __forceinline__ float wave_sum(float v) {
#pragma unroll
    for (int o = 32; o > 0; o >>= 1) v += __shfl_xor(v, o);
    return v;
}
__device__ __forceinline__ int mod_row(int r) { const int b = r / PB, p = r - b * PB; return p < CTX ? 8 : b; }
__device__ __forceinline__ const float* in_row(const Params& P_, int r) {
    const int b = r / PB, p = r - b * PB;
    return p < CTX ? P_.ctx + ((size_t)b * CTX + p) * D : P_.x + ((size_t)b * SEQ + (p - CTX)) * D;
}

__device__ void tconv_tile(const float* __restrict__ W, int K, int N, bf16_t* __restrict__ Wt, const float* __restrict__ rowscale, int tile, float* sm) {
    const int ntn = N / 64, tk = tile / ntn, tn = tile % ntn, tid = threadIdx.x;
#pragma unroll
    for (int i = 0; i < 4; ++i) {
        const int k = (tid >> 4) + 16 * i;
        f32x4 v = *(const f32x4*)(W + (size_t)(tk * 64 + k) * N + tn * 64 + (tid & 15) * 4);
        const float s = rowscale ? rowscale[tk * 64 + k] : 1.0f;
#pragma unroll
        for (int q = 0; q < 4; ++q) sm[k * 65 + (tid & 15) * 4 + q] = v[q] * s;
    }
    __syncthreads();
    const int n = tid >> 2, kc = tid & 3;
    unsigned w[8];
#pragma unroll
    for (int kk = 0; kk < 8; ++kk) w[kk] = pack2(sm[(kc * 16 + 2 * kk) * 65 + n], sm[(kc * 16 + 2 * kk + 1) * 65 + n]);
    bf16_t* dst = Wt + (size_t)(tn * 64 + n) * K + tk * 64 + kc * 16;
    *(u32x4*)dst = (u32x4){w[0], w[1], w[2], w[3]};
    *(u32x4*)(dst + 8) = (u32x4){w[4], w[5], w[6], w[7]};
    __syncthreads();
}
__device__ void tconv_all(const float* W, int K, int N, bf16_t* Wt, const float* rowscale, float* sm) {
    const int nt = (K / 64) * (N / 64);
    for (int t = blockIdx.x; t < nt; t += gridDim.x) tconv_tile(W, K, N, Wt, rowscale, t, sm);
}

__device__ void ph_prologue(const Params& p, unsigned char* smem) {
    float* sm = (float*)smem;
    tconv_all(p.ev_w_in, 1024, EV_IN, p.wt_ev_in, nullptr, sm);
    tconv_all(p.ev_w_uq, 384, 768, p.wt_uq, p.ev_q_norm, sm);
    tconv_all(p.ev_w_ukv, 256, 1024, p.wt_ukv, p.ev_kv_norm, sm);
    tconv_all(p.ev_w_out, 1024, 1024, p.wt_ev_out, nullptr, sm);
    tconv_all(p.od_w_in, 1024, 2560, p.wt_od_in, nullptr, sm);
    for (int g = 0; g < 40; ++g) tconv_all(p.od_gate_w + (size_t)g * 16384, 128, 128, p.wt_gate + (size_t)g * 16384, nullptr, sm);
    tconv_all(p.od_w_out, 1280, 1024, p.wt_od_out, nullptr, sm);
    for (int l = 0; l < 2; ++l) tconv_all(p.peer_wq + (size_t)l * 1024 * 2048, 1024, 2048, p.wt_pq + (size_t)l * 1024 * 2048, nullptr, sm);
    for (int i = blockIdx.x * 256 + threadIdx.x; i < 2 * 2 * 16384; i += gridDim.x * 256) {
        const int l = i / 32768, h = (i / 16384) & 1, e = i & 16383;
        p.wt_k[i] = f2bf((h ? p.peer_k2 : p.peer_k1)[(size_t)l * 16384 + e]);
    }
    for (int i = blockIdx.x * 256 + threadIdx.x; i < SEQ * 16; i += gridDim.x * 256) {
        const int s = i >> 4, f = i & 15;
        const float pos = (float)(f < 8 ? (s >> 6) : (s & 63));
        const float inv = powf(10000.0f, -(float)(f & 7) / 8.0f);
        const float ang = pos * inv;
        p.rope_cos[i] = cosf(ang); p.rope_sin[i] = sinf(ang);
    }
    float* sc = sm;
    for (int u = blockIdx.x; u < 2 * 96; u += gridDim.x) {
        const int l = u / 96, c0 = (u % 96) * 64, tid = threadIdx.x;
        __syncthreads();
        for (int i = tid; i < 9 * 1024; i += 256) { const int rr = i >> 10, k = i & 1023; sc[i] = silu_f(rr < 8 ? p.c[rr * 1024 + k] : p.c_ctx[k]); }
        __syncthreads();
        const int col = c0 + (tid & 63), kq = tid >> 6;
        float acc[9];
#pragma unroll
        for (int rr = 0; rr < 9; ++rr) acc[rr] = 0.f;
        const float* w = p.mod_w + (size_t)l * 1024 * 6144 + col;
        for (int k = kq * 256; k < kq * 256 + 256; ++k) {
            const float wv = w[(size_t)k * 6144];
#pragma unroll
            for (int rr = 0; rr < 9; ++rr) acc[rr] += sc[rr * 1024 + k] * wv;
        }
        __syncthreads();
        float* red = sm + 9 * 1024;
#pragma unroll
        for (int rr = 0; rr < 9; ++rr) red[(kq * 9 + rr) * 64 + (tid & 63)] = acc[rr];
        __syncthreads();
        for (int i = tid; i < 9 * 64; i += 256) {
            const int rr = i >> 6, cc = i & 63;
            const float s = red[(0 * 9 + rr) * 64 + cc] + red[(1 * 9 + rr) * 64 + cc] + red[(2 * 9 + rr) * 64 + cc] + red[(3 * 9 + rr) * 64 + cc];
            p.mod[((size_t)l * 9 + rr) * 6144 + c0 + cc] = s + p.mod_b[l * 6144 + c0 + cc];
        }
    }
}

__device__ void ph_modulate0(const Params& p) {
    const int wid = threadIdx.x >> 6, lane = threadIdx.x & 63;
    for (int u = blockIdx.x; u < R / 4; u += gridDim.x) {
        const int r = u * 4 + wid;
        const float* src = in_row(p, r);
        const float* md = p.mod + (size_t)(0 * 9 + mod_row(r)) * 6144;
#pragma unroll
        for (int q = 0; q < 4; ++q) {
            const int c = q * 256 + lane * 4;
            const f32x4 h = *(const f32x4*)(src + c), sh = *(const f32x4*)(md + c), scl = *(const f32x4*)(md + 1024 + c);
            const f32x4 v = h * (1.0f + scl) + sh;
            *(u32x2*)(p.A16 + (size_t)r * D + c) = (u32x2){pack2(v[0], v[1]), pack2(v[2], v[3])};
        }
    }
}

constexpr int GBK = 64, GLDS = 72  ;
struct RowMap { int lat_only; __device__ __forceinline__ int ntiles() const { return lat_only ? 256 : 272; }
    __device__ __forceinline__ int row0(int t) const { return lat_only ? (t >> 5) * PB + CTX + (t & 31) * 128 : t * 128; } };

template <class Epi>
__device__ void gemm_phase(const bf16_t* __restrict__ A, int lda, const bf16_t* __restrict__ Bt, int K, int N, RowMap rm, const Epi& epi, unsigned char* smem) {
    bf16_t* sA = (bf16_t*)smem; bf16_t* sB = sA + 128 * GLDS;
    const int tid = threadIdx.x, lane = tid & 63, wid = tid >> 6, wm = wid >> 1, wn = wid & 1, fr = lane & 15, fq = lane >> 4;
    const int ntn = (N + 127) / 128, nunits = rm.ntiles() * ntn, nk = K / GBK;
    for (int u = blockIdx.x; u < nunits; u += gridDim.x) {
        const int tm = u / ntn, tn = u % ntn, m0 = rm.row0(tm), n0 = tn * 128;
        f32x4 acc[4][4];
#pragma unroll
        for (int i = 0; i < 4; ++i)
#pragma unroll
            for (int j = 0; j < 4; ++j) acc[i][j] = (f32x4){0.f, 0.f, 0.f, 0.f};
        u32x4 ra[4], rb[4];
        auto gload = [&](int kt) {
#pragma unroll
            for (int i = 0; i < 4; ++i) {
                const int id = tid + 256 * i, row = id >> 3, ch = id & 7;
                ra[i] = *(const u32x4*)(A + (size_t)(m0 + row) * lda + kt * GBK + ch * 8);
                int brow = n0 + row; brow = brow < N ? brow : N - 1;
                rb[i] = *(const u32x4*)(Bt + (size_t)brow * K + kt * GBK + ch * 8);
            }
        };
        auto lstore = [&]() {
#pragma unroll
            for (int i = 0; i < 4; ++i) {
                const int id = tid + 256 * i, row = id >> 3, ch = id & 7;
                *(u32x4*)(sA + row * GLDS + ch * 8) = ra[i];
                *(u32x4*)(sB + row * GLDS + ch * 8) = rb[i];
            }
        };
        gload(0);
        __syncthreads();
        lstore();
        __syncthreads();
        for (int kt = 0; kt < nk; ++kt) {
            if (kt + 1 < nk) gload(kt + 1);
#pragma unroll
            for (int ks = 0; ks < 2; ++ks) {
                bf16x8 af[4], bfr[4];
#pragma unroll
                for (int i = 0; i < 4; ++i) af[i] = *(const bf16x8*)(sA + (wm * 64 + i * 16 + fr) * GLDS + ks * 32 + fq * 8);
#pragma unroll
                for (int j = 0; j < 4; ++j) bfr[j] = *(const bf16x8*)(sB + (wn * 64 + j * 16 + fr) * GLDS + ks * 32 + fq * 8);
#pragma unroll
                for (int i = 0; i < 4; ++i)
#pragma unroll
                    for (int j = 0; j < 4; ++j) acc[i][j] = __builtin_amdgcn_mfma_f32_16x16x32_bf16(bfr[j], af[i], acc[i][j], 0, 0, 0);
            }
            __syncthreads();
            if (kt + 1 < nk) { lstore(); __syncthreads(); }
        }
        epi(acc, m0 + wm * 64, n0 + wn * 64, fr, fq);
    }
}

struct EpiBf16 {
    bf16_t* C; int ldc, N;
    __device__ __forceinline__ void operator()(const f32x4 (&acc)[4][4], int mb, int nb, int fr, int fq) const {
#pragma unroll
        for (int i = 0; i < 4; ++i)
#pragma unroll
            for (int j = 0; j < 4; ++j) {
                const int m = mb + i * 16 + fr, n = nb + j * 16 + 4 * fq;
                if (n < N) *(u32x2*)(C + (size_t)m * ldc + n) = (u32x2){pack2(acc[i][j][0], acc[i][j][1]), pack2(acc[i][j][2], acc[i][j][3])};
            }
    }
};
struct EpiQ {
    bf16_t* Q; const float *rsq, *rc, *rs;
    __device__ __forceinline__ void operator()(const f32x4 (&acc)[4][4], int mb, int nb, int fr, int fq) const {
#pragma unroll
        for (int i = 0; i < 4; ++i) {
            const int m = mb + i * 16 + fr, b = m / PB, pp = m - b * PB;
            const float sc = rsq[m] * MLA_SCALE;
#pragma unroll
            for (int j = 0; j < 4; j += 2) {
                const int n = nb + j * 16 + 4 * fq;
                f32x4 v0 = acc[i][j] * sc, v1 = acc[i][j + 1] * sc;
                const int d = n % 96;
                if (d >= 64 && pp >= CTX) {
                    const int s = pp - CTX, f = (d - 64) + 0;
                    const f32x4 cs = *(const f32x4*)(rc + s * 16 + f), sn = *(const f32x4*)(rs + s * 16 + f);
                    const f32x4 o0 = v0 * cs - v1 * sn, o1 = v0 * sn + v1 * cs; v0 = o0; v1 = o1;
                }
                *(u32x2*)(Q + (size_t)m * 768 + n) = (u32x2){pack2(v0[0], v0[1]), pack2(v0[2], v0[3])};
                *(u32x2*)(Q + (size_t)m * 768 + n + 16) = (u32x2){pack2(v1[0], v1[1]), pack2(v1[2], v1[3])};
            }
        }
    }
};
struct EpiKV {
    bf16_t *Kd, *Vd; const float* rsq;
    __device__ __forceinline__ void operator()(const f32x4 (&acc)[4][4], int mb, int nb, int fr, int fq) const {
#pragma unroll
        for (int i = 0; i < 4; ++i) {
            const int m = mb + i * 16 + fr; const float sc = rsq[m];
#pragma unroll
            for (int j = 0; j < 4; ++j) {
                const int n = nb + j * 16 + 4 * fq, hd = n >> 7, d = n & 127;
                const f32x4 v = acc[i][j] * sc;
                bf16_t* dst = d < 64 ? Kd + (size_t)m * 768 + hd * 96 + d : Vd + (size_t)m * 512 + hd * 64 + (d - 64);
                *(u32x2*)dst = (u32x2){pack2(v[0], v[1]), pack2(v[2], v[3])};
            }
        }
    }
};
struct EpiResid {
    const float *x, *ctx, *mod; float* H; int layer;
    __device__ __forceinline__ void operator()(const f32x4 (&acc)[4][4], int mb, int nb, int fr, int fq) const {
#pragma unroll
        for (int i = 0; i < 4; ++i) {
            const int m = mb + i * 16 + fr, b = m / PB, pp = m - b * PB;
            const float* hin = layer == 0 ? (pp < CTX ? ctx + ((size_t)b * CTX + pp) * D : x + ((size_t)b * SEQ + (pp - CTX)) * D) : H + (size_t)m * D;
            const float* gate = mod + ((size_t)layer * 9 + (pp < CTX ? 8 : b)) * 6144 + 2 * 1024;
#pragma unroll
            for (int j = 0; j < 4; ++j) {
                const int n = nb + j * 16 + 4 * fq;
                const f32x4 h = *(const f32x4*)(hin + n), g = *(const f32x4*)(gate + n);
                *(f32x4*)(H + (size_t)m * D + n) = ALPHA * h + g * acc[i][j];
            }
        }
    }
};

__device__ void ph_rowpost(const Params& p) {
    const int wid = threadIdx.x >> 6, lane = threadIdx.x & 63;
    for (int u = blockIdx.x; u < R / 4; u += gridDim.x) {
        const int r = u * 4 + wid, b = r / PB, pp = r - b * PB;
        const bf16_t* row = p.P + (size_t)r * EV_IN;
        float sq = 0.f, skv = 0.f;
#pragma unroll
        for (int i = 0; i < 10; ++i) { const float v = bf2f(row[lane + 64 * i]); if (i < 6) sq += v * v; else skv += v * v; }
        sq = wave_sum(sq); skv = wave_sum(skv);
        if (lane == 0) { p.rsq[r] = rsqrtf(sq / 384.0f + LN_EPS); p.rsq[R + r] = rsqrtf(skv / 256.0f + LN_EPS); }
        if (lane < 16) {
            float x1 = bf2f(row[C_KPE + lane]), x2 = bf2f(row[C_KPE + 16 + lane]);
            if (pp >= CTX) { const int s = pp - CTX; const float cs = p.rope_cos[s * 16 + lane], sn = p.rope_sin[s * 16 + lane];
                const float o1 = x1 * cs - x2 * sn, o2 = x1 * sn + x2 * cs; x1 = o1; x2 = o2; }
            const bf16_t b1 = f2bf(x1), b2 = f2bf(x2);
#pragma unroll
            for (int hd = 0; hd < 8; ++hd) { p.K16[(size_t)r * 768 + hd * 96 + 64 + lane] = b1; p.K16[(size_t)r * 768 + hd * 96 + 80 + lane] = b2; }
        }
    }
}

__device__ void ph_attn_naive(const Params& p, unsigned char* smem) {
    float* Ks = (float*)smem;
    float* Vs = Ks + 16 * 96;
    const int tid = threadIdx.x;
    for (int u = blockIdx.x; u < 1024 + 64; u += gridDim.x) {
        int b, hd, q0, nkeys;
        if (u < 1024) { b = u >> 7; hd = (u >> 4) & 7; q0 = CTX + (u & 15) * 256; nkeys = PB; }
        else { const int v = u - 1024; b = v >> 3; hd = v & 7; q0 = 0; nkeys = CTX; }
        const int r = b * PB + q0 + tid;
        unsigned qp[48]; float o[64];
#pragma unroll
        for (int d = 0; d < 48; d += 4) { const u32x4 w = *(const u32x4*)(p.Q16 + (size_t)r * 768 + hd * 96 + 2 * d); qp[d] = w[0]; qp[d + 1] = w[1]; qp[d + 2] = w[2]; qp[d + 3] = w[3]; }
#pragma unroll
        for (int d = 0; d < 64; ++d) o[d] = 0.f;
        float m = -1e30f, l = 0.f;
        for (int k0 = 0; k0 < nkeys; k0 += 16) {
            __syncthreads();
            for (int i = tid; i < 16 * 96; i += 256) { const int kk = i / 96, d = i % 96; Ks[i] = bf2f(p.K16[(size_t)(b * PB + k0 + kk) * 768 + hd * 96 + d]); }
            for (int i = tid; i < 16 * 64; i += 256) { const int kk = i >> 6, d = i & 63; Vs[i] = bf2f(p.V16[(size_t)(b * PB + k0 + kk) * 512 + hd * 64 + d]); }
            __syncthreads();
            float s[16]; float mx = -1e30f;
#pragma unroll
            for (int kk = 0; kk < 16; ++kk) {
                float a = 0.f;
#pragma unroll
                for (int d = 0; d < 96; d += 4) {
                    const f32x4 kv = *(const f32x4*)(Ks + kk * 96 + d);
                    a += __uint_as_float(qp[d / 2] << 16) * kv[0] + __uint_as_float(qp[d / 2] & 0xffff0000u) * kv[1]
                       + __uint_as_float(qp[d / 2 + 1] << 16) * kv[2] + __uint_as_float(qp[d / 2 + 1] & 0xffff0000u) * kv[3];
                }
                s[kk] = a; mx = fmaxf(mx, a);
            }
            const float mn = fmaxf(m, mx), al = expf(m - mn);
            l *= al;
#pragma unroll
            for (int d = 0; d < 64; ++d) o[d] *= al;
#pragma unroll
            for (int kk = 0; kk < 16; ++kk) {
                const float pr = expf(s[kk] - mn); l += pr;
#pragma unroll
                for (int d = 0; d < 64; d += 4) { const f32x4 vv = *(const f32x4*)(Vs + kk * 64 + d); o[d] += pr * vv[0]; o[d + 1] += pr * vv[1]; o[d + 2] += pr * vv[2]; o[d + 3] += pr * vv[3]; }
            }
            m = mn;
        }
        const float il = 1.0f / l;
#pragma unroll
        for (int d = 0; d < 64; d += 2) *(unsigned*)(p.A16 + (size_t)r * D + hd * 64 + d) = pack2(o[d] * il, o[d + 1] * il);
    }
}

__device__ void ph_gla_naive(const Params& p, unsigned char* smem) {
    float* sq = (float*)smem;
    float* sk = sq + 16 * 64;
    float* sa = sk + 16 * 64;
    float* sv = sa + 16 * 64;
    float* sop = sv + 16 * 128;
    float* sga = sop + 2 * 16 * 128;
    float* OF = (float*)p.G;
    const int tid = threadIdx.x, j = tid & 127, half = tid >> 7, lane = tid & 63, wid = tid >> 6;
    for (int u = blockIdx.x; u < 32; u += gridDim.x) {
        const int b = u >> 2, hd = u & 3;
        for (int dir = 0; dir < 2; ++dir) {
            float S[32];
#pragma unroll
            for (int dd = 0; dd < 32; ++dd) S[dd] = 0.f;
            const float* wa = p.ev_gla_wa2 + (size_t)dir * 16 * 256;
            const float* ba = p.ev_gla_ba + dir * 256;
            for (int bi = 0; bi < PB / 16; ++bi) {
                __syncthreads();
                for (int e = tid; e < 16 * 64; e += 256) {
                    const int i = e >> 6, d = e & 63, st = bi * 16 + i;
                    const int pp = dir == 0 ? st : (st < CTX ? CTX - 1 - st : PB + CTX - 1 - st);
                    const bf16_t* row = p.P + (size_t)(b * PB + pp) * EV_IN;
                    sq[e] = bf2f(row[C_GQ + hd * 64 + d]) * 0.125f;
                    sk[e] = bf2f(row[C_GK + hd * 64 + d]);
                }
                for (int e = tid; e < 16 * 128; e += 256) {
                    const int i = e >> 7, jj = e & 127, st = bi * 16 + i;
                    const int pp = dir == 0 ? st : (st < CTX ? CTX - 1 - st : PB + CTX - 1 - st);
                    sv[e] = bf2f(p.P[(size_t)(b * PB + pp) * EV_IN + C_GV + hd * 128 + jj]);
                }
                {
                    const int i = tid >> 4, g = tid & 15, st = bi * 16 + i;
                    const int pp = dir == 0 ? st : (st < CTX ? CTX - 1 - st : PB + CTX - 1 - st);
                    sga[tid] = bf2f(p.P[(size_t)(b * PB + pp) * EV_IN + C_GAF + dir * 16 + g]);
                }
                __syncthreads();
                for (int e = tid; e < 16 * 64; e += 256) {
                    const int i = e >> 6, d = e & 63;
                    float z = ba[hd * 64 + d];
#pragma unroll
                    for (int g = 0; g < 16; ++g) z += sga[i * 16 + g] * wa[g * 256 + hd * 64 + d];
                    const float ls = fminf(z, 0.f) - log1pf(expf(-fabsf(z)));
                    sa[e] = expf(ls * (1.0f / 16.0f));
                }
                __syncthreads();
                for (int i = 0; i < 16; ++i) {
                    const float vj = sv[i * 128 + j]; float op = 0.f;
#pragma unroll
                    for (int dd = 0; dd < 32; ++dd) { const int d = half * 32 + dd; S[dd] = sa[i * 64 + d] * S[dd] + sk[i * 64 + d] * vj; op += sq[i * 64 + d] * S[dd]; }
                    sop[(half * 16 + i) * 128 + j] = op;
                }
                __syncthreads();
                if (dir == 0) {
                    for (int e = tid; e < 16 * 128; e += 256) {
                        const int i = e >> 7, jj = e & 127, st = bi * 16 + i;
                        OF[(size_t)(b * PB + st) * 512 + hd * 128 + jj] = sop[i * 128 + jj] + sop[(16 + i) * 128 + jj];
                    }
                } else {
#pragma unroll
                    for (int ii = 0; ii < 4; ++ii) {
                        const int i = wid * 4 + ii, st = bi * 16 + i;
                        const int pp = st < CTX ? CTX - 1 - st : PB + CTX - 1 - st;
                        const size_t r = (size_t)b * PB + pp;
                        const float t0 = OF[r * 512 + hd * 128 + lane] + sop[i * 128 + lane] + sop[(16 + i) * 128 + lane];
                        const float t1 = OF[r * 512 + hd * 128 + 64 + lane] + sop[i * 128 + 64 + lane] + sop[(16 + i) * 128 + 64 + lane];
                        const float ss = wave_sum(t0 * t0 + t1 * t1);
                        const float rs = rsqrtf(ss / 128.0f + LN_EPS);
                        const float g0 = bf2f(p.P[r * EV_IN + C_GG + hd * 128 + lane]), g1 = bf2f(p.P[r * EV_IN + C_GG + hd * 128 + 64 + lane]);
                        p.A16[r * D + 512 + hd * 128 + lane] = f2bf(t0 * rs * p.ev_gla_norm[hd * 128 + lane] * silu_f(g0));
                        p.A16[r * D + 512 + hd * 128 + 64 + lane] = f2bf(t1 * rs * p.ev_gla_norm[hd * 128 + 64 + lane] * silu_f(g1));
                    }
                }
            }
        }
    }
}

__device__ void ph_ln_mod(const Params& p, int layer, int lnidx, int lat_only) {
    const int wid = threadIdx.x >> 6, lane = threadIdx.x & 63;
    const int nrows = lat_only ? NB * SEQ : R;
    const float* g = p.ln_g + (size_t)(layer * 2 + lnidx) * D; const float* bb = p.ln_b + (size_t)(layer * 2 + lnidx) * D;
    for (int u = blockIdx.x; u < nrows / 4; u += gridDim.x) {
        const int rr = u * 4 + wid, r = lat_only ? (rr >> 12) * PB + CTX + (rr & 4095) : rr;
        float* hrow = p.H + (size_t)r * D;
        f32x4 v[4]; float s = 0.f;
#pragma unroll
        for (int q = 0; q < 4; ++q) { v[q] = *(const f32x4*)(hrow + q * 256 + lane * 4); s += v[q][0] + v[q][1] + v[q][2] + v[q][3]; }
        const float mu = wave_sum(s) * (1.0f / 1024.0f);
        float ss = 0.f;
#pragma unroll
        for (int q = 0; q < 4; ++q) { v[q] = v[q] - mu; ss += v[q][0] * v[q][0] + v[q][1] * v[q][1] + v[q][2] * v[q][2] + v[q][3] * v[q][3]; }
        const float rstd = rsqrtf(wave_sum(ss) * (1.0f / 1024.0f) + LN_EPS);
        const float* md = p.mod + ((size_t)layer * 9 + mod_row(r)) * 6144;
#pragma unroll
        for (int q = 0; q < 4; ++q) {
            const int c = q * 256 + lane * 4;
            const f32x4 h = v[q] * rstd * *(const f32x4*)(g + c) + *(const f32x4*)(bb + c);
            *(f32x4*)(hrow + c) = h;
            const f32x4 a = h * (1.0f + *(const f32x4*)(md + 4 * 1024 + c)) + *(const f32x4*)(md + 3 * 1024 + c);
            *(u32x2*)(p.A16 + (size_t)r * D + c) = (u32x2){pack2(a[0], a[1]), pack2(a[2], a[3])};
        }
    }
}

__device__ void ph_scores_naive(const Params& p, int layer, int lat_only, unsigned char* smem) {
    float* ks = (float*)smem;
    const bf16_t* QP = p.P;
    float* T = (float*)p.G;
    const int tid = threadIdx.x, rl = tid >> 3, hd = tid & 7;
    const int nrows = lat_only ? NB * SEQ : R;
    for (int u = blockIdx.x; u < nrows / 32; u += gridDim.x) {
        const int rr = u * 32 + rl, r = lat_only ? (rr >> 12) * PB + CTX + (rr & 4095) : rr;
        for (int half = 0; half < 2; ++half) {
            __syncthreads();
            const bf16_t* kk = p.wt_k + ((size_t)layer * 2 + half) * 16384;
            for (int i = tid; i < 16384; i += 256) ks[i] = bf2f(kk[i]);
            __syncthreads();
            float q[128];
#pragma unroll
            for (int d = 0; d < 128; d += 8) {
                const u32x4 w = *(const u32x4*)(QP + (size_t)r * 2048 + hd * 256 + half * 128 + d);
#pragma unroll
                for (int e = 0; e < 4; ++e) { q[d + 2 * e] = __uint_as_float(w[e] << 16); q[d + 2 * e + 1] = __uint_as_float(w[e] & 0xffff0000u); }
            }
            float top[16];
#pragma unroll
            for (int t = 0; t < 16; ++t) top[t] = -3.0e38f;
            for (int k = 0; k < 128; ++k) {
                float s = 0.f;
#pragma unroll
                for (int d = 0; d < 128; d += 4) { const f32x4 kv = *(const f32x4*)(ks + k * 128 + d); s += q[d] * kv[0] + q[d + 1] * kv[1] + q[d + 2] * kv[2] + q[d + 3] * kv[3]; }
                float xv = __uint_as_float((__float_as_uint(s) & ~127u) | (unsigned)k);
#pragma unroll
                for (int t = 0; t < 16; ++t) { const float hi = fmaxf(top[t], xv); xv = fminf(top[t], xv); top[t] = hi; }
            }
            float* dst = T + (((size_t)r * 8 + hd) * 2 + half) * 16;
#pragma unroll
            for (int t = 0; t < 16; t += 4) *(f32x4*)(dst + t) = (f32x4){top[t], top[t + 1], top[t + 2], top[t + 3]};
        }
    }
}

__device__ void ph_combine(const Params& p, int lat_only) {
    const float* T = (const float*)p.G;
    int* EIDX = (int*)(p.G + (size_t)R * 8 * 2 * 16 * 4);
    float* EG = (float*)(p.G + (size_t)R * 8 * 2 * 16 * 4 + (size_t)R * 8 * 16 * 4);
    const int nrows = lat_only ? NB * SEQ : R;
    for (int g = blockIdx.x * 256 + threadIdx.x; g < nrows * 8; g += gridDim.x * 256) {
        const int rr = g >> 3, hd = g & 7, r = lat_only ? (rr >> 12) * PB + CTX + (rr & 4095) : rr;
        const float* t = T + ((size_t)r * 8 + hd) * 32;
        float t2[16];
#pragma unroll
        for (int i = 0; i < 16; ++i) t2[i] = __uint_as_float(__float_as_uint(t[16 + i]) & ~127u);
        float top[16];
#pragma unroll
        for (int k = 0; k < 16; ++k) top[k] = -3.0e38f;
        for (int i = 0; i < 16; ++i) {
            const float t1i = __uint_as_float(__float_as_uint(t[i]) & ~127u);
#pragma unroll
            for (int j = 0; j < 16; ++j) {
                float xv = __uint_as_float((__float_as_uint(t1i + t2[j]) & ~255u) | (unsigned)(i * 16 + j));
#pragma unroll
                for (int k = 0; k < 16; ++k) { const float hi = fmaxf(top[k], xv); xv = fminf(top[k], xv); top[k] = hi; }
            }
        }
        float e[16], sum = 0.f; const float mx = __uint_as_float(__float_as_uint(top[0]) & ~255u);
#pragma unroll
        for (int k = 0; k < 16; ++k) { e[k] = expf(__uint_as_float(__float_as_uint(top[k]) & ~255u) - mx); sum += e[k]; }
        const float inv = 1.0f / sum;
#pragma unroll
        for (int k = 0; k < 16; ++k) {
            const unsigned code = __float_as_uint(top[k]) & 255u, i = code >> 4, j = code & 15;
            const unsigned i1 = __float_as_uint(t[i]) & 127u, i2 = __float_as_uint(t[16 + j]) & 127u;
            EIDX[((size_t)r * 8 + hd) * 16 + k] = (int)(i1 * 128 + i2);
            EG[((size_t)r * 8 + hd) * 16 + k] = e[k] * inv;
        }
    }
}

__device__ void ph_gather_ln(const Params& p, int layer, int lat_only) {
    const int wid = threadIdx.x >> 6, lane = threadIdx.x & 63;
    const int* EIDX = (const int*)(p.G + (size_t)R * 8 * 2 * 16 * 4);
    const float* EG = (const float*)(p.G + (size_t)R * 8 * 2 * 16 * 4 + (size_t)R * 8 * 16 * 4);
    const float* U = p.peer_u + (size_t)layer * PEER_N * D; const float* V = p.peer_v + (size_t)layer * PEER_N * D;
    const float* g = p.ln_g + (size_t)(layer * 2 + 1) * D; const float* bb = p.ln_b + (size_t)(layer * 2 + 1) * D;
    const int nrows = lat_only ? NB * SEQ : R;
    for (int u = blockIdx.x; u < nrows / 4; u += gridDim.x) {
        const int rr = u * 4 + wid, r = lat_only ? (rr >> 12) * PB + CTX + (rr & 4095) : rr;
        f32x4 hm[4], acc[4];
#pragma unroll
        for (int q = 0; q < 4; ++q) {
            const u32x2 w = *(const u32x2*)(p.A16 + (size_t)r * D + q * 256 + lane * 4);
            hm[q] = (f32x4){__uint_as_float(w[0] << 16), __uint_as_float(w[0] & 0xffff0000u), __uint_as_float(w[1] << 16), __uint_as_float(w[1] & 0xffff0000u)};
            acc[q] = (f32x4){0.f, 0.f, 0.f, 0.f};
        }
        for (int e0 = 0; e0 < 128; e0 += 2) {
            const int ea = EIDX[(size_t)r * 128 + e0], eb = EIDX[(size_t)r * 128 + e0 + 1];
            const float ga = EG[(size_t)r * 128 + e0], gb = EG[(size_t)r * 128 + e0 + 1];
            f32x4 ua[4], ub[4];
#pragma unroll
            for (int q = 0; q < 4; ++q) { ua[q] = *(const f32x4*)(U + (size_t)ea * D + q * 256 + lane * 4); ub[q] = *(const f32x4*)(U + (size_t)eb * D + q * 256 + lane * 4); }
            float da = 0.f, db = 0.f;
#pragma unroll
            for (int q = 0; q < 4; ++q) { da += hm[q][0] * ua[q][0] + hm[q][1] * ua[q][1] + hm[q][2] * ua[q][2] + hm[q][3] * ua[q][3]; db += hm[q][0] * ub[q][0] + hm[q][1] * ub[q][1] + hm[q][2] * ub[q][2] + hm[q][3] * ub[q][3]; }
            da = wave_sum(da); db = wave_sum(db);
            const float wa = ga * gelu_f(da), wb = gb * gelu_f(db);
#pragma unroll
            for (int q = 0; q < 4; ++q) {
                acc[q] += wa * *(const f32x4*)(V + (size_t)ea * D + q * 256 + lane * 4);
                acc[q] += wb * *(const f32x4*)(V + (size_t)eb * D + q * 256 + lane * 4);
            }
        }
        const float* md = p.mod + ((size_t)layer * 9 + mod_row(r)) * 6144;
        float* hrow = p.H + (size_t)r * D;
        f32x4 v[4]; float s = 0.f;
#pragma unroll
        for (int q = 0; q < 4; ++q) { const int c = q * 256 + lane * 4; v[q] = ALPHA * *(const f32x4*)(hrow + c) + *(const f32x4*)(md + 5 * 1024 + c) * acc[q]; s += v[q][0] + v[q][1] + v[q][2] + v[q][3]; }
        const float mu = wave_sum(s) * (1.0f / 1024.0f);
        float ss = 0.f;
#pragma unroll
        for (int q = 0; q < 4; ++q) { v[q] = v[q] - mu; ss += v[q][0] * v[q][0] + v[q][1] * v[q][1] + v[q][2] * v[q][2] + v[q][3] * v[q][3]; }
        const float rstd = rsqrtf(wave_sum(ss) * (1.0f / 1024.0f) + LN_EPS);
        if (layer == 0) {
            const float* md1 = p.mod + ((size_t)1 * 9 + mod_row(r)) * 6144;
#pragma unroll
            for (int q = 0; q < 4; ++q) {
                const int c = q * 256 + lane * 4;
                const f32x4 h = v[q] * rstd * *(const f32x4*)(g + c) + *(const f32x4*)(bb + c);
                *(f32x4*)(hrow + c) = h;
                const f32x4 a = h * (1.0f + *(const f32x4*)(md1 + 1024 + c)) + *(const f32x4*)(md1 + c);
                *(u32x2*)(p.A16 + (size_t)r * D + c) = (u32x2){pack2(a[0], a[1]), pack2(a[2], a[3])};
            }
        } else {
            float* orow = p.out + (size_t)rr * D;
#pragma unroll
            for (int q = 0; q < 4; ++q) { const int c = q * 256 + lane * 4; *(f32x4*)(orow + c) = v[q] * rstd * *(const f32x4*)(g + c) + *(const f32x4*)(bb + c); }
        }
    }
}

__device__ void ph_rglru_naive(const Params& p, unsigned char* smem) {
    float* sz = (float*)smem;
    bf16_t* PR = p.P;
    bf16_t* YF = (bf16_t*)p.G;
    const int tid = threadIdx.x, c = tid >> 1, gate = tid & 1;
    for (int u = blockIdx.x; u < 80; u += gridDim.x) {
        const int b = u / 10, n = u % 10, ch = n * 128 + c;
        for (int dir = 0; dir < 2; ++dir) {
            float wcol[128];
            const float* gw = p.od_gate_w + ((size_t)(dir * 2 + gate) * 10 + n) * 16384;
#pragma unroll
            for (int k = 0; k < 128; ++k) wcol[k] = gw[k * 128 + c];
            const float gbias = p.od_gate_b[(dir * 2 + gate) * RGW + ch];
            const float lam = p.od_lambda[dir * RGW + ch];
            const float sp = fmaxf(-lam, 0.f) + log1pf(expf(-fabsf(lam)));
            const float coef = -8.0f * sp;
            float h = 0.f;
            for (int bi = 0; bi < PB / 16; ++bi) {
                __syncthreads();
                for (int e = tid; e < 16 * 128; e += 256) {
                    const int i = e >> 7, k = e & 127, st = bi * 16 + i, cc = n * 128 + k;
                    const int pp = dir == 0 ? st : (st < CTX ? CTX - 1 - st : PB + CTX - 1 - st);
                    const int lo = pp < CTX ? 0 : CTX, hi = pp < CTX ? CTX : PB;
                    float v = p.od_conv_b[cc];
#pragma unroll
                    for (int tap = 0; tap < 4; ++tap) { const int q = pp + tap - 2; if (q >= lo && q < hi) v += p.od_conv_w[tap * RGW + cc] * bf2f(PR[(size_t)(b * PB + q) * 2560 + RGW + cc]); }
                    sz[e] = v;
                }
                __syncthreads();
                for (int i = 0; i < 16; ++i) {
                    float dot = gbias;
#pragma unroll
                    for (int k = 0; k < 128; k += 4) { const f32x4 zv = *(const f32x4*)(sz + i * 128 + k); dot += zv[0] * wcol[k] + zv[1] * wcol[k + 1] + zv[2] * wcol[k + 2] + zv[3] * wcol[k + 3]; }
                    const float sg = sigmoid_f(dot), other = __shfl_xor(sg, 1);
                    const float rg = gate == 0 ? sg : other, ig = gate == 0 ? other : sg;
                    const float la = coef * rg, a = expf(la), xin = sqrtf(-expm1f(2.0f * la)) * ig * sz[i * 128 + c];
                    h = a * h + xin;
                    const int st = bi * 16 + i;
                    const int pp = dir == 0 ? st : (st < CTX ? CTX - 1 - st : PB + CTX - 1 - st);
                    if (gate == 0 && pp >= CTX) {
                        const size_t rl = (size_t)b * SEQ + (pp - CTX);
                        if (dir == 0) YF[rl * RGW + ch] = f2bf(h);
                        else {
                            const size_t r = (size_t)b * PB + pp;
                            const float y = bf2f(YF[rl * RGW + ch]) + h;
                            PR[r * 2560 + ch] = f2bf(gelu_f(bf2f(PR[r * 2560 + ch])) * y);
                        }
                    }
                }
            }
        }
    }
}

#define SMEM_DECL __shared__ __attribute__((aligned(16))) unsigned char smem[65536]
__global__ void __launch_bounds__(256) k_prologue(Params p) { SMEM_DECL; ph_prologue(p, smem); }
__global__ void __launch_bounds__(256) k_modulate0(Params p) { ph_modulate0(p); }
__global__ void __launch_bounds__(256) k_gemm_ev_in(Params p) { SMEM_DECL; gemm_phase(p.A16, D, p.wt_ev_in, 1024, EV_IN, RowMap{0}, EpiBf16{p.P, EV_IN, EV_IN}, smem); }
__global__ void __launch_bounds__(256) k_rowpost(Params p) { ph_rowpost(p); }
__global__ void __launch_bounds__(256) k_gemm_q(Params p) { SMEM_DECL; gemm_phase(p.P + C_CQ, EV_IN, p.wt_uq, 384, 768, RowMap{0}, EpiQ{p.Q16, p.rsq, p.rope_cos, p.rope_sin}, smem); }
__global__ void __launch_bounds__(256) k_gemm_kv(Params p) { SMEM_DECL; gemm_phase(p.P + C_CKV, EV_IN, p.wt_ukv, 256, 1024, RowMap{0}, EpiKV{p.K16, p.V16, p.rsq + R}, smem); }
__global__ void __launch_bounds__(256) k_attn(Params p) { SMEM_DECL; ph_attn_naive(p, smem); }
__global__ void __launch_bounds__(256) k_gla(Params p) { SMEM_DECL; ph_gla_naive(p, smem); }
__global__ void __launch_bounds__(256) k_gemm_ev_out(Params p) { SMEM_DECL; gemm_phase(p.A16, D, p.wt_ev_out, 1024, 1024, RowMap{0}, EpiResid{p.x, p.ctx, p.mod, p.H, 0}, smem); }
__global__ void __launch_bounds__(256) k_ln_mod(Params p, int layer, int lat_only) { ph_ln_mod(p, layer, 0, lat_only); }
__global__ void __launch_bounds__(256) k_gemm_pq(Params p, int layer, int lat_only) { SMEM_DECL; gemm_phase(p.A16, D, p.wt_pq + (size_t)layer * 2048 * 1024, 1024, 2048, RowMap{lat_only}, EpiBf16{p.P, 2048, 2048}, smem); }
__global__ void __launch_bounds__(256) k_scores(Params p, int layer, int lat_only) { SMEM_DECL; ph_scores_naive(p, layer, lat_only, smem); }
__global__ void __launch_bounds__(256) k_combine(Params p, int lat_only) { ph_combine(p, lat_only); }
__global__ void __launch_bounds__(256) k_gather(Params p, int layer, int lat_only) { ph_gather_ln(p, layer, lat_only); }
__global__ void __launch_bounds__(256) k_gemm_od_in(Params p) { SMEM_DECL; gemm_phase(p.A16, D, p.wt_od_in, 1024, 2560, RowMap{0}, EpiBf16{p.P, 2560, 2560}, smem); }
__global__ void __launch_bounds__(256) k_rglru(Params p) { SMEM_DECL; ph_rglru_naive(p, smem); }
__global__ void __launch_bounds__(256) k_gemm_od_out(Params p) { SMEM_DECL; gemm_phase(p.P, 2560, p.wt_od_out, 1280, 1024, RowMap{1}, EpiResid{p.x, p.ctx, p.mod, p.H, 1}, smem); }

extern "C" void kernel_launch(void* const* d_in, const int* in_sizes, int n_in, void* d_out, int out_size, void* d_ws, size_t ws_size, hipStream_t stream) {
    Params p{};
    const float** f = (const float**)d_in;
    p.x = f[0]; p.c = f[1]; p.ctx = f[2]; p.c_ctx = f[3]; p.mod_w = f[4]; p.mod_b = f[5]; p.ln_g = f[6]; p.ln_b = f[7];
    p.ev_w_in = f[8]; p.ev_q_norm = f[9]; p.ev_kv_norm = f[10]; p.ev_w_uq = f[11]; p.ev_w_ukv = f[12]; p.ev_gla_wa2 = f[13]; p.ev_gla_ba = f[14]; p.ev_gla_norm = f[15]; p.ev_w_out = f[16];
    p.od_w_in = f[17]; p.od_conv_w = f[18]; p.od_conv_b = f[19]; p.od_gate_w = f[20]; p.od_gate_b = f[21]; p.od_lambda = f[22]; p.od_w_out = f[23];
    p.peer_wq = f[24]; p.peer_k1 = f[25]; p.peer_k2 = f[26]; p.peer_u = f[27]; p.peer_v = f[28];
    p.out = (float*)d_out;
    unsigned char* w = (unsigned char*)d_ws; size_t off = 0;
    auto take = [&](size_t bytes) { unsigned char* r = w + off; off += (bytes + 255) & ~(size_t)255; return r; };
    p.wt_ev_in = (bf16_t*)take((size_t)EV_IN * 1024 * 2); p.wt_uq = (bf16_t*)take(768 * 384 * 2); p.wt_ukv = (bf16_t*)take(1024 * 256 * 2);
    p.wt_ev_out = (bf16_t*)take(1024 * 1024 * 2); p.wt_od_in = (bf16_t*)take(2560 * 1024 * 2); p.wt_gate = (bf16_t*)take(40 * 16384 * 2);
    p.wt_od_out = (bf16_t*)take(1024 * 1280 * 2); p.wt_pq = (bf16_t*)take((size_t)2 * 2048 * 1024 * 2); p.wt_k = (bf16_t*)take(4 * 16384 * 2);
    p.mod = (float*)take(2 * 9 * 6144 * 4); p.rope_cos = (float*)take(SEQ * 16 * 4); p.rope_sin = (float*)take(SEQ * 16 * 4); p.rsq = (float*)take((size_t)2 * R * 4);
    p.H = (float*)take((size_t)R * D * 4);
    p.Q16 = (bf16_t*)p.H; p.K16 = p.Q16 + (size_t)R * 768; p.V16 = p.K16 + (size_t)R * 768;
    p.A16 = (bf16_t*)take((size_t)R * D * 2);
    p.P = (bf16_t*)take((size_t)R * 2560 * 2);
    p.G = take((size_t)94371840);
    if (off > ws_size) { fprintf(stderr, "workspace too small: need %zu have %zu\n", off, ws_size); return; }
    const int G = 1024;
    k_prologue<<<G, 256, 0, stream>>>(p);
    k_modulate0<<<G, 256, 0, stream>>>(p);
    k_gemm_ev_in<<<G, 256, 0, stream>>>(p);
    k_rowpost<<<G, 256, 0, stream>>>(p);
    k_gemm_q<<<G, 256, 0, stream>>>(p);
    k_gemm_kv<<<G, 256, 0, stream>>>(p);
    k_attn<<<1088, 256, 0, stream>>>(p);
    k_gla<<<32, 256, 0, stream>>>(p);
    k_gemm_ev_out<<<G, 256, 0, stream>>>(p);
    k_ln_mod<<<G, 256, 0, stream>>>(p, 0, 0);
    k_gemm_pq<<<G, 256, 0, stream>>>(p, 0, 0);
    k_scores<<<G, 256, 0, stream>>>(p, 0, 0);
    k_combine<<<G, 256, 0, stream>>>(p, 0);
    k_gather<<<2048, 256, 0, stream>>>(p, 0, 0);
    k_gemm_od_in<<<G, 256, 0, stream>>>(p);
    k_rglru<<<80, 256, 0, stream>>>(p);
    k_gemm_od_out<<<G, 256, 0, stream>>>(p);
    k_ln_mod<<<G, 256, 0, stream>>>(p, 1, 1);
    k_gemm_pq<<<G, 256, 0, stream>>>(p, 1, 1);
    k_scores<<<G, 256, 0, stream>>>(p, 1, 1);
    k_combine<<<G, 256, 0, stream>>>(p, 1);
    k_gather<<<2048, 256, 0, stream>>>(p, 1, 1);
}
```

```cpp
#include <hip/hip_runtime.h>
#include <hip/hip_cooperative_groups.h>
#include <cstdio>
#include <cstdint>

namespace cg = cooperative_groups;
typedef unsigned short bf16_t;
typedef short bf16x8 __attribute__((ext_vector_type(8)));
typedef float f32x4 __attribute__((ext_vector_type(4)));
typedef unsigned u32x4 __attribute__((ext_vector_type(4)));
typedef unsigned u32x2 __attribute__((ext_vector_type(2)));

constexpr int D = 1024, NB = 8, SEQ = 4096, CTX = 256, PB = SEQ + CTX  , R = NB * PB  ;
constexpr int EV_IN = 2240, RGW = 1280;
constexpr int C_CQ = 0, C_CKV = 384, C_KPE = 640, C_GQ = 672, C_GK = 928, C_GV = 1184, C_GG = 1696, C_GAF = 2208;
constexpr float LN_EPS = 1e-6f, ALPHA = 1.41421356237f, MLA_SCALE = 0.10206207261596577f  ;
constexpr int PEER_N = 16384;

struct Params {
    const float *x, *c, *ctx, *c_ctx, *mod_w, *mod_b, *ln_g, *ln_b;
    const float *ev_w_in, *ev_q_norm, *ev_kv_norm, *ev_w_uq, *ev_w_ukv, *ev_gla_wa2, *ev_gla_ba, *ev_gla_norm, *ev_w_out;
    const float *od_w_in, *od_conv_w, *od_conv_b, *od_gate_w, *od_gate_b, *od_lambda, *od_w_out;
    const float *peer_wq, *peer_k1, *peer_k2, *peer_u, *peer_v;
    float* out;
    bf16_t *wt_ev_in, *wt_uq, *wt_ukv, *wt_ev_out, *wt_od_in, *wt_gate, *wt_od_out, *wt_pq, *wt_k;
    float *mod, *rope_cos, *rope_sin, *rsq;
    float* H; bf16_t *Q16, *K16, *V16;
    bf16_t* A16; bf16_t* P; unsigned char* G;
};

__device__ __forceinline__ bf16_t f2bf(float f) { unsigned u = __float_as_uint(f); u += 0x7fffu + ((u >> 16) & 1u); return (bf16_t)(u >> 16); }
__device__ __forceinline__ float bf2f(bf16_t h) { return __uint_as_float(((unsigned)h) << 16); }
__device__ __forceinline__ unsigned pack2(float a, float b) { return (unsigned)f2bf(a) | ((unsigned)f2bf(b) << 16); }
__device__ __forceinline__ float silu_f(float x) { return x / (1.0f + expf(-x)); }
__device__ __forceinline__ float sigmoid_f(float x) { return 1.0f / (1.0f + expf(-x)); }
__device__ __forceinline__ float gelu_f(float x) { return 0.5f * x * (1.0f + erff(x * 0.70710678118654752f)); }
__device__ __forceinline__ float wave_sum(float v) {
#pragma unroll
    for (int o = 32; o > 0; o >>= 1) v += __shfl_xor(v, o);
    return v;
}
__device__ __forceinline__ int mod_row(int r) { const int b = r / PB, p = r - b * PB; return p < CTX ? 8 : b; }
__device__ __forceinline__ const float* in_row(const Params& P_, int r) {
    const int b = r / PB, p = r - b * PB;
    return p < CTX ? P_.ctx + ((size_t)b * CTX + p) * D : P_.x + ((size_t)b * SEQ + (p - CTX)) * D;
}

__device__ void tconv_tile(const float* __restrict__ W, int K, int N, bf16_t* __restrict__ Wt, const float* __restrict__ rowscale, int tile, float* sm) {
    const int ntn = N / 64, tk = tile / ntn, tn = tile % ntn, tid = threadIdx.x;
#pragma unroll
    for (int i = 0; i < 4; ++i) {
        const int k = (tid >> 4) + 16 * i;
        f32x4 v = *(const f32x4*)(W + (size_t)(tk * 64 + k) * N + tn * 64 + (tid & 15) * 4);
        const float s = rowscale ? rowscale[tk * 64 + k] : 1.0f;
#pragma unroll
        for (int q = 0; q < 4; ++q) sm[k * 65 + (tid & 15) * 4 + q] = v[q] * s;
    }
    __syncthreads();
    const int n = tid >> 2, kc = tid & 3;
    unsigned w[8];
#pragma unroll
    for (int kk = 0; kk < 8; ++kk) w[kk] = pack2(sm[(kc * 16 + 2 * kk) * 65 + n], sm[(kc * 16 + 2 * kk + 1) * 65 + n]);
    bf16_t* dst = Wt + (size_t)(tn * 64 + n) * K + tk * 64 + kc * 16;
    *(u32x4*)dst = (u32x4){w[0], w[1], w[2], w[3]};
    *(u32x4*)(dst + 8) = (u32x4){w[4], w[5], w[6], w[7]};
    __syncthreads();
}
__device__ void tconv_all(const float* W, int K, int N, bf16_t* Wt, const float* rowscale, float* sm) {
    const int nt = (K / 64) * (N / 64);
    for (int t = blockIdx.x; t < nt; t += gridDim.x) tconv_tile(W, K, N, Wt, rowscale, t, sm);
}

__device__ void ph_prologue(const Params& p, unsigned char* smem) {
    float* sm = (float*)smem;
    tconv_all(p.ev_w_in, 1024, EV_IN, p.wt_ev_in, nullptr, sm);
    tconv_all(p.ev_w_uq, 384, 768, p.wt_uq, p.ev_q_norm, sm);
    tconv_all(p.ev_w_ukv, 256, 1024, p.wt_ukv, p.ev_kv_norm, sm);
    tconv_all(p.ev_w_out, 1024, 1024, p.wt_ev_out, nullptr, sm);
    tconv_all(p.od_w_in, 1024, 2560, p.wt_od_in, nullptr, sm);
    for (int g = 0; g < 40; ++g) tconv_all(p.od_gate_w + (size_t)g * 16384, 128, 128, p.wt_gate + (size_t)g * 16384, nullptr, sm);
    tconv_all(p.od_w_out, 1280, 1024, p.wt_od_out, nullptr, sm);
    for (int l = 0; l < 2; ++l) tconv_all(p.peer_wq + (size_t)l * 1024 * 2048, 1024, 2048, p.wt_pq + (size_t)l * 1024 * 2048, nullptr, sm);
    for (int i = blockIdx.x * 256 + threadIdx.x; i < 2 * 2 * 16384; i += gridDim.x * 256) {
        const int l = i / 32768, h = (i / 16384) & 1, e = i & 16383;
        p.wt_k[i] = f2bf((h ? p.peer_k2 : p.peer_k1)[(size_t)l * 16384 + e]);
    }
    for (int i = blockIdx.x * 256 + threadIdx.x; i < SEQ * 16; i += gridDim.x * 256) {
        const int s = i >> 4, f = i & 15;
        const float pos = (float)(f < 8 ? (s >> 6) : (s & 63));
        const float inv = powf(10000.0f, -(float)(f & 7) / 8.0f);
        const float ang = pos * inv;
        p.rope_cos[i] = cosf(ang); p.rope_sin[i] = sinf(ang);
    }
    float* sc = sm;
    for (int u = blockIdx.x; u < 2 * 96; u += gridDim.x) {
        const int l = u / 96, c0 = (u % 96) * 64, tid = threadIdx.x;
        __syncthreads();
        for (int i = tid; i < 9 * 1024; i += 256) { const int rr = i >> 10, k = i & 1023; sc[i] = silu_f(rr < 8 ? p.c[rr * 1024 + k] : p.c_ctx[k]); }
        __syncthreads();
        const int col = c0 + (tid & 63), kq = tid >> 6;
        float acc[9];
#pragma unroll
        for (int rr = 0; rr < 9; ++rr) acc[rr] = 0.f;
        const float* w = p.mod_w + (size_t)l * 1024 * 6144 + col;
        for (int k = kq * 256; k < kq * 256 + 256; ++k) {
            const float wv = w[(size_t)k * 6144];
#pragma unroll
            for (int rr = 0; rr < 9; ++rr) acc[rr] += sc[rr * 1024 + k] * wv;
        }
        __syncthreads();
        float* red = sm + 9 * 1024;
#pragma unroll
        for (int rr = 0; rr < 9; ++rr) red[(kq * 9 + rr) * 64 + (tid & 63)] = acc[rr];
        __syncthreads();
        for (int i = tid; i < 9 * 64; i += 256) {
            const int rr = i >> 6, cc = i & 63;
            const float s = red[(0 * 9 + rr) * 64 + cc] + red[(1 * 9 + rr) * 64 + cc] + red[(2 * 9 + rr) * 64 + cc] + red[(3 * 9 + rr) * 64 + cc];
            p.mod[((size_t)l * 9 + rr) * 6144 + c0 + cc] = s + p.mod_b[l * 6144 + c0 + cc];
        }
    }
}

__device__ void ph_modulate0(const Params& p) {
    const int wid = threadIdx.x >> 6, lane = threadIdx.x & 63;
    for (int u = blockIdx.x; u < R / 4; u += gridDim.x) {
        const int r = u * 4 + wid;
        const float* src = in_row(p, r);
        const float* md = p.mod + (size_t)(0 * 9 + mod_row(r)) * 6144;
#pragma unroll
        for (int q = 0; q < 4; ++q) {
            const int c = q * 256 + lane * 4;
            const f32x4 h = *(const f32x4*)(src + c), sh = *(const f32x4*)(md + c), scl = *(const f32x4*)(md + 1024 + c);
            const f32x4 v = h * (1.0f + scl) + sh;
            *(u32x2*)(p.A16 + (size_t)r * D + c) = (u32x2){pack2(v[0], v[1]), pack2(v[2], v[3])};
        }
    }
}

constexpr int GBK = 64, GLDS = 72  ;
struct RowMap { int lat_only; __device__ __forceinline__ int ntiles() const { return lat_only ? 256 : 272; }
    __device__ __forceinline__ int row0(int t) const { return lat_only ? (t >> 5) * PB + CTX + (t & 31) * 128 : t * 128; } };

template <class Epi>
__device__ void gemm_phase(const bf16_t* __restrict__ A, int lda, const bf16_t* __restrict__ Bt, int K, int N, RowMap rm, const Epi& epi, unsigned char* smem) {
    bf16_t* sA = (bf16_t*)smem; bf16_t* sB = sA + 128 * GLDS;
    const int tid = threadIdx.x, lane = tid & 63, wid = tid >> 6, wm = wid >> 1, wn = wid & 1, fr = lane & 15, fq = lane >> 4;
    const int ntn = (N + 127) / 128, nunits = rm.ntiles() * ntn, nk = K / GBK;
    for (int u = blockIdx.x; u < nunits; u += gridDim.x) {
        const int tm = u / ntn, tn = u % ntn, m0 = rm.row0(tm), n0 = tn * 128;
        f32x4 acc[4][4];
#pragma unroll
        for (int i = 0; i < 4; ++i)
#pragma unroll
            for (int j = 0; j < 4; ++j) acc[i][j] = (f32x4){0.f, 0.f, 0.f, 0.f};
        u32x4 ra[4], rb[4];
        auto gload = [&](int kt) {
#pragma unroll
            for (int i = 0; i < 4; ++i) {
                const int id = tid + 256 * i, row = id >> 3, ch = id & 7;
                ra[i] = *(const u32x4*)(A + (size_t)(m0 + row) * lda + kt * GBK + ch * 8);
                int brow = n0 + row; brow = brow < N ? brow : N - 1;
                rb[i] = *(const u32x4*)(Bt + (size_t)brow * K + kt * GBK + ch * 8);
            }
        };
        auto lstore = [&]() {
#pragma unroll
            for (int i = 0; i < 4; ++i) {
                const int id = tid + 256 * i, row = id >> 3, ch = id & 7;
                *(u32x4*)(sA + row * GLDS + ch * 8) = ra[i];
                *(u32x4*)(sB + row * GLDS + ch * 8) = rb[i];
            }
        };
        gload(0);
        __syncthreads();
        lstore();
        __syncthreads();
        for (int kt = 0; kt < nk; ++kt) {
            if (kt + 1 < nk) gload(kt + 1);
#pragma unroll
            for (int ks = 0; ks < 2; ++ks) {
                bf16x8 af[4], bfr[4];
#pragma unroll
                for (int i = 0; i < 4; ++i) af[i] = *(const bf16x8*)(sA + (wm * 64 + i * 16 + fr) * GLDS + ks * 32 + fq * 8);
#pragma unroll
                for (int j = 0; j < 4; ++j) bfr[j] = *(const bf16x8*)(sB + (wn * 64 + j * 16 + fr) * GLDS + ks * 32 + fq * 8);
#pragma unroll
                for (int i = 0; i < 4; ++i)
#pragma unroll
                    for (int j = 0; j < 4; ++j) acc[i][j] = __builtin_amdgcn_mfma_f32_16x16x32_bf16(bfr[j], af[i], acc[i][j], 0, 0, 0);
            }
            __syncthreads();
            if (kt + 1 < nk) { lstore(); __syncthreads(); }
        }
        epi(acc, m0 + wm * 64, n0 + wn * 64, fr, fq);
    }
}

struct EpiBf16 {
    bf16_t* C; int ldc, N;
    __device__ __forceinline__ void operator()(const f32x4 (&acc)[4][4], int mb, int nb, int fr, int fq) const {
#pragma unroll
        for (int i = 0; i < 4; ++i)
#pragma unroll
            for (int j = 0; j < 4; ++j) {
                const int m = mb + i * 16 + fr, n = nb + j * 16 + 4 * fq;
                if (n < N) *(u32x2*)(C + (size_t)m * ldc + n) = (u32x2){pack2(acc[i][j][0], acc[i][j][1]), pack2(acc[i][j][2], acc[i][j][3])};
            }
    }
};
struct EpiQ {
    bf16_t* Q; const float *rsq, *rc, *rs;
    __device__ __forceinline__ void operator()(const f32x4 (&acc)[4][4], int mb, int nb, int fr, int fq) const {
#pragma unroll
        for (int i = 0; i < 4; ++i) {
            const int m = mb + i * 16 + fr, b = m / PB, pp = m - b * PB;
            const float sc = rsq[m] * MLA_SCALE;
#pragma unroll
            for (int j = 0; j < 4; j += 2) {
                const int n = nb + j * 16 + 4 * fq;
                f32x4 v0 = acc[i][j] * sc, v1 = acc[i][j + 1] * sc;
                const int d = n % 96;
                if (d >= 64 && pp >= CTX) {
                    const int s = pp - CTX, f = (d - 64) + 0;
                    const f32x4 cs = *(const f32x4*)(rc + s * 16 + f), sn = *(const f32x4*)(rs + s * 16 + f);
                    const f32x4 o0 = v0 * cs - v1 * sn, o1 = v0 * sn + v1 * cs; v0 = o0; v1 = o1;
                }
                *(u32x2*)(Q + (size_t)m * 768 + n) = (u32x2){pack2(v0[0], v0[1]), pack2(v0[2], v0[3])};
                *(u32x2*)(Q + (size_t)m * 768 + n + 16) = (u32x2){pack2(v1[0], v1[1]), pack2(v1[2], v1[3])};
            }
        }
    }
};
struct EpiKV {
    bf16_t *Kd, *Vd; const float* rsq;
    __device__ __forceinline__ void operator()(const f32x4 (&acc)[4][4], int mb, int nb, int fr, int fq) const {
#pragma unroll
        for (int i = 0; i < 4; ++i) {
            const int m = mb + i * 16 + fr; const float sc = rsq[m];
#pragma unroll
            for (int j = 0; j < 4; ++j) {
                const int n = nb + j * 16 + 4 * fq, hd = n >> 7, d = n & 127;
                const f32x4 v = acc[i][j] * sc;
                bf16_t* dst = d < 64 ? Kd + (size_t)m * 768 + hd * 96 + d : Vd + (size_t)m * 512 + hd * 64 + (d - 64);
                *(u32x2*)dst = (u32x2){pack2(v[0], v[1]), pack2(v[2], v[3])};
            }
        }
    }
};
struct EpiResid {
    const float *x, *ctx, *mod; float* H; int layer;
    __device__ __forceinline__ void operator()(const f32x4 (&acc)[4][4], int mb, int nb, int fr, int fq) const {
#pragma unroll
        for (int i = 0; i < 4; ++i) {
            const int m = mb + i * 16 + fr, b = m / PB, pp = m - b * PB;
            const float* hin = layer == 0 ? (pp < CTX ? ctx + ((size_t)b * CTX + pp) * D : x + ((size_t)b * SEQ + (pp - CTX)) * D) : H + (size_t)m * D;
            const float* gate = mod + ((size_t)layer * 9 + (pp < CTX ? 8 : b)) * 6144 + 2 * 1024;
#pragma unroll
            for (int j = 0; j < 4; ++j) {
                const int n = nb + j * 16 + 4 * fq;
                const f32x4 h = *(const f32x4*)(hin + n), g = *(const f32x4*)(gate + n);
                *(f32x4*)(H + (size_t)m * D + n) = ALPHA * h + g * acc[i][j];
            }
        }
    }
};

__device__ void ph_rowpost(const Params& p) {
    const int wid = threadIdx.x >> 6, lane = threadIdx.x & 63;
    for (int u = blockIdx.x; u < R / 4; u += gridDim.x) {
        const int r = u * 4 + wid, b = r / PB, pp = r - b * PB;
        const bf16_t* row = p.P + (size_t)r * EV_IN;
        float sq = 0.f, skv = 0.f;
#pragma unroll
        for (int i = 0; i < 10; ++i) { const float v = bf2f(row[lane + 64 * i]); if (i < 6) sq += v * v; else skv += v * v; }
        sq = wave_sum(sq); skv = wave_sum(skv);
        if (lane == 0) { p.rsq[r] = rsqrtf(sq / 384.0f + LN_EPS); p.rsq[R + r] = rsqrtf(skv / 256.0f + LN_EPS); }
        if (lane < 16) {
            float x1 = bf2f(row[C_KPE + lane]), x2 = bf2f(row[C_KPE + 16 + lane]);
            if (pp >= CTX) { const int s = pp - CTX; const float cs = p.rope_cos[s * 16 + lane], sn = p.rope_sin[s * 16 + lane];
                const float o1 = x1 * cs - x2 * sn, o2 = x1 * sn + x2 * cs; x1 = o1; x2 = o2; }
            const bf16_t b1 = f2bf(x1), b2 = f2bf(x2);
#pragma unroll
            for (int hd = 0; hd < 8; ++hd) { p.K16[(size_t)r * 768 + hd * 96 + 64 + lane] = b1; p.K16[(size_t)r * 768 + hd * 96 + 80 + lane] = b2; }
        }
    }
}

__device__ void ph_attn_naive(const Params& p, unsigned char* smem, int bid, int nblk) {
    float* Ks = (float*)smem;
    float* Vs = Ks + 16 * 96;
    const int tid = threadIdx.x;
    for (int u = bid; u < 1024 + 64; u += nblk) {
        int b, hd, q0, nkeys;
        if (u < 1024) { b = u >> 7; hd = (u >> 4) & 7; q0 = CTX + (u & 15) * 256; nkeys = PB; }
        else { const int v = u - 1024; b = v >> 3; hd = v & 7; q0 = 0; nkeys = CTX; }
        const int r = b * PB + q0 + tid;
        unsigned qp[48]; float o[64];
#pragma unroll
        for (int d = 0; d < 48; d += 4) { const u32x4 w = *(const u32x4*)(p.Q16 + (size_t)r * 768 + hd * 96 + 2 * d); qp[d] = w[0]; qp[d + 1] = w[1]; qp[d + 2] = w[2]; qp[d + 3] = w[3]; }
#pragma unroll
        for (int d = 0; d < 64; ++d) o[d] = 0.f;
        float m = -1e30f, l = 0.f;
        for (int k0 = 0; k0 < nkeys; k0 += 16) {
            __syncthreads();
            for (int i = tid; i < 16 * 96; i += 256) { const int kk = i / 96, d = i % 96; Ks[i] = bf2f(p.K16[(size_t)(b * PB + k0 + kk) * 768 + hd * 96 + d]); }
            for (int i = tid; i < 16 * 64; i += 256) { const int kk = i >> 6, d = i & 63; Vs[i] = bf2f(p.V16[(size_t)(b * PB + k0 + kk) * 512 + hd * 64 + d]); }
            __syncthreads();
            float s[16]; float mx = -1e30f;
#pragma unroll
            for (int kk = 0; kk < 16; ++kk) {
                float a = 0.f;
#pragma unroll
                for (int d = 0; d < 96; d += 4) {
                    const f32x4 kv = *(const f32x4*)(Ks + kk * 96 + d);
                    a += __uint_as_float(qp[d / 2] << 16) * kv[0] + __uint_as_float(qp[d / 2] & 0xffff0000u) * kv[1]
                       + __uint_as_float(qp[d / 2 + 1] << 16) * kv[2] + __uint_as_float(qp[d / 2 + 1] & 0xffff0000u) * kv[3];
                }
                s[kk] = a; mx = fmaxf(mx, a);
            }
            const float mn = fmaxf(m, mx), al = expf(m - mn);
            l *= al;
#pragma unroll
            for (int d = 0; d < 64; ++d) o[d] *= al;
#pragma unroll
            for (int kk = 0; kk < 16; ++kk) {
                const float pr = expf(s[kk] - mn); l += pr;
#pragma unroll
                for (int d = 0; d < 64; d += 4) { const f32x4 vv = *(const f32x4*)(Vs + kk * 64 + d); o[d] += pr * vv[0]; o[d + 1] += pr * vv[1]; o[d + 2] += pr * vv[2]; o[d + 3] += pr * vv[3]; }
            }
            m = mn;
        }
        const float il = 1.0f / l;
#pragma unroll
        for (int d = 0; d < 64; d += 2) *(unsigned*)(p.A16 + (size_t)r * D + hd * 64 + d) = pack2(o[d] * il, o[d + 1] * il);
    }
}

__device__ void ph_gla_naive(const Params& p, unsigned char* smem) {
    float* sq = (float*)smem;
    float* sk = sq + 16 * 64;
    float* sa = sk + 16 * 64;
    float* sv = sa + 16 * 64;
    float* sop = sv + 16 * 128;
    float* sga = sop + 2 * 16 * 128;
    float* OF = (float*)p.G;
    const int tid = threadIdx.x, j = tid & 127, half = tid >> 7, lane = tid & 63, wid = tid >> 6;
    for (int u = blockIdx.x; u < 32; u += gridDim.x) {
        const int b = u >> 2, hd = u & 3;
        for (int dir = 0; dir < 2; ++dir) {
            float S[32];
#pragma unroll
            for (int dd = 0; dd < 32; ++dd) S[dd] = 0.f;
            const float* wa = p.ev_gla_wa2 + (size_t)dir * 16 * 256;
            const float* ba = p.ev_gla_ba + dir * 256;
            for (int bi = 0; bi < PB / 16; ++bi) {
                __syncthreads();
                for (int e = tid; e < 16 * 64; e += 256) {
                    const int i = e >> 6, d = e & 63, st = bi * 16 + i;
                    const int pp = dir == 0 ? st : (st < CTX ? CTX - 1 - st : PB + CTX - 1 - st);
                    const bf16_t* row = p.P + (size_t)(b * PB + pp) * EV_IN;
                    sq[e] = bf2f(row[C_GQ + hd * 64 + d]) * 0.125f;
                    sk[e] = bf2f(row[C_GK + hd * 64 + d]);
                }
                for (int e = tid; e < 16 * 128; e += 256) {
                    const int i = e >> 7, jj = e & 127, st = bi * 16 + i;
                    const int pp = dir == 0 ? st : (st < CTX ? CTX - 1 - st : PB + CTX - 1 - st);
                    sv[e] = bf2f(p.P[(size_t)(b * PB + pp) * EV_IN + C_GV + hd * 128 + jj]);
                }
                {
                    const int i = tid >> 4, g = tid & 15, st = bi * 16 + i;
                    const int pp = dir == 0 ? st : (st < CTX ? CTX - 1 - st : PB + CTX - 1 - st);
                    sga[tid] = bf2f(p.P[(size_t)(b * PB + pp) * EV_IN + C_GAF + dir * 16 + g]);
                }
                __syncthreads();
                for (int e = tid; e < 16 * 64; e += 256) {
                    const int i = e >> 6, d = e & 63;
                    float z = ba[hd * 64 + d];
#pragma unroll
                    for (int g = 0; g < 16; ++g) z += sga[i * 16 + g] * wa[g * 256 + hd * 64 + d];
                    const float ls = fminf(z, 0.f) - log1pf(expf(-fabsf(z)));
                    sa[e] = expf(ls * (1.0f / 16.0f));
                }
                __syncthreads();
                for (int i = 0; i < 16; ++i) {
                    const float vj = sv[i * 128 + j]; float op = 0.f;
#pragma unroll
                    for (int dd = 0; dd < 32; ++dd) { const int d = half * 32 + dd; S[dd] = sa[i * 64 + d] * S[dd] + sk[i * 64 + d] * vj; op += sq[i * 64 + d] * S[dd]; }
                    sop[(half * 16 + i) * 128 + j] = op;
                }
                __syncthreads();
                if (dir == 0) {
                    for (int e = tid; e < 16 * 128; e += 256) {
                        const int i = e >> 7, jj = e & 127, st = bi * 16 + i;
                        OF[(size_t)(b * PB + st) * 512 + hd * 128 + jj] = sop[i * 128 + jj] + sop[(16 + i) * 128 + jj];
                    }
                } else {
#pragma unroll
                    for (int ii = 0; ii < 4; ++ii) {
                        const int i = wid * 4 + ii, st = bi * 16 + i;
                        const int pp = st < CTX ? CTX - 1 - st : PB + CTX - 1 - st;
                        const size_t r = (size_t)b * PB + pp;
                        const float t0 = OF[r * 512 + hd * 128 + lane] + sop[i * 128 + lane] + sop[(16 + i) * 128 + lane];
                        const float t1 = OF[r * 512 + hd * 128 + 64 + lane] + sop[i * 128 + 64 + lane] + sop[(16 + i) * 128 + 64 + lane];
                        const float ss = wave_sum(t0 * t0 + t1 * t1);
                        const float rs = rsqrtf(ss / 128.0f + LN_EPS);
                        const float g0 = bf2f(p.P[r * EV_IN + C_GG + hd * 128 + lane]), g1 = bf2f(p.P[r * EV_IN + C_GG + hd * 128 + 64 + lane]);
                        p.A16[r * D + 512 + hd * 128 + lane] = f2bf(t0 * rs * p.ev_gla_norm[hd * 128 + lane] * silu_f(g0));
                        p.A16[r * D + 512 + hd * 128 + 64 + lane] = f2bf(t1 * rs * p.ev_gla_norm[hd * 128 + 64 + lane] * silu_f(g1));
                    }
                }
            }
        }
    }
}

__device__ void ph_ln_mod(const Params& p, int layer, int lnidx, int lat_only) {
    const int wid = threadIdx.x >> 6, lane = threadIdx.x & 63;
    const int nrows = lat_only ? NB * SEQ : R;
    const float* g = p.ln_g + (size_t)(layer * 2 + lnidx) * D; const float* bb = p.ln_b + (size_t)(layer * 2 + lnidx) * D;
    for (int u = blockIdx.x; u < nrows / 4; u += gridDim.x) {
        const int rr = u * 4 + wid, r = lat_only ? (rr >> 12) * PB + CTX + (rr & 4095) : rr;
        float* hrow = p.H + (size_t)r * D;
        f32x4 v[4]; float s = 0.f;
#pragma unroll
        for (int q = 0; q < 4; ++q) { v[q] = *(const f32x4*)(hrow + q * 256 + lane * 4); s += v[q][0] + v[q][1] + v[q][2] + v[q][3]; }
        const float mu = wave_sum(s) * (1.0f / 1024.0f);
        float ss = 0.f;
#pragma unroll
        for (int q = 0; q < 4; ++q) { v[q] = v[q] - mu; ss += v[q][0] * v[q][0] + v[q][1] * v[q][1] + v[q][2] * v[q][2] + v[q][3] * v[q][3]; }
        const float rstd = rsqrtf(wave_sum(ss) * (1.0f / 1024.0f) + LN_EPS);
        const float* md = p.mod + ((size_t)layer * 9 + mod_row(r)) * 6144;
#pragma unroll
        for (int q = 0; q < 4; ++q) {
            const int c = q * 256 + lane * 4;
            const f32x4 h = v[q] * rstd * *(const f32x4*)(g + c) + *(const f32x4*)(bb + c);
            *(f32x4*)(hrow + c) = h;
            const f32x4 a = h * (1.0f + *(const f32x4*)(md + 4 * 1024 + c)) + *(const f32x4*)(md + 3 * 1024 + c);
            *(u32x2*)(p.A16 + (size_t)r * D + c) = (u32x2){pack2(a[0], a[1]), pack2(a[2], a[3])};
        }
    }
}

__device__ void ph_scores_naive(const Params& p, int layer, int lat_only, unsigned char* smem) {
    float* ks = (float*)smem;
    const bf16_t* QP = p.P;
    float* T = (float*)p.G;
    const int tid = threadIdx.x, rl = tid >> 3, hd = tid & 7;
    const int nrows = lat_only ? NB * SEQ : R;
    for (int u = blockIdx.x; u < nrows / 32; u += gridDim.x) {
        const int rr = u * 32 + rl, r = lat_only ? (rr >> 12) * PB + CTX + (rr & 4095) : rr;
        for (int half = 0; half < 2; ++half) {
            __syncthreads();
            const bf16_t* kk = p.wt_k + ((size_t)layer * 2 + half) * 16384;
            for (int i = tid; i < 16384; i += 256) ks[i] = bf2f(kk[i]);
            __syncthreads();
            float q[128];
#pragma unroll
            for (int d = 0; d < 128; d += 8) {
                const u32x4 w = *(const u32x4*)(QP + (size_t)r * 2048 + hd * 256 + half * 128 + d);
#pragma unroll
                for (int e = 0; e < 4; ++e) { q[d + 2 * e] = __uint_as_float(w[e] << 16); q[d + 2 * e + 1] = __uint_as_float(w[e] & 0xffff0000u); }
            }
            float top[16];
#pragma unroll
            for (int t = 0; t < 16; ++t) top[t] = -3.0e38f;
            for (int k = 0; k < 128; ++k) {
                float s = 0.f;
#pragma unroll
                for (int d = 0; d < 128; d += 4) { const f32x4 kv = *(const f32x4*)(ks + k * 128 + d); s += q[d] * kv[0] + q[d + 1] * kv[1] + q[d + 2] * kv[2] + q[d + 3] * kv[3]; }
                float xv = __uint_as_float((__float_as_uint(s) & ~127u) | (unsigned)k);
#pragma unroll
                for (int t = 0; t < 16; ++t) { const float hi = fmaxf(top[t], xv); xv = fminf(top[t], xv); top[t] = hi; }
            }
            float* dst = T + (((size_t)r * 8 + hd) * 2 + half) * 16;
#pragma unroll
            for (int t = 0; t < 16; t += 4) *(f32x4*)(dst + t) = (f32x4){top[t], top[t + 1], top[t + 2], top[t + 3]};
        }
    }
}

__device__ void ph_combine(const Params& p, int lat_only) {
    const float* T = (const float*)p.G;
    int* EIDX = (int*)(p.G + (size_t)R * 8 * 2 * 16 * 4);
    float* EG = (float*)(p.G + (size_t)R * 8 * 2 * 16 * 4 + (size_t)R * 8 * 16 * 4);
    const int nrows = lat_only ? NB * SEQ : R;
    for (int g = blockIdx.x * 256 + threadIdx.x; g < nrows * 8; g += gridDim.x * 256) {
        const int rr = g >> 3, hd = g & 7, r = lat_only ? (rr >> 12) * PB + CTX + (rr & 4095) : rr;
        const float* t = T + ((size_t)r * 8 + hd) * 32;
        float t2[16];
#pragma unroll
        for (int i = 0; i < 16; ++i) t2[i] = __uint_as_float(__float_as_uint(t[16 + i]) & ~127u);
        float top[16];
#pragma unroll
        for (int k = 0; k < 16; ++k) top[k] = -3.0e38f;
        for (int i = 0; i < 16; ++i) {
            const float t1i = __uint_as_float(__float_as_uint(t[i]) & ~127u);
#pragma unroll
            for (int j = 0; j < 16; ++j) {
                float xv = __uint_as_float((__float_as_uint(t1i + t2[j]) & ~255u) | (unsigned)(i * 16 + j));
#pragma unroll
                for (int k = 0; k < 16; ++k) { const float hi = fmaxf(top[k], xv); xv = fminf(top[k], xv); top[k] = hi; }
            }
        }
        float e[16], sum = 0.f; const float mx = __uint_as_float(__float_as_uint(top[0]) & ~255u);
#pragma unroll
        for (int k = 0; k < 16; ++k) { e[k] = expf(__uint_as_float(__float_as_uint(top[k]) & ~255u) - mx); sum += e[k]; }
        const float inv = 1.0f / sum;
#pragma unroll
        for (int k = 0; k < 16; ++k) {
            const unsigned code = __float_as_uint(top[k]) & 255u, i = code >> 4, j = code & 15;
            const unsigned i1 = __float_as_uint(t[i]) & 127u, i2 = __float_as_uint(t[16 + j]) & 127u;
            EIDX[((size_t)r * 8 + hd) * 16 + k] = (int)(i1 * 128 + i2);
            EG[((size_t)r * 8 + hd) * 16 + k] = e[k] * inv;
        }
    }
}

__device__ void ph_gather_ln(const Params& p, int layer, int lat_only) {
    const int wid = threadIdx.x >> 6, lane = threadIdx.x & 63;
    const int* EIDX = (const int*)(p.G + (size_t)R * 8 * 2 * 16 * 4);
    const float* EG = (const float*)(p.G + (size_t)R * 8 * 2 * 16 * 4 + (size_t)R * 8 * 16 * 4);
    const float* U = p.peer_u + (size_t)layer * PEER_N * D; const float* V = p.peer_v + (size_t)layer * PEER_N * D;
    const float* g = p.ln_g + (size_t)(layer * 2 + 1) * D; const float* bb = p.ln_b + (size_t)(layer * 2 + 1) * D;
    const int nrows = lat_only ? NB * SEQ : R;
    for (int u = blockIdx.x; u < nrows / 4; u += gridDim.x) {
        const int rr = u * 4 + wid, r = lat_only ? (rr >> 12) * PB + CTX + (rr & 4095) : rr;
        f32x4 hm[4], acc[4];
#pragma unroll
        for (int q = 0; q < 4; ++q) {
            const u32x2 w = *(const u32x2*)(p.A16 + (size_t)r * D + q * 256 + lane * 4);
            hm[q] = (f32x4){__uint_as_float(w[0] << 16), __uint_as_float(w[0] & 0xffff0000u), __uint_as_float(w[1] << 16), __uint_as_float(w[1] & 0xffff0000u)};
            acc[q] = (f32x4){0.f, 0.f, 0.f, 0.f};
        }
        for (int e0 = 0; e0 < 128; e0 += 2) {
            const int ea = EIDX[(size_t)r * 128 + e0], eb = EIDX[(size_t)r * 128 + e0 + 1];
            const float ga = EG[(size_t)r * 128 + e0], gb = EG[(size_t)r * 128 + e0 + 1];
            f32x4 ua[4], ub[4];
#pragma unroll
            for (int q = 0; q < 4; ++q) { ua[q] = *(const f32x4*)(U + (size_t)ea * D + q * 256 + lane * 4); ub[q] = *(const f32x4*)(U + (size_t)eb * D + q * 256 + lane * 4); }
            float da = 0.f, db = 0.f;
#pragma unroll
            for (int q = 0; q < 4; ++q) { da += hm[q][0] * ua[q][0] + hm[q][1] * ua[q][1] + hm[q][2] * ua[q][2] + hm[q][3] * ua[q][3]; db += hm[q][0] * ub[q][0] + hm[q][1] * ub[q][1] + hm[q][2] * ub[q][2] + hm[q][3] * ub[q][3]; }
            da = wave_sum(da); db = wave_sum(db);
            const float wa = ga * gelu_f(da), wb = gb * gelu_f(db);
#pragma unroll
            for (int q = 0; q < 4; ++q) {
                acc[q] += wa * *(const f32x4*)(V + (size_t)ea * D + q * 256 + lane * 4);
                acc[q] += wb * *(const f32x4*)(V + (size_t)eb * D + q * 256 + lane * 4);
            }
        }
        const float* md = p.mod + ((size_t)layer * 9 + mod_row(r)) * 6144;
        float* hrow = p.H + (size_t)r * D;
        f32x4 v[4]; float s = 0.f;
#pragma unroll
        for (int q = 0; q < 4; ++q) { const int c = q * 256 + lane * 4; v[q] = ALPHA * *(const f32x4*)(hrow + c) + *(const f32x4*)(md + 5 * 1024 + c) * acc[q]; s += v[q][0] + v[q][1] + v[q][2] + v[q][3]; }
        const float mu = wave_sum(s) * (1.0f / 1024.0f);
        float ss = 0.f;
#pragma unroll
        for (int q = 0; q < 4; ++q) { v[q] = v[q] - mu; ss += v[q][0] * v[q][0] + v[q][1] * v[q][1] + v[q][2] * v[q][2] + v[q][3] * v[q][3]; }
        const float rstd = rsqrtf(wave_sum(ss) * (1.0f / 1024.0f) + LN_EPS);
        if (layer == 0) {
            const float* md1 = p.mod + ((size_t)1 * 9 + mod_row(r)) * 6144;
#pragma unroll
            for (int q = 0; q < 4; ++q) {
                const int c = q * 256 + lane * 4;
                const f32x4 h = v[q] * rstd * *(const f32x4*)(g + c) + *(const f32x4*)(bb + c);
                *(f32x4*)(hrow + c) = h;
                const f32x4 a = h * (1.0f + *(const f32x4*)(md1 + 1024 + c)) + *(const f32x4*)(md1 + c);
                *(u32x2*)(p.A16 + (size_t)r * D + c) = (u32x2){pack2(a[0], a[1]), pack2(a[2], a[3])};
            }
        } else {
            float* orow = p.out + (size_t)rr * D;
#pragma unroll
            for (int q = 0; q < 4; ++q) { const int c = q * 256 + lane * 4; *(f32x4*)(orow + c) = v[q] * rstd * *(const f32x4*)(g + c) + *(const f32x4*)(bb + c); }
        }
    }
}

__device__ void ph_rglru_naive(const Params& p, unsigned char* smem) {
    float* sz = (float*)smem;
    bf16_t* PR = p.P;
    bf16_t* YF = (bf16_t*)p.G;
    const int tid = threadIdx.x, c = tid >> 1, gate = tid & 1;
    for (int u = blockIdx.x; u < 80; u += gridDim.x) {
        const int b = u / 10, n = u % 10, ch = n * 128 + c;
        for (int dir = 0; dir < 2; ++dir) {
            float wcol[128];
            const float* gw = p.od_gate_w + ((size_t)(dir * 2 + gate) * 10 + n) * 16384;
#pragma unroll
            for (int k = 0; k < 128; ++k) wcol[k] = gw[k * 128 + c];
            const float gbias = p.od_gate_b[(dir * 2 + gate) * RGW + ch];
            const float lam = p.od_lambda[dir * RGW + ch];
            const float sp = fmaxf(-lam, 0.f) + log1pf(expf(-fabsf(lam)));
            const float coef = -8.0f * sp;
            float h = 0.f;
            for (int bi = 0; bi < PB / 16; ++bi) {
                __syncthreads();
                for (int e = tid; e < 16 * 128; e += 256) {
                    const int i = e >> 7, k = e & 127, st = bi * 16 + i, cc = n * 128 + k;
                    const int pp = dir == 0 ? st : (st < CTX ? CTX - 1 - st : PB + CTX - 1 - st);
                    const int lo = pp < CTX ? 0 : CTX, hi = pp < CTX ? CTX : PB;
                    float v = p.od_conv_b[cc];
#pragma unroll
                    for (int tap = 0; tap < 4; ++tap) { const int q = pp + tap - 2; if (q >= lo && q < hi) v += p.od_conv_w[tap * RGW + cc] * bf2f(PR[(size_t)(b * PB + q) * 2560 + RGW + cc]); }
                    sz[e] = v;
                }
                __syncthreads();
                for (int i = 0; i < 16; ++i) {
                    float dot = gbias;
#pragma unroll
                    for (int k = 0; k < 128; k += 4) { const f32x4 zv = *(const f32x4*)(sz + i * 128 + k); dot += zv[0] * wcol[k] + zv[1] * wcol[k + 1] + zv[2] * wcol[k + 2] + zv[3] * wcol[k + 3]; }
                    const float sg = sigmoid_f(dot), other = __shfl_xor(sg, 1);
                    const float rg = gate == 0 ? sg : other, ig = gate == 0 ? other : sg;
                    const float la = coef * rg, a = expf(la), xin = sqrtf(-expm1f(2.0f * la)) * ig * sz[i * 128 + c];
                    h = a * h + xin;
                    const int st = bi * 16 + i;
                    const int pp = dir == 0 ? st : (st < CTX ? CTX - 1 - st : PB + CTX - 1 - st);
                    if (gate == 0 && pp >= CTX) {
                        const size_t rl = (size_t)b * SEQ + (pp - CTX);
                        if (dir == 0) YF[rl * RGW + ch] = f2bf(h);
                        else {
                            const size_t r = (size_t)b * PB + pp;
                            const float y = bf2f(YF[rl * RGW + ch]) + h;
                            PR[r * 2560 + ch] = f2bf(gelu_f(bf2f(PR[r * 2560 + ch])) * y);
                        }
                    }
                }
            }
        }
    }
}

#define SMEM_DECL __shared__ __attribute__((aligned(16))) unsigned char smem[65536]
__global__ void __launch_bounds__(256) k_prologue(Params p) { SMEM_DECL; ph_prologue(p, smem); }
__global__ void __launch_bounds__(256) k_modulate0(Params p) { ph_modulate0(p); }
__global__ void __launch_bounds__(256) k_gemm_ev_in(Params p) { SMEM_DECL; gemm_phase(p.A16, D, p.wt_ev_in, 1024, EV_IN, RowMap{0}, EpiBf16{p.P, EV_IN, EV_IN}, smem); }
__global__ void __launch_bounds__(256) k_rowpost(Params p) { ph_rowpost(p); }
__global__ void __launch_bounds__(256) k_gemm_q(Params p) { SMEM_DECL; gemm_phase(p.P + C_CQ, EV_IN, p.wt_uq, 384, 768, RowMap{0}, EpiQ{p.Q16, p.rsq, p.rope_cos, p.rope_sin}, smem); }
__global__ void __launch_bounds__(256) k_gemm_kv(Params p) { SMEM_DECL; gemm_phase(p.P + C_CKV, EV_IN, p.wt_ukv, 256, 1024, RowMap{0}, EpiKV{p.K16, p.V16, p.rsq + R}, smem); }
__global__ void __launch_bounds__(256) k_attn(Params p) { SMEM_DECL; ph_attn_naive(p, smem, blockIdx.x, gridDim.x); }
__global__ void __launch_bounds__(256) k_gla(Params p) { SMEM_DECL; ph_gla_naive(p, smem); }
__global__ void __launch_bounds__(256) k_gemm_ev_out(Params p) { SMEM_DECL; gemm_phase(p.A16, D, p.wt_ev_out, 1024, 1024, RowMap{0}, EpiResid{p.x, p.ctx, p.mod, p.H, 0}, smem); }
__global__ void __launch_bounds__(256) k_ln_mod(Params p, int layer, int lat_only) { ph_ln_mod(p, layer, 0, lat_only); }
__global__ void __launch_bounds__(256) k_gemm_pq(Params p, int layer, int lat_only) { SMEM_DECL; gemm_phase(p.A16, D, p.wt_pq + (size_t)layer * 2048 * 1024, 1024, 2048, RowMap{lat_only}, EpiBf16{p.P, 2048, 2048}, smem); }
__global__ void __launch_bounds__(256) k_scores(Params p, int layer, int lat_only) { SMEM_DECL; ph_scores_naive(p, layer, lat_only, smem); }
__global__ void __launch_bounds__(256) k_combine(Params p, int lat_only) { ph_combine(p, lat_only); }
__global__ void __launch_bounds__(256) k_gather(Params p, int layer, int lat_only) { ph_gather_ln(p, layer, lat_only); }
__global__ void __launch_bounds__(256) k_gemm_od_in(Params p) { SMEM_DECL; gemm_phase(p.A16, D, p.wt_od_in, 1024, 2560, RowMap{0}, EpiBf16{p.P, 2560, 2560}, smem); }
__global__ void __launch_bounds__(256) k_rglru(Params p) { SMEM_DECL; ph_rglru_naive(p, smem); }
__global__ void __launch_bounds__(256) k_gemm_od_out(Params p) { SMEM_DECL; gemm_phase(p.P, 2560, p.wt_od_out, 1280, 1024, RowMap{1}, EpiResid{p.x, p.ctx, p.mod, p.H, 1}, smem); }

__global__ void __launch_bounds__(256) k_mega(Params p) {
    SMEM_DECL;
    cg::grid_group grid = cg::this_grid();
    ph_prologue(p, smem); grid.sync();
    ph_modulate0(p); grid.sync();
    gemm_phase(p.A16, D, p.wt_ev_in, 1024, EV_IN, RowMap{0}, EpiBf16{p.P, EV_IN, EV_IN}, smem); grid.sync();
    ph_rowpost(p); grid.sync();
    gemm_phase(p.P + C_CQ, EV_IN, p.wt_uq, 384, 768, RowMap{0}, EpiQ{p.Q16, p.rsq, p.rope_cos, p.rope_sin}, smem);
    gemm_phase(p.P + C_CKV, EV_IN, p.wt_ukv, 256, 1024, RowMap{0}, EpiKV{p.K16, p.V16, p.rsq + R}, smem); grid.sync();
    if (blockIdx.x < 32) ph_gla_naive(p, smem); else ph_attn_naive(p, smem, blockIdx.x - 32, gridDim.x - 32);
    grid.sync();
    gemm_phase(p.A16, D, p.wt_ev_out, 1024, 1024, RowMap{0}, EpiResid{p.x, p.ctx, p.mod, p.H, 0}, smem); grid.sync();
    ph_ln_mod(p, 0, 0, 0); grid.sync();
    gemm_phase(p.A16, D, p.wt_pq, 1024, 2048, RowMap{0}, EpiBf16{p.P, 2048, 2048}, smem); grid.sync();
    ph_scores_naive(p, 0, 0, smem); grid.sync();
    ph_combine(p, 0); grid.sync();
    ph_gather_ln(p, 0, 0); grid.sync();
    gemm_phase(p.A16, D, p.wt_od_in, 1024, 2560, RowMap{0}, EpiBf16{p.P, 2560, 2560}, smem); grid.sync();
    ph_rglru_naive(p, smem); grid.sync();
    gemm_phase(p.P, 2560, p.wt_od_out, 1280, 1024, RowMap{1}, EpiResid{p.x, p.ctx, p.mod, p.H, 1}, smem); grid.sync();
    ph_ln_mod(p, 1, 0, 1); grid.sync();
    gemm_phase(p.A16, D, p.wt_pq + (size_t)2048 * 1024, 1024, 2048, RowMap{1}, EpiBf16{p.P, 2048, 2048}, smem); grid.sync();
    ph_scores_naive(p, 1, 1, smem); grid.sync();
    ph_combine(p, 1); grid.sync();
    ph_gather_ln(p, 1, 1);
}

extern "C" void kernel_launch(void* const* d_in, const int* in_sizes, int n_in, void* d_out, int out_size, void* d_ws, size_t ws_size, hipStream_t stream) {
    Params p{};
    const float** f = (const float**)d_in;
    p.x = f[0]; p.c = f[1]; p.ctx = f[2]; p.c_ctx = f[3]; p.mod_w = f[4]; p.mod_b = f[5]; p.ln_g = f[6]; p.ln_b = f[7];
    p.ev_w_in = f[8]; p.ev_q_norm = f[9]; p.ev_kv_norm = f[10]; p.ev_w_uq = f[11]; p.ev_w_ukv = f[12]; p.ev_gla_wa2 = f[13]; p.ev_gla_ba = f[14]; p.ev_gla_norm = f[15]; p.ev_w_out = f[16];
    p.od_w_in = f[17]; p.od_conv_w = f[18]; p.od_conv_b = f[19]; p.od_gate_w = f[20]; p.od_gate_b = f[21]; p.od_lambda = f[22]; p.od_w_out = f[23];
    p.peer_wq = f[24]; p.peer_k1 = f[25]; p.peer_k2 = f[26]; p.peer_u = f[27]; p.peer_v = f[28];
    p.out = (float*)d_out;
    unsigned char* w = (unsigned char*)d_ws; size_t off = 0;
    auto take = [&](size_t bytes) { unsigned char* r = w + off; off += (bytes + 255) & ~(size_t)255; return r; };
    p.wt_ev_in = (bf16_t*)take((size_t)EV_IN * 1024 * 2); p.wt_uq = (bf16_t*)take(768 * 384 * 2); p.wt_ukv = (bf16_t*)take(1024 * 256 * 2);
    p.wt_ev_out = (bf16_t*)take(1024 * 1024 * 2); p.wt_od_in = (bf16_t*)take(2560 * 1024 * 2); p.wt_gate = (bf16_t*)take(40 * 16384 * 2);
    p.wt_od_out = (bf16_t*)take(1024 * 1280 * 2); p.wt_pq = (bf16_t*)take((size_t)2 * 2048 * 1024 * 2); p.wt_k = (bf16_t*)take(4 * 16384 * 2);
    p.mod = (float*)take(2 * 9 * 6144 * 4); p.rope_cos = (float*)take(SEQ * 16 * 4); p.rope_sin = (float*)take(SEQ * 16 * 4); p.rsq = (float*)take((size_t)2 * R * 4);
    p.H = (float*)take((size_t)R * D * 4);
    p.Q16 = (bf16_t*)p.H; p.K16 = p.Q16 + (size_t)R * 768; p.V16 = p.K16 + (size_t)R * 768;
    p.A16 = (bf16_t*)take((size_t)R * D * 2);
    p.P = (bf16_t*)take((size_t)R * 2560 * 2);
    p.G = take((size_t)94371840);
    if (off > ws_size) { fprintf(stderr, "workspace too small: need %zu have %zu\n", off, ws_size); return; }
    static int grid_blocks = 0;
    if (!grid_blocks) {
        int dev = 0, cus = 0, per_cu = 0;
        (void)hipGetDevice(&dev);
        (void)hipDeviceGetAttribute(&cus, hipDeviceAttributeMultiprocessorCount, dev);
        (void)hipOccupancyMaxActiveBlocksPerMultiprocessor(&per_cu, k_mega, 256, 0);
        if (per_cu > 2) per_cu = 2;
        if (per_cu < 1) per_cu = 1;
        grid_blocks = cus * per_cu;
    }
    void* args[] = {&p};
    hipError_t e = hipLaunchCooperativeKernel((void*)k_mega, dim3(grid_blocks), dim3(256), args, 0, stream);
    if (e != hipSuccess) fprintf(stderr, "cooperative launch failed: %s (grid %d)\n", hipGetErrorString(e), grid_blocks);
}
```

```cpp
#include <hip/hip_runtime.h>
#include <hip/hip_cooperative_groups.h>
#include <cstdio>
#include <cstdint>

namespace cg = cooperative_groups;
typedef unsigned short bf16_t;
typedef short bf16x8 __attribute__((ext_vector_type(8)));
typedef float f32x4 __attribute__((ext_vector_type(4)));
typedef unsigned u32x4 __attribute__((ext_vector_type(4)));
typedef unsigned u32x2 __attribute__((ext_vector_type(2)));

constexpr int D = 1024, NB = 8, SEQ = 4096, CTX = 256, PB = SEQ + CTX  , R = NB * PB  ;
constexpr int EV_IN = 2240, RGW = 1280;
constexpr int C_CQ = 0, C_CKV = 384, C_KPE = 640, C_GQ = 672, C_GK = 928, C_GV = 1184, C_GG = 1696, C_GAF = 2208;
constexpr float LN_EPS = 1e-6f, ALPHA = 1.41421356237f, MLA_SCALE = 0.10206207261596577f  ;
constexpr int PEER_N = 16384;

struct Params {
    const float *x, *c, *ctx, *c_ctx, *mod_w, *mod_b, *ln_g, *ln_b;
    const float *ev_w_in, *ev_q_norm, *ev_kv_norm, *ev_w_uq, *ev_w_ukv, *ev_gla_wa2, *ev_gla_ba, *ev_gla_norm, *ev_w_out;
    const float *od_w_in, *od_conv_w, *od_conv_b, *od_gate_w, *od_gate_b, *od_lambda, *od_w_out;
    const float *peer_wq, *peer_k1, *peer_k2, *peer_u, *peer_v;
    float* out;
    bf16_t *wt_ev_in, *wt_uq, *wt_ukv, *wt_ev_out, *wt_od_in, *wt_gate, *wt_od_out, *wt_pq, *wt_k;
    float *mod, *rope_cos, *rope_sin, *rsq;
    float* H; bf16_t *Q16, *K16, *V16;
    bf16_t* A16; bf16_t* P; unsigned char* G;
};

__device__ __forceinline__ bf16_t f2bf(float f) { unsigned u = __float_as_uint(f); u += 0x7fffu + ((u >> 16) & 1u); return (bf16_t)(u >> 16); }
__device__ __forceinline__ float bf2f(bf16_t h) { return __uint_as_float(((unsigned)h) << 16); }
__device__ __forceinline__ unsigned pack2(float a, float b) { unsigned r; asm volatile("v_cvt_pk_bf16_f32 %0, %1, %2" : "=v"(r) : "v"(a), "v"(b)); return r; }
__device__ __forceinline__ float silu_f(float x) { return x / (1.0f + expf(-x)); }
__device__ __forceinline__ float sigmoid_f(float x) { return 1.0f / (1.0f + expf(-x)); }
__device__ __forceinline__ float gelu_f(float x) { return 0.5f * x * (1.0f + erff(x * 0.70710678118654752f)); }
__device__ __forceinline__ float wave_sum(float v) {
#pragma unroll
    for (int o = 32; o > 0; o >>= 1) v += __shfl_xor(v, o);
    return v;
}
__device__ __forceinline__ int mod_row(int r) { const int b = r / PB, p = r - b * PB; return p < CTX ? 8 : b; }
__device__ __forceinline__ const float* in_row(const Params& P_, int r) {
    const int b = r / PB, p = r - b * PB;
    return p < CTX ? P_.ctx + ((size_t)b * CTX + p) * D : P_.x + ((size_t)b * SEQ + (p - CTX)) * D;
}

__device__ void tconv_tile(const float* __restrict__ W, int K, int N, bf16_t* __restrict__ Wt, const float* __restrict__ rowscale, int tile, float* sm) {
    const int ntn = N / 64, tk = tile / ntn, tn = tile % ntn, tid = threadIdx.x;
#pragma unroll
    for (int i = 0; i < 4; ++i) {
        const int k = (tid >> 4) + 16 * i;
        f32x4 v = *(const f32x4*)(W + (size_t)(tk * 64 + k) * N + tn * 64 + (tid & 15) * 4);
        const float s = rowscale ? rowscale[tk * 64 + k] : 1.0f;
#pragma unroll
        for (int q = 0; q < 4; ++q) sm[k * 65 + (tid & 15) * 4 + q] = v[q] * s;
    }
    __syncthreads();
    const int n = tid >> 2, kc = tid & 3;
    unsigned w[8];
#pragma unroll
    for (int kk = 0; kk < 8; ++kk) w[kk] = pack2(sm[(kc * 16 + 2 * kk) * 65 + n], sm[(kc * 16 + 2 * kk + 1) * 65 + n]);
    bf16_t* dst = Wt + (size_t)(tn * 64 + n) * K + tk * 64 + kc * 16;
    *(u32x4*)dst = (u32x4){w[0], w[1], w[2], w[3]};
    *(u32x4*)(dst + 8) = (u32x4){w[4], w[5], w[6], w[7]};
    __syncthreads();
}
__device__ void tconv_all(const float* W, int K, int N, bf16_t* Wt, const float* rowscale, float* sm) {
    const int nt = (K / 64) * (N / 64);
    for (int t = blockIdx.x; t < nt; t += gridDim.x) tconv_tile(W, K, N, Wt, rowscale, t, sm);
}

__device__ void ph_prologue(const Params& p, unsigned char* smem) {
    float* sm = (float*)smem;
    tconv_all(p.ev_w_in, 1024, EV_IN, p.wt_ev_in, nullptr, sm);
    tconv_all(p.ev_w_uq, 384, 768, p.wt_uq, p.ev_q_norm, sm);
    tconv_all(p.ev_w_ukv, 256, 1024, p.wt_ukv, p.ev_kv_norm, sm);
    tconv_all(p.ev_w_out, 1024, 1024, p.wt_ev_out, nullptr, sm);
    tconv_all(p.od_w_in, 1024, 2560, p.wt_od_in, nullptr, sm);
    for (int g = 0; g < 40; ++g) tconv_all(p.od_gate_w + (size_t)g * 16384, 128, 128, p.wt_gate + (size_t)g * 16384, nullptr, sm);
    tconv_all(p.od_w_out, 1280, 1024, p.wt_od_out, nullptr, sm);
    for (int l = 0; l < 2; ++l) tconv_all(p.peer_wq + (size_t)l * 1024 * 2048, 1024, 2048, p.wt_pq + (size_t)l * 1024 * 2048, nullptr, sm);
    for (int i = blockIdx.x * 256 + threadIdx.x; i < 2 * 2 * 16384; i += gridDim.x * 256) {
        const int l = i / 32768, h = (i / 16384) & 1, e = i & 16383;
        p.wt_k[i] = f2bf((h ? p.peer_k2 : p.peer_k1)[(size_t)l * 16384 + e]);
    }
    for (int i = blockIdx.x * 256 + threadIdx.x; i < SEQ * 16; i += gridDim.x * 256) {
        const int s = i >> 4, f = i & 15;
        const float pos = (float)(f < 8 ? (s >> 6) : (s & 63));
        const float inv = powf(10000.0f, -(float)(f & 7) / 8.0f);
        const float ang = pos * inv;
        p.rope_cos[i] = cosf(ang); p.rope_sin[i] = sinf(ang);
    }
    float* sc = sm;
    for (int u = blockIdx.x; u < 2 * 96; u += gridDim.x) {
        const int l = u / 96, c0 = (u % 96) * 64, tid = threadIdx.x;
        __syncthreads();
        for (int i = tid; i < 9 * 1024; i += 256) { const int rr = i >> 10, k = i & 1023; sc[i] = silu_f(rr < 8 ? p.c[rr * 1024 + k] : p.c_ctx[k]); }
        __syncthreads();
        const int col = c0 + (tid & 63), kq = tid >> 6;
        float acc[9];
#pragma unroll
        for (int rr = 0; rr < 9; ++rr) acc[rr] = 0.f;
        const float* w = p.mod_w + (size_t)l * 1024 * 6144 + col;
        for (int k = kq * 256; k < kq * 256 + 256; ++k) {
            const float wv = w[(size_t)k * 6144];
#pragma unroll
            for (int rr = 0; rr < 9; ++rr) acc[rr] += sc[rr * 1024 + k] * wv;
        }
        __syncthreads();
        float* red = sm + 9 * 1024;
#pragma unroll
        for (int rr = 0; rr < 9; ++rr) red[(kq * 9 + rr) * 64 + (tid & 63)] = acc[rr];
        __syncthreads();
        for (int i = tid; i < 9 * 64; i += 256) {
            const int rr = i >> 6, cc = i & 63;
            const float s = red[(0 * 9 + rr) * 64 + cc] + red[(1 * 9 + rr) * 64 + cc] + red[(2 * 9 + rr) * 64 + cc] + red[(3 * 9 + rr) * 64 + cc];
            p.mod[((size_t)l * 9 + rr) * 6144 + c0 + cc] = s + p.mod_b[l * 6144 + c0 + cc];
        }
    }
}

__device__ void ph_modulate0(const Params& p) {
    const int wid = threadIdx.x >> 6, lane = threadIdx.x & 63;
    for (int u = blockIdx.x; u < R / 4; u += gridDim.x) {
        const int r = u * 4 + wid;
        const float* src = in_row(p, r);
        const float* md = p.mod + (size_t)(0 * 9 + mod_row(r)) * 6144;
#pragma unroll
        for (int q = 0; q < 4; ++q) {
            const int c = q * 256 + lane * 4;
            const f32x4 h = *(const f32x4*)(src + c), sh = *(const f32x4*)(md + c), scl = *(const f32x4*)(md + 1024 + c);
            const f32x4 v = h * (1.0f + scl) + sh;
            *(u32x2*)(p.A16 + (size_t)r * D + c) = (u32x2){pack2(v[0], v[1]), pack2(v[2], v[3])};
        }
    }
}

constexpr int GBK = 64, GLDS = 72  ;
struct RowMap { int lat_only; __device__ __forceinline__ int ntiles() const { return lat_only ? 256 : 272; }
    __device__ __forceinline__ int row0(int t) const { return lat_only ? (t >> 5) * PB + CTX + (t & 31) * 128 : t * 128; } };

template <class Epi>
__device__ void gemm_phase(const bf16_t* __restrict__ A, int lda, const bf16_t* __restrict__ Bt, int K, int N, RowMap rm, const Epi& epi, unsigned char* smem) {
    bf16_t* sA = (bf16_t*)smem; bf16_t* sB = sA + 128 * GLDS;
    const int tid = threadIdx.x, lane = tid & 63, wid = tid >> 6, wm = wid >> 1, wn = wid & 1, fr = lane & 15, fq = lane >> 4;
    const int ntn = (N + 127) / 128, nunits = rm.ntiles() * ntn, nk = K / GBK;
    for (int u = blockIdx.x; u < nunits; u += gridDim.x) {
        const int tm = u / ntn, tn = u % ntn, m0 = rm.row0(tm), n0 = tn * 128;
        f32x4 acc[4][4];
#pragma unroll
        for (int i = 0; i < 4; ++i)
#pragma unroll
            for (int j = 0; j < 4; ++j) acc[i][j] = (f32x4){0.f, 0.f, 0.f, 0.f};
        u32x4 ra[4], rb[4];
        auto gload = [&](int kt) {
#pragma unroll
            for (int i = 0; i < 4; ++i) {
                const int id = tid + 256 * i, row = id >> 3, ch = id & 7;
                ra[i] = *(const u32x4*)(A + (size_t)(m0 + row) * lda + kt * GBK + ch * 8);
                int brow = n0 + row; brow = brow < N ? brow : N - 1;
                rb[i] = *(const u32x4*)(Bt + (size_t)brow * K + kt * GBK + ch * 8);
            }
        };
        auto lstore = [&]() {
#pragma unroll
            for (int i = 0; i < 4; ++i) {
                const int id = tid + 256 * i, row = id >> 3, ch = id & 7;
                *(u32x4*)(sA + row * GLDS + ch * 8) = ra[i];
                *(u32x4*)(sB + row * GLDS + ch * 8) = rb[i];
            }
        };
        gload(0);
        __syncthreads();
        lstore();
        __syncthreads();
        for (int kt = 0; kt < nk; ++kt) {
            if (kt + 1 < nk) gload(kt + 1);
#pragma unroll
            for (int ks = 0; ks < 2; ++ks) {
                bf16x8 af[4], bfr[4];
#pragma unroll
                for (int i = 0; i < 4; ++i) af[i] = *(const bf16x8*)(sA + (wm * 64 + i * 16 + fr) * GLDS + ks * 32 + fq * 8);
#pragma unroll
                for (int j = 0; j < 4; ++j) bfr[j] = *(const bf16x8*)(sB + (wn * 64 + j * 16 + fr) * GLDS + ks * 32 + fq * 8);
#pragma unroll
                for (int i = 0; i < 4; ++i)
#pragma unroll
                    for (int j = 0; j < 4; ++j) acc[i][j] = __builtin_amdgcn_mfma_f32_16x16x32_bf16(bfr[j], af[i], acc[i][j], 0, 0, 0);
            }
            __syncthreads();
            if (kt + 1 < nk) { lstore(); __syncthreads(); }
        }
        epi(acc, m0 + wm * 64, n0 + wn * 64, fr, fq);
    }
}

struct EpiBf16 {
    bf16_t* C; int ldc, N;
    __device__ __forceinline__ void operator()(const f32x4 (&acc)[4][4], int mb, int nb, int fr, int fq) const {
#pragma unroll
        for (int i = 0; i < 4; ++i)
#pragma unroll
            for (int j = 0; j < 4; ++j) {
                const int m = mb + i * 16 + fr, n = nb + j * 16 + 4 * fq;
                if (n < N) *(u32x2*)(C + (size_t)m * ldc + n) = (u32x2){pack2(acc[i][j][0], acc[i][j][1]), pack2(acc[i][j][2], acc[i][j][3])};
            }
    }
};
struct EpiQ {
    bf16_t* Q; const float *rsq, *rc, *rs;
    __device__ __forceinline__ void operator()(const f32x4 (&acc)[4][4], int mb, int nb, int fr, int fq) const {
#pragma unroll
        for (int i = 0; i < 4; ++i) {
            const int m = mb + i * 16 + fr, b = m / PB, pp = m - b * PB;
            const float sc = rsq[m] * MLA_SCALE;
#pragma unroll
            for (int j = 0; j < 4; j += 2) {
                const int n = nb + j * 16 + 4 * fq;
                f32x4 v0 = acc[i][j] * sc, v1 = acc[i][j + 1] * sc;
                const int d = n % 96;
                if (d >= 64 && pp >= CTX) {
                    const int s = pp - CTX, f = (d - 64) + 0;
                    const f32x4 cs = *(const f32x4*)(rc + s * 16 + f), sn = *(const f32x4*)(rs + s * 16 + f);
                    const f32x4 o0 = v0 * cs - v1 * sn, o1 = v0 * sn + v1 * cs; v0 = o0; v1 = o1;
                }
                *(u32x2*)(Q + (size_t)m * 768 + n) = (u32x2){pack2(v0[0], v0[1]), pack2(v0[2], v0[3])};
                *(u32x2*)(Q + (size_t)m * 768 + n + 16) = (u32x2){pack2(v1[0], v1[1]), pack2(v1[2], v1[3])};
            }
        }
    }
};
struct EpiKV {
    bf16_t *Kd, *Vd; const float* rsq;
    __device__ __forceinline__ void operator()(const f32x4 (&acc)[4][4], int mb, int nb, int fr, int fq) const {
#pragma unroll
        for (int i = 0; i < 4; ++i) {
            const int m = mb + i * 16 + fr; const float sc = rsq[m];
#pragma unroll
            for (int j = 0; j < 4; ++j) {
                const int n = nb + j * 16 + 4 * fq, hd = n >> 7, d = n & 127;
                const f32x4 v = acc[i][j] * sc;
                bf16_t* dst = d < 64 ? Kd + (size_t)m * 768 + hd * 96 + d : Vd + (size_t)m * 512 + hd * 64 + (d - 64);
                *(u32x2*)dst = (u32x2){pack2(v[0], v[1]), pack2(v[2], v[3])};
            }
        }
    }
};
struct EpiResid {
    const float *x, *ctx, *mod; float* H; int layer;
    __device__ __forceinline__ void operator()(const f32x4 (&acc)[4][4], int mb, int nb, int fr, int fq) const {
#pragma unroll
        for (int i = 0; i < 4; ++i) {
            const int m = mb + i * 16 + fr, b = m / PB, pp = m - b * PB;
            const float* hin = layer == 0 ? (pp < CTX ? ctx + ((size_t)b * CTX + pp) * D : x + ((size_t)b * SEQ + (pp - CTX)) * D) : H + (size_t)m * D;
            const float* gate = mod + ((size_t)layer * 9 + (pp < CTX ? 8 : b)) * 6144 + 2 * 1024;
#pragma unroll
            for (int j = 0; j < 4; ++j) {
                const int n = nb + j * 16 + 4 * fq;
                const f32x4 h = *(const f32x4*)(hin + n), g = *(const f32x4*)(gate + n);
                *(f32x4*)(H + (size_t)m * D + n) = ALPHA * h + g * acc[i][j];
            }
        }
    }
};

__device__ void ph_rowpost(const Params& p) {
    const int wid = threadIdx.x >> 6, lane = threadIdx.x & 63;
    for (int u = blockIdx.x; u < R / 4; u += gridDim.x) {
        const int r = u * 4 + wid, b = r / PB, pp = r - b * PB;
        const bf16_t* row = p.P + (size_t)r * EV_IN;
        float sq = 0.f, skv = 0.f;
#pragma unroll
        for (int i = 0; i < 10; ++i) { const float v = bf2f(row[lane + 64 * i]); if (i < 6) sq += v * v; else skv += v * v; }
        sq = wave_sum(sq); skv = wave_sum(skv);
        if (lane == 0) { p.rsq[r] = rsqrtf(sq / 384.0f + LN_EPS); p.rsq[R + r] = rsqrtf(skv / 256.0f + LN_EPS); }
        if (lane < 16) {
            float x1 = bf2f(row[C_KPE + lane]), x2 = bf2f(row[C_KPE + 16 + lane]);
            if (pp >= CTX) { const int s = pp - CTX; const float cs = p.rope_cos[s * 16 + lane], sn = p.rope_sin[s * 16 + lane];
                const float o1 = x1 * cs - x2 * sn, o2 = x1 * sn + x2 * cs; x1 = o1; x2 = o2; }
            const bf16_t b1 = f2bf(x1), b2 = f2bf(x2);
#pragma unroll
            for (int hd = 0; hd < 8; ++hd) { p.K16[(size_t)r * 768 + hd * 96 + 64 + lane] = b1; p.K16[(size_t)r * 768 + hd * 96 + 80 + lane] = b2; }
        }
    }
}

__device__ void ph_attn_naive(const Params& p, unsigned char* smem, int bid, int nblk) {
    float* Ks = (float*)smem;
    float* Vs = Ks + 16 * 96;
    const int tid = threadIdx.x;
    for (int u = bid; u < 1024 + 64; u += nblk) {
        int b, hd, q0, nkeys;
        if (u < 1024) { b = u >> 7; hd = (u >> 4) & 7; q0 = CTX + (u & 15) * 256; nkeys = PB; }
        else { const int v = u - 1024; b = v >> 3; hd = v & 7; q0 = 0; nkeys = CTX; }
        const int r = b * PB + q0 + tid;
        unsigned qp[48]; float o[64];
#pragma unroll
        for (int d = 0; d < 48; d += 4) { const u32x4 w = *(const u32x4*)(p.Q16 + (size_t)r * 768 + hd * 96 + 2 * d); qp[d] = w[0]; qp[d + 1] = w[1]; qp[d + 2] = w[2]; qp[d + 3] = w[3]; }
#pragma unroll
        for (int d = 0; d < 64; ++d) o[d] = 0.f;
        float m = -1e30f, l = 0.f;
        for (int k0 = 0; k0 < nkeys; k0 += 16) {
            __syncthreads();
            for (int i = tid; i < 16 * 96; i += 256) { const int kk = i / 96, d = i % 96; Ks[i] = bf2f(p.K16[(size_t)(b * PB + k0 + kk) * 768 + hd * 96 + d]); }
            for (int i = tid; i < 16 * 64; i += 256) { const int kk = i >> 6, d = i & 63; Vs[i] = bf2f(p.V16[(size_t)(b * PB + k0 + kk) * 512 + hd * 64 + d]); }
            __syncthreads();
            float s[16]; float mx = -1e30f;
#pragma unroll
            for (int kk = 0; kk < 16; ++kk) {
                float a = 0.f;
#pragma unroll
                for (int d = 0; d < 96; d += 4) {
                    const f32x4 kv = *(const f32x4*)(Ks + kk * 96 + d);
                    a += __uint_as_float(qp[d / 2] << 16) * kv[0] + __uint_as_float(qp[d / 2] & 0xffff0000u) * kv[1]
                       + __uint_as_float(qp[d / 2 + 1] << 16) * kv[2] + __uint_as_float(qp[d / 2 + 1] & 0xffff0000u) * kv[3];
                }
                s[kk] = a; mx = fmaxf(mx, a);
            }
            const float mn = fmaxf(m, mx), al = expf(m - mn);
            l *= al;
#pragma unroll
            for (int d = 0; d < 64; ++d) o[d] *= al;
#pragma unroll
            for (int kk = 0; kk < 16; ++kk) {
                const float pr = expf(s[kk] - mn); l += pr;
#pragma unroll
                for (int d = 0; d < 64; d += 4) { const f32x4 vv = *(const f32x4*)(Vs + kk * 64 + d); o[d] += pr * vv[0]; o[d + 1] += pr * vv[1]; o[d + 2] += pr * vv[2]; o[d + 3] += pr * vv[3]; }
            }
            m = mn;
        }
        const float il = 1.0f / l;
#pragma unroll
        for (int d = 0; d < 64; d += 2) *(unsigned*)(p.A16 + (size_t)r * D + hd * 64 + d) = pack2(o[d] * il, o[d + 1] * il);
    }
}

__device__ void ph_gla_naive(const Params& p, unsigned char* smem) {
    float* sq = (float*)smem;
    float* sk = sq + 16 * 64;
    float* sa = sk + 16 * 64;
    float* sv = sa + 16 * 64;
    float* sop = sv + 16 * 128;
    float* sga = sop + 2 * 16 * 128;
    float* OF = (float*)p.G;
    const int tid = threadIdx.x, j = tid & 127, half = tid >> 7, lane = tid & 63, wid = tid >> 6;
    for (int u = blockIdx.x; u < 32; u += gridDim.x) {
        const int b = u >> 2, hd = u & 3;
        for (int dir = 0; dir < 2; ++dir) {
            float S[32];
#pragma unroll
            for (int dd = 0; dd < 32; ++dd) S[dd] = 0.f;
            const float* wa = p.ev_gla_wa2 + (size_t)dir * 16 * 256;
            const float* ba = p.ev_gla_ba + dir * 256;
            for (int bi = 0; bi < PB / 16; ++bi) {
                __syncthreads();
                for (int e = tid; e < 16 * 64; e += 256) {
                    const int i = e >> 6, d = e & 63, st = bi * 16 + i;
                    const int pp = dir == 0 ? st : (st < CTX ? CTX - 1 - st : PB + CTX - 1 - st);
                    const bf16_t* row = p.P + (size_t)(b * PB + pp) * EV_IN;
                    sq[e] = bf2f(row[C_GQ + hd * 64 + d]) * 0.125f;
                    sk[e] = bf2f(row[C_GK + hd * 64 + d]);
                }
                for (int e = tid; e < 16 * 128; e += 256) {
                    const int i = e >> 7, jj = e & 127, st = bi * 16 + i;
                    const int pp = dir == 0 ? st : (st < CTX ? CTX - 1 - st : PB + CTX - 1 - st);
                    sv[e] = bf2f(p.P[(size_t)(b * PB + pp) * EV_IN + C_GV + hd * 128 + jj]);
                }
                {
                    const int i = tid >> 4, g = tid & 15, st = bi * 16 + i;
                    const int pp = dir == 0 ? st : (st < CTX ? CTX - 1 - st : PB + CTX - 1 - st);
                    sga[tid] = bf2f(p.P[(size_t)(b * PB + pp) * EV_IN + C_GAF + dir * 16 + g]);
                }
                __syncthreads();
                for (int e = tid; e < 16 * 64; e += 256) {
                    const int i = e >> 6, d = e & 63;
                    float z = ba[hd * 64 + d];
#pragma unroll
                    for (int g = 0; g < 16; ++g) z += sga[i * 16 + g] * wa[g * 256 + hd * 64 + d];
                    const float ls = fminf(z, 0.f) - log1pf(expf(-fabsf(z)));
                    sa[e] = expf(ls * (1.0f / 16.0f));
                }
                __syncthreads();
                for (int i = 0; i < 16; ++i) {
                    const float vj = sv[i * 128 + j]; float op = 0.f;
#pragma unroll
                    for (int dd = 0; dd < 32; ++dd) { const int d = half * 32 + dd; S[dd] = sa[i * 64 + d] * S[dd] + sk[i * 64 + d] * vj; op += sq[i * 64 + d] * S[dd]; }
                    sop[(half * 16 + i) * 128 + j] = op;
                }
                __syncthreads();
                if (dir == 0) {
                    for (int e = tid; e < 16 * 128; e += 256) {
                        const int i = e >> 7, jj = e & 127, st = bi * 16 + i;
                        OF[(size_t)(b * PB + st) * 512 + hd * 128 + jj] = sop[i * 128 + jj] + sop[(16 + i) * 128 + jj];
                    }
                } else {
#pragma unroll
                    for (int ii = 0; ii < 4; ++ii) {
                        const int i = wid * 4 + ii, st = bi * 16 + i;
                        const int pp = st < CTX ? CTX - 1 - st : PB + CTX - 1 - st;
                        const size_t r = (size_t)b * PB + pp;
                        const float t0 = OF[r * 512 + hd * 128 + lane] + sop[i * 128 + lane] + sop[(16 + i) * 128 + lane];
                        const float t1 = OF[r * 512 + hd * 128 + 64 + lane] + sop[i * 128 + 64 + lane] + sop[(16 + i) * 128 + 64 + lane];
                        const float ss = wave_sum(t0 * t0 + t1 * t1);
                        const float rs = rsqrtf(ss / 128.0f + LN_EPS);
                        const float g0 = bf2f(p.P[r * EV_IN + C_GG + hd * 128 + lane]), g1 = bf2f(p.P[r * EV_IN + C_GG + hd * 128 + 64 + lane]);
                        p.A16[r * D + 512 + hd * 128 + lane] = f2bf(t0 * rs * p.ev_gla_norm[hd * 128 + lane] * silu_f(g0));
                        p.A16[r * D + 512 + hd * 128 + 64 + lane] = f2bf(t1 * rs * p.ev_gla_norm[hd * 128 + 64 + lane] * silu_f(g1));
                    }
                }
            }
        }
    }
}

__device__ void ph_ln_mod(const Params& p, int layer, int lnidx, int lat_only) {
    const int wid = threadIdx.x >> 6, lane = threadIdx.x & 63;
    const int nrows = lat_only ? NB * SEQ : R;
    const float* g = p.ln_g + (size_t)(layer * 2 + lnidx) * D; const float* bb = p.ln_b + (size_t)(layer * 2 + lnidx) * D;
    for (int u = blockIdx.x; u < nrows / 4; u += gridDim.x) {
        const int rr = u * 4 + wid, r = lat_only ? (rr >> 12) * PB + CTX + (rr & 4095) : rr;
        float* hrow = p.H + (size_t)r * D;
        f32x4 v[4]; float s = 0.f;
#pragma unroll
        for (int q = 0; q < 4; ++q) { v[q] = *(const f32x4*)(hrow + q * 256 + lane * 4); s += v[q][0] + v[q][1] + v[q][2] + v[q][3]; }
        const float mu = wave_sum(s) * (1.0f / 1024.0f);
        float ss = 0.f;
#pragma unroll
        for (int q = 0; q < 4; ++q) { v[q] = v[q] - mu; ss += v[q][0] * v[q][0] + v[q][1] * v[q][1] + v[q][2] * v[q][2] + v[q][3] * v[q][3]; }
        const float rstd = rsqrtf(wave_sum(ss) * (1.0f / 1024.0f) + LN_EPS);
        const float* md = p.mod + ((size_t)layer * 9 + mod_row(r)) * 6144;
#pragma unroll
        for (int q = 0; q < 4; ++q) {
            const int c = q * 256 + lane * 4;
            const f32x4 h = v[q] * rstd * *(const f32x4*)(g + c) + *(const f32x4*)(bb + c);
            *(f32x4*)(hrow + c) = h;
            const f32x4 a = h * (1.0f + *(const f32x4*)(md + 4 * 1024 + c)) + *(const f32x4*)(md + 3 * 1024 + c);
            *(u32x2*)(p.A16 + (size_t)r * D + c) = (u32x2){pack2(a[0], a[1]), pack2(a[2], a[3])};
        }
    }
}

__device__ void ph_scores_naive(const Params& p, int layer, int lat_only, unsigned char* smem) {
    float* ks = (float*)smem;
    const bf16_t* QP = p.P;
    float* T = (float*)p.G;
    const int tid = threadIdx.x, rl = tid >> 3, hd = tid & 7;
    const int nrows = lat_only ? NB * SEQ : R;
    for (int u = blockIdx.x; u < nrows / 32; u += gridDim.x) {
        const int rr = u * 32 + rl, r = lat_only ? (rr >> 12) * PB + CTX + (rr & 4095) : rr;
        for (int half = 0; half < 2; ++half) {
            __syncthreads();
            const bf16_t* kk = p.wt_k + ((size_t)layer * 2 + half) * 16384;
            for (int i = tid; i < 16384; i += 256) ks[i] = bf2f(kk[i]);
            __syncthreads();
            float q[128];
#pragma unroll
            for (int d = 0; d < 128; d += 8) {
                const u32x4 w = *(const u32x4*)(QP + (size_t)r * 2048 + hd * 256 + half * 128 + d);
#pragma unroll
                for (int e = 0; e < 4; ++e) { q[d + 2 * e] = __uint_as_float(w[e] << 16); q[d + 2 * e + 1] = __uint_as_float(w[e] & 0xffff0000u); }
            }
            float top[16];
#pragma unroll
            for (int t = 0; t < 16; ++t) top[t] = -3.0e38f;
            for (int k = 0; k < 128; ++k) {
                float s = 0.f;
#pragma unroll
                for (int d = 0; d < 128; d += 4) { const f32x4 kv = *(const f32x4*)(ks + k * 128 + d); s += q[d] * kv[0] + q[d + 1] * kv[1] + q[d + 2] * kv[2] + q[d + 3] * kv[3]; }
                float xv = __uint_as_float((__float_as_uint(s) & ~127u) | (unsigned)k);
#pragma unroll
                for (int t = 0; t < 16; ++t) { const float hi = fmaxf(top[t], xv); xv = fminf(top[t], xv); top[t] = hi; }
            }
            float* dst = T + (((size_t)r * 8 + hd) * 2 + half) * 16;
#pragma unroll
            for (int t = 0; t < 16; t += 4) *(f32x4*)(dst + t) = (f32x4){top[t], top[t + 1], top[t + 2], top[t + 3]};
        }
    }
}

__device__ void ph_combine(const Params& p, int lat_only) {
    const float* T = (const float*)p.G;
    int* EIDX = (int*)(p.G + (size_t)R * 8 * 2 * 16 * 4);
    float* EG = (float*)(p.G + (size_t)R * 8 * 2 * 16 * 4 + (size_t)R * 8 * 16 * 4);
    const int nrows = lat_only ? NB * SEQ : R;
    for (int g = blockIdx.x * 256 + threadIdx.x; g < nrows * 8; g += gridDim.x * 256) {
        const int rr = g >> 3, hd = g & 7, r = lat_only ? (rr >> 12) * PB + CTX + (rr & 4095) : rr;
        const float* t = T + ((size_t)r * 8 + hd) * 32;
        float t2[16];
#pragma unroll
        for (int i = 0; i < 16; ++i) t2[i] = __uint_as_float(__float_as_uint(t[16 + i]) & ~127u);
        float top[16];
#pragma unroll
        for (int k = 0; k < 16; ++k) top[k] = -3.0e38f;
        for (int i = 0; i < 16; ++i) {
            const float t1i = __uint_as_float(__float_as_uint(t[i]) & ~127u);
#pragma unroll
            for (int j = 0; j < 16; ++j) {
                float xv = __uint_as_float((__float_as_uint(t1i + t2[j]) & ~255u) | (unsigned)(i * 16 + j));
#pragma unroll
                for (int k = 0; k < 16; ++k) { const float hi = fmaxf(top[k], xv); xv = fminf(top[k], xv); top[k] = hi; }
            }
        }
        float e[16], sum = 0.f; const float mx = __uint_as_float(__float_as_uint(top[0]) & ~255u);
#pragma unroll
        for (int k = 0; k < 16; ++k) { e[k] = expf(__uint_as_float(__float_as_uint(top[k]) & ~255u) - mx); sum += e[k]; }
        const float inv = 1.0f / sum;
#pragma unroll
        for (int k = 0; k < 16; ++k) {
            const unsigned code = __float_as_uint(top[k]) & 255u, i = code >> 4, j = code & 15;
            const unsigned i1 = __float_as_uint(t[i]) & 127u, i2 = __float_as_uint(t[16 + j]) & 127u;
            EIDX[((size_t)r * 8 + hd) * 16 + k] = (int)(i1 * 128 + i2);
            EG[((size_t)r * 8 + hd) * 16 + k] = e[k] * inv;
        }
    }
}

__device__ void ph_gather_ln(const Params& p, int layer, int lat_only) {
    const int wid = threadIdx.x >> 6, lane = threadIdx.x & 63;
    const int* EIDX = (const int*)(p.G + (size_t)R * 8 * 2 * 16 * 4);
    const float* EG = (const float*)(p.G + (size_t)R * 8 * 2 * 16 * 4 + (size_t)R * 8 * 16 * 4);
    const float* U = p.peer_u + (size_t)layer * PEER_N * D; const float* V = p.peer_v + (size_t)layer * PEER_N * D;
    const float* g = p.ln_g + (size_t)(layer * 2 + 1) * D; const float* bb = p.ln_b + (size_t)(layer * 2 + 1) * D;
    const int nrows = lat_only ? NB * SEQ : R;
    for (int u = blockIdx.x; u < nrows / 4; u += gridDim.x) {
        const int rr = u * 4 + wid, r = lat_only ? (rr >> 12) * PB + CTX + (rr & 4095) : rr;
        f32x4 hm[4], acc[4];
#pragma unroll
        for (int q = 0; q < 4; ++q) {
            const u32x2 w = *(const u32x2*)(p.A16 + (size_t)r * D + q * 256 + lane * 4);
            hm[q] = (f32x4){__uint_as_float(w[0] << 16), __uint_as_float(w[0] & 0xffff0000u), __uint_as_float(w[1] << 16), __uint_as_float(w[1] & 0xffff0000u)};
            acc[q] = (f32x4){0.f, 0.f, 0.f, 0.f};
        }
        for (int e0 = 0; e0 < 128; e0 += 2) {
            const int ea = EIDX[(size_t)r * 128 + e0], eb = EIDX[(size_t)r * 128 + e0 + 1];
            const float ga = EG[(size_t)r * 128 + e0], gb = EG[(size_t)r * 128 + e0 + 1];
            f32x4 ua[4], ub[4];
#pragma unroll
            for (int q = 0; q < 4; ++q) { ua[q] = *(const f32x4*)(U + (size_t)ea * D + q * 256 + lane * 4); ub[q] = *(const f32x4*)(U + (size_t)eb * D + q * 256 + lane * 4); }
            float da = 0.f, db = 0.f;
#pragma unroll
            for (int q = 0; q < 4; ++q) { da += hm[q][0] * ua[q][0] + hm[q][1] * ua[q][1] + hm[q][2] * ua[q][2] + hm[q][3] * ua[q][3]; db += hm[q][0] * ub[q][0] + hm[q][1] * ub[q][1] + hm[q][2] * ub[q][2] + hm[q][3] * ub[q][3]; }
            da = wave_sum(da); db = wave_sum(db);
            const float wa = ga * gelu_f(da), wb = gb * gelu_f(db);
#pragma unroll
            for (int q = 0; q < 4; ++q) {
                acc[q] += wa * *(const f32x4*)(V + (size_t)ea * D + q * 256 + lane * 4);
                acc[q] += wb * *(const f32x4*)(V + (size_t)eb * D + q * 256 + lane * 4);
            }
        }
        const float* md = p.mod + ((size_t)layer * 9 + mod_row(r)) * 6144;
        float* hrow = p.H + (size_t)r * D;
        f32x4 v[4]; float s = 0.f;
#pragma unroll
        for (int q = 0; q < 4; ++q) { const int c = q * 256 + lane * 4; v[q] = ALPHA * *(const f32x4*)(hrow + c) + *(const f32x4*)(md + 5 * 1024 + c) * acc[q]; s += v[q][0] + v[q][1] + v[q][2] + v[q][3]; }
        const float mu = wave_sum(s) * (1.0f / 1024.0f);
        float ss = 0.f;
#pragma unroll
        for (int q = 0; q < 4; ++q) { v[q] = v[q] - mu; ss += v[q][0] * v[q][0] + v[q][1] * v[q][1] + v[q][2] * v[q][2] + v[q][3] * v[q][3]; }
        const float rstd = rsqrtf(wave_sum(ss) * (1.0f / 1024.0f) + LN_EPS);
        if (layer == 0) {
            const float* md1 = p.mod + ((size_t)1 * 9 + mod_row(r)) * 6144;
#pragma unroll
            for (int q = 0; q < 4; ++q) {
                const int c = q * 256 + lane * 4;
                const f32x4 h = v[q] * rstd * *(const f32x4*)(g + c) + *(const f32x4*)(bb + c);
                *(f32x4*)(hrow + c) = h;
                const f32x4 a = h * (1.0f + *(const f32x4*)(md1 + 1024 + c)) + *(const f32x4*)(md1 + c);
                *(u32x2*)(p.A16 + (size_t)r * D + c) = (u32x2){pack2(a[0], a[1]), pack2(a[2], a[3])};
            }
        } else {
            float* orow = p.out + (size_t)rr * D;
#pragma unroll
            for (int q = 0; q < 4; ++q) { const int c = q * 256 + lane * 4; *(f32x4*)(orow + c) = v[q] * rstd * *(const f32x4*)(g + c) + *(const f32x4*)(bb + c); }
        }
    }
}

__device__ void ph_convert_uv(const Params& p, int layer) {
    const float* src0 = p.peer_u + (size_t)layer * PEER_N * D;
    const float* src1 = p.peer_v + (size_t)layer * PEER_N * D;
    const int n8 = PEER_N * D / 8;
    for (int i = blockIdx.x * 256 + threadIdx.x; i < n8; i += gridDim.x * 256) {
        const f32x4 a = *(const f32x4*)(src0 + (size_t)i * 8), b = *(const f32x4*)(src0 + (size_t)i * 8 + 4);
        *(u32x4*)(p.P + (size_t)i * 8) = (u32x4){pack2(a[0], a[1]), pack2(a[2], a[3]), pack2(b[0], b[1]), pack2(b[2], b[3])};
        const f32x4 c = *(const f32x4*)(src1 + (size_t)i * 8), d = *(const f32x4*)(src1 + (size_t)i * 8 + 4);
        *(u32x4*)(p.P + (size_t)PEER_N * D + (size_t)i * 8) = (u32x4){pack2(c[0], c[1]), pack2(c[2], c[3]), pack2(d[0], d[1]), pack2(d[2], d[3])};
    }
}

__device__ void ph_gather_mfma(const Params& p, int layer, int lat_only, unsigned char* smem) {
    const int tid = threadIdx.x, wid = tid >> 6, lane = tid & 63, c = lane & 15, g = lane >> 4;
    bf16_t* hs = (bf16_t*)(smem + wid * 3072);
    int* se = (int*)(smem + wid * 3072 + 2048);
    float* sw = (float*)(smem + wid * 3072 + 2560);
    const int* EIDX = (const int*)(p.G + (size_t)R * 8 * 2 * 16 * 4);
    const float* EG = (const float*)(p.G + (size_t)R * 8 * 2 * 16 * 4 + (size_t)R * 8 * 16 * 4);
    const bf16_t* U = p.P; const bf16_t* V = p.P + (size_t)PEER_N * D;
    const float* gam = p.ln_g + (size_t)(layer * 2 + 1) * D; const float* bet = p.ln_b + (size_t)(layer * 2 + 1) * D;
    const int nrows = lat_only ? NB * SEQ : R;
    for (int u = blockIdx.x; u < nrows / 4; u += gridDim.x) {
        const int rr = u * 4 + wid, r = lat_only ? (rr >> 12) * PB + CTX + (rr & 4095) : rr;
        __syncthreads();
        *(u32x4*)(hs + lane * 8) = *(const u32x4*)(p.A16 + (size_t)r * D + lane * 8);
        *(u32x4*)(hs + 512 + lane * 8) = *(const u32x4*)(p.A16 + (size_t)r * D + 512 + lane * 8);
        se[lane] = EIDX[(size_t)r * 128 + lane]; se[64 + lane] = EIDX[(size_t)r * 128 + 64 + lane];
        sw[lane] = EG[(size_t)r * 128 + lane]; sw[64 + lane] = EG[(size_t)r * 128 + 64 + lane];
        __syncthreads();
        for (int hd = 0; hd < 8; ++hd) {
            f32x4 dacc = (f32x4){0.f, 0.f, 0.f, 0.f};
            const bf16_t* urow = U + (size_t)se[hd * 16 + c] * D + g * 8;
#pragma unroll 16
            for (int s = 0; s < 32; ++s) {
                const bf16x8 bq = *(const bf16x8*)(urow + s * 32);
                const bf16x8 aq = *(const bf16x8*)(hs + s * 32 + g * 8);
                dacc = __builtin_amdgcn_mfma_f32_16x16x32_bf16(aq, bq, dacc, 0, 0, 0);
            }
            const float wv = sw[hd * 16 + c] * gelu_f(dacc[0]);
            if (g == 0) sw[hd * 16 + c] = wv;
        }
        __syncthreads();
        f32x4 oacc[8];
#pragma unroll
        for (int blk = 0; blk < 8; ++blk) oacc[blk] = (f32x4){0.f, 0.f, 0.f, 0.f};
#pragma unroll 2
        for (int it = 0; it < 32; ++it) {
            const int e = se[4 * it + g];
            const float wv = sw[4 * it + g];
            const unsigned wb = (unsigned)f2bf(wv) << (16 * (c & 1));
            u32x4 aw;
#pragma unroll
            for (int q = 0; q < 4; ++q) aw[q] = (c < 8 && (c >> 1) == q) ? wb : 0u;
            const bf16x8 aq = __builtin_bit_cast(bf16x8, aw);
            const bf16_t* vrow = V + (size_t)e * D + c * 8;
#pragma unroll
            for (int blk = 0; blk < 8; ++blk) {
                const bf16x8 bq = *(const bf16x8*)(vrow + blk * 128);
                oacc[blk] = __builtin_amdgcn_mfma_f32_16x16x32_bf16(aq, bq, oacc[blk], 0, 0, 0);
            }
        }
        const float* md = p.mod + ((size_t)layer * 9 + mod_row(r)) * 6144;
        float* hrow = p.H + (size_t)r * D;
        const bool act = g < 2;
        f32x4 v[8]; float s = 0.f;
#pragma unroll
        for (int blk = 0; blk < 8; ++blk) {
            const int n = 128 * blk + 8 * c + 4 * (g & 1);
            v[blk] = ALPHA * *(const f32x4*)(hrow + n) + *(const f32x4*)(md + 5 * 1024 + n) * oacc[blk];
            if (!act) v[blk] = (f32x4){0.f, 0.f, 0.f, 0.f};
            s += v[blk][0] + v[blk][1] + v[blk][2] + v[blk][3];
        }
        const float mu = wave_sum(s) * (1.0f / 1024.0f);
        float ss = 0.f;
#pragma unroll
        for (int blk = 0; blk < 8; ++blk) { v[blk] = v[blk] - mu; if (act) ss += v[blk][0] * v[blk][0] + v[blk][1] * v[blk][1] + v[blk][2] * v[blk][2] + v[blk][3] * v[blk][3]; }
        const float rstd = rsqrtf(wave_sum(ss) * (1.0f / 1024.0f) + LN_EPS);
        if (act) {
            if (layer == 0) {
                const float* md1 = p.mod + ((size_t)1 * 9 + mod_row(r)) * 6144;
#pragma unroll
                for (int blk = 0; blk < 8; ++blk) {
                    const int n = 128 * blk + 8 * c + 4 * g;
                    const f32x4 h = v[blk] * rstd * *(const f32x4*)(gam + n) + *(const f32x4*)(bet + n);
                    *(f32x4*)(hrow + n) = h;
                    const f32x4 a = h * (1.0f + *(const f32x4*)(md1 + 1024 + n)) + *(const f32x4*)(md1 + n);
                    *(u32x2*)(p.A16 + (size_t)r * D + n) = (u32x2){pack2(a[0], a[1]), pack2(a[2], a[3])};
                }
            } else {
                float* orow = p.out + (size_t)rr * D;
#pragma unroll
                for (int blk = 0; blk < 8; ++blk) { const int n = 128 * blk + 8 * c + 4 * g; *(f32x4*)(orow + n) = v[blk] * rstd * *(const f32x4*)(gam + n) + *(const f32x4*)(bet + n); }
            }
        }
    }
}

__device__ void ph_rglru_naive(const Params& p, unsigned char* smem) {
    float* sz = (float*)smem;
    bf16_t* PR = p.P;
    bf16_t* YF = (bf16_t*)p.G;
    const int tid = threadIdx.x, c = tid >> 1, gate = tid & 1;
    for (int u = blockIdx.x; u < 80; u += gridDim.x) {
        const int b = u / 10, n = u % 10, ch = n * 128 + c;
        for (int dir = 0; dir < 2; ++dir) {
            float wcol[128];
            const float* gw = p.od_gate_w + ((size_t)(dir * 2 + gate) * 10 + n) * 16384;
#pragma unroll
            for (int k = 0; k < 128; ++k) wcol[k] = gw[k * 128 + c];
            const float gbias = p.od_gate_b[(dir * 2 + gate) * RGW + ch];
            const float lam = p.od_lambda[dir * RGW + ch];
            const float sp = fmaxf(-lam, 0.f) + log1pf(expf(-fabsf(lam)));
            const float coef = -8.0f * sp;
            float h = 0.f;
            for (int bi = 0; bi < PB / 16; ++bi) {
                __syncthreads();
                for (int e = tid; e < 16 * 128; e += 256) {
                    const int i = e >> 7, k = e & 127, st = bi * 16 + i, cc = n * 128 + k;
                    const int pp = dir == 0 ? st : (st < CTX ? CTX - 1 - st : PB + CTX - 1 - st);
                    const int lo = pp < CTX ? 0 : CTX, hi = pp < CTX ? CTX : PB;
                    float v = p.od_conv_b[cc];
#pragma unroll
                    for (int tap = 0; tap < 4; ++tap) { const int q = pp + tap - 2; if (q >= lo && q < hi) v += p.od_conv_w[tap * RGW + cc] * bf2f(PR[(size_t)(b * PB + q) * 2560 + RGW + cc]); }
                    sz[e] = v;
                }
                __syncthreads();
                for (int i = 0; i < 16; ++i) {
                    float dot = gbias;
#pragma unroll
                    for (int k = 0; k < 128; k += 4) { const f32x4 zv = *(const f32x4*)(sz + i * 128 + k); dot += zv[0] * wcol[k] + zv[1] * wcol[k + 1] + zv[2] * wcol[k + 2] + zv[3] * wcol[k + 3]; }
                    const float sg = sigmoid_f(dot), other = __shfl_xor(sg, 1);
                    const float rg = gate == 0 ? sg : other, ig = gate == 0 ? other : sg;
                    const float la = coef * rg, a = expf(la), xin = sqrtf(-expm1f(2.0f * la)) * ig * sz[i * 128 + c];
                    h = a * h + xin;
                    const int st = bi * 16 + i;
                    const int pp = dir == 0 ? st : (st < CTX ? CTX - 1 - st : PB + CTX - 1 - st);
                    if (gate == 0 && pp >= CTX) {
                        const size_t rl = (size_t)b * SEQ + (pp - CTX);
                        if (dir == 0) YF[rl * RGW + ch] = f2bf(h);
                        else {
                            const size_t r = (size_t)b * PB + pp;
                            const float y = bf2f(YF[rl * RGW + ch]) + h;
                            PR[r * 2560 + ch] = f2bf(gelu_f(bf2f(PR[r * 2560 + ch])) * y);
                        }
                    }
                }
            }
        }
    }
}

#define SMEM_DECL __shared__ __attribute__((aligned(16))) unsigned char smem[65536]
__global__ void __launch_bounds__(256) k_prologue(Params p) { SMEM_DECL; ph_prologue(p, smem); }
__global__ void __launch_bounds__(256) k_modulate0(Params p) { ph_modulate0(p); }
__global__ void __launch_bounds__(256) k_gemm_ev_in(Params p) { SMEM_DECL; gemm_phase(p.A16, D, p.wt_ev_in, 1024, EV_IN, RowMap{0}, EpiBf16{p.P, EV_IN, EV_IN}, smem); }
__global__ void __launch_bounds__(256) k_rowpost(Params p) { ph_rowpost(p); }
__global__ void __launch_bounds__(256) k_gemm_q(Params p) { SMEM_DECL; gemm_phase(p.P + C_CQ, EV_IN, p.wt_uq, 384, 768, RowMap{0}, EpiQ{p.Q16, p.rsq, p.rope_cos, p.rope_sin}, smem); }
__global__ void __launch_bounds__(256) k_gemm_kv(Params p) { SMEM_DECL; gemm_phase(p.P + C_CKV, EV_IN, p.wt_ukv, 256, 1024, RowMap{0}, EpiKV{p.K16, p.V16, p.rsq + R}, smem); }
__global__ void __launch_bounds__(256) k_attn(Params p) { SMEM_DECL; ph_attn_naive(p, smem, blockIdx.x, gridDim.x); }
__global__ void __launch_bounds__(256) k_gla(Params p) { SMEM_DECL; ph_gla_naive(p, smem); }
__global__ void __launch_bounds__(256) k_gemm_ev_out(Params p) { SMEM_DECL; gemm_phase(p.A16, D, p.wt_ev_out, 1024, 1024, RowMap{0}, EpiResid{p.x, p.ctx, p.mod, p.H, 0}, smem); }
__global__ void __launch_bounds__(256) k_ln_mod(Params p, int layer, int lat_only) { ph_ln_mod(p, layer, 0, lat_only); }
__global__ void __launch_bounds__(256) k_gemm_pq(Params p, int layer, int lat_only) { SMEM_DECL; gemm_phase(p.A16, D, p.wt_pq + (size_t)layer * 2048 * 1024, 1024, 2048, RowMap{lat_only}, EpiBf16{p.P, 2048, 2048}, smem); }
__global__ void __launch_bounds__(256) k_scores(Params p, int layer, int lat_only) { SMEM_DECL; ph_scores_naive(p, layer, lat_only, smem); }
__global__ void __launch_bounds__(256) k_combine(Params p, int lat_only) { ph_combine(p, lat_only); }
__global__ void __launch_bounds__(256) k_gather(Params p, int layer, int lat_only) { ph_gather_ln(p, layer, lat_only); }
__global__ void __launch_bounds__(256) k_gemm_od_in(Params p) { SMEM_DECL; gemm_phase(p.A16, D, p.wt_od_in, 1024, 2560, RowMap{0}, EpiBf16{p.P, 2560, 2560}, smem); }
__global__ void __launch_bounds__(256) k_rglru(Params p) { SMEM_DECL; ph_rglru_naive(p, smem); }
__global__ void __launch_bounds__(256) k_gemm_od_out(Params p) { SMEM_DECL; gemm_phase(p.P, 2560, p.wt_od_out, 1280, 1024, RowMap{1}, EpiResid{p.x, p.ctx, p.mod, p.H, 1}, smem); }

__global__ void __launch_bounds__(256) k_mega(Params p) {
    SMEM_DECL;
    cg::grid_group grid = cg::this_grid();
    ph_prologue(p, smem); grid.sync();
    ph_modulate0(p); grid.sync();
    gemm_phase(p.A16, D, p.wt_ev_in, 1024, EV_IN, RowMap{0}, EpiBf16{p.P, EV_IN, EV_IN}, smem); grid.sync();
    ph_rowpost(p); grid.sync();
    gemm_phase(p.P + C_CQ, EV_IN, p.wt_uq, 384, 768, RowMap{0}, EpiQ{p.Q16, p.rsq, p.rope_cos, p.rope_sin}, smem);
    gemm_phase(p.P + C_CKV, EV_IN, p.wt_ukv, 256, 1024, RowMap{0}, EpiKV{p.K16, p.V16, p.rsq + R}, smem); grid.sync();
    if (blockIdx.x < 32) ph_gla_naive(p, smem); else ph_attn_naive(p, smem, blockIdx.x - 32, gridDim.x - 32);
    grid.sync();
    gemm_phase(p.A16, D, p.wt_ev_out, 1024, 1024, RowMap{0}, EpiResid{p.x, p.ctx, p.mod, p.H, 0}, smem); grid.sync();
    ph_ln_mod(p, 0, 0, 0); grid.sync();
    gemm_phase(p.A16, D, p.wt_pq, 1024, 2048, RowMap{0}, EpiBf16{p.P, 2048, 2048}, smem); grid.sync();
    ph_scores_naive(p, 0, 0, smem); grid.sync();
    ph_combine(p, 0); ph_convert_uv(p, 0); grid.sync();
    ph_gather_mfma(p, 0, 0, smem); grid.sync();
    gemm_phase(p.A16, D, p.wt_od_in, 1024, 2560, RowMap{0}, EpiBf16{p.P, 2560, 2560}, smem); grid.sync();
    ph_rglru_naive(p, smem); grid.sync();
    gemm_phase(p.P, 2560, p.wt_od_out, 1280, 1024, RowMap{1}, EpiResid{p.x, p.ctx, p.mod, p.H, 1}, smem); grid.sync();
    ph_ln_mod(p, 1, 0, 1); grid.sync();
    gemm_phase(p.A16, D, p.wt_pq + (size_t)2048 * 1024, 1024, 2048, RowMap{1}, EpiBf16{p.P, 2048, 2048}, smem); grid.sync();
    ph_scores_naive(p, 1, 1, smem); grid.sync();
    ph_combine(p, 1); ph_convert_uv(p, 1); grid.sync();
    ph_gather_mfma(p, 1, 1, smem);
}

extern "C" void kernel_launch(void* const* d_in, const int* in_sizes, int n_in, void* d_out, int out_size, void* d_ws, size_t ws_size, hipStream_t stream) {
    Params p{};
    const float** f = (const float**)d_in;
    p.x = f[0]; p.c = f[1]; p.ctx = f[2]; p.c_ctx = f[3]; p.mod_w = f[4]; p.mod_b = f[5]; p.ln_g = f[6]; p.ln_b = f[7];
    p.ev_w_in = f[8]; p.ev_q_norm = f[9]; p.ev_kv_norm = f[10]; p.ev_w_uq = f[11]; p.ev_w_ukv = f[12]; p.ev_gla_wa2 = f[13]; p.ev_gla_ba = f[14]; p.ev_gla_norm = f[15]; p.ev_w_out = f[16];
    p.od_w_in = f[17]; p.od_conv_w = f[18]; p.od_conv_b = f[19]; p.od_gate_w = f[20]; p.od_gate_b = f[21]; p.od_lambda = f[22]; p.od_w_out = f[23];
    p.peer_wq = f[24]; p.peer_k1 = f[25]; p.peer_k2 = f[26]; p.peer_u = f[27]; p.peer_v = f[28];
    p.out = (float*)d_out;
    unsigned char* w = (unsigned char*)d_ws; size_t off = 0;
    auto take = [&](size_t bytes) { unsigned char* r = w + off; off += (bytes + 255) & ~(size_t)255; return r; };
    p.wt_ev_in = (bf16_t*)take((size_t)EV_IN * 1024 * 2); p.wt_uq = (bf16_t*)take(768 * 384 * 2); p.wt_ukv = (bf16_t*)take(1024 * 256 * 2);
    p.wt_ev_out = (bf16_t*)take(1024 * 1024 * 2); p.wt_od_in = (bf16_t*)take(2560 * 1024 * 2); p.wt_gate = (bf16_t*)take(40 * 16384 * 2);
    p.wt_od_out = (bf16_t*)take(1024 * 1280 * 2); p.wt_pq = (bf16_t*)take((size_t)2 * 2048 * 1024 * 2); p.wt_k = (bf16_t*)take(4 * 16384 * 2);
    p.mod = (float*)take(2 * 9 * 6144 * 4); p.rope_cos = (float*)take(SEQ * 16 * 4); p.rope_sin = (float*)take(SEQ * 16 * 4); p.rsq = (float*)take((size_t)2 * R * 4);
    p.H = (float*)take((size_t)R * D * 4);
    p.Q16 = (bf16_t*)p.H; p.K16 = p.Q16 + (size_t)R * 768; p.V16 = p.K16 + (size_t)R * 768;
    p.A16 = (bf16_t*)take((size_t)R * D * 2);
    p.P = (bf16_t*)take((size_t)R * 2560 * 2);
    p.G = take((size_t)94371840);
    if (off > ws_size) { fprintf(stderr, "workspace too small: need %zu have %zu\n", off, ws_size); return; }
    static int grid_blocks = 0;
    if (!grid_blocks) {
        int dev = 0, cus = 0, per_cu = 0;
        (void)hipGetDevice(&dev);
        (void)hipDeviceGetAttribute(&cus, hipDeviceAttributeMultiprocessorCount, dev);
        (void)hipOccupancyMaxActiveBlocksPerMultiprocessor(&per_cu, k_mega, 256, 0);
        if (per_cu > 2) per_cu = 2;
        if (per_cu < 1) per_cu = 1;
        grid_blocks = cus * per_cu;
    }
    void* args[] = {&p};
    hipError_t e = hipLaunchCooperativeKernel((void*)k_mega, dim3(grid_blocks), dim3(256), args, 0, stream);
    if (e != hipSuccess) fprintf(stderr, "cooperative launch failed: %s (grid %d)\n", hipGetErrorString(e), grid_blocks);
}
__global__ void __launch_bounds__(256) k_gather2(Params p, int layer, int lat_only) { SMEM_DECL; ph_gather_mfma(p, layer, lat_only, smem); }
```

```cpp
#include <hip/hip_runtime.h>
#include <hip/hip_cooperative_groups.h>
#include <cstdio>
#include <cstdint>

namespace cg = cooperative_groups;
typedef unsigned short bf16_t;
typedef short bf16x8 __attribute__((ext_vector_type(8)));
typedef float f32x4 __attribute__((ext_vector_type(4)));
typedef float f32x16 __attribute__((ext_vector_type(16)));
typedef unsigned u32x4 __attribute__((ext_vector_type(4)));
typedef unsigned u32x2 __attribute__((ext_vector_type(2)));

constexpr int D = 1024, NB = 8, SEQ = 4096, CTX = 256, PB = SEQ + CTX  , R = NB * PB  ;
constexpr int EV_IN = 2240, RGW = 1280;
constexpr int C_CQ = 0, C_CKV = 384, C_KPE = 640, C_GQ = 672, C_GK = 928, C_GV = 1184, C_GG = 1696, C_GAF = 2208;
constexpr float LN_EPS = 1e-6f, ALPHA = 1.41421356237f, MLA_SCALE = 0.10206207261596577f  ;
constexpr int PEER_N = 16384;

struct Params {
    const float *x, *c, *ctx, *c_ctx, *mod_w, *mod_b, *ln_g, *ln_b;
    const float *ev_w_in, *ev_q_norm, *ev_kv_norm, *ev_w_uq, *ev_w_ukv, *ev_gla_wa2, *ev_gla_ba, *ev_gla_norm, *ev_w_out;
    const float *od_w_in, *od_conv_w, *od_conv_b, *od_gate_w, *od_gate_b, *od_lambda, *od_w_out;
    const float *peer_wq, *peer_k1, *peer_k2, *peer_u, *peer_v;
    float* out;
    bf16_t *wt_ev_in, *wt_uq, *wt_ukv, *wt_ev_out, *wt_od_in, *wt_gate, *wt_od_out, *wt_pq, *wt_k;
    float *mod, *rope_cos, *rope_sin, *rsq;
    float* H; bf16_t *Q16, *K16, *V16;
    bf16_t* A16; bf16_t* P; unsigned char* G;
};

__device__ __forceinline__ bf16_t f2bf(float f) { unsigned u = __float_as_uint(f); u += 0x7fffu + ((u >> 16) & 1u); return (bf16_t)(u >> 16); }
__device__ __forceinline__ float bf2f(bf16_t h) { return __uint_as_float(((unsigned)h) << 16); }
__device__ __forceinline__ unsigned pack2(float a, float b) { unsigned r; asm volatile("v_cvt_pk_bf16_f32 %0, %1, %2" : "=v"(r) : "v"(a), "v"(b)); return r; }
__device__ __forceinline__ float silu_f(float x) { return x / (1.0f + expf(-x)); }
__device__ __forceinline__ float sigmoid_f(float x) { return 1.0f / (1.0f + expf(-x)); }
__device__ __forceinline__ float gelu_f(float x) { return 0.5f * x * (1.0f + erff(x * 0.70710678118654752f)); }
__device__ __forceinline__ float wave_sum(float v) {
#pragma unroll
    for (int o = 32; o > 0; o >>= 1) v += __shfl_xor(v, o);
    return v;
}
__device__ __forceinline__ int mod_row(int r) { const int b = r / PB, p = r - b * PB; return p < CTX ? 8 : b; }
__device__ __forceinline__ const float* in_row(const Params& P_, int r) {
    const int b = r / PB, p = r - b * PB;
    return p < CTX ? P_.ctx + ((size_t)b * CTX + p) * D : P_.x + ((size_t)b * SEQ + (p - CTX)) * D;
}

__device__ void tconv_tile(const float* __restrict__ W, int K, int N, bf16_t* __restrict__ Wt, const float* __restrict__ rowscale, int tile, float* sm) {
    const int ntn = N / 64, tk = tile / ntn, tn = tile % ntn, tid = threadIdx.x;
#pragma unroll
    for (int i = 0; i < 4; ++i) {
        const int k = (tid >> 4) + 16 * i;
        f32x4 v = *(const f32x4*)(W + (size_t)(tk * 64 + k) * N + tn * 64 + (tid & 15) * 4);
        const float s = rowscale ? rowscale[tk * 64 + k] : 1.0f;
#pragma unroll
        for (int q = 0; q < 4; ++q) sm[k * 65 + (tid & 15) * 4 + q] = v[q] * s;
    }
    __syncthreads();
    const int n = tid >> 2, kc = tid & 3;
    unsigned w[8];
#pragma unroll
    for (int kk = 0; kk < 8; ++kk) w[kk] = pack2(sm[(kc * 16 + 2 * kk) * 65 + n], sm[(kc * 16 + 2 * kk + 1) * 65 + n]);
    bf16_t* dst = Wt + (size_t)(tn * 64 + n) * K + tk * 64 + kc * 16;
    *(u32x4*)dst = (u32x4){w[0], w[1], w[2], w[3]};
    *(u32x4*)(dst + 8) = (u32x4){w[4], w[5], w[6], w[7]};
    __syncthreads();
}
__device__ void tconv_all(const float* W, int K, int N, bf16_t* Wt, const float* rowscale, float* sm) {
    const int nt = (K / 64) * (N / 64);
    for (int t = blockIdx.x; t < nt; t += gridDim.x) tconv_tile(W, K, N, Wt, rowscale, t, sm);
}

__device__ void ph_prologue(const Params& p, unsigned char* smem) {
    float* sm = (float*)smem;
    tconv_all(p.ev_w_in, 1024, EV_IN, p.wt_ev_in, nullptr, sm);
    tconv_all(p.ev_w_uq, 384, 768, p.wt_uq, p.ev_q_norm, sm);
    tconv_all(p.ev_w_ukv, 256, 1024, p.wt_ukv, p.ev_kv_norm, sm);
    tconv_all(p.ev_w_out, 1024, 1024, p.wt_ev_out, nullptr, sm);
    tconv_all(p.od_w_in, 1024, 2560, p.wt_od_in, nullptr, sm);
    for (int g = 0; g < 40; ++g) tconv_all(p.od_gate_w + (size_t)g * 16384, 128, 128, p.wt_gate + (size_t)g * 16384, nullptr, sm);
    tconv_all(p.od_w_out, 1280, 1024, p.wt_od_out, nullptr, sm);
    for (int l = 0; l < 2; ++l) tconv_all(p.peer_wq + (size_t)l * 1024 * 2048, 1024, 2048, p.wt_pq + (size_t)l * 1024 * 2048, nullptr, sm);
    for (int i = blockIdx.x * 256 + threadIdx.x; i < 2 * 2 * 16384; i += gridDim.x * 256) {
        const int l = i / 32768, h = (i / 16384) & 1, e = i & 16383;
        p.wt_k[i] = f2bf((h ? p.peer_k2 : p.peer_k1)[(size_t)l * 16384 + e]);
    }
    for (int i = blockIdx.x * 256 + threadIdx.x; i < SEQ * 16; i += gridDim.x * 256) {
        const int s = i >> 4, f = i & 15;
        const float pos = (float)(f < 8 ? (s >> 6) : (s & 63));
        const float inv = powf(10000.0f, -(float)(f & 7) / 8.0f);
        const float ang = pos * inv;
        p.rope_cos[i] = cosf(ang); p.rope_sin[i] = sinf(ang);
    }
    float* sc = sm;
    for (int u = blockIdx.x; u < 2 * 96; u += gridDim.x) {
        const int l = u / 96, c0 = (u % 96) * 64, tid = threadIdx.x;
        __syncthreads();
        for (int i = tid; i < 9 * 1024; i += 256) { const int rr = i >> 10, k = i & 1023; sc[i] = silu_f(rr < 8 ? p.c[rr * 1024 + k] : p.c_ctx[k]); }
        __syncthreads();
        const int col = c0 + (tid & 63), kq = tid >> 6;
        float acc[9];
#pragma unroll
        for (int rr = 0; rr < 9; ++rr) acc[rr] = 0.f;
        const float* w = p.mod_w + (size_t)l * 1024 * 6144 + col;
        for (int k = kq * 256; k < kq * 256 + 256; ++k) {
            const float wv = w[(size_t)k * 6144];
#pragma unroll
            for (int rr = 0; rr < 9; ++rr) acc[rr] += sc[rr * 1024 + k] * wv;
        }
        __syncthreads();
        float* red = sm + 9 * 1024;
#pragma unroll
        for (int rr = 0; rr < 9; ++rr) red[(kq * 9 + rr) * 64 + (tid & 63)] = acc[rr];
        __syncthreads();
        for (int i = tid; i < 9 * 64; i += 256) {
            const int rr = i >> 6, cc = i & 63;
            const float s = red[(0 * 9 + rr) * 64 + cc] + red[(1 * 9 + rr) * 64 + cc] + red[(2 * 9 + rr) * 64 + cc] + red[(3 * 9 + rr) * 64 + cc];
            p.mod[((size_t)l * 9 + rr) * 6144 + c0 + cc] = s + p.mod_b[l * 6144 + c0 + cc];
        }
    }
}

__device__ void ph_modulate0(const Params& p) {
    const int wid = threadIdx.x >> 6, lane = threadIdx.x & 63;
    for (int u = blockIdx.x; u < R / 4; u += gridDim.x) {
        const int r = u * 4 + wid;
        const float* src = in_row(p, r);
        const float* md = p.mod + (size_t)(0 * 9 + mod_row(r)) * 6144;
#pragma unroll
        for (int q = 0; q < 4; ++q) {
            const int c = q * 256 + lane * 4;
            const f32x4 h = *(const f32x4*)(src + c), sh = *(const f32x4*)(md + c), scl = *(const f32x4*)(md + 1024 + c);
            const f32x4 v = h * (1.0f + scl) + sh;
            *(u32x2*)(p.A16 + (size_t)r * D + c) = (u32x2){pack2(v[0], v[1]), pack2(v[2], v[3])};
        }
    }
}

constexpr int GBK = 64, GLDS = 72  ;
struct RowMap { int lat_only; __device__ __forceinline__ int ntiles() const { return lat_only ? 256 : 272; }
    __device__ __forceinline__ int row0(int t) const { return lat_only ? (t >> 5) * PB + CTX + (t & 31) * 128 : t * 128; } };

template <class Epi>
__device__ void gemm_phase(const bf16_t* __restrict__ A, int lda, const bf16_t* __restrict__ Bt, int K, int N, RowMap rm, const Epi& epi, unsigned char* smem) {
    bf16_t* sA = (bf16_t*)smem; bf16_t* sB = sA + 128 * GLDS;
    const int tid = threadIdx.x, lane = tid & 63, wid = tid >> 6, wm = wid >> 1, wn = wid & 1, fr = lane & 15, fq = lane >> 4;
    const int ntn = (N + 127) / 128, nunits = rm.ntiles() * ntn, nk = K / GBK;
    for (int u = blockIdx.x; u < nunits; u += gridDim.x) {
        const int tm = u / ntn, tn = u % ntn, m0 = rm.row0(tm), n0 = tn * 128;
        f32x4 acc[4][4];
#pragma unroll
        for (int i = 0; i < 4; ++i)
#pragma unroll
            for (int j = 0; j < 4; ++j) acc[i][j] = (f32x4){0.f, 0.f, 0.f, 0.f};
        u32x4 ra[4], rb[4];
        auto gload = [&](int kt) {
#pragma unroll
            for (int i = 0; i < 4; ++i) {
                const int id = tid + 256 * i, row = id >> 3, ch = id & 7;
                ra[i] = *(const u32x4*)(A + (size_t)(m0 + row) * lda + kt * GBK + ch * 8);
                int brow = n0 + row; brow = brow < N ? brow : N - 1;
                rb[i] = *(const u32x4*)(Bt + (size_t)brow * K + kt * GBK + ch * 8);
            }
        };
        auto lstore = [&]() {
#pragma unroll
            for (int i = 0; i < 4; ++i) {
                const int id = tid + 256 * i, row = id >> 3, ch = id & 7;
                *(u32x4*)(sA + row * GLDS + ch * 8) = ra[i];
                *(u32x4*)(sB + row * GLDS + ch * 8) = rb[i];
            }
        };
        gload(0);
        __syncthreads();
        lstore();
        __syncthreads();
        for (int kt = 0; kt < nk; ++kt) {
            if (kt + 1 < nk) gload(kt + 1);
#pragma unroll
            for (int ks = 0; ks < 2; ++ks) {
                bf16x8 af[4], bfr[4];
#pragma unroll
                for (int i = 0; i < 4; ++i) af[i] = *(const bf16x8*)(sA + (wm * 64 + i * 16 + fr) * GLDS + ks * 32 + fq * 8);
#pragma unroll
                for (int j = 0; j < 4; ++j) bfr[j] = *(const bf16x8*)(sB + (wn * 64 + j * 16 + fr) * GLDS + ks * 32 + fq * 8);
#pragma unroll
                for (int i = 0; i < 4; ++i)
#pragma unroll
                    for (int j = 0; j < 4; ++j) acc[i][j] = __builtin_amdgcn_mfma_f32_16x16x32_bf16(bfr[j], af[i], acc[i][j], 0, 0, 0);
            }
            __syncthreads();
            if (kt + 1 < nk) { lstore(); __syncthreads(); }
        }
        epi(acc, m0 + wm * 64, n0 + wn * 64, fr, fq);
    }
}

struct EpiBf16 {
    bf16_t* C; int ldc, N;
    __device__ __forceinline__ void operator()(const f32x4 (&acc)[4][4], int mb, int nb, int fr, int fq) const {
#pragma unroll
        for (int i = 0; i < 4; ++i)
#pragma unroll
            for (int j = 0; j < 4; ++j) {
                const int m = mb + i * 16 + fr, n = nb + j * 16 + 4 * fq;
                if (n < N) *(u32x2*)(C + (size_t)m * ldc + n) = (u32x2){pack2(acc[i][j][0], acc[i][j][1]), pack2(acc[i][j][2], acc[i][j][3])};
            }
    }
};
struct EpiQ {
    bf16_t* Q; const float *rsq, *rc, *rs;
    __device__ __forceinline__ void operator()(const f32x4 (&acc)[4][4], int mb, int nb, int fr, int fq) const {
#pragma unroll
        for (int i = 0; i < 4; ++i) {
            const int m = mb + i * 16 + fr, b = m / PB, pp = m - b * PB;
            const float sc = rsq[m] * (MLA_SCALE * 1.4426950408889634f);
#pragma unroll
            for (int j = 0; j < 4; j += 2) {
                const int n = nb + j * 16 + 4 * fq;
                f32x4 v0 = acc[i][j] * sc, v1 = acc[i][j + 1] * sc;
                const int d = n % 96;
                if (d >= 64 && pp >= CTX) {
                    const int s = pp - CTX, f = (d - 64) + 0;
                    const f32x4 cs = *(const f32x4*)(rc + s * 16 + f), sn = *(const f32x4*)(rs + s * 16 + f);
                    const f32x4 o0 = v0 * cs - v1 * sn, o1 = v0 * sn + v1 * cs; v0 = o0; v1 = o1;
                }
                *(u32x2*)(Q + (size_t)m * 768 + n) = (u32x2){pack2(v0[0], v0[1]), pack2(v0[2], v0[3])};
                *(u32x2*)(Q + (size_t)m * 768 + n + 16) = (u32x2){pack2(v1[0], v1[1]), pack2(v1[2], v1[3])};
            }
        }
    }
};
struct EpiKV {
    bf16_t *Kd, *Vd; const float* rsq;
    __device__ __forceinline__ void operator()(const f32x4 (&acc)[4][4], int mb, int nb, int fr, int fq) const {
#pragma unroll
        for (int i = 0; i < 4; ++i) {
            const int m = mb + i * 16 + fr; const float sc = rsq[m];
#pragma unroll
            for (int j = 0; j < 4; ++j) {
                const int n = nb + j * 16 + 4 * fq, hd = n >> 7, d = n & 127;
                const f32x4 v = acc[i][j] * sc;
                bf16_t* dst = d < 64 ? Kd + (size_t)m * 768 + hd * 96 + d : Vd + (size_t)m * 512 + hd * 64 + (d - 64);
                *(u32x2*)dst = (u32x2){pack2(v[0], v[1]), pack2(v[2], v[3])};
            }
        }
    }
};
struct EpiResid {
    const float *x, *ctx, *mod; float* H; int layer;
    __device__ __forceinline__ void operator()(const f32x4 (&acc)[4][4], int mb, int nb, int fr, int fq) const {
#pragma unroll
        for (int i = 0; i < 4; ++i) {
            const int m = mb + i * 16 + fr, b = m / PB, pp = m - b * PB;
            const float* hin = layer == 0 ? (pp < CTX ? ctx + ((size_t)b * CTX + pp) * D : x + ((size_t)b * SEQ + (pp - CTX)) * D) : H + (size_t)m * D;
            const float* gate = mod + ((size_t)layer * 9 + (pp < CTX ? 8 : b)) * 6144 + 2 * 1024;
#pragma unroll
            for (int j = 0; j < 4; ++j) {
                const int n = nb + j * 16 + 4 * fq;
                const f32x4 h = *(const f32x4*)(hin + n), g = *(const f32x4*)(gate + n);
                *(f32x4*)(H + (size_t)m * D + n) = ALPHA * h + g * acc[i][j];
            }
        }
    }
};

__device__ void ph_rowpost(const Params& p) {
    const int wid = threadIdx.x >> 6, lane = threadIdx.x & 63;
    for (int u = blockIdx.x; u < R / 4; u += gridDim.x) {
        const int r = u * 4 + wid, b = r / PB, pp = r - b * PB;
        const bf16_t* row = p.P + (size_t)r * EV_IN;
        float sq = 0.f, skv = 0.f;
#pragma unroll
        for (int i = 0; i < 10; ++i) { const float v = bf2f(row[lane + 64 * i]); if (i < 6) sq += v * v; else skv += v * v; }
        sq = wave_sum(sq); skv = wave_sum(skv);
        if (lane == 0) { p.rsq[r] = rsqrtf(sq / 384.0f + LN_EPS); p.rsq[R + r] = rsqrtf(skv / 256.0f + LN_EPS); }
        if (lane < 16) {
            float x1 = bf2f(row[C_KPE + lane]), x2 = bf2f(row[C_KPE + 16 + lane]);
            if (pp >= CTX) { const int s = pp - CTX; const float cs = p.rope_cos[s * 16 + lane], sn = p.rope_sin[s * 16 + lane];
                const float o1 = x1 * cs - x2 * sn, o2 = x1 * sn + x2 * cs; x1 = o1; x2 = o2; }
            const bf16_t b1 = f2bf(x1), b2 = f2bf(x2);
#pragma unroll
            for (int hd = 0; hd < 8; ++hd) { p.K16[(size_t)r * 768 + hd * 96 + 64 + lane] = b1; p.K16[(size_t)r * 768 + hd * 96 + 80 + lane] = b2; }
        }
    }
}

constexpr int AT_KS = 104, AT_VS = 68, AT_BUF = 64 * AT_KS * 2 + 64 * AT_VS * 2;
__device__ void ph_attn(const Params& p, unsigned char* smem, int bid, int nblk) {
    const int tid = threadIdx.x, wid = tid >> 6, lane = tid & 63, q = lane & 31, h = lane >> 5;
    for (int u = bid; u < 2048 + 128; u += nblk) {
        int b, hd, q0, nkeys;
        if (u < 2048) { b = u >> 8; hd = (u >> 5) & 7; q0 = CTX + (u & 31) * 128; nkeys = PB; }
        else { const int v = u - 2048; b = v >> 4; hd = (v >> 1) & 7; q0 = (v & 1) * 128; nkeys = CTX; }
        const size_t rq = (size_t)b * PB + q0 + wid * 32 + q;
        bf16x8 qf[6];
#pragma unroll
        for (int s = 0; s < 6; ++s) qf[s] = *(const bf16x8*)(p.Q16 + rq * 768 + hd * 96 + 16 * s + 8 * h);
        f32x16 o[2];
#pragma unroll
        for (int i = 0; i < 16; ++i) { o[0][i] = 0.f; o[1][i] = 0.f; }
        float m = -1e30f, l = 0.f;
        const int ntiles = nkeys / 64;
        const bf16_t* Kg = p.K16 + (size_t)b * PB * 768 + hd * 96;
        const bf16_t* Vg = p.V16 + (size_t)b * PB * 512 + hd * 64;
        u32x4 rk[3], rv[2];
        auto gload = [&](int t) {
#pragma unroll
            for (int i = 0; i < 3; ++i) { const int id = tid + 256 * i, key = id / 12, ch = id % 12; rk[i] = *(const u32x4*)(Kg + (size_t)(t * 64 + key) * 768 + ch * 8); }
#pragma unroll
            for (int i = 0; i < 2; ++i) { const int id = tid + 256 * i, key = id >> 3, dch = id & 7; rv[i] = *(const u32x4*)(Vg + (size_t)(t * 64 + key) * 512 + dch * 8); }
        };
        auto lstore = [&](int buf) {
            bf16_t* Ks = (bf16_t*)(smem + buf * AT_BUF); bf16_t* Vt = Ks + 64 * AT_KS;
#pragma unroll
            for (int i = 0; i < 3; ++i) { const int id = tid + 256 * i, key = id / 12, ch = id % 12; *(u32x4*)(Ks + key * AT_KS + ch * 8) = rk[i]; }
#pragma unroll
            for (int i = 0; i < 2; ++i) {
                const int id = tid + 256 * i, key = id >> 3, dch = id & 7;
#pragma unroll
                for (int e = 0; e < 4; ++e) { Vt[(dch * 8 + 2 * e) * AT_VS + key] = (bf16_t)(rv[i][e] & 0xffffu); Vt[(dch * 8 + 2 * e + 1) * AT_VS + key] = (bf16_t)(rv[i][e] >> 16); }
            }
        };
        __syncthreads();
        gload(0); lstore(0);
        __syncthreads();
        for (int t = 0; t < ntiles; ++t) {
            if (t + 1 < ntiles) gload(t + 1);
            const bf16_t* Ks = (const bf16_t*)(smem + (t & 1) * AT_BUF); const bf16_t* Vt = Ks + 64 * AT_KS;
            f32x16 sa[2];
#pragma unroll
            for (int kb = 0; kb < 2; ++kb) {
#pragma unroll
                for (int i = 0; i < 16; ++i) sa[kb][i] = 0.f;
#pragma unroll
                for (int s = 0; s < 6; ++s) {
                    const bf16x8 kf = *(const bf16x8*)(Ks + (kb * 32 + q) * AT_KS + 16 * s + 8 * h);
                    sa[kb] = __builtin_amdgcn_mfma_f32_32x32x16_bf16(kf, qf[s], sa[kb], 0, 0, 0);
                }
            }
            float mx = sa[0][0];
#pragma unroll
            for (int i = 1; i < 16; ++i) mx = fmaxf(mx, sa[0][i]);
#pragma unroll
            for (int i = 0; i < 16; ++i) mx = fmaxf(mx, sa[1][i]);
            mx = fmaxf(mx, __shfl_xor(mx, 32));
            const float mn = fmaxf(m, mx), al = __builtin_amdgcn_exp2f(m - mn);
            m = mn;
            float ps = 0.f;
#pragma unroll
            for (int kb = 0; kb < 2; ++kb)
#pragma unroll
                for (int i = 0; i < 16; ++i) { const float e = __builtin_amdgcn_exp2f(sa[kb][i] - mn); sa[kb][i] = e; ps += e; }
            l = l * al + ps;
#pragma unroll
            for (int i = 0; i < 16; ++i) { o[0][i] *= al; o[1][i] *= al; }
#pragma unroll
            for (int kb = 0; kb < 2; ++kb)
#pragma unroll
                for (int s2 = 0; s2 < 2; ++s2) {
                    u32x4 pw;
#pragma unroll
                    for (int e = 0; e < 4; ++e) pw[e] = pack2(sa[kb][8 * s2 + 2 * e], sa[kb][8 * s2 + 2 * e + 1]);
                    const bf16x8 pf = __builtin_bit_cast(bf16x8, pw);
                    const int base = kb * 32 + 16 * s2;
#pragma unroll
                    for (int db = 0; db < 2; ++db) {
                        const bf16_t* vp = Vt + (db * 32 + q) * AT_VS + base + 4 * h;
                        const u32x2 v0 = *(const u32x2*)vp, v1 = *(const u32x2*)(vp + 8);
                        const bf16x8 vf = __builtin_bit_cast(bf16x8, (u32x4){v0[0], v0[1], v1[0], v1[1]});
                        o[db] = __builtin_amdgcn_mfma_f32_32x32x16_bf16(vf, pf, o[db], 0, 0, 0);
                    }
                }
            if (t + 1 < ntiles) lstore((t + 1) & 1);
            __syncthreads();
        }
        l += __shfl_xor(l, 32);
        const float il = 1.0f / l;
#pragma unroll
        for (int db = 0; db < 2; ++db)
#pragma unroll
            for (int gq = 0; gq < 4; ++gq) {
                const int d = db * 32 + 8 * gq + 4 * h;
                *(u32x2*)(p.A16 + rq * D + hd * 64 + d) = (u32x2){pack2(o[db][4 * gq] * il, o[db][4 * gq + 1] * il), pack2(o[db][4 * gq + 2] * il, o[db][4 * gq + 3] * il)};
            }
    }
}

__device__ void ph_gla_naive(const Params& p, unsigned char* smem) {
    float* sq = (float*)smem;
    float* sk = sq + 16 * 64;
    float* sa = sk + 16 * 64;
    float* sv = sa + 16 * 64;
    float* sop = sv + 16 * 128;
    float* sga = sop + 2 * 16 * 128;
    float* OF = (float*)p.G;
    const int tid = threadIdx.x, j = tid & 127, half = tid >> 7, lane = tid & 63, wid = tid >> 6;
    for (int u = blockIdx.x; u < 32; u += gridDim.x) {
        const int b = u >> 2, hd = u & 3;
        for (int dir = 0; dir < 2; ++dir) {
            float S[32];
#pragma unroll
            for (int dd = 0; dd < 32; ++dd) S[dd] = 0.f;
            const float* wa = p.ev_gla_wa2 + (size_t)dir * 16 * 256;
            const float* ba = p.ev_gla_ba + dir * 256;
            for (int bi = 0; bi < PB / 16; ++bi) {
                __syncthreads();
                for (int e = tid; e < 16 * 64; e += 256) {
                    const int i = e >> 6, d = e & 63, st = bi * 16 + i;
                    const int pp = dir == 0 ? st : (st < CTX ? CTX - 1 - st : PB + CTX - 1 - st);
                    const bf16_t* row = p.P + (size_t)(b * PB + pp) * EV_IN;
                    sq[e] = bf2f(row[C_GQ + hd * 64 + d]) * 0.125f;
                    sk[e] = bf2f(row[C_GK + hd * 64 + d]);
                }
                for (int e = tid; e < 16 * 128; e += 256) {
                    const int i = e >> 7, jj = e & 127, st = bi * 16 + i;
                    const int pp = dir == 0 ? st : (st < CTX ? CTX - 1 - st : PB + CTX - 1 - st);
                    sv[e] = bf2f(p.P[(size_t)(b * PB + pp) * EV_IN + C_GV + hd * 128 + jj]);
                }
                {
                    const int i = tid >> 4, g = tid & 15, st = bi * 16 + i;
                    const int pp = dir == 0 ? st : (st < CTX ? CTX - 1 - st : PB + CTX - 1 - st);
                    sga[tid] = bf2f(p.P[(size_t)(b * PB + pp) * EV_IN + C_GAF + dir * 16 + g]);
                }
                __syncthreads();
                for (int e = tid; e < 16 * 64; e += 256) {
                    const int i = e >> 6, d = e & 63;
                    float z = ba[hd * 64 + d];
#pragma unroll
                    for (int g = 0; g < 16; ++g) z += sga[i * 16 + g] * wa[g * 256 + hd * 64 + d];
                    const float ls = fminf(z, 0.f) - log1pf(expf(-fabsf(z)));
                    sa[e] = expf(ls * (1.0f / 16.0f));
                }
                __syncthreads();
                for (int i = 0; i < 16; ++i) {
                    const float vj = sv[i * 128 + j]; float op = 0.f;
#pragma unroll
                    for (int dd = 0; dd < 32; ++dd) { const int d = half * 32 + dd; S[dd] = sa[i * 64 + d] * S[dd] + sk[i * 64 + d] * vj; op += sq[i * 64 + d] * S[dd]; }
                    sop[(half * 16 + i) * 128 + j] = op;
                }
                __syncthreads();
                if (dir == 0) {
                    for (int e = tid; e < 16 * 128; e += 256) {
                        const int i = e >> 7, jj = e & 127, st = bi * 16 + i;
                        OF[(size_t)(b * PB + st) * 512 + hd * 128 + jj] = sop[i * 128 + jj] + sop[(16 + i) * 128 + jj];
                    }
                } else {
#pragma unroll
                    for (int ii = 0; ii < 4; ++ii) {
                        const int i = wid * 4 + ii, st = bi * 16 + i;
                        const int pp = st < CTX ? CTX - 1 - st : PB + CTX - 1 - st;
                        const size_t r = (size_t)b * PB + pp;
                        const float t0 = OF[r * 512 + hd * 128 + lane] + sop[i * 128 + lane] + sop[(16 + i) * 128 + lane];
                        const float t1 = OF[r * 512 + hd * 128 + 64 + lane] + sop[i * 128 + 64 + lane] + sop[(16 + i) * 128 + 64 + lane];
                        const float ss = wave_sum(t0 * t0 + t1 * t1);
                        const float rs = rsqrtf(ss / 128.0f + LN_EPS);
                        const float g0 = bf2f(p.P[r * EV_IN + C_GG + hd * 128 + lane]), g1 = bf2f(p.P[r * EV_IN + C_GG + hd * 128 + 64 + lane]);
                        p.A16[r * D + 512 + hd * 128 + lane] = f2bf(t0 * rs * p.ev_gla_norm[hd * 128 + lane] * silu_f(g0));
                        p.A16[r * D + 512 + hd * 128 + 64 + lane] = f2bf(t1 * rs * p.ev_gla_norm[hd * 128 + 64 + lane] * silu_f(g1));
                    }
                }
            }
        }
    }
}

__device__ void ph_ln_mod(const Params& p, int layer, int lnidx, int lat_only) {
    const int wid = threadIdx.x >> 6, lane = threadIdx.x & 63;
    const int nrows = lat_only ? NB * SEQ : R;
    const float* g = p.ln_g + (size_t)(layer * 2 + lnidx) * D; const float* bb = p.ln_b + (size_t)(layer * 2 + lnidx) * D;
    for (int u = blockIdx.x; u < nrows / 4; u += gridDim.x) {
        const int rr = u * 4 + wid, r = lat_only ? (rr >> 12) * PB + CTX + (rr & 4095) : rr;
        float* hrow = p.H + (size_t)r * D;
        f32x4 v[4]; float s = 0.f;
#pragma unroll
        for (int q = 0; q < 4; ++q) { v[q] = *(const f32x4*)(hrow + q * 256 + lane * 4); s += v[q][0] + v[q][1] + v[q][2] + v[q][3]; }
        const float mu = wave_sum(s) * (1.0f / 1024.0f);
        float ss = 0.f;
#pragma unroll
        for (int q = 0; q < 4; ++q) { v[q] = v[q] - mu; ss += v[q][0] * v[q][0] + v[q][1] * v[q][1] + v[q][2] * v[q][2] + v[q][3] * v[q][3]; }
        const float rstd = rsqrtf(wave_sum(ss) * (1.0f / 1024.0f) + LN_EPS);
        const float* md = p.mod + ((size_t)layer * 9 + mod_row(r)) * 6144;
#pragma unroll
        for (int q = 0; q < 4; ++q) {
            const int c = q * 256 + lane * 4;
            const f32x4 h = v[q] * rstd * *(const f32x4*)(g + c) + *(const f32x4*)(bb + c);
            *(f32x4*)(hrow + c) = h;
            const f32x4 a = h * (1.0f + *(const f32x4*)(md + 4 * 1024 + c)) + *(const f32x4*)(md + 3 * 1024 + c);
            *(u32x2*)(p.A16 + (size_t)r * D + c) = (u32x2){pack2(a[0], a[1]), pack2(a[2], a[3])};
        }
    }
}

__device__ void ph_scores_naive(const Params& p, int layer, int lat_only, unsigned char* smem) {
    float* ks = (float*)smem;
    const bf16_t* QP = p.P;
    float* T = (float*)p.G;
    const int tid = threadIdx.x, rl = tid >> 3, hd = tid & 7;
    const int nrows = lat_only ? NB * SEQ : R;
    for (int u = blockIdx.x; u < nrows / 32; u += gridDim.x) {
        const int rr = u * 32 + rl, r = lat_only ? (rr >> 12) * PB + CTX + (rr & 4095) : rr;
        for (int half = 0; half < 2; ++half) {
            __syncthreads();
            const bf16_t* kk = p.wt_k + ((size_t)layer * 2 + half) * 16384;
            for (int i = tid; i < 16384; i += 256) ks[i] = bf2f(kk[i]);
            __syncthreads();
            float q[128];
#pragma unroll
            for (int d = 0; d < 128; d += 8) {
                const u32x4 w = *(const u32x4*)(QP + (size_t)r * 2048 + hd * 256 + half * 128 + d);
#pragma unroll
                for (int e = 0; e < 4; ++e) { q[d + 2 * e] = __uint_as_float(w[e] << 16); q[d + 2 * e + 1] = __uint_as_float(w[e] & 0xffff0000u); }
            }
            float top[16];
#pragma unroll
            for (int t = 0; t < 16; ++t) top[t] = -3.0e38f;
            for (int k = 0; k < 128; ++k) {
                float s = 0.f;
#pragma unroll
                for (int d = 0; d < 128; d += 4) { const f32x4 kv = *(const f32x4*)(ks + k * 128 + d); s += q[d] * kv[0] + q[d + 1] * kv[1] + q[d + 2] * kv[2] + q[d + 3] * kv[3]; }
                float xv = __uint_as_float((__float_as_uint(s) & ~127u) | (unsigned)k);
#pragma unroll
                for (int t = 0; t < 16; ++t) { const float hi = fmaxf(top[t], xv); xv = fminf(top[t], xv); top[t] = hi; }
            }
            float* dst = T + (((size_t)r * 8 + hd) * 2 + half) * 16;
#pragma unroll
            for (int t = 0; t < 16; t += 4) *(f32x4*)(dst + t) = (f32x4){top[t], top[t + 1], top[t + 2], top[t + 3]};
        }
    }
}

__device__ void ph_combine(const Params& p, int lat_only) {
    const float* T = (const float*)p.G;
    int* EIDX = (int*)(p.G + (size_t)R * 8 * 2 * 16 * 4);
    float* EG = (float*)(p.G + (size_t)R * 8 * 2 * 16 * 4 + (size_t)R * 8 * 16 * 4);
    const int nrows = lat_only ? NB * SEQ : R;
    for (int g = blockIdx.x * 256 + threadIdx.x; g < nrows * 8; g += gridDim.x * 256) {
        const int rr = g >> 3, hd = g & 7, r = lat_only ? (rr >> 12) * PB + CTX + (rr & 4095) : rr;
        const float* t = T + ((size_t)r * 8 + hd) * 32;
        float t2[16];
#pragma unroll
        for (int i = 0; i < 16; ++i) t2[i] = __uint_as_float(__float_as_uint(t[16 + i]) & ~127u);
        float top[16];
#pragma unroll
        for (int k = 0; k < 16; ++k) top[k] = -3.0e38f;
        for (int i = 0; i < 16; ++i) {
            const float t1i = __uint_as_float(__float_as_uint(t[i]) & ~127u);
#pragma unroll
            for (int j = 0; j < 16; ++j) {
                float xv = __uint_as_float((__float_as_uint(t1i + t2[j]) & ~255u) | (unsigned)(i * 16 + j));
#pragma unroll
                for (int k = 0; k < 16; ++k) { const float hi = fmaxf(top[k], xv); xv = fminf(top[k], xv); top[k] = hi; }
            }
        }
        float e[16], sum = 0.f; const float mx = __uint_as_float(__float_as_uint(top[0]) & ~255u);
#pragma unroll
        for (int k = 0; k < 16; ++k) { e[k] = expf(__uint_as_float(__float_as_uint(top[k]) & ~255u) - mx); sum += e[k]; }
        const float inv = 1.0f / sum;
#pragma unroll
        for (int k = 0; k < 16; ++k) {
            const unsigned code = __float_as_uint(top[k]) & 255u, i = code >> 4, j = code & 15;
            const unsigned i1 = __float_as_uint(t[i]) & 127u, i2 = __float_as_uint(t[16 + j]) & 127u;
            EIDX[((size_t)r * 8 + hd) * 16 + k] = (int)(i1 * 128 + i2);
            EG[((size_t)r * 8 + hd) * 16 + k] = e[k] * inv;
        }
    }
}

__device__ void ph_gather_ln(const Params& p, int layer, int lat_only) {
    const int wid = threadIdx.x >> 6, lane = threadIdx.x & 63;
    const int* EIDX = (const int*)(p.G + (size_t)R * 8 * 2 * 16 * 4);
    const float* EG = (const float*)(p.G + (size_t)R * 8 * 2 * 16 * 4 + (size_t)R * 8 * 16 * 4);
    const float* U = p.peer_u + (size_t)layer * PEER_N * D; const float* V = p.peer_v + (size_t)layer * PEER_N * D;
    const float* g = p.ln_g + (size_t)(layer * 2 + 1) * D; const float* bb = p.ln_b + (size_t)(layer * 2 + 1) * D;
    const int nrows = lat_only ? NB * SEQ : R;
    for (int u = blockIdx.x; u < nrows / 4; u += gridDim.x) {
        const int rr = u * 4 + wid, r = lat_only ? (rr >> 12) * PB + CTX + (rr & 4095) : rr;
        f32x4 hm[4], acc[4];
#pragma unroll
        for (int q = 0; q < 4; ++q) {
            const u32x2 w = *(const u32x2*)(p.A16 + (size_t)r * D + q * 256 + lane * 4);
            hm[q] = (f32x4){__uint_as_float(w[0] << 16), __uint_as_float(w[0] & 0xffff0000u), __uint_as_float(w[1] << 16), __uint_as_float(w[1] & 0xffff0000u)};
            acc[q] = (f32x4){0.f, 0.f, 0.f, 0.f};
        }
        for (int e0 = 0; e0 < 128; e0 += 2) {
            const int ea = EIDX[(size_t)r * 128 + e0], eb = EIDX[(size_t)r * 128 + e0 + 1];
            const float ga = EG[(size_t)r * 128 + e0], gb = EG[(size_t)r * 128 + e0 + 1];
            f32x4 ua[4], ub[4];
#pragma unroll
            for (int q = 0; q < 4; ++q) { ua[q] = *(const f32x4*)(U + (size_t)ea * D + q * 256 + lane * 4); ub[q] = *(const f32x4*)(U + (size_t)eb * D + q * 256 + lane * 4); }
            float da = 0.f, db = 0.f;
#pragma unroll
            for (int q = 0; q < 4; ++q) { da += hm[q][0] * ua[q][0] + hm[q][1] * ua[q][1] + hm[q][2] * ua[q][2] + hm[q][3] * ua[q][3]; db += hm[q][0] * ub[q][0] + hm[q][1] * ub[q][1] + hm[q][2] * ub[q][2] + hm[q][3] * ub[q][3]; }
            da = wave_sum(da); db = wave_sum(db);
            const float wa = ga * gelu_f(da), wb = gb * gelu_f(db);
#pragma unroll
            for (int q = 0; q < 4; ++q) {
                acc[q] += wa * *(const f32x4*)(V + (size_t)ea * D + q * 256 + lane * 4);
                acc[q] += wb * *(const f32x4*)(V + (size_t)eb * D + q * 256 + lane * 4);
            }
        }
        const float* md = p.mod + ((size_t)layer * 9 + mod_row(r)) * 6144;
        float* hrow = p.H + (size_t)r * D;
        f32x4 v[4]; float s = 0.f;
#pragma unroll
        for (int q = 0; q < 4; ++q) { const int c = q * 256 + lane * 4; v[q] = ALPHA * *(const f32x4*)(hrow + c) + *(const f32x4*)(md + 5 * 1024 + c) * acc[q]; s += v[q][0] + v[q][1] + v[q][2] + v[q][3]; }
        const float mu = wave_sum(s) * (1.0f / 1024.0f);
        float ss = 0.f;
#pragma unroll
        for (int q = 0; q < 4; ++q) { v[q] = v[q] - mu; ss += v[q][0] * v[q][0] + v[q][1] * v[q][1] + v[q][2] * v[q][2] + v[q][3] * v[q][3]; }
        const float rstd = rsqrtf(wave_sum(ss) * (1.0f / 1024.0f) + LN_EPS);
        if (layer == 0) {
            const float* md1 = p.mod + ((size_t)1 * 9 + mod_row(r)) * 6144;
#pragma unroll
            for (int q = 0; q < 4; ++q) {
                const int c = q * 256 + lane * 4;
                const f32x4 h = v[q] * rstd * *(const f32x4*)(g + c) + *(const f32x4*)(bb + c);
                *(f32x4*)(hrow + c) = h;
                const f32x4 a = h * (1.0f + *(const f32x4*)(md1 + 1024 + c)) + *(const f32x4*)(md1 + c);
                *(u32x2*)(p.A16 + (size_t)r * D + c) = (u32x2){pack2(a[0], a[1]), pack2(a[2], a[3])};
            }
        } else {
            float* orow = p.out + (size_t)rr * D;
#pragma unroll
            for (int q = 0; q < 4; ++q) { const int c = q * 256 + lane * 4; *(f32x4*)(orow + c) = v[q] * rstd * *(const f32x4*)(g + c) + *(const f32x4*)(bb + c); }
        }
    }
}

__device__ void ph_convert_uv(const Params& p, int layer) {
    const float* src0 = p.peer_u + (size_t)layer * PEER_N * D;
    const float* src1 = p.peer_v + (size_t)layer * PEER_N * D;
    const int n8 = PEER_N * D / 8;
    for (int i = blockIdx.x * 256 + threadIdx.x; i < n8; i += gridDim.x * 256) {
        const f32x4 a = *(const f32x4*)(src0 + (size_t)i * 8), b = *(const f32x4*)(src0 + (size_t)i * 8 + 4);
        *(u32x4*)(p.P + (size_t)i * 8) = (u32x4){pack2(a[0], a[1]), pack2(a[2], a[3]), pack2(b[0], b[1]), pack2(b[2], b[3])};
        const f32x4 c = *(const f32x4*)(src1 + (size_t)i * 8), d = *(const f32x4*)(src1 + (size_t)i * 8 + 4);
        *(u32x4*)(p.P + (size_t)PEER_N * D + (size_t)i * 8) = (u32x4){pack2(c[0], c[1]), pack2(c[2], c[3]), pack2(d[0], d[1]), pack2(d[2], d[3])};
    }
}

__device__ void ph_gather_mfma(const Params& p, int layer, int lat_only, unsigned char* smem) {
    const int tid = threadIdx.x, wid = tid >> 6, lane = tid & 63, c = lane & 15, g = lane >> 4;
    bf16_t* hs = (bf16_t*)(smem + wid * 3072);
    int* se = (int*)(smem + wid * 3072 + 2048);
    float* sw = (float*)(smem + wid * 3072 + 2560);
    const int* EIDX = (const int*)(p.G + (size_t)R * 8 * 2 * 16 * 4);
    const float* EG = (const float*)(p.G + (size_t)R * 8 * 2 * 16 * 4 + (size_t)R * 8 * 16 * 4);
    const bf16_t* U = p.P; const bf16_t* V = p.P + (size_t)PEER_N * D;
    const float* gam = p.ln_g + (size_t)(layer * 2 + 1) * D; const float* bet = p.ln_b + (size_t)(layer * 2 + 1) * D;
    const int nrows = lat_only ? NB * SEQ : R;
    for (int u = blockIdx.x; u < nrows / 4; u += gridDim.x) {
        const int rr = u * 4 + wid, r = lat_only ? (rr >> 12) * PB + CTX + (rr & 4095) : rr;
        __syncthreads();
        *(u32x4*)(hs + lane * 8) = *(const u32x4*)(p.A16 + (size_t)r * D + lane * 8);
        *(u32x4*)(hs + 512 + lane * 8) = *(const u32x4*)(p.A16 + (size_t)r * D + 512 + lane * 8);
        se[lane] = EIDX[(size_t)r * 128 + lane]; se[64 + lane] = EIDX[(size_t)r * 128 + 64 + lane];
        sw[lane] = EG[(size_t)r * 128 + lane]; sw[64 + lane] = EG[(size_t)r * 128 + 64 + lane];
        __syncthreads();
        for (int hd = 0; hd < 8; ++hd) {
            f32x4 dacc = (f32x4){0.f, 0.f, 0.f, 0.f};
            const bf16_t* urow = U + (size_t)se[hd * 16 + c] * D + g * 8;
#pragma unroll 16
            for (int s = 0; s < 32; ++s) {
                const bf16x8 bq = *(const bf16x8*)(urow + s * 32);
                const bf16x8 aq = *(const bf16x8*)(hs + s * 32 + g * 8);
                dacc = __builtin_amdgcn_mfma_f32_16x16x32_bf16(aq, bq, dacc, 0, 0, 0);
            }
            const float wv = sw[hd * 16 + c] * gelu_f(dacc[0]);
            if (g == 0) sw[hd * 16 + c] = wv;
        }
        __syncthreads();
        f32x4 oacc[8];
#pragma unroll
        for (int blk = 0; blk < 8; ++blk) oacc[blk] = (f32x4){0.f, 0.f, 0.f, 0.f};
#pragma unroll 2
        for (int it = 0; it < 32; ++it) {
            const int e = se[4 * it + g];
            const float wv = sw[4 * it + g];
            const unsigned wb = (unsigned)f2bf(wv) << (16 * (c & 1));
            u32x4 aw;
#pragma unroll
            for (int q = 0; q < 4; ++q) aw[q] = (c < 8 && (c >> 1) == q) ? wb : 0u;
            const bf16x8 aq = __builtin_bit_cast(bf16x8, aw);
            const bf16_t* vrow = V + (size_t)e * D + c * 8;
#pragma unroll
            for (int blk = 0; blk < 8; ++blk) {
                const bf16x8 bq = *(const bf16x8*)(vrow + blk * 128);
                oacc[blk] = __builtin_amdgcn_mfma_f32_16x16x32_bf16(aq, bq, oacc[blk], 0, 0, 0);
            }
        }
        const float* md = p.mod + ((size_t)layer * 9 + mod_row(r)) * 6144;
        float* hrow = p.H + (size_t)r * D;
        const bool act = g < 2;
        f32x4 v[8]; float s = 0.f;
#pragma unroll
        for (int blk = 0; blk < 8; ++blk) {
            const int n = 128 * blk + 8 * c + 4 * (g & 1);
            v[blk] = ALPHA * *(const f32x4*)(hrow + n) + *(const f32x4*)(md + 5 * 1024 + n) * oacc[blk];
            if (!act) v[blk] = (f32x4){0.f, 0.f, 0.f, 0.f};
            s += v[blk][0] + v[blk][1] + v[blk][2] + v[blk][3];
        }
        const float mu = wave_sum(s) * (1.0f / 1024.0f);
        float ss = 0.f;
#pragma unroll
        for (int blk = 0; blk < 8; ++blk) { v[blk] = v[blk] - mu; if (act) ss += v[blk][0] * v[blk][0] + v[blk][1] * v[blk][1] + v[blk][2] * v[blk][2] + v[blk][3] * v[blk][3]; }
        const float rstd = rsqrtf(wave_sum(ss) * (1.0f / 1024.0f) + LN_EPS);
        if (act) {
            if (layer == 0) {
                const float* md1 = p.mod + ((size_t)1 * 9 + mod_row(r)) * 6144;
#pragma unroll
                for (int blk = 0; blk < 8; ++blk) {
                    const int n = 128 * blk + 8 * c + 4 * g;
                    const f32x4 h = v[blk] * rstd * *(const f32x4*)(gam + n) + *(const f32x4*)(bet + n);
                    *(f32x4*)(hrow + n) = h;
                    const f32x4 a = h * (1.0f + *(const f32x4*)(md1 + 1024 + n)) + *(const f32x4*)(md1 + n);
                    *(u32x2*)(p.A16 + (size_t)r * D + n) = (u32x2){pack2(a[0], a[1]), pack2(a[2], a[3])};
                }
            } else {
                float* orow = p.out + (size_t)rr * D;
#pragma unroll
                for (int blk = 0; blk < 8; ++blk) { const int n = 128 * blk + 8 * c + 4 * g; *(f32x4*)(orow + n) = v[blk] * rstd * *(const f32x4*)(gam + n) + *(const f32x4*)(bet + n); }
            }
        }
    }
}

__device__ void ph_rglru_naive(const Params& p, unsigned char* smem) {
    float* sz = (float*)smem;
    bf16_t* PR = p.P;
    bf16_t* YF = (bf16_t*)p.G;
    const int tid = threadIdx.x, c = tid >> 1, gate = tid & 1;
    for (int u = blockIdx.x; u < 80; u += gridDim.x) {
        const int b = u / 10, n = u % 10, ch = n * 128 + c;
        for (int dir = 0; dir < 2; ++dir) {
            float wcol[128];
            const float* gw = p.od_gate_w + ((size_t)(dir * 2 + gate) * 10 + n) * 16384;
#pragma unroll
            for (int k = 0; k < 128; ++k) wcol[k] = gw[k * 128 + c];
            const float gbias = p.od_gate_b[(dir * 2 + gate) * RGW + ch];
            const float lam = p.od_lambda[dir * RGW + ch];
            const float sp = fmaxf(-lam, 0.f) + log1pf(expf(-fabsf(lam)));
            const float coef = -8.0f * sp;
            float h = 0.f;
            for (int bi = 0; bi < PB / 16; ++bi) {
                __syncthreads();
                for (int e = tid; e < 16 * 128; e += 256) {
                    const int i = e >> 7, k = e & 127, st = bi * 16 + i, cc = n * 128 + k;
                    const int pp = dir == 0 ? st : (st < CTX ? CTX - 1 - st : PB + CTX - 1 - st);
                    const int lo = pp < CTX ? 0 : CTX, hi = pp < CTX ? CTX : PB;
                    float v = p.od_conv_b[cc];
#pragma unroll
                    for (int tap = 0; tap < 4; ++tap) { const int q = pp + tap - 2; if (q >= lo && q < hi) v += p.od_conv_w[tap * RGW + cc] * bf2f(PR[(size_t)(b * PB + q) * 2560 + RGW + cc]); }
                    sz[e] = v;
                }
                __syncthreads();
                for (int i = 0; i < 16; ++i) {
                    float dot = gbias;
#pragma unroll
                    for (int k = 0; k < 128; k += 4) { const f32x4 zv = *(const f32x4*)(sz + i * 128 + k); dot += zv[0] * wcol[k] + zv[1] * wcol[k + 1] + zv[2] * wcol[k + 2] + zv[3] * wcol[k + 3]; }
                    const float sg = sigmoid_f(dot), other = __shfl_xor(sg, 1);
                    const float rg = gate == 0 ? sg : other, ig = gate == 0 ? other : sg;
                    const float la = coef * rg, a = expf(la), xin = sqrtf(-expm1f(2.0f * la)) * ig * sz[i * 128 + c];
                    h = a * h + xin;
                    const int st = bi * 16 + i;
                    const int pp = dir == 0 ? st : (st < CTX ? CTX - 1 - st : PB + CTX - 1 - st);
                    if (gate == 0 && pp >= CTX) {
                        const size_t rl = (size_t)b * SEQ + (pp - CTX);
                        if (dir == 0) YF[rl * RGW + ch] = f2bf(h);
                        else {
                            const size_t r = (size_t)b * PB + pp;
                            const float y = bf2f(YF[rl * RGW + ch]) + h;
                            PR[r * 2560 + ch] = f2bf(gelu_f(bf2f(PR[r * 2560 + ch])) * y);
                        }
                    }
                }
            }
        }
    }
}

#define SMEM_DECL __shared__ __attribute__((aligned(16))) unsigned char smem[65536]
__global__ void __launch_bounds__(256) k_prologue(Params p) { SMEM_DECL; ph_prologue(p, smem); }
__global__ void __launch_bounds__(256) k_modulate0(Params p) { ph_modulate0(p); }
__global__ void __launch_bounds__(256) k_gemm_ev_in(Params p) { SMEM_DECL; gemm_phase(p.A16, D, p.wt_ev_in, 1024, EV_IN, RowMap{0}, EpiBf16{p.P, EV_IN, EV_IN}, smem); }
__global__ void __launch_bounds__(256) k_rowpost(Params p) { ph_rowpost(p); }
__global__ void __launch_bounds__(256) k_gemm_q(Params p) { SMEM_DECL; gemm_phase(p.P + C_CQ, EV_IN, p.wt_uq, 384, 768, RowMap{0}, EpiQ{p.Q16, p.rsq, p.rope_cos, p.rope_sin}, smem); }
__global__ void __launch_bounds__(256) k_gemm_kv(Params p) { SMEM_DECL; gemm_phase(p.P + C_CKV, EV_IN, p.wt_ukv, 256, 1024, RowMap{0}, EpiKV{p.K16, p.V16, p.rsq + R}, smem); }
__global__ void __launch_bounds__(256) k_gla(Params p) { SMEM_DECL; ph_gla_naive(p, smem); }
__global__ void __launch_bounds__(256) k_gemm_ev_out(Params p) { SMEM_DECL; gemm_phase(p.A16, D, p.wt_ev_out, 1024, 1024, RowMap{0}, EpiResid{p.x, p.ctx, p.mod, p.H, 0}, smem); }
__global__ void __launch_bounds__(256) k_ln_mod(Params p, int layer, int lat_only) { ph_ln_mod(p, layer, 0, lat_only); }
__global__ void __launch_bounds__(256) k_gemm_pq(Params p, int layer, int lat_only) { SMEM_DECL; gemm_phase(p.A16, D, p.wt_pq + (size_t)layer * 2048 * 1024, 1024, 2048, RowMap{lat_only}, EpiBf16{p.P, 2048, 2048}, smem); }
__global__ void __launch_bounds__(256) k_scores(Params p, int layer, int lat_only) { SMEM_DECL; ph_scores_naive(p, layer, lat_only, smem); }
__global__ void __launch_bounds__(256) k_combine(Params p, int lat_only) { ph_combine(p, lat_only); }
__global__ void __launch_bounds__(256) k_gather(Params p, int layer, int lat_only) { ph_gather_ln(p, layer, lat_only); }
__global__ void __launch_bounds__(256) k_gemm_od_in(Params p) { SMEM_DECL; gemm_phase(p.A16, D, p.wt_od_in, 1024, 2560, RowMap{0}, EpiBf16{p.P, 2560, 2560}, smem); }
__global__ void __launch_bounds__(256) k_rglru(Params p) { SMEM_DECL; ph_rglru_naive(p, smem); }
__global__ void __launch_bounds__(256) k_gemm_od_out(Params p) { SMEM_DECL; gemm_phase(p.P, 2560, p.wt_od_out, 1280, 1024, RowMap{1}, EpiResid{p.x, p.ctx, p.mod, p.H, 1}, smem); }

__global__ void __launch_bounds__(256) k_mega(Params p) {
    SMEM_DECL;
    cg::grid_group grid = cg::this_grid();
    ph_prologue(p, smem); grid.sync();
    ph_modulate0(p); grid.sync();
    gemm_phase(p.A16, D, p.wt_ev_in, 1024, EV_IN, RowMap{0}, EpiBf16{p.P, EV_IN, EV_IN}, smem); grid.sync();
    ph_rowpost(p); grid.sync();
    gemm_phase(p.P + C_CQ, EV_IN, p.wt_uq, 384, 768, RowMap{0}, EpiQ{p.Q16, p.rsq, p.rope_cos, p.rope_sin}, smem);
    gemm_phase(p.P + C_CKV, EV_IN, p.wt_ukv, 256, 1024, RowMap{0}, EpiKV{p.K16, p.V16, p.rsq + R}, smem); grid.sync();
    if (blockIdx.x < 32) ph_gla_naive(p, smem); else ph_attn(p, smem, blockIdx.x - 32, gridDim.x - 32);
    grid.sync();
    gemm_phase(p.A16, D, p.wt_ev_out, 1024, 1024, RowMap{0}, EpiResid{p.x, p.ctx, p.mod, p.H, 0}, smem); grid.sync();
    ph_ln_mod(p, 0, 0, 0); grid.sync();
    gemm_phase(p.A16, D, p.wt_pq, 1024, 2048, RowMap{0}, EpiBf16{p.P, 2048, 2048}, smem); grid.sync();
    ph_scores_naive(p, 0, 0, smem); grid.sync();
    ph_combine(p, 0); ph_convert_uv(p, 0); grid.sync();
    ph_gather_mfma(p, 0, 0, smem); grid.sync();
    gemm_phase(p.A16, D, p.wt_od_in, 1024, 2560, RowMap{0}, EpiBf16{p.P, 2560, 2560}, smem); grid.sync();
    ph_rglru_naive(p, smem); grid.sync();
    gemm_phase(p.P, 2560, p.wt_od_out, 1280, 1024, RowMap{1}, EpiResid{p.x, p.ctx, p.mod, p.H, 1}, smem); grid.sync();
    ph_ln_mod(p, 1, 0, 1); grid.sync();
    gemm_phase(p.A16, D, p.wt_pq + (size_t)2048 * 1024, 1024, 2048, RowMap{1}, EpiBf16{p.P, 2048, 2048}, smem); grid.sync();
    ph_scores_naive(p, 1, 1, smem); grid.sync();
    ph_combine(p, 1); ph_convert_uv(p, 1); grid.sync();
    ph_gather_mfma(p, 1, 1, smem);
}

extern "C" void kernel_launch(void* const* d_in, const int* in_sizes, int n_in, void* d_out, int out_size, void* d_ws, size_t ws_size, hipStream_t stream) {
    Params p{};
    const float** f = (const float**)d_in;
    p.x = f[0]; p.c = f[1]; p.ctx = f[2]; p.c_ctx = f[3]; p.mod_w = f[4]; p.mod_b = f[5]; p.ln_g = f[6]; p.ln_b = f[7];
    p.ev_w_in = f[8]; p.ev_q_norm = f[9]; p.ev_kv_norm = f[10]; p.ev_w_uq = f[11]; p.ev_w_ukv = f[12]; p.ev_gla_wa2 = f[13]; p.ev_gla_ba = f[14]; p.ev_gla_norm = f[15]; p.ev_w_out = f[16];
    p.od_w_in = f[17]; p.od_conv_w = f[18]; p.od_conv_b = f[19]; p.od_gate_w = f[20]; p.od_gate_b = f[21]; p.od_lambda = f[22]; p.od_w_out = f[23];
    p.peer_wq = f[24]; p.peer_k1 = f[25]; p.peer_k2 = f[26]; p.peer_u = f[27]; p.peer_v = f[28];
    p.out = (float*)d_out;
    unsigned char* w = (unsigned char*)d_ws; size_t off = 0;
    auto take = [&](size_t bytes) { unsigned char* r = w + off; off += (bytes + 255) & ~(size_t)255; return r; };
    p.wt_ev_in = (bf16_t*)take((size_t)EV_IN * 1024 * 2); p.wt_uq = (bf16_t*)take(768 * 384 * 2); p.wt_ukv = (bf16_t*)take(1024 * 256 * 2);
    p.wt_ev_out = (bf16_t*)take(1024 * 1024 * 2); p.wt_od_in = (bf16_t*)take(2560 * 1024 * 2); p.wt_gate = (bf16_t*)take(40 * 16384 * 2);
    p.wt_od_out = (bf16_t*)take(1024 * 1280 * 2); p.wt_pq = (bf16_t*)take((size_t)2 * 2048 * 1024 * 2); p.wt_k = (bf16_t*)take(4 * 16384 * 2);
    p.mod = (float*)take(2 * 9 * 6144 * 4); p.rope_cos = (float*)take(SEQ * 16 * 4); p.rope_sin = (float*)take(SEQ * 16 * 4); p.rsq = (float*)take((size_t)2 * R * 4);
    p.H = (float*)take((size_t)R * D * 4);
    p.Q16 = (bf16_t*)p.H; p.K16 = p.Q16 + (size_t)R * 768; p.V16 = p.K16 + (size_t)R * 768;
    p.A16 = (bf16_t*)take((size_t)R * D * 2);
    p.P = (bf16_t*)take((size_t)R * 2560 * 2);
    p.G = take((size_t)94371840);
    if (off > ws_size) { fprintf(stderr, "workspace too small: need %zu have %zu\n", off, ws_size); return; }
    static int grid_blocks = 0;
    if (!grid_blocks) {
        int dev = 0, cus = 0, per_cu = 0;
        (void)hipGetDevice(&dev);
        (void)hipDeviceGetAttribute(&cus, hipDeviceAttributeMultiprocessorCount, dev);
        (void)hipOccupancyMaxActiveBlocksPerMultiprocessor(&per_cu, k_mega, 256, 0);
        if (per_cu > 2) per_cu = 2;
        if (per_cu < 1) per_cu = 1;
        grid_blocks = cus * per_cu;
    }
    void* args[] = {&p};
    hipError_t e = hipLaunchCooperativeKernel((void*)k_mega, dim3(grid_blocks), dim3(256), args, 0, stream);
    if (e != hipSuccess) fprintf(stderr, "cooperative launch failed: %s (grid %d)\n", hipGetErrorString(e), grid_blocks);
}
__global__ void __launch_bounds__(256) k_gather2(Params p, int layer, int lat_only) { SMEM_DECL; ph_gather_mfma(p, layer, lat_only, smem); }
```

```cpp
#include <hip/hip_runtime.h>
#include <hip/hip_cooperative_groups.h>
#include <cstdio>
#include <cstdint>

namespace cg = cooperative_groups;
typedef unsigned short bf16_t;
typedef short bf16x8 __attribute__((ext_vector_type(8)));
typedef float f32x4 __attribute__((ext_vector_type(4)));
typedef float f32x16 __attribute__((ext_vector_type(16)));
typedef unsigned u32x4 __attribute__((ext_vector_type(4)));
typedef unsigned u32x2 __attribute__((ext_vector_type(2)));

constexpr int D = 1024, NB = 8, SEQ = 4096, CTX = 256, PB = SEQ + CTX  , R = NB * PB  ;
constexpr int EV_IN = 2240, RGW = 1280;
constexpr int C_CQ = 0, C_CKV = 384, C_KPE = 640, C_GQ = 672, C_GK = 928, C_GV = 1184, C_GG = 1696, C_GAF = 2208;
constexpr float LN_EPS = 1e-6f, ALPHA = 1.41421356237f, MLA_SCALE = 0.10206207261596577f  ;
constexpr int PEER_N = 16384;

struct Params {
    const float *x, *c, *ctx, *c_ctx, *mod_w, *mod_b, *ln_g, *ln_b;
    const float *ev_w_in, *ev_q_norm, *ev_kv_norm, *ev_w_uq, *ev_w_ukv, *ev_gla_wa2, *ev_gla_ba, *ev_gla_norm, *ev_w_out;
    const float *od_w_in, *od_conv_w, *od_conv_b, *od_gate_w, *od_gate_b, *od_lambda, *od_w_out;
    const float *peer_wq, *peer_k1, *peer_k2, *peer_u, *peer_v;
    float* out;
    bf16_t *wt_ev_in, *wt_uq, *wt_ukv, *wt_ev_out, *wt_od_in, *wt_gate, *wt_od_out, *wt_pq, *wt_k;
    float *mod, *rope_cos, *rope_sin, *rsq;
    float* H; bf16_t *Q16, *K16, *V16;
    bf16_t* A16; bf16_t* P; unsigned char* G;
};

__device__ __forceinline__ bf16_t f2bf(float f) { unsigned u = __float_as_uint(f); u += 0x7fffu + ((u >> 16) & 1u); return (bf16_t)(u >> 16); }
__device__ __forceinline__ float bf2f(bf16_t h) { return __uint_as_float(((unsigned)h) << 16); }
__device__ __forceinline__ unsigned pack2(float a, float b) { unsigned r; asm volatile("v_cvt_pk_bf16_f32 %0, %1, %2" : "=v"(r) : "v"(a), "v"(b)); return r; }
__device__ __forceinline__ float silu_f(float x) { return x / (1.0f + expf(-x)); }
__device__ __forceinline__ float sigmoid_f(float x) { return 1.0f / (1.0f + expf(-x)); }
__device__ __forceinline__ float gelu_f(float x) { return 0.5f * x * (1.0f + erff(x * 0.70710678118654752f)); }
__device__ __forceinline__ float wave_sum(float v) {
#pragma unroll
    for (int o = 32; o > 0; o >>= 1) v += __shfl_xor(v, o);
    return v;
}
__device__ __forceinline__ int mod_row(int r) { const int b = r / PB, p = r - b * PB; return p < CTX ? 8 : b; }
__device__ __forceinline__ const float* in_row(const Params& P_, int r) {
    const int b = r / PB, p = r - b * PB;
    return p < CTX ? P_.ctx + ((size_t)b * CTX + p) * D : P_.x + ((size_t)b * SEQ + (p - CTX)) * D;
}

__device__ __forceinline__ void tconv_tile(const float* __restrict__ W, int K, int N, bf16_t* __restrict__ Wt, const float* __restrict__ rowscale, int tile, float* sm) {
    const int ntn = N / 64, tk = tile / ntn, tn = tile % ntn, tid = threadIdx.x;
#pragma unroll
    for (int i = 0; i < 4; ++i) {
        const int k = (tid >> 4) + 16 * i;
        f32x4 v = *(const f32x4*)(W + (size_t)(tk * 64 + k) * N + tn * 64 + (tid & 15) * 4);
        const float s = rowscale ? rowscale[tk * 64 + k] : 1.0f;
#pragma unroll
        for (int q = 0; q < 4; ++q) sm[k * 65 + (tid & 15) * 4 + q] = v[q] * s;
    }
    __syncthreads();
    const int n = tid >> 2, kc = tid & 3;
    unsigned w[8];
#pragma unroll
    for (int kk = 0; kk < 8; ++kk) w[kk] = pack2(sm[(kc * 16 + 2 * kk) * 65 + n], sm[(kc * 16 + 2 * kk + 1) * 65 + n]);
    bf16_t* dst = Wt + (size_t)(tn * 64 + n) * K + tk * 64 + kc * 16;
    *(u32x4*)dst = (u32x4){w[0], w[1], w[2], w[3]};
    *(u32x4*)(dst + 8) = (u32x4){w[4], w[5], w[6], w[7]};
    __syncthreads();
}
__device__ __forceinline__ void tconv_all(const float* W, int K, int N, bf16_t* Wt, const float* rowscale, float* sm) {
    const int nt = (K / 64) * (N / 64);
    for (int t = blockIdx.x; t < nt; t += gridDim.x) tconv_tile(W, K, N, Wt, rowscale, t, sm);
}

__device__ __forceinline__ void ph_prologue(const Params& p, unsigned char* smem) {
    float* sm = (float*)smem;
    tconv_all(p.ev_w_in, 1024, EV_IN, p.wt_ev_in, nullptr, sm);
    tconv_all(p.ev_w_uq, 384, 768, p.wt_uq, p.ev_q_norm, sm);
    tconv_all(p.ev_w_ukv, 256, 1024, p.wt_ukv, p.ev_kv_norm, sm);
    tconv_all(p.ev_w_out, 1024, 1024, p.wt_ev_out, nullptr, sm);
    tconv_all(p.od_w_in, 1024, 2560, p.wt_od_in, nullptr, sm);
    for (int g = 0; g < 40; ++g) tconv_all(p.od_gate_w + (size_t)g * 16384, 128, 128, p.wt_gate + (size_t)g * 16384, nullptr, sm);
    tconv_all(p.od_w_out, 1280, 1024, p.wt_od_out, nullptr, sm);
    for (int l = 0; l < 2; ++l) tconv_all(p.peer_wq + (size_t)l * 1024 * 2048, 1024, 2048, p.wt_pq + (size_t)l * 1024 * 2048, nullptr, sm);
    for (int i = blockIdx.x * 256 + threadIdx.x; i < 2 * 2 * 16384; i += gridDim.x * 256) {
        const int l = i / 32768, h = (i / 16384) & 1, e = i & 16383;
        p.wt_k[i] = f2bf((h ? p.peer_k2 : p.peer_k1)[(size_t)l * 16384 + e]);
    }
    for (int i = blockIdx.x * 256 + threadIdx.x; i < SEQ * 16; i += gridDim.x * 256) {
        const int s = i >> 4, f = i & 15;
        const float pos = (float)(f < 8 ? (s >> 6) : (s & 63));
        const float inv = powf(10000.0f, -(float)(f & 7) / 8.0f);
        const float ang = pos * inv;
        p.rope_cos[i] = cosf(ang); p.rope_sin[i] = sinf(ang);
    }
    float* sc = sm;
    for (int u = blockIdx.x; u < 2 * 96; u += gridDim.x) {
        const int l = u / 96, c0 = (u % 96) * 64, tid = threadIdx.x;
        __syncthreads();
        for (int i = tid; i < 9 * 1024; i += 256) { const int rr = i >> 10, k = i & 1023; sc[i] = silu_f(rr < 8 ? p.c[rr * 1024 + k] : p.c_ctx[k]); }
        __syncthreads();
        const int col = c0 + (tid & 63), kq = tid >> 6;
        float acc[9];
#pragma unroll
        for (int rr = 0; rr < 9; ++rr) acc[rr] = 0.f;
        const float* w = p.mod_w + (size_t)l * 1024 * 6144 + col;
        for (int k = kq * 256; k < kq * 256 + 256; ++k) {
            const float wv = w[(size_t)k * 6144];
#pragma unroll
            for (int rr = 0; rr < 9; ++rr) acc[rr] += sc[rr * 1024 + k] * wv;
        }
        __syncthreads();
        float* red = sm + 9 * 1024;
#pragma unroll
        for (int rr = 0; rr < 9; ++rr) red[(kq * 9 + rr) * 64 + (tid & 63)] = acc[rr];
        __syncthreads();
        for (int i = tid; i < 9 * 64; i += 256) {
            const int rr = i >> 6, cc = i & 63;
            const float s = red[(0 * 9 + rr) * 64 + cc] + red[(1 * 9 + rr) * 64 + cc] + red[(2 * 9 + rr) * 64 + cc] + red[(3 * 9 + rr) * 64 + cc];
            p.mod[((size_t)l * 9 + rr) * 6144 + c0 + cc] = s + p.mod_b[l * 6144 + c0 + cc];
        }
    }
}

__device__ __forceinline__ void ph_modulate0(const Params& p) {
    const int wid = threadIdx.x >> 6, lane = threadIdx.x & 63;
    for (int u = blockIdx.x; u < R / 4; u += gridDim.x) {
        const int r = u * 4 + wid;
        const float* src = in_row(p, r);
        const float* md = p.mod + (size_t)(0 * 9 + mod_row(r)) * 6144;
#pragma unroll
        for (int q = 0; q < 4; ++q) {
            const int c = q * 256 + lane * 4;
            const f32x4 h = *(const f32x4*)(src + c), sh = *(const f32x4*)(md + c), scl = *(const f32x4*)(md + 1024 + c);
            const f32x4 v = h * (1.0f + scl) + sh;
            *(u32x2*)(p.A16 + (size_t)r * D + c) = (u32x2){pack2(v[0], v[1]), pack2(v[2], v[3])};
        }
    }
}

constexpr int GBK = 64, GLDS = 72  ;
struct RowMap { int lat_only; __device__ __forceinline__ int ntiles() const { return lat_only ? 256 : 272; }
    __device__ __forceinline__ int row0(int t) const { return lat_only ? (t >> 5) * PB + CTX + (t & 31) * 128 : t * 128; } };

template <class Epi>
__device__ __forceinline__ void gemm_phase(const bf16_t* __restrict__ A, int lda, const bf16_t* __restrict__ Bt, int K, int N, RowMap rm, const Epi& epi, unsigned char* smem) {
    bf16_t* sA = (bf16_t*)smem; bf16_t* sB = sA + 128 * GLDS;
    const int tid = threadIdx.x, lane = tid & 63, wid = tid >> 6, wm = wid >> 1, wn = wid & 1, fr = lane & 15, fq = lane >> 4;
    const int ntn = (N + 127) / 128, nunits = rm.ntiles() * ntn, nk = K / GBK;
    for (int u = blockIdx.x; u < nunits; u += gridDim.x) {
        const int tm = u / ntn, tn = u % ntn, m0 = rm.row0(tm), n0 = tn * 128;
        f32x4 acc[4][4];
#pragma unroll
        for (int i = 0; i < 4; ++i)
#pragma unroll
            for (int j = 0; j < 4; ++j) acc[i][j] = (f32x4){0.f, 0.f, 0.f, 0.f};
        u32x4 ra[4], rb[4];
        auto gload = [&](int kt) {
#pragma unroll
            for (int i = 0; i < 4; ++i) {
                const int id = tid + 256 * i, row = id >> 3, ch = id & 7;
                ra[i] = *(const u32x4*)(A + (size_t)(m0 + row) * lda + kt * GBK + ch * 8);
                int brow = n0 + row; brow = brow < N ? brow : N - 1;
                rb[i] = *(const u32x4*)(Bt + (size_t)brow * K + kt * GBK + ch * 8);
            }
        };
        auto lstore = [&]() {
#pragma unroll
            for (int i = 0; i < 4; ++i) {
                const int id = tid + 256 * i, row = id >> 3, ch = id & 7;
                *(u32x4*)(sA + row * GLDS + ch * 8) = ra[i];
                *(u32x4*)(sB + row * GLDS + ch * 8) = rb[i];
            }
        };
        gload(0);
        __syncthreads();
        lstore();
        __syncthreads();
        for (int kt = 0; kt < nk; ++kt) {
            if (kt + 1 < nk) gload(kt + 1);
#pragma unroll
            for (int ks = 0; ks < 2; ++ks) {
                bf16x8 af[4], bfr[4];
#pragma unroll
                for (int i = 0; i < 4; ++i) af[i] = *(const bf16x8*)(sA + (wm * 64 + i * 16 + fr) * GLDS + ks * 32 + fq * 8);
#pragma unroll
                for (int j = 0; j < 4; ++j) bfr[j] = *(const bf16x8*)(sB + (wn * 64 + j * 16 + fr) * GLDS + ks * 32 + fq * 8);
#pragma unroll
                for (int i = 0; i < 4; ++i)
#pragma unroll
                    for (int j = 0; j < 4; ++j) acc[i][j] = __builtin_amdgcn_mfma_f32_16x16x32_bf16(bfr[j], af[i], acc[i][j], 0, 0, 0);
            }
            __syncthreads();
            if (kt + 1 < nk) { lstore(); __syncthreads(); }
        }
        epi(acc, m0 + wm * 64, n0 + wn * 64, fr, fq);
    }
}

struct EpiBf16 {
    bf16_t* C; int ldc, N;
    __device__ __forceinline__ void operator()(const f32x4 (&acc)[4][4], int mb, int nb, int fr, int fq) const {
#pragma unroll
        for (int i = 0; i < 4; ++i)
#pragma unroll
            for (int j = 0; j < 4; ++j) {
                const int m = mb + i * 16 + fr, n = nb + j * 16 + 4 * fq;
                if (n < N) *(u32x2*)(C + (size_t)m * ldc + n) = (u32x2){pack2(acc[i][j][0], acc[i][j][1]), pack2(acc[i][j][2], acc[i][j][3])};
            }
    }
};
struct EpiQ {
    bf16_t* Q; const float *rsq, *rc, *rs;
    __device__ __forceinline__ void operator()(const f32x4 (&acc)[4][4], int mb, int nb, int fr, int fq) const {
#pragma unroll
        for (int i = 0; i < 4; ++i) {
            const int m = mb + i * 16 + fr, b = m / PB, pp = m - b * PB;
            const float sc = rsq[m] * (MLA_SCALE * 1.4426950408889634f);
#pragma unroll
            for (int j = 0; j < 4; j += 2) {
                const int n = nb + j * 16 + 4 * fq;
                f32x4 v0 = acc[i][j] * sc, v1 = acc[i][j + 1] * sc;
                const int d = n % 96;
                if (d >= 64 && pp >= CTX) {
                    const int s = pp - CTX, f = (d - 64) + 0;
                    const f32x4 cs = *(const f32x4*)(rc + s * 16 + f), sn = *(const f32x4*)(rs + s * 16 + f);
                    const f32x4 o0 = v0 * cs - v1 * sn, o1 = v0 * sn + v1 * cs; v0 = o0; v1 = o1;
                }
                *(u32x2*)(Q + (size_t)m * 768 + n) = (u32x2){pack2(v0[0], v0[1]), pack2(v0[2], v0[3])};
                *(u32x2*)(Q + (size_t)m * 768 + n + 16) = (u32x2){pack2(v1[0], v1[1]), pack2(v1[2], v1[3])};
            }
        }
    }
};
struct EpiKV {
    bf16_t *Kd, *Vd; const float* rsq;
    __device__ __forceinline__ void operator()(const f32x4 (&acc)[4][4], int mb, int nb, int fr, int fq) const {
#pragma unroll
        for (int i = 0; i < 4; ++i) {
            const int m = mb + i * 16 + fr; const float sc = rsq[m];
#pragma unroll
            for (int j = 0; j < 4; ++j) {
                const int n = nb + j * 16 + 4 * fq, hd = n >> 7, d = n & 127;
                const f32x4 v = acc[i][j] * sc;
                bf16_t* dst = d < 64 ? Kd + (size_t)m * 768 + hd * 96 + d : Vd + (size_t)m * 512 + hd * 64 + (d - 64);
                *(u32x2*)dst = (u32x2){pack2(v[0], v[1]), pack2(v[2], v[3])};
            }
        }
    }
};
struct EpiResid {
    const float *x, *ctx, *mod; float* H; int layer;
    __device__ __forceinline__ void operator()(const f32x4 (&acc)[4][4], int mb, int nb, int fr, int fq) const {
#pragma unroll
        for (int i = 0; i < 4; ++i) {
            const int m = mb + i * 16 + fr, b = m / PB, pp = m - b * PB;
            const float* hin = layer == 0 ? (pp < CTX ? ctx + ((size_t)b * CTX + pp) * D : x + ((size_t)b * SEQ + (pp - CTX)) * D) : H + (size_t)m * D;
            const float* gate = mod + ((size_t)layer * 9 + (pp < CTX ? 8 : b)) * 6144 + 2 * 1024;
#pragma unroll
            for (int j = 0; j < 4; ++j) {
                const int n = nb + j * 16 + 4 * fq;
                const f32x4 h = *(const f32x4*)(hin + n), g = *(const f32x4*)(gate + n);
                *(f32x4*)(H + (size_t)m * D + n) = ALPHA * h + g * acc[i][j];
            }
        }
    }
};

__device__ __forceinline__ void ph_rowpost(const Params& p) {
    const int wid = threadIdx.x >> 6, lane = threadIdx.x & 63;
    for (int u = blockIdx.x; u < R / 4; u += gridDim.x) {
        const int r = u * 4 + wid, b = r / PB, pp = r - b * PB;
        const bf16_t* row = p.P + (size_t)r * EV_IN;
        float sq = 0.f, skv = 0.f;
#pragma unroll
        for (int i = 0; i < 10; ++i) { const float v = bf2f(row[lane + 64 * i]); if (i < 6) sq += v * v; else skv += v * v; }
        sq = wave_sum(sq); skv = wave_sum(skv);
        if (lane == 0) { p.rsq[r] = rsqrtf(sq / 384.0f + LN_EPS); p.rsq[R + r] = rsqrtf(skv / 256.0f + LN_EPS); }
        if (lane < 16) {
            float x1 = bf2f(row[C_KPE + lane]), x2 = bf2f(row[C_KPE + 16 + lane]);
            if (pp >= CTX) { const int s = pp - CTX; const float cs = p.rope_cos[s * 16 + lane], sn = p.rope_sin[s * 16 + lane];
                const float o1 = x1 * cs - x2 * sn, o2 = x1 * sn + x2 * cs; x1 = o1; x2 = o2; }
            const bf16_t b1 = f2bf(x1), b2 = f2bf(x2);
#pragma unroll
            for (int hd = 0; hd < 8; ++hd) { p.K16[(size_t)r * 768 + hd * 96 + 64 + lane] = b1; p.K16[(size_t)r * 768 + hd * 96 + 80 + lane] = b2; }
        }
    }
}

constexpr int AT_KS = 104, AT_VS = 68, AT_BUF = 64 * AT_KS * 2 + 64 * AT_VS * 2;
__device__ __forceinline__ void ph_attn(const Params& p, unsigned char* smem, int bid, int nblk) {
    const int tid = threadIdx.x, wid = tid >> 6, lane = tid & 63, q = lane & 31, h = lane >> 5;
    for (int u = bid; u < 2048 + 128; u += nblk) {
        int b, hd, q0, nkeys;
        if (u < 2048) { b = u >> 8; hd = (u >> 5) & 7; q0 = CTX + (u & 31) * 128; nkeys = PB; }
        else { const int v = u - 2048; b = v >> 4; hd = (v >> 1) & 7; q0 = (v & 1) * 128; nkeys = CTX; }
        const size_t rq = (size_t)b * PB + q0 + wid * 32 + q;
        bf16x8 qf[6];
#pragma unroll
        for (int s = 0; s < 6; ++s) qf[s] = *(const bf16x8*)(p.Q16 + rq * 768 + hd * 96 + 16 * s + 8 * h);
        f32x16 o[2];
#pragma unroll
        for (int i = 0; i < 16; ++i) { o[0][i] = 0.f; o[1][i] = 0.f; }
        float m = -1e30f, l = 0.f;
        const int ntiles = nkeys / 64;
        const bf16_t* Kg = p.K16 + (size_t)b * PB * 768 + hd * 96;
        const bf16_t* Vg = p.V16 + (size_t)b * PB * 512 + hd * 64;
        u32x4 rk[3], rv[2];
        auto gload = [&](int t) {
#pragma unroll
            for (int i = 0; i < 3; ++i) { const int id = tid + 256 * i, key = id / 12, ch = id % 12; rk[i] = *(const u32x4*)(Kg + (size_t)(t * 64 + key) * 768 + ch * 8); }
#pragma unroll
            for (int i = 0; i < 2; ++i) { const int id = tid + 256 * i, key = id >> 3, dch = id & 7; rv[i] = *(const u32x4*)(Vg + (size_t)(t * 64 + key) * 512 + dch * 8); }
        };
        auto lstore = [&](int buf) {
            bf16_t* Ks = (bf16_t*)(smem + buf * AT_BUF); bf16_t* Vt = Ks + 64 * AT_KS;
#pragma unroll
            for (int i = 0; i < 3; ++i) { const int id = tid + 256 * i, key = id / 12, ch = id % 12; *(u32x4*)(Ks + key * AT_KS + ch * 8) = rk[i]; }
#pragma unroll
            for (int i = 0; i < 2; ++i) {
                const int id = tid + 256 * i, key = id >> 3, dch = id & 7;
#pragma unroll
                for (int e = 0; e < 4; ++e) { Vt[(dch * 8 + 2 * e) * AT_VS + key] = (bf16_t)(rv[i][e] & 0xffffu); Vt[(dch * 8 + 2 * e + 1) * AT_VS + key] = (bf16_t)(rv[i][e] >> 16); }
            }
        };
        __syncthreads();
        gload(0); lstore(0);
        __syncthreads();
        for (int t = 0; t < ntiles; ++t) {
            if (t + 1 < ntiles) gload(t + 1);
            const bf16_t* Ks = (const bf16_t*)(smem + (t & 1) * AT_BUF); const bf16_t* Vt = Ks + 64 * AT_KS;
            f32x16 sa[2];
#pragma unroll
            for (int kb = 0; kb < 2; ++kb) {
#pragma unroll
                for (int i = 0; i < 16; ++i) sa[kb][i] = 0.f;
#pragma unroll
                for (int s = 0; s < 6; ++s) {
                    const bf16x8 kf = *(const bf16x8*)(Ks + (kb * 32 + q) * AT_KS + 16 * s + 8 * h);
                    sa[kb] = __builtin_amdgcn_mfma_f32_32x32x16_bf16(kf, qf[s], sa[kb], 0, 0, 0);
                }
            }
            float mx = sa[0][0];
#pragma unroll
            for (int i = 1; i < 16; ++i) mx = fmaxf(mx, sa[0][i]);
#pragma unroll
            for (int i = 0; i < 16; ++i) mx = fmaxf(mx, sa[1][i]);
            mx = fmaxf(mx, __shfl_xor(mx, 32));
            const float mn = fmaxf(m, mx), al = __builtin_amdgcn_exp2f(m - mn);
            m = mn;
            float ps = 0.f;
#pragma unroll
            for (int kb = 0; kb < 2; ++kb)
#pragma unroll
                for (int i = 0; i < 16; ++i) { const float e = __builtin_amdgcn_exp2f(sa[kb][i] - mn); sa[kb][i] = e; ps += e; }
            l = l * al + ps;
#pragma unroll
            for (int i = 0; i < 16; ++i) { o[0][i] *= al; o[1][i] *= al; }
#pragma unroll
            for (int kb = 0; kb < 2; ++kb)
#pragma unroll
                for (int s2 = 0; s2 < 2; ++s2) {
                    u32x4 pw;
#pragma unroll
                    for (int e = 0; e < 4; ++e) pw[e] = pack2(sa[kb][8 * s2 + 2 * e], sa[kb][8 * s2 + 2 * e + 1]);
                    const bf16x8 pf = __builtin_bit_cast(bf16x8, pw);
                    const int base = kb * 32 + 16 * s2;
#pragma unroll
                    for (int db = 0; db < 2; ++db) {
                        const bf16_t* vp = Vt + (db * 32 + q) * AT_VS + base + 4 * h;
                        const u32x2 v0 = *(const u32x2*)vp, v1 = *(const u32x2*)(vp + 8);
                        const bf16x8 vf = __builtin_bit_cast(bf16x8, (u32x4){v0[0], v0[1], v1[0], v1[1]});
                        o[db] = __builtin_amdgcn_mfma_f32_32x32x16_bf16(vf, pf, o[db], 0, 0, 0);
                    }
                }
            if (t + 1 < ntiles) lstore((t + 1) & 1);
            __syncthreads();
        }
        l += __shfl_xor(l, 32);
        const float il = 1.0f / l;
#pragma unroll
        for (int db = 0; db < 2; ++db)
#pragma unroll
            for (int gq = 0; gq < 4; ++gq) {
                const int d = db * 32 + 8 * gq + 4 * h;
                *(u32x2*)(p.A16 + rq * D + hd * 64 + d) = (u32x2){pack2(o[db][4 * gq] * il, o[db][4 * gq + 1] * il), pack2(o[db][4 * gq + 2] * il, o[db][4 * gq + 3] * il)};
            }
    }
}

constexpr size_t GLA_KS_BYTES = (size_t)NB * 4 * 68 * 2 * 8192 * 2;
constexpr int GL_S = 72;
__device__ __forceinline__ void gla_cum(const Params& p, size_t row0, int hd, int dir, float* sga, float* spart, float (&c)[16], float& T) {
    const int tid = threadIdx.x, d = tid & 63, part = tid >> 6;
    {
        const int j = tid >> 2, g4 = tid & 3;
        const u32x2 w = *(const u32x2*)(p.P + (row0 + j) * EV_IN + C_GAF + dir * 16 + g4 * 4);
        sga[j * 16 + g4 * 4 + 0] = __uint_as_float(w[0] << 16); sga[j * 16 + g4 * 4 + 1] = __uint_as_float(w[0] & 0xffff0000u);
        sga[j * 16 + g4 * 4 + 2] = __uint_as_float(w[1] << 16); sga[j * 16 + g4 * 4 + 3] = __uint_as_float(w[1] & 0xffff0000u);
    }
    __syncthreads();
    float wc[16];
    const float* wa = p.ev_gla_wa2 + (size_t)dir * 16 * 256 + hd * 64 + d;
#pragma unroll
    for (int g = 0; g < 16; ++g) wc[g] = wa[g * 256];
    const float bias = p.ev_gla_ba[dir * 256 + hd * 64 + d];
    float lv[16]; float run = 0.f;
#pragma unroll
    for (int jj = 0; jj < 16; ++jj) {
        const int j = part * 16 + jj;
        float z = bias;
#pragma unroll
        for (int g = 0; g < 16; g += 4) { const f32x4 a = *(const f32x4*)(sga + j * 16 + g); z += a[0] * wc[g] + a[1] * wc[g + 1] + a[2] * wc[g + 2] + a[3] * wc[g + 3]; }
        const float ls = (fminf(z, 0.f) - log1pf(expf(-fabsf(z)))) * (1.0f / 16.0f);
        lv[jj] = ls; run += ls; c[jj] = run;
    }
    spart[part * 64 + d] = run;
    __syncthreads();
    float off = 0.f; T = 0.f;
#pragma unroll
    for (int pp = 0; pp < 4; ++pp) { const float v = spart[pp * 64 + d]; T += v; if (pp < part) off += v; }
#pragma unroll
    for (int jj = 0; jj < 16; ++jj) c[jj] = dir == 0 ? off + c[jj] : T - (off + c[jj]) + lv[jj];
}
__device__ __forceinline__ void gla_stage_vt(const Params& p, size_t row0, int hd, bf16_t* Vt) {
    const int tid = threadIdx.x;
#pragma unroll
    for (int i = 0; i < 4; ++i) {
        const int id = tid + 256 * i, j = id >> 4, ech = id & 15;
        const u32x4 w = *(const u32x4*)(p.P + (row0 + j) * EV_IN + C_GV + hd * 128 + ech * 8);
#pragma unroll
        for (int e = 0; e < 4; ++e) { Vt[(ech * 8 + 2 * e) * GL_S + j] = (bf16_t)(w[e] & 0xffffu); Vt[(ech * 8 + 2 * e + 1) * GL_S + j] = (bf16_t)(w[e] >> 16); }
    }
}
__device__ __forceinline__ void ph_gla_a(const Params& p, unsigned char* smem) {
    bf16_t* kwT = (bf16_t*)smem; bf16_t* Vt = kwT + 64 * GL_S; float* sga = (float*)(Vt + 128 * GL_S); float* spart = sga + 1024;
    bf16_t* KS = (bf16_t*)p.G; float* DEC = (float*)(p.G + GLA_KS_BYTES);
    const int tid = threadIdx.x, lane = tid & 63, wid = tid >> 6, fr = lane & 15, fq = lane >> 4, d = tid & 63, part = tid >> 6;
    for (int u = blockIdx.x; u < NB * 4 * 68; u += gridDim.x) {
        const int b = u / 272, hd = (u / 68) & 3, ci = u % 68;
        const size_t row0 = (size_t)b * PB + ci * 64;
        __syncthreads();
        gla_stage_vt(p, row0, hd, Vt);
        for (int dir = 0; dir < 2; ++dir) {
            float c[16], T;
            gla_cum(p, row0, hd, dir, sga, spart, c, T);
            unsigned kw[8];
#pragma unroll
            for (int jj = 0; jj < 16; jj += 2) {
                const float k0 = bf2f(p.P[(row0 + part * 16 + jj) * EV_IN + C_GK + hd * 64 + d]), k1 = bf2f(p.P[(row0 + part * 16 + jj + 1) * EV_IN + C_GK + hd * 64 + d]);
                kw[jj >> 1] = pack2(k0 * expf(T - c[jj]), k1 * expf(T - c[jj + 1]));
            }
            *(u32x4*)(kwT + d * GL_S + part * 16) = (u32x4){kw[0], kw[1], kw[2], kw[3]};
            *(u32x4*)(kwT + d * GL_S + part * 16 + 8) = (u32x4){kw[4], kw[5], kw[6], kw[7]};
            if (part == 0) DEC[((size_t)u * 2 + dir) * 64 + d] = expf(T);
            __syncthreads();
            f32x4 acc[8];
#pragma unroll
            for (int et = 0; et < 8; ++et) acc[et] = (f32x4){0.f, 0.f, 0.f, 0.f};
#pragma unroll
            for (int s = 0; s < 2; ++s) {
                const bf16x8 a = *(const bf16x8*)(kwT + (16 * wid + fr) * GL_S + 32 * s + 8 * fq);
#pragma unroll
                for (int et = 0; et < 8; ++et) {
                    const bf16x8 bq = *(const bf16x8*)(Vt + (16 * et + fr) * GL_S + 32 * s + 8 * fq);
                    acc[et] = __builtin_amdgcn_mfma_f32_16x16x32_bf16(a, bq, acc[et], 0, 0, 0);
                }
            }
#pragma unroll
            for (int et = 0; et < 8; ++et)
                *(u32x2*)(KS + (((size_t)u * 2 + dir) * 128 + 16 * et + fr) * 64 + 16 * wid + 4 * fq) = (u32x2){pack2(acc[et][0], acc[et][1]), pack2(acc[et][2], acc[et][3])};
            __syncthreads();
        }
    }
}
__device__ __forceinline__ void ph_gla_b(const Params& p) {
    unsigned* KS32 = (unsigned*)p.G; const float* DEC = (const float*)(p.G + GLA_KS_BYTES);
    for (int gid = blockIdx.x * 256 + threadIdx.x; gid < 64 * 4096; gid += gridDim.x * 256) {
        const int seq = gid >> 12, pi = gid & 4095, dir = seq & 1, bh = seq >> 1, d = (2 * pi) & 63;
        float s0 = 0.f, s1 = 0.f;
#pragma unroll 4
        for (int step = 0; step < 68; ++step) {
            const int ci = dir == 0 ? step : (step < 4 ? 3 - step : 71 - step);
            const size_t ud = ((size_t)bh * 68 + ci) * 2 + dir;
            const unsigned w = KS32[ud * 4096 + pi];
            const float dc0 = DEC[ud * 64 + d], dc1 = DEC[ud * 64 + d + 1];
            KS32[ud * 4096 + pi] = pack2(s0, s1);
            s0 = dc0 * s0 + __uint_as_float(w << 16); s1 = dc1 * s1 + __uint_as_float(w & 0xffff0000u);
        }
    }
}
__device__ __forceinline__ void ph_gla_c(const Params& p, unsigned char* smem) {
    bf16_t* qs = (bf16_t*)smem; bf16_t* ks = qs + 64 * GL_S; bf16_t* Vt = ks + 64 * GL_S; float* sga = (float*)(Vt + 128 * GL_S); float* spart = sga + 1024;
    const bf16_t* KS = (const bf16_t*)p.G;
    const int tid = threadIdx.x, lane = tid & 63, wid = tid >> 6, fr = lane & 15, fq = lane >> 4, d = tid & 63, part = tid >> 6;
    for (int u = blockIdx.x; u < NB * 4 * 68; u += gridDim.x) {
        const int b = u / 272, hd = (u / 68) & 3, ci = u % 68;
        const size_t row0 = (size_t)b * PB + ci * 64;
        const int i = 16 * wid + fr;
        __syncthreads();
        gla_stage_vt(p, row0, hd, Vt);
        f32x4 oacc[8], pt[4];
#pragma unroll
        for (int et = 0; et < 8; ++et) oacc[et] = (f32x4){0.f, 0.f, 0.f, 0.f};
#pragma unroll
        for (int jt = 0; jt < 4; ++jt) pt[jt] = (f32x4){0.f, 0.f, 0.f, 0.f};
        for (int dir = 0; dir < 2; ++dir) {
            float c[16], T;
            gla_cum(p, row0, hd, dir, sga, spart, c, T);
#pragma unroll
            for (int jj = 0; jj < 16; ++jj) {
                const size_t ro = (row0 + part * 16 + jj) * EV_IN + hd * 64 + d;
                qs[(part * 16 + jj) * GL_S + d] = f2bf(bf2f(p.P[ro + C_GQ]) * 0.125f * expf(c[jj]));
                ks[(part * 16 + jj) * GL_S + d] = f2bf(bf2f(p.P[ro + C_GK]) * expf(-c[jj]));
            }
            __syncthreads();
            bf16x8 qf[2];
#pragma unroll
            for (int s = 0; s < 2; ++s) qf[s] = *(const bf16x8*)(qs + i * GL_S + 32 * s + 8 * fq);
#pragma unroll
            for (int jt = 0; jt < 4; ++jt) {
                f32x4 t = (f32x4){0.f, 0.f, 0.f, 0.f};
#pragma unroll
                for (int s = 0; s < 2; ++s) { const bf16x8 a = *(const bf16x8*)(ks + (16 * jt + fr) * GL_S + 32 * s + 8 * fq); t = __builtin_amdgcn_mfma_f32_16x16x32_bf16(a, qf[s], t, 0, 0, 0); }
#pragma unroll
                for (int rg = 0; rg < 4; ++rg) { const int j = 16 * jt + 4 * fq + rg; const bool keep = dir == 0 ? (j <= i) : (j >= i); pt[jt][rg] += keep ? t[rg] : 0.f; }
            }
            const bf16_t* Sg = KS + ((size_t)u * 2 + dir) * 8192;
#pragma unroll
            for (int et = 0; et < 8; ++et)
#pragma unroll
                for (int s = 0; s < 2; ++s) { const bf16x8 a = *(const bf16x8*)(Sg + (16 * et + fr) * 64 + 32 * s + 8 * fq); oacc[et] = __builtin_amdgcn_mfma_f32_16x16x32_bf16(a, qf[s], oacc[et], 0, 0, 0); }
            __syncthreads();
        }
#pragma unroll
        for (int k2 = 0; k2 < 2; ++k2) {
            const u32x4 pw = (u32x4){pack2(pt[2 * k2][0], pt[2 * k2][1]), pack2(pt[2 * k2][2], pt[2 * k2][3]), pack2(pt[2 * k2 + 1][0], pt[2 * k2 + 1][1]), pack2(pt[2 * k2 + 1][2], pt[2 * k2 + 1][3])};
            const bf16x8 pf = __builtin_bit_cast(bf16x8, pw);
#pragma unroll
            for (int et = 0; et < 8; ++et) {
                const bf16_t* vp = Vt + (16 * et + fr) * GL_S + 32 * k2 + 4 * fq;
                const u32x2 v0 = *(const u32x2*)vp, v1 = *(const u32x2*)(vp + 16);
                const bf16x8 vf = __builtin_bit_cast(bf16x8, (u32x4){v0[0], v0[1], v1[0], v1[1]});
                oacc[et] = __builtin_amdgcn_mfma_f32_16x16x32_bf16(vf, pf, oacc[et], 0, 0, 0);
            }
        }
        float ss = 0.f;
#pragma unroll
        for (int et = 0; et < 8; ++et) ss += oacc[et][0] * oacc[et][0] + oacc[et][1] * oacc[et][1] + oacc[et][2] * oacc[et][2] + oacc[et][3] * oacc[et][3];
        ss += __shfl_xor(ss, 16); ss += __shfl_xor(ss, 32);
        const float rs = rsqrtf(ss * (1.0f / 128.0f) + LN_EPS);
        const size_t r = row0 + i;
#pragma unroll
        for (int et = 0; et < 8; ++et) {
            const int e = 16 * et + 4 * fq;
            const u32x2 gw = *(const u32x2*)(p.P + r * EV_IN + C_GG + hd * 128 + e);
            const f32x4 nr = *(const f32x4*)(p.ev_gla_norm + hd * 128 + e);
            const float g0 = __uint_as_float(gw[0] << 16), g1 = __uint_as_float(gw[0] & 0xffff0000u), g2 = __uint_as_float(gw[1] << 16), g3 = __uint_as_float(gw[1] & 0xffff0000u);
            *(u32x2*)(p.A16 + r * D + 512 + hd * 128 + e) = (u32x2){pack2(oacc[et][0] * rs * nr[0] * silu_f(g0), oacc[et][1] * rs * nr[1] * silu_f(g1)),
                                                                   pack2(oacc[et][2] * rs * nr[2] * silu_f(g2), oacc[et][3] * rs * nr[3] * silu_f(g3))};
        }
    }
}

__device__ __forceinline__ void ph_ln_mod(const Params& p, int layer, int lnidx, int lat_only) {
    const int wid = threadIdx.x >> 6, lane = threadIdx.x & 63;
    const int nrows = lat_only ? NB * SEQ : R;
    const float* g = p.ln_g + (size_t)(layer * 2 + lnidx) * D; const float* bb = p.ln_b + (size_t)(layer * 2 + lnidx) * D;
    for (int u = blockIdx.x; u < nrows / 4; u += gridDim.x) {
        const int rr = u * 4 + wid, r = lat_only ? (rr >> 12) * PB + CTX + (rr & 4095) : rr;
        float* hrow = p.H + (size_t)r * D;
        f32x4 v[4]; float s = 0.f;
#pragma unroll
        for (int q = 0; q < 4; ++q) { v[q] = *(const f32x4*)(hrow + q * 256 + lane * 4); s += v[q][0] + v[q][1] + v[q][2] + v[q][3]; }
        const float mu = wave_sum(s) * (1.0f / 1024.0f);
        float ss = 0.f;
#pragma unroll
        for (int q = 0; q < 4; ++q) { v[q] = v[q] - mu; ss += v[q][0] * v[q][0] + v[q][1] * v[q][1] + v[q][2] * v[q][2] + v[q][3] * v[q][3]; }
        const float rstd = rsqrtf(wave_sum(ss) * (1.0f / 1024.0f) + LN_EPS);
        const float* md = p.mod + ((size_t)layer * 9 + mod_row(r)) * 6144;
#pragma unroll
        for (int q = 0; q < 4; ++q) {
            const int c = q * 256 + lane * 4;
            const f32x4 h = v[q] * rstd * *(const f32x4*)(g + c) + *(const f32x4*)(bb + c);
            *(f32x4*)(hrow + c) = h;
            const f32x4 a = h * (1.0f + *(const f32x4*)(md + 4 * 1024 + c)) + *(const f32x4*)(md + 3 * 1024 + c);
            *(u32x2*)(p.A16 + (size_t)r * D + c) = (u32x2){pack2(a[0], a[1]), pack2(a[2], a[3])};
        }
    }
}

__device__ __forceinline__ void ph_scores_naive(const Params& p, int layer, int lat_only, unsigned char* smem) {
    float* ks = (float*)smem;
    const bf16_t* QP = p.P;
    float* T = (float*)p.G;
    const int tid = threadIdx.x, rl = tid >> 3, hd = tid & 7;
    const int nrows = lat_only ? NB * SEQ : R;
    for (int u = blockIdx.x; u < nrows / 32; u += gridDim.x) {
        const int rr = u * 32 + rl, r = lat_only ? (rr >> 12) * PB + CTX + (rr & 4095) : rr;
        for (int half = 0; half < 2; ++half) {
            __syncthreads();
            const bf16_t* kk = p.wt_k + ((size_t)layer * 2 + half) * 16384;
            for (int i = tid; i < 16384; i += 256) ks[i] = bf2f(kk[i]);
            __syncthreads();
            float q[128];
#pragma unroll
            for (int d = 0; d < 128; d += 8) {
                const u32x4 w = *(const u32x4*)(QP + (size_t)r * 2048 + hd * 256 + half * 128 + d);
#pragma unroll
                for (int e = 0; e < 4; ++e) { q[d + 2 * e] = __uint_as_float(w[e] << 16); q[d + 2 * e + 1] = __uint_as_float(w[e] & 0xffff0000u); }
            }
            float top[16];
#pragma unroll
            for (int t = 0; t < 16; ++t) top[t] = -3.0e38f;
            for (int k = 0; k < 128; ++k) {
                float s = 0.f;
#pragma unroll
                for (int d = 0; d < 128; d += 4) { const f32x4 kv = *(const f32x4*)(ks + k * 128 + d); s += q[d] * kv[0] + q[d + 1] * kv[1] + q[d + 2] * kv[2] + q[d + 3] * kv[3]; }
                float xv = __uint_as_float((__float_as_uint(s) & ~127u) | (unsigned)k);
#pragma unroll
                for (int t = 0; t < 16; ++t) { const float hi = fmaxf(top[t], xv); xv = fminf(top[t], xv); top[t] = hi; }
            }
            float* dst = T + (((size_t)r * 8 + hd) * 2 + half) * 16;
#pragma unroll
            for (int t = 0; t < 16; t += 4) *(f32x4*)(dst + t) = (f32x4){top[t], top[t + 1], top[t + 2], top[t + 3]};
        }
    }
}

__device__ __forceinline__ void ph_combine(const Params& p, int lat_only) {
    const float* T = (const float*)p.G;
    int* EIDX = (int*)(p.G + (size_t)R * 8 * 2 * 16 * 4);
    float* EG = (float*)(p.G + (size_t)R * 8 * 2 * 16 * 4 + (size_t)R * 8 * 16 * 4);
    const int nrows = lat_only ? NB * SEQ : R;
    for (int g = blockIdx.x * 256 + threadIdx.x; g < nrows * 8; g += gridDim.x * 256) {
        const int rr = g >> 3, hd = g & 7, r = lat_only ? (rr >> 12) * PB + CTX + (rr & 4095) : rr;
        const float* t = T + ((size_t)r * 8 + hd) * 32;
        float t2[16];
#pragma unroll
        for (int i = 0; i < 16; ++i) t2[i] = __uint_as_float(__float_as_uint(t[16 + i]) & ~127u);
        float top[16];
#pragma unroll
        for (int k = 0; k < 16; ++k) top[k] = -3.0e38f;
        for (int i = 0; i < 16; ++i) {
            const float t1i = __uint_as_float(__float_as_uint(t[i]) & ~127u);
#pragma unroll
            for (int j = 0; j < 16; ++j) {
                float xv = __uint_as_float((__float_as_uint(t1i + t2[j]) & ~255u) | (unsigned)(i * 16 + j));
#pragma unroll
                for (int k = 0; k < 16; ++k) { const float hi = fmaxf(top[k], xv); xv = fminf(top[k], xv); top[k] = hi; }
            }
        }
        float e[16], sum = 0.f; const float mx = __uint_as_float(__float_as_uint(top[0]) & ~255u);
#pragma unroll
        for (int k = 0; k < 16; ++k) { e[k] = expf(__uint_as_float(__float_as_uint(top[k]) & ~255u) - mx); sum += e[k]; }
        const float inv = 1.0f / sum;
#pragma unroll
        for (int k = 0; k < 16; ++k) {
            const unsigned code = __float_as_uint(top[k]) & 255u, i = code >> 4, j = code & 15;
            const unsigned i1 = __float_as_uint(t[i]) & 127u, i2 = __float_as_uint(t[16 + j]) & 127u;
            EIDX[((size_t)r * 8 + hd) * 16 + k] = (int)(i1 * 128 + i2);
            EG[((size_t)r * 8 + hd) * 16 + k] = e[k] * inv;
        }
    }
}

__device__ __forceinline__ void ph_gather_ln(const Params& p, int layer, int lat_only) {
    const int wid = threadIdx.x >> 6, lane = threadIdx.x & 63;
    const int* EIDX = (const int*)(p.G + (size_t)R * 8 * 2 * 16 * 4);
    const float* EG = (const float*)(p.G + (size_t)R * 8 * 2 * 16 * 4 + (size_t)R * 8 * 16 * 4);
    const float* U = p.peer_u + (size_t)layer * PEER_N * D; const float* V = p.peer_v + (size_t)layer * PEER_N * D;
    const float* g = p.ln_g + (size_t)(layer * 2 + 1) * D; const float* bb = p.ln_b + (size_t)(layer * 2 + 1) * D;
    const int nrows = lat_only ? NB * SEQ : R;
    for (int u = blockIdx.x; u < nrows / 4; u += gridDim.x) {
        const int rr = u * 4 + wid, r = lat_only ? (rr >> 12) * PB + CTX + (rr & 4095) : rr;
        f32x4 hm[4], acc[4];
#pragma unroll
        for (int q = 0; q < 4; ++q) {
            const u32x2 w = *(const u32x2*)(p.A16 + (size_t)r * D + q * 256 + lane * 4);
            hm[q] = (f32x4){__uint_as_float(w[0] << 16), __uint_as_float(w[0] & 0xffff0000u), __uint_as_float(w[1] << 16), __uint_as_float(w[1] & 0xffff0000u)};
            acc[q] = (f32x4){0.f, 0.f, 0.f, 0.f};
        }
        for (int e0 = 0; e0 < 128; e0 += 2) {
            const int ea = EIDX[(size_t)r * 128 + e0], eb = EIDX[(size_t)r * 128 + e0 + 1];
            const float ga = EG[(size_t)r * 128 + e0], gb = EG[(size_t)r * 128 + e0 + 1];
            f32x4 ua[4], ub[4];
#pragma unroll
            for (int q = 0; q < 4; ++q) { ua[q] = *(const f32x4*)(U + (size_t)ea * D + q * 256 + lane * 4); ub[q] = *(const f32x4*)(U + (size_t)eb * D + q * 256 + lane * 4); }
            float da = 0.f, db = 0.f;
#pragma unroll
            for (int q = 0; q < 4; ++q) { da += hm[q][0] * ua[q][0] + hm[q][1] * ua[q][1] + hm[q][2] * ua[q][2] + hm[q][3] * ua[q][3]; db += hm[q][0] * ub[q][0] + hm[q][1] * ub[q][1] + hm[q][2] * ub[q][2] + hm[q][3] * ub[q][3]; }
            da = wave_sum(da); db = wave_sum(db);
            const float wa = ga * gelu_f(da), wb = gb * gelu_f(db);
#pragma unroll
            for (int q = 0; q < 4; ++q) {
                acc[q] += wa * *(const f32x4*)(V + (size_t)ea * D + q * 256 + lane * 4);
                acc[q] += wb * *(const f32x4*)(V + (size_t)eb * D + q * 256 + lane * 4);
            }
        }
        const float* md = p.mod + ((size_t)layer * 9 + mod_row(r)) * 6144;
        float* hrow = p.H + (size_t)r * D;
        f32x4 v[4]; float s = 0.f;
#pragma unroll
        for (int q = 0; q < 4; ++q) { const int c = q * 256 + lane * 4; v[q] = ALPHA * *(const f32x4*)(hrow + c) + *(const f32x4*)(md + 5 * 1024 + c) * acc[q]; s += v[q][0] + v[q][1] + v[q][2] + v[q][3]; }
        const float mu = wave_sum(s) * (1.0f / 1024.0f);
        float ss = 0.f;
#pragma unroll
        for (int q = 0; q < 4; ++q) { v[q] = v[q] - mu; ss += v[q][0] * v[q][0] + v[q][1] * v[q][1] + v[q][2] * v[q][2] + v[q][3] * v[q][3]; }
        const float rstd = rsqrtf(wave_sum(ss) * (1.0f / 1024.0f) + LN_EPS);
        if (layer == 0) {
            const float* md1 = p.mod + ((size_t)1 * 9 + mod_row(r)) * 6144;
#pragma unroll
            for (int q = 0; q < 4; ++q) {
                const int c = q * 256 + lane * 4;
                const f32x4 h = v[q] * rstd * *(const f32x4*)(g + c) + *(const f32x4*)(bb + c);
                *(f32x4*)(hrow + c) = h;
                const f32x4 a = h * (1.0f + *(const f32x4*)(md1 + 1024 + c)) + *(const f32x4*)(md1 + c);
                *(u32x2*)(p.A16 + (size_t)r * D + c) = (u32x2){pack2(a[0], a[1]), pack2(a[2], a[3])};
            }
        } else {
            float* orow = p.out + (size_t)rr * D;
#pragma unroll
            for (int q = 0; q < 4; ++q) { const int c = q * 256 + lane * 4; *(f32x4*)(orow + c) = v[q] * rstd * *(const f32x4*)(g + c) + *(const f32x4*)(bb + c); }
        }
    }
}

__device__ __forceinline__ void ph_convert_uv(const Params& p, int layer) {
    const float* src0 = p.peer_u + (size_t)layer * PEER_N * D;
    const float* src1 = p.peer_v + (size_t)layer * PEER_N * D;
    const int n8 = PEER_N * D / 8;
    for (int i = blockIdx.x * 256 + threadIdx.x; i < n8; i += gridDim.x * 256) {
        const f32x4 a = *(const f32x4*)(src0 + (size_t)i * 8), b = *(const f32x4*)(src0 + (size_t)i * 8 + 4);
        *(u32x4*)(p.P + (size_t)i * 8) = (u32x4){pack2(a[0], a[1]), pack2(a[2], a[3]), pack2(b[0], b[1]), pack2(b[2], b[3])};
        const f32x4 c = *(const f32x4*)(src1 + (size_t)i * 8), d = *(const f32x4*)(src1 + (size_t)i * 8 + 4);
        *(u32x4*)(p.P + (size_t)PEER_N * D + (size_t)i * 8) = (u32x4){pack2(c[0], c[1]), pack2(c[2], c[3]), pack2(d[0], d[1]), pack2(d[2], d[3])};
    }
}

__device__ __forceinline__ void ph_gather_mfma(const Params& p, int layer, int lat_only, unsigned char* smem) {
    const int tid = threadIdx.x, wid = tid >> 6, lane = tid & 63, c = lane & 15, g = lane >> 4;
    bf16_t* hs = (bf16_t*)(smem + wid * 3072);
    int* se = (int*)(smem + wid * 3072 + 2048);
    float* sw = (float*)(smem + wid * 3072 + 2560);
    const int* EIDX = (const int*)(p.G + (size_t)R * 8 * 2 * 16 * 4);
    const float* EG = (const float*)(p.G + (size_t)R * 8 * 2 * 16 * 4 + (size_t)R * 8 * 16 * 4);
    const bf16_t* U = p.P; const bf16_t* V = p.P + (size_t)PEER_N * D;
    const float* gam = p.ln_g + (size_t)(layer * 2 + 1) * D; const float* bet = p.ln_b + (size_t)(layer * 2 + 1) * D;
    const int nrows = lat_only ? NB * SEQ : R;
    for (int u = blockIdx.x; u < nrows / 4; u += gridDim.x) {
        const int rr = u * 4 + wid, r = lat_only ? (rr >> 12) * PB + CTX + (rr & 4095) : rr;
        __syncthreads();
        *(u32x4*)(hs + lane * 8) = *(const u32x4*)(p.A16 + (size_t)r * D + lane * 8);
        *(u32x4*)(hs + 512 + lane * 8) = *(const u32x4*)(p.A16 + (size_t)r * D + 512 + lane * 8);
        se[lane] = EIDX[(size_t)r * 128 + lane]; se[64 + lane] = EIDX[(size_t)r * 128 + 64 + lane];
        sw[lane] = EG[(size_t)r * 128 + lane]; sw[64 + lane] = EG[(size_t)r * 128 + 64 + lane];
        __syncthreads();
        for (int hd = 0; hd < 8; ++hd) {
            f32x4 dacc = (f32x4){0.f, 0.f, 0.f, 0.f};
            const bf16_t* urow = U + (size_t)se[hd * 16 + c] * D + g * 8;
#pragma unroll 16
            for (int s = 0; s < 32; ++s) {
                const bf16x8 bq = *(const bf16x8*)(urow + s * 32);
                const bf16x8 aq = *(const bf16x8*)(hs + s * 32 + g * 8);
                dacc = __builtin_amdgcn_mfma_f32_16x16x32_bf16(aq, bq, dacc, 0, 0, 0);
            }
            const float wv = sw[hd * 16 + c] * gelu_f(dacc[0]);
            if (g == 0) sw[hd * 16 + c] = wv;
        }
        __syncthreads();
        f32x4 oacc[8];
#pragma unroll
        for (int blk = 0; blk < 8; ++blk) oacc[blk] = (f32x4){0.f, 0.f, 0.f, 0.f};
#pragma unroll 2
        for (int it = 0; it < 32; ++it) {
            const int e = se[4 * it + g];
            const float wv = sw[4 * it + g];
            const unsigned wb = (unsigned)f2bf(wv) << (16 * (c & 1));
            u32x4 aw;
#pragma unroll
            for (int q = 0; q < 4; ++q) aw[q] = (c < 8 && (c >> 1) == q) ? wb : 0u;
            const bf16x8 aq = __builtin_bit_cast(bf16x8, aw);
            const bf16_t* vrow = V + (size_t)e * D + c * 8;
#pragma unroll
            for (int blk = 0; blk < 8; ++blk) {
                const bf16x8 bq = *(const bf16x8*)(vrow + blk * 128);
                oacc[blk] = __builtin_amdgcn_mfma_f32_16x16x32_bf16(aq, bq, oacc[blk], 0, 0, 0);
            }
        }
        const float* md = p.mod + ((size_t)layer * 9 + mod_row(r)) * 6144;
        float* hrow = p.H + (size_t)r * D;
        const bool act = g < 2;
        f32x4 v[8]; float s = 0.f;
#pragma unroll
        for (int blk = 0; blk < 8; ++blk) {
            const int n = 128 * blk + 8 * c + 4 * (g & 1);
            v[blk] = ALPHA * *(const f32x4*)(hrow + n) + *(const f32x4*)(md + 5 * 1024 + n) * oacc[blk];
            if (!act) v[blk] = (f32x4){0.f, 0.f, 0.f, 0.f};
            s += v[blk][0] + v[blk][1] + v[blk][2] + v[blk][3];
        }
        const float mu = wave_sum(s) * (1.0f / 1024.0f);
        float ss = 0.f;
#pragma unroll
        for (int blk = 0; blk < 8; ++blk) { v[blk] = v[blk] - mu; if (act) ss += v[blk][0] * v[blk][0] + v[blk][1] * v[blk][1] + v[blk][2] * v[blk][2] + v[blk][3] * v[blk][3]; }
        const float rstd = rsqrtf(wave_sum(ss) * (1.0f / 1024.0f) + LN_EPS);
        if (act) {
            if (layer == 0) {
                const float* md1 = p.mod + ((size_t)1 * 9 + mod_row(r)) * 6144;
#pragma unroll
                for (int blk = 0; blk < 8; ++blk) {
                    const int n = 128 * blk + 8 * c + 4 * g;
                    const f32x4 h = v[blk] * rstd * *(const f32x4*)(gam + n) + *(const f32x4*)(bet + n);
                    *(f32x4*)(hrow + n) = h;
                    const f32x4 a = h * (1.0f + *(const f32x4*)(md1 + 1024 + n)) + *(const f32x4*)(md1 + n);
                    *(u32x2*)(p.A16 + (size_t)r * D + n) = (u32x2){pack2(a[0], a[1]), pack2(a[2], a[3])};
                }
            } else {
                float* orow = p.out + (size_t)rr * D;
#pragma unroll
                for (int blk = 0; blk < 8; ++blk) { const int n = 128 * blk + 8 * c + 4 * g; *(f32x4*)(orow + n) = v[blk] * rstd * *(const f32x4*)(gam + n) + *(const f32x4*)(bet + n); }
            }
        }
    }
}

constexpr int RG_ZS = 136;
constexpr size_t RG_SUM_BYTES = (size_t)NB * 34 * 2 * RGW * 2 * 4;
__device__ __forceinline__ void rg_stage_z(const Params& p, int b, int c34, int n, bf16_t* zc) {
    const int tid = threadIdx.x, k2 = tid & 63, tq = tid >> 6, ch = n * 128 + 2 * k2;
    const int lo = c34 < 2 ? 0 : CTX, hi = c34 < 2 ? CTX : PB, p0 = c34 * 128 + 32 * tq;
    float w0[4], w1[4];
#pragma unroll
    for (int tap = 0; tap < 4; ++tap) { w0[tap] = p.od_conv_w[tap * RGW + ch]; w1[tap] = p.od_conv_w[tap * RGW + ch + 1]; }
    const float b0 = p.od_conv_b[ch], b1 = p.od_conv_b[ch + 1];
    const bf16_t* base = p.P + (size_t)b * PB * 2560 + RGW + ch;
    auto ld = [&](int pp, float& a, float& c) { if (pp >= lo && pp < hi) { const unsigned w = *(const unsigned*)(base + (size_t)pp * 2560); a = __uint_as_float(w << 16); c = __uint_as_float(w & 0xffff0000u); } else { a = 0.f; c = 0.f; } };
    float am2, cm2, am1, cm1, a0, c0, ap1, cp1;
    ld(p0 - 2, am2, cm2); ld(p0 - 1, am1, cm1); ld(p0, a0, c0);
#pragma unroll 4
    for (int t = 0; t < 32; ++t) {
        ld(p0 + t + 1, ap1, cp1);
        const float y0 = b0 + w0[0] * am2 + w0[1] * am1 + w0[2] * a0 + w0[3] * ap1;
        const float y1 = b1 + w1[0] * cm2 + w1[1] * cm1 + w1[2] * c0 + w1[3] * cp1;
        *(unsigned*)(zc + (32 * tq + t) * RG_ZS + 2 * k2) = pack2(y0, y1);
        am2 = am1; cm2 = cm1; am1 = a0; cm1 = c0; a0 = ap1; c0 = cp1;
    }
}
__device__ __forceinline__ float gelu_fast(float v) {
    const float av = fabsf(v), t = __builtin_amdgcn_rcpf(av * 0.2316418882f + 1.0f);
    float q = t * 0.5307027145f + (-0.7265760135f); q = q * t + 0.7107068705f; q = q * t + (-0.142248368f); q = q * t + 0.127414796f; q = q * t;
    const float e = __builtin_amdgcn_exp2f(v * v * (-0.72134752044f));
    const float m = v * (q * e);
    return v < 0.f ? m : v - m;
}
struct RgCtx { bf16x8 wr[4], wi[4]; float br, bi, coef; };
__device__ __forceinline__ void rg_ctx_load(const Params& p, int n, int cl, int dir, RgCtx& c) {
    const int lane = threadIdx.x & 63, fr = lane & 15, fq = lane >> 4, ch = n * 128 + cl + fr;
    const bf16_t* gr = p.wt_gate + ((size_t)(dir * 2 + 0) * 10 + n) * 16384 + (size_t)(cl + fr) * 128 + 8 * fq;
    const bf16_t* gi = p.wt_gate + ((size_t)(dir * 2 + 1) * 10 + n) * 16384 + (size_t)(cl + fr) * 128 + 8 * fq;
#pragma unroll
    for (int s = 0; s < 4; ++s) { c.wr[s] = *(const bf16x8*)(gr + 32 * s); c.wi[s] = *(const bf16x8*)(gi + 32 * s); }
    c.br = p.od_gate_b[(dir * 2 + 0) * RGW + ch]; c.bi = p.od_gate_b[(dir * 2 + 1) * RGW + ch];
    const float lam = p.od_lambda[dir * RGW + ch];
    c.coef = -8.0f * (fmaxf(-lam, 0.f) + log1pf(expf(-fabsf(lam)))) * 1.4426950408889634f;
}
__device__ __forceinline__ void rg_tile(const bf16_t* zc, int mt, int cl, const RgCtx& c, f32x4& a4, f32x4& x4) {
    const int lane = threadIdx.x & 63, fr = lane & 15, fq = lane >> 4;
    f32x4 r = (f32x4){0.f, 0.f, 0.f, 0.f}, ig = (f32x4){0.f, 0.f, 0.f, 0.f};
#pragma unroll
    for (int s = 0; s < 4; ++s) {
        const bf16x8 a = *(const bf16x8*)(zc + (16 * mt + fr) * RG_ZS + 32 * s + 8 * fq);
        r = __builtin_amdgcn_mfma_f32_16x16x32_bf16(a, c.wr[s], r, 0, 0, 0);
        ig = __builtin_amdgcn_mfma_f32_16x16x32_bf16(a, c.wi[s], ig, 0, 0, 0);
    }
#pragma unroll
    for (int rg = 0; rg < 4; ++rg) {
        const float rr = __builtin_amdgcn_rcpf(1.0f + __builtin_amdgcn_exp2f(-1.4426950408889634f * (r[rg] + c.br)));
        const float ii = __builtin_amdgcn_rcpf(1.0f + __builtin_amdgcn_exp2f(-1.4426950408889634f * (ig[rg] + c.bi)));
        const float a = __builtin_amdgcn_exp2f(c.coef * rr);
        const float z = bf2f(zc[(16 * mt + 4 * fq + rg) * RG_ZS + cl + fr]);
        a4[rg] = a; x4[rg] = sqrtf((1.0f - a) * (1.0f + a)) * ii * z;
    }
}
template <int DIR> __device__ __forceinline__ void rg_sum_dir(const Params& p, const bf16_t* zc, int b, int c34, int n, int cl, float* SUM) {
    const int lane = threadIdx.x & 63, fr = lane & 15, fq = lane >> 4;
    RgCtx c; rg_ctx_load(p, n, cl, DIR, c);
    float h = 0.f, pt = 1.f;
#pragma unroll 2
    for (int m2 = 0; m2 < 8; ++m2) {
        const int mt = DIR == 0 ? m2 : 7 - m2;
        f32x4 a, x; rg_tile(zc, mt, cl, c, a, x);
        const float P4 = a[0] * a[1] * a[2] * a[3];
        const float B4 = DIR == 0 ? ((x[0] * a[1] + x[1]) * a[2] + x[2]) * a[3] + x[3] : ((x[3] * a[2] + x[2]) * a[1] + x[1]) * a[0] + x[0];
#pragma unroll
        for (int g2 = 0; g2 < 4; ++g2) {
            const int gs = DIR == 0 ? g2 : 3 - g2;
            const float Pg = __shfl(P4, 16 * gs + fr), Bg = __shfl(B4, 16 * gs + fr);
            h = Pg * h + Bg; pt *= Pg;
        }
    }
    if (fq == 0) { float* dst = SUM + ((((size_t)b * 34 + c34) * 2 + DIR) * RGW + n * 128 + cl + fr) * 2; dst[0] = pt; dst[1] = h; }
}
__device__ __forceinline__ void ph_rg_a(const Params& p, unsigned char* smem) {
    bf16_t* zc = (bf16_t*)smem;
    float* SUM = (float*)p.G;
    const int wid = threadIdx.x >> 6;
    for (int u = blockIdx.x; u < NB * 34 * 10; u += gridDim.x) {
        const int b = u / 340, c34 = (u / 10) % 34, n = u % 10;
        __syncthreads();
        rg_stage_z(p, b, c34, n, zc);
        __syncthreads();
        for (int nt = 0; nt < 2; ++nt) {
            const int cl = 32 * wid + 16 * nt;
            rg_sum_dir<0>(p, zc, b, c34, n, cl, SUM);
            rg_sum_dir<1>(p, zc, b, c34, n, cl, SUM);
        }
    }
}
__device__ __forceinline__ void ph_rg_b(const Params& p) {
    const float* SUM = (const float*)p.G; float* HIN = (float*)(p.G + RG_SUM_BYTES);
    for (int gid = blockIdx.x * 256 + threadIdx.x; gid < NB * 2 * RGW; gid += gridDim.x * 256) {
        const int ch = gid % RGW, dir = (gid / RGW) & 1, b = gid / (2 * RGW);
        float h = 0.f;
#pragma unroll 2
        for (int step = 0; step < 34; ++step) {
            const int c34 = dir == 0 ? step : (step < 2 ? 1 - step : 35 - step);
            const size_t o = (((size_t)b * 34 + c34) * 2 + dir) * RGW + ch;
            HIN[o] = h;
            h = SUM[o * 2] * h + SUM[o * 2 + 1];
        }
    }
}
template <int DIR> __device__ __forceinline__ void rg_apply_dir(const Params& p, const bf16_t* zc, bf16_t* yf, int b, int c34, int n, int cl, const float* HIN) {
    const int lane = threadIdx.x & 63, fr = lane & 15, fq = lane >> 4, ch = n * 128 + cl + fr;
    RgCtx c; rg_ctx_load(p, n, cl, DIR, c);
    float h = HIN[(((size_t)b * 34 + c34) * 2 + DIR) * RGW + ch];
#pragma unroll 2
    for (int m2 = 0; m2 < 8; ++m2) {
        const int mt = DIR == 0 ? m2 : 7 - m2;
        f32x4 a, x; rg_tile(zc, mt, cl, c, a, x);
        const float P4 = a[0] * a[1] * a[2] * a[3];
        const float B4 = DIR == 0 ? ((x[0] * a[1] + x[1]) * a[2] + x[2]) * a[3] + x[3] : ((x[3] * a[2] + x[2]) * a[1] + x[1]) * a[0] + x[0];
        float hin = 0.f;
#pragma unroll
        for (int g2 = 0; g2 < 4; ++g2) {
            const int gs = DIR == 0 ? g2 : 3 - g2;
            const float Pg = __shfl(P4, 16 * gs + fr), Bg = __shfl(B4, 16 * gs + fr);
            if (fq == gs) hin = h;
            h = Pg * h + Bg;
        }
        f32x4 y;
        if (DIR == 0) {
            y[0] = a[0] * hin + x[0]; y[1] = a[1] * y[0] + x[1]; y[2] = a[2] * y[1] + x[2]; y[3] = a[3] * y[2] + x[3];
#pragma unroll
            for (int rg = 0; rg < 4; ++rg) yf[(16 * mt + 4 * fq + rg) * 16 + fr] = f2bf(y[rg]);
        } else {
            y[3] = a[3] * hin + x[3]; y[2] = a[2] * y[3] + x[2]; y[1] = a[1] * y[2] + x[1]; y[0] = a[0] * y[1] + x[0];
#pragma unroll
            for (int rg = 0; rg < 4; ++rg) {
                bf16_t* pb = p.P + ((size_t)b * PB + c34 * 128 + 16 * mt + 4 * fq + rg) * 2560 + ch;
                *pb = f2bf(gelu_fast(bf2f(*pb)) * (y[rg] + bf2f(yf[(16 * mt + 4 * fq + rg) * 16 + fr])));
            }
        }
    }
}
__device__ __forceinline__ void ph_rg_c(const Params& p, unsigned char* smem) {
    bf16_t* zc = (bf16_t*)smem;
    const float* HIN = (const float*)(p.G + RG_SUM_BYTES);
    const int wid = threadIdx.x >> 6;
    bf16_t* yf = (bf16_t*)(smem + 128 * RG_ZS * 2) + wid * 2048;
    for (int u = blockIdx.x; u < NB * 32 * 10; u += gridDim.x) {
        const int b = u / 320, c34 = 2 + (u / 10) % 32, n = u % 10;
        __syncthreads();
        rg_stage_z(p, b, c34, n, zc);
        __syncthreads();
        for (int nt = 0; nt < 2; ++nt) {
            const int cl = 32 * wid + 16 * nt;
            rg_apply_dir<0>(p, zc, yf, b, c34, n, cl, HIN);
            rg_apply_dir<1>(p, zc, yf, b, c34, n, cl, HIN);
        }
    }
}

#define SMEM_DECL __shared__ __attribute__((aligned(16))) unsigned char smem[65536]
__global__ void __launch_bounds__(256) k_prologue(Params p) { SMEM_DECL; ph_prologue(p, smem); }
__global__ void __launch_bounds__(256) k_modulate0(Params p) { ph_modulate0(p); }
__global__ void __launch_bounds__(256) k_gemm_ev_in(Params p) { SMEM_DECL; gemm_phase(p.A16, D, p.wt_ev_in, 1024, EV_IN, RowMap{0}, EpiBf16{p.P, EV_IN, EV_IN}, smem); }
__global__ void __launch_bounds__(256) k_rowpost(Params p) { ph_rowpost(p); }
__global__ void __launch_bounds__(256) k_gemm_q(Params p) { SMEM_DECL; gemm_phase(p.P + C_CQ, EV_IN, p.wt_uq, 384, 768, RowMap{0}, EpiQ{p.Q16, p.rsq, p.rope_cos, p.rope_sin}, smem); }
__global__ void __launch_bounds__(256) k_gemm_kv(Params p) { SMEM_DECL; gemm_phase(p.P + C_CKV, EV_IN, p.wt_ukv, 256, 1024, RowMap{0}, EpiKV{p.K16, p.V16, p.rsq + R}, smem); }
__global__ void __launch_bounds__(256) k_gemm_ev_out(Params p) { SMEM_DECL; gemm_phase(p.A16, D, p.wt_ev_out, 1024, 1024, RowMap{0}, EpiResid{p.x, p.ctx, p.mod, p.H, 0}, smem); }
__global__ void __launch_bounds__(256) k_ln_mod(Params p, int layer, int lat_only) { ph_ln_mod(p, layer, 0, lat_only); }
__global__ void __launch_bounds__(256) k_gemm_pq(Params p, int layer, int lat_only) { SMEM_DECL; gemm_phase(p.A16, D, p.wt_pq + (size_t)layer * 2048 * 1024, 1024, 2048, RowMap{lat_only}, EpiBf16{p.P, 2048, 2048}, smem); }
__global__ void __launch_bounds__(256) k_scores(Params p, int layer, int lat_only) { SMEM_DECL; ph_scores_naive(p, layer, lat_only, smem); }
__global__ void __launch_bounds__(256) k_combine(Params p, int lat_only) { ph_combine(p, lat_only); }
__global__ void __launch_bounds__(256) k_gather(Params p, int layer, int lat_only) { ph_gather_ln(p, layer, lat_only); }
__global__ void __launch_bounds__(256) k_gemm_od_in(Params p) { SMEM_DECL; gemm_phase(p.A16, D, p.wt_od_in, 1024, 2560, RowMap{0}, EpiBf16{p.P, 2560, 2560}, smem); }
__global__ void __launch_bounds__(256) k_gemm_od_out(Params p) { SMEM_DECL; gemm_phase(p.P, 2560, p.wt_od_out, 1280, 1024, RowMap{1}, EpiResid{p.x, p.ctx, p.mod, p.H, 1}, smem); }

__global__ void __launch_bounds__(256) k_mega(Params p) {
    SMEM_DECL;
    cg::grid_group grid = cg::this_grid();
    ph_prologue(p, smem); grid.sync();
    ph_modulate0(p); grid.sync();
    gemm_phase(p.A16, D, p.wt_ev_in, 1024, EV_IN, RowMap{0}, EpiBf16{p.P, EV_IN, EV_IN}, smem); grid.sync();
    ph_rowpost(p); ph_gla_a(p, smem); grid.sync();
    gemm_phase(p.P + C_CQ, EV_IN, p.wt_uq, 384, 768, RowMap{0}, EpiQ{p.Q16, p.rsq, p.rope_cos, p.rope_sin}, smem);
    gemm_phase(p.P + C_CKV, EV_IN, p.wt_ukv, 256, 1024, RowMap{0}, EpiKV{p.K16, p.V16, p.rsq + R}, smem); ph_gla_b(p); grid.sync();
    ph_gla_c(p, smem); ph_attn(p, smem, blockIdx.x, gridDim.x); grid.sync();
    gemm_phase(p.A16, D, p.wt_ev_out, 1024, 1024, RowMap{0}, EpiResid{p.x, p.ctx, p.mod, p.H, 0}, smem); grid.sync();
    ph_ln_mod(p, 0, 0, 0); grid.sync();
    gemm_phase(p.A16, D, p.wt_pq, 1024, 2048, RowMap{0}, EpiBf16{p.P, 2048, 2048}, smem); grid.sync();
    ph_scores_naive(p, 0, 0, smem); grid.sync();
    ph_combine(p, 0); ph_convert_uv(p, 0); grid.sync();
    ph_gather_mfma(p, 0, 0, smem); grid.sync();
    gemm_phase(p.A16, D, p.wt_od_in, 1024, 2560, RowMap{0}, EpiBf16{p.P, 2560, 2560}, smem); grid.sync();
    ph_rg_a(p, smem); grid.sync();
    ph_rg_b(p); grid.sync();
    ph_rg_c(p, smem); grid.sync();
    gemm_phase(p.P, 2560, p.wt_od_out, 1280, 1024, RowMap{1}, EpiResid{p.x, p.ctx, p.mod, p.H, 1}, smem); grid.sync();
    ph_ln_mod(p, 1, 0, 1); grid.sync();
    gemm_phase(p.A16, D, p.wt_pq + (size_t)2048 * 1024, 1024, 2048, RowMap{1}, EpiBf16{p.P, 2048, 2048}, smem); grid.sync();
    ph_scores_naive(p, 1, 1, smem); grid.sync();
    ph_combine(p, 1); ph_convert_uv(p, 1); grid.sync();
    ph_gather_mfma(p, 1, 1, smem);
}

extern "C" void kernel_launch(void* const* d_in, const int* in_sizes, int n_in, void* d_out, int out_size, void* d_ws, size_t ws_size, hipStream_t stream) {
    Params p{};
    const float** f = (const float**)d_in;
    p.x = f[0]; p.c = f[1]; p.ctx = f[2]; p.c_ctx = f[3]; p.mod_w = f[4]; p.mod_b = f[5]; p.ln_g = f[6]; p.ln_b = f[7];
    p.ev_w_in = f[8]; p.ev_q_norm = f[9]; p.ev_kv_norm = f[10]; p.ev_w_uq = f[11]; p.ev_w_ukv = f[12]; p.ev_gla_wa2 = f[13]; p.ev_gla_ba = f[14]; p.ev_gla_norm = f[15]; p.ev_w_out = f[16];
    p.od_w_in = f[17]; p.od_conv_w = f[18]; p.od_conv_b = f[19]; p.od_gate_w = f[20]; p.od_gate_b = f[21]; p.od_lambda = f[22]; p.od_w_out = f[23];
    p.peer_wq = f[24]; p.peer_k1 = f[25]; p.peer_k2 = f[26]; p.peer_u = f[27]; p.peer_v = f[28];
    p.out = (float*)d_out;
    unsigned char* w = (unsigned char*)d_ws; size_t off = 0;
    auto take = [&](size_t bytes) { unsigned char* r = w + off; off += (bytes + 255) & ~(size_t)255; return r; };
    p.wt_ev_in = (bf16_t*)take((size_t)EV_IN * 1024 * 2); p.wt_uq = (bf16_t*)take(768 * 384 * 2); p.wt_ukv = (bf16_t*)take(1024 * 256 * 2);
    p.wt_ev_out = (bf16_t*)take(1024 * 1024 * 2); p.wt_od_in = (bf16_t*)take(2560 * 1024 * 2); p.wt_gate = (bf16_t*)take(40 * 16384 * 2);
    p.wt_od_out = (bf16_t*)take(1024 * 1280 * 2); p.wt_pq = (bf16_t*)take((size_t)2 * 2048 * 1024 * 2); p.wt_k = (bf16_t*)take(4 * 16384 * 2);
    p.mod = (float*)take(2 * 9 * 6144 * 4); p.rope_cos = (float*)take(SEQ * 16 * 4); p.rope_sin = (float*)take(SEQ * 16 * 4); p.rsq = (float*)take((size_t)2 * R * 4);
    p.H = (float*)take((size_t)R * D * 4);
    p.Q16 = (bf16_t*)p.H; p.K16 = p.Q16 + (size_t)R * 768; p.V16 = p.K16 + (size_t)R * 768;
    p.A16 = (bf16_t*)take((size_t)R * D * 2);
    p.P = (bf16_t*)take((size_t)R * 2560 * 2);
    p.G = take((size_t)94371840);
    if (off > ws_size) { fprintf(stderr, "workspace too small: need %zu have %zu\n", off, ws_size); return; }
    static int grid_blocks = 0;
    if (!grid_blocks) {
        int dev = 0, cus = 0, per_cu = 0;
        (void)hipGetDevice(&dev);
        (void)hipDeviceGetAttribute(&cus, hipDeviceAttributeMultiprocessorCount, dev);
        (void)hipOccupancyMaxActiveBlocksPerMultiprocessor(&per_cu, k_mega, 256, 0);
        if (per_cu > 2) per_cu = 2;
        if (per_cu < 1) per_cu = 1;
        grid_blocks = cus * per_cu;
    }
    void* args[] = {&p};
    hipError_t e = hipLaunchCooperativeKernel((void*)k_mega, dim3(grid_blocks), dim3(256), args, 0, stream);
    if (e != hipSuccess) fprintf(stderr, "cooperative launch failed: %s (grid %d)\n", hipGetErrorString(e), grid_blocks);
}
__global__ void __launch_bounds__(256) k_gather2(Params p, int layer, int lat_only) { SMEM_DECL; ph_gather_mfma(p, layer, lat_only, smem); }
__global__ void __launch_bounds__(256) k_rga(Params p) { SMEM_DECL; ph_rg_a(p, smem); }
__global__ void __launch_bounds__(256) k_rgc(Params p) { SMEM_DECL; ph_rg_c(p, smem); }
__global__ void __launch_bounds__(256) k_glaa(Params p) { SMEM_DECL; ph_gla_a(p, smem); }
__global__ void __launch_bounds__(256) k_glac(Params p) { SMEM_DECL; ph_gla_c(p, smem); }
__global__ void __launch_bounds__(256) k_attn2(Params p) { SMEM_DECL; ph_attn(p, smem, blockIdx.x, gridDim.x); }
```

```cpp
#include <hip/hip_runtime.h>
#include <hip/hip_cooperative_groups.h>
#include <cstdio>
#include <cstdint>

namespace cg = cooperative_groups;
typedef unsigned short bf16_t;
typedef short bf16x8 __attribute__((ext_vector_type(8)));
typedef float f32x4 __attribute__((ext_vector_type(4)));
typedef float f32x16 __attribute__((ext_vector_type(16)));
typedef unsigned u32x4 __attribute__((ext_vector_type(4)));
typedef unsigned u32x2 __attribute__((ext_vector_type(2)));

constexpr int D = 1024, NB = 8, SEQ = 4096, CTX = 256, PB = SEQ + CTX  , R = NB * PB  ;
constexpr int EV_IN = 2240, RGW = 1280;
constexpr int C_CQ = 0, C_CKV = 384, C_KPE = 640, C_GQ = 672, C_GK = 928, C_GV = 1184, C_GG = 1696, C_GAF = 2208;
constexpr float LN_EPS = 1e-6f, ALPHA = 1.41421356237f, MLA_SCALE = 0.10206207261596577f  ;
constexpr int PEER_N = 16384;

struct Params {
    const float *x, *c, *ctx, *c_ctx, *mod_w, *mod_b, *ln_g, *ln_b;
    const float *ev_w_in, *ev_q_norm, *ev_kv_norm, *ev_w_uq, *ev_w_ukv, *ev_gla_wa2, *ev_gla_ba, *ev_gla_norm, *ev_w_out;
    const float *od_w_in, *od_conv_w, *od_conv_b, *od_gate_w, *od_gate_b, *od_lambda, *od_w_out;
    const float *peer_wq, *peer_k1, *peer_k2, *peer_u, *peer_v;
    float* out;
    bf16_t *wt_ev_in, *wt_uq, *wt_ukv, *wt_ev_out, *wt_od_in, *wt_gate, *wt_od_out, *wt_pq, *wt_k;
    float *mod, *rope_cos, *rope_sin, *rsq;
    float* H; bf16_t *Q16, *K16, *V16;
    bf16_t* A16; bf16_t* P; unsigned char* G;
};

__device__ __forceinline__ bf16_t f2bf(float f) { unsigned u = __float_as_uint(f); u += 0x7fffu + ((u >> 16) & 1u); return (bf16_t)(u >> 16); }
__device__ __forceinline__ float bf2f(bf16_t h) { return __uint_as_float(((unsigned)h) << 16); }
__device__ __forceinline__ unsigned pack2(float a, float b) { unsigned r; asm volatile("v_cvt_pk_bf16_f32 %0, %1, %2" : "=v"(r) : "v"(a), "v"(b)); return r; }
__device__ __forceinline__ float silu_f(float x) { return x / (1.0f + expf(-x)); }
__device__ __forceinline__ float sigmoid_f(float x) { return 1.0f / (1.0f + expf(-x)); }
__device__ __forceinline__ float gelu_f(float x) { return 0.5f * x * (1.0f + erff(x * 0.70710678118654752f)); }
__device__ __forceinline__ float wave_sum(float v) {
#pragma unroll
    for (int o = 32; o > 0; o >>= 1) v += __shfl_xor(v, o);
    return v;
}
__device__ __forceinline__ int otid() { int t = threadIdx.x; asm volatile("" : "+v"(t)); return t; }
__device__ __forceinline__ int mod_row(int r) { const int b = r / PB, p = r - b * PB; return p < CTX ? 8 : b; }
__device__ __forceinline__ const float* in_row(const Params& P_, int r) {
    const int b = r / PB, p = r - b * PB;
    return p < CTX ? P_.ctx + ((size_t)b * CTX + p) * D : P_.x + ((size_t)b * SEQ + (p - CTX)) * D;
}

__device__ __forceinline__ void tconv_tile(const float* __restrict__ W, int K, int N, bf16_t* __restrict__ Wt, const float* __restrict__ rowscale, int tile, float* sm) {
    const int ntn = N / 64, tk = tile / ntn, tn = tile % ntn, tid = threadIdx.x;
#pragma unroll
    for (int i = 0; i < 4; ++i) {
        const int k = (tid >> 4) + 16 * i;
        f32x4 v = *(const f32x4*)(W + (size_t)(tk * 64 + k) * N + tn * 64 + (tid & 15) * 4);
        const float s = rowscale ? rowscale[tk * 64 + k] : 1.0f;
#pragma unroll
        for (int q = 0; q < 4; ++q) sm[k * 65 + (tid & 15) * 4 + q] = v[q] * s;
    }
    __syncthreads();
    const int n = tid >> 2, kc = tid & 3;
    unsigned w[8];
#pragma unroll
    for (int kk = 0; kk < 8; ++kk) w[kk] = pack2(sm[(kc * 16 + 2 * kk) * 65 + n], sm[(kc * 16 + 2 * kk + 1) * 65 + n]);
    bf16_t* dst = Wt + (size_t)(tn * 64 + n) * K + tk * 64 + kc * 16;
    *(u32x4*)dst = (u32x4){w[0], w[1], w[2], w[3]};
    *(u32x4*)(dst + 8) = (u32x4){w[4], w[5], w[6], w[7]};
    __syncthreads();
}
__device__ __forceinline__ void tconv_all(const float* W, int K, int N, bf16_t* Wt, const float* rowscale, float* sm) {
    const int nt = (K / 64) * (N / 64);
    for (int t = blockIdx.x; t < nt; t += gridDim.x) tconv_tile(W, K, N, Wt, rowscale, t, sm);
}

__device__ __forceinline__ void ph_prologue(const Params& p, unsigned char* smem) {
    float* sm = (float*)smem;
    tconv_all(p.ev_w_in, 1024, EV_IN, p.wt_ev_in, nullptr, sm);
    tconv_all(p.ev_w_uq, 384, 768, p.wt_uq, p.ev_q_norm, sm);
    tconv_all(p.ev_w_ukv, 256, 1024, p.wt_ukv, p.ev_kv_norm, sm);
    tconv_all(p.ev_w_out, 1024, 1024, p.wt_ev_out, nullptr, sm);
    tconv_all(p.od_w_in, 1024, 2560, p.wt_od_in, nullptr, sm);
    for (int g = 0; g < 40; ++g) tconv_all(p.od_gate_w + (size_t)g * 16384, 128, 128, p.wt_gate + (size_t)g * 16384, nullptr, sm);
    tconv_all(p.od_w_out, 1280, 1024, p.wt_od_out, nullptr, sm);
    for (int l = 0; l < 2; ++l) tconv_all(p.peer_wq + (size_t)l * 1024 * 2048, 1024, 2048, p.wt_pq + (size_t)l * 1024 * 2048, nullptr, sm);
    for (int i = blockIdx.x * 256 + threadIdx.x; i < 2 * 2 * 16384; i += gridDim.x * 256) {
        const int l = i / 32768, h = (i / 16384) & 1, e = i & 16383;
        p.wt_k[i] = f2bf((h ? p.peer_k2 : p.peer_k1)[(size_t)l * 16384 + e]);
    }
    for (int i = blockIdx.x * 256 + threadIdx.x; i < SEQ * 16; i += gridDim.x * 256) {
        const int s = i >> 4, f = i & 15;
        const float pos = (float)(f < 8 ? (s >> 6) : (s & 63));
        const float inv = powf(10000.0f, -(float)(f & 7) / 8.0f);
        const float ang = pos * inv;
        p.rope_cos[i] = cosf(ang); p.rope_sin[i] = sinf(ang);
    }
    float* sc = sm;
    for (int u = blockIdx.x; u < 2 * 96; u += gridDim.x) {
        const int l = u / 96, c0 = (u % 96) * 64, tid = threadIdx.x;
        __syncthreads();
        for (int i = tid; i < 9 * 1024; i += 256) { const int rr = i >> 10, k = i & 1023; sc[i] = silu_f(rr < 8 ? p.c[rr * 1024 + k] : p.c_ctx[k]); }
        __syncthreads();
        const int col = c0 + (tid & 63), kq = tid >> 6;
        float acc[9];
#pragma unroll
        for (int rr = 0; rr < 9; ++rr) acc[rr] = 0.f;
        const float* w = p.mod_w + (size_t)l * 1024 * 6144 + col;
        for (int k = kq * 256; k < kq * 256 + 256; ++k) {
            const float wv = w[(size_t)k * 6144];
#pragma unroll
            for (int rr = 0; rr < 9; ++rr) acc[rr] += sc[rr * 1024 + k] * wv;
        }
        __syncthreads();
        float* red = sm + 9 * 1024;
#pragma unroll
        for (int rr = 0; rr < 9; ++rr) red[(kq * 9 + rr) * 64 + (tid & 63)] = acc[rr];
        __syncthreads();
        for (int i = tid; i < 9 * 64; i += 256) {
            const int rr = i >> 6, cc = i & 63;
            const float s = red[(0 * 9 + rr) * 64 + cc] + red[(1 * 9 + rr) * 64 + cc] + red[(2 * 9 + rr) * 64 + cc] + red[(3 * 9 + rr) * 64 + cc];
            p.mod[((size_t)l * 9 + rr) * 6144 + c0 + cc] = s + p.mod_b[l * 6144 + c0 + cc];
        }
    }
}

__device__ __forceinline__ void ph_modulate0(const Params& p) {
    const int tid_ = otid(), wid = tid_ >> 6, lane = tid_ & 63;
    for (int u = blockIdx.x; u < R / 4; u += gridDim.x) {
        const int r = u * 4 + wid;
        const float* src = in_row(p, r);
        const float* md = p.mod + (size_t)(0 * 9 + mod_row(r)) * 6144;
#pragma unroll
        for (int q = 0; q < 4; ++q) {
            const int c = q * 256 + lane * 4;
            const f32x4 h = *(const f32x4*)(src + c), sh = *(const f32x4*)(md + c), scl = *(const f32x4*)(md + 1024 + c);
            const f32x4 v = h * (1.0f + scl) + sh;
            *(u32x2*)(p.A16 + (size_t)r * D + c) = (u32x2){pack2(v[0], v[1]), pack2(v[2], v[3])};
        }
    }
}

constexpr int GBK = 64, GLDS = 72  ;
struct RowMap { int lat_only; __device__ __forceinline__ int ntiles() const { return lat_only ? 256 : 272; }
    __device__ __forceinline__ int row0(int t) const { return lat_only ? (t >> 5) * PB + CTX + (t & 31) * 128 : t * 128; } };

template <class Epi>
__device__ __forceinline__ void gemm_phase(const bf16_t* __restrict__ A, int lda, const bf16_t* __restrict__ Bt, int K, int N, RowMap rm, const Epi& epi, unsigned char* smem) {
    bf16_t* sA = (bf16_t*)smem; bf16_t* sB = sA + 128 * GLDS;
    const int tid = otid(), lane = tid & 63, wid = tid >> 6, wm = wid >> 1, wn = wid & 1, fr = lane & 15, fq = lane >> 4;
    const int ntn = (N + 127) / 128, nunits = rm.ntiles() * ntn, nk = K / GBK;
    for (int u = blockIdx.x; u < nunits; u += gridDim.x) {
        const int tm = u / ntn, tn = u % ntn, m0 = rm.row0(tm), n0 = tn * 128;
        f32x4 acc[4][4];
#pragma unroll
        for (int i = 0; i < 4; ++i)
#pragma unroll
            for (int j = 0; j < 4; ++j) acc[i][j] = (f32x4){0.f, 0.f, 0.f, 0.f};
        u32x4 ra[4], rb[4];
        auto gload = [&](int kt) {
#pragma unroll
            for (int i = 0; i < 4; ++i) {
                const int id = tid + 256 * i, row = id >> 3, ch = id & 7;
                ra[i] = *(const u32x4*)(A + (size_t)(m0 + row) * lda + kt * GBK + ch * 8);
                int brow = n0 + row; brow = brow < N ? brow : N - 1;
                rb[i] = *(const u32x4*)(Bt + (size_t)brow * K + kt * GBK + ch * 8);
            }
        };
        auto lstore = [&]() {
#pragma unroll
            for (int i = 0; i < 4; ++i) {
                const int id = tid + 256 * i, row = id >> 3, ch = id & 7;
                *(u32x4*)(sA + row * GLDS + ch * 8) = ra[i];
                *(u32x4*)(sB + row * GLDS + ch * 8) = rb[i];
            }
        };
        gload(0);
        __syncthreads();
        lstore();
        __syncthreads();
        for (int kt = 0; kt < nk; ++kt) {
            if (kt + 1 < nk) gload(kt + 1);
#pragma unroll
            for (int ks = 0; ks < 2; ++ks) {
                bf16x8 af[4], bfr[4];
#pragma unroll
                for (int i = 0; i < 4; ++i) af[i] = *(const bf16x8*)(sA + (wm * 64 + i * 16 + fr) * GLDS + ks * 32 + fq * 8);
#pragma unroll
                for (int j = 0; j < 4; ++j) bfr[j] = *(const bf16x8*)(sB + (wn * 64 + j * 16 + fr) * GLDS + ks * 32 + fq * 8);
#pragma unroll
                for (int i = 0; i < 4; ++i)
#pragma unroll
                    for (int j = 0; j < 4; ++j) acc[i][j] = __builtin_amdgcn_mfma_f32_16x16x32_bf16(bfr[j], af[i], acc[i][j], 0, 0, 0);
            }
            __syncthreads();
            if (kt + 1 < nk) { lstore(); __syncthreads(); }
        }
        epi(acc, m0 + wm * 64, n0 + wn * 64, fr, fq);
    }
}

struct EpiBf16 {
    bf16_t* C; int ldc, N;
    __device__ __forceinline__ void operator()(const f32x4 (&acc)[4][4], int mb, int nb, int fr, int fq) const {
#pragma unroll
        for (int i = 0; i < 4; ++i)
#pragma unroll
            for (int j = 0; j < 4; ++j) {
                const int m = mb + i * 16 + fr, n = nb + j * 16 + 4 * fq;
                if (n < N) *(u32x2*)(C + (size_t)m * ldc + n) = (u32x2){pack2(acc[i][j][0], acc[i][j][1]), pack2(acc[i][j][2], acc[i][j][3])};
            }
    }
};
struct EpiQ {
    bf16_t* Q; const float *rsq, *rc, *rs;
    __device__ __forceinline__ void operator()(const f32x4 (&acc)[4][4], int mb, int nb, int fr, int fq) const {
#pragma unroll
        for (int i = 0; i < 4; ++i) {
            const int m = mb + i * 16 + fr, b = m / PB, pp = m - b * PB;
            const float sc = rsq[m] * (MLA_SCALE * 1.4426950408889634f);
#pragma unroll
            for (int j = 0; j < 4; j += 2) {
                const int n = nb + j * 16 + 4 * fq;
                f32x4 v0 = acc[i][j] * sc, v1 = acc[i][j + 1] * sc;
                const int d = n % 96;
                if (d >= 64 && pp >= CTX) {
                    const int s = pp - CTX, f = (d - 64) + 0;
                    const f32x4 cs = *(const f32x4*)(rc + s * 16 + f), sn = *(const f32x4*)(rs + s * 16 + f);
                    const f32x4 o0 = v0 * cs - v1 * sn, o1 = v0 * sn + v1 * cs; v0 = o0; v1 = o1;
                }
                *(u32x2*)(Q + (size_t)m * 768 + n) = (u32x2){pack2(v0[0], v0[1]), pack2(v0[2], v0[3])};
                *(u32x2*)(Q + (size_t)m * 768 + n + 16) = (u32x2){pack2(v1[0], v1[1]), pack2(v1[2], v1[3])};
            }
        }
    }
};
struct EpiKV {
    bf16_t *Kd, *Vd; const float* rsq;
    __device__ __forceinline__ void operator()(const f32x4 (&acc)[4][4], int mb, int nb, int fr, int fq) const {
#pragma unroll
        for (int i = 0; i < 4; ++i) {
            const int m = mb + i * 16 + fr; const float sc = rsq[m];
#pragma unroll
            for (int j = 0; j < 4; ++j) {
                const int n = nb + j * 16 + 4 * fq, hd = n >> 7, d = n & 127;
                const f32x4 v = acc[i][j] * sc;
                bf16_t* dst = d < 64 ? Kd + (size_t)m * 768 + hd * 96 + d : Vd + (size_t)m * 512 + hd * 64 + (d - 64);
                *(u32x2*)dst = (u32x2){pack2(v[0], v[1]), pack2(v[2], v[3])};
            }
        }
    }
};
struct EpiResid {
    const float *x, *ctx, *mod; float* H; int layer;
    __device__ __forceinline__ void operator()(const f32x4 (&acc)[4][4], int mb, int nb, int fr, int fq) const {
#pragma unroll
        for (int i = 0; i < 4; ++i) {
            const int m = mb + i * 16 + fr, b = m / PB, pp = m - b * PB;
            const float* hin = layer == 0 ? (pp < CTX ? ctx + ((size_t)b * CTX + pp) * D : x + ((size_t)b * SEQ + (pp - CTX)) * D) : H + (size_t)m * D;
            const float* gate = mod + ((size_t)layer * 9 + (pp < CTX ? 8 : b)) * 6144 + 2 * 1024;
#pragma unroll
            for (int j = 0; j < 4; ++j) {
                const int n = nb + j * 16 + 4 * fq;
                const f32x4 h = *(const f32x4*)(hin + n), g = *(const f32x4*)(gate + n);
                *(f32x4*)(H + (size_t)m * D + n) = ALPHA * h + g * acc[i][j];
            }
        }
    }
};

__device__ __forceinline__ void ph_rowpost(const Params& p) {
    const int tid_ = otid(), wid = tid_ >> 6, lane = tid_ & 63;
    for (int u = blockIdx.x; u < R / 4; u += gridDim.x) {
        const int r = u * 4 + wid, b = r / PB, pp = r - b * PB;
        const bf16_t* row = p.P + (size_t)r * EV_IN;
        float sq = 0.f, skv = 0.f;
#pragma unroll
        for (int i = 0; i < 10; ++i) { const float v = bf2f(row[lane + 64 * i]); if (i < 6) sq += v * v; else skv += v * v; }
        sq = wave_sum(sq); skv = wave_sum(skv);
        if (lane == 0) { p.rsq[r] = rsqrtf(sq / 384.0f + LN_EPS); p.rsq[R + r] = rsqrtf(skv / 256.0f + LN_EPS); }
        if (lane < 16) {
            float x1 = bf2f(row[C_KPE + lane]), x2 = bf2f(row[C_KPE + 16 + lane]);
            if (pp >= CTX) { const int s = pp - CTX; const float cs = p.rope_cos[s * 16 + lane], sn = p.rope_sin[s * 16 + lane];
                const float o1 = x1 * cs - x2 * sn, o2 = x1 * sn + x2 * cs; x1 = o1; x2 = o2; }
            const bf16_t b1 = f2bf(x1), b2 = f2bf(x2);
#pragma unroll
            for (int hd = 0; hd < 8; ++hd) { p.K16[(size_t)r * 768 + hd * 96 + 64 + lane] = b1; p.K16[(size_t)r * 768 + hd * 96 + 80 + lane] = b2; }
        }
    }
}

constexpr int AT_KS = 104, AT_VS = 68, AT_BUF = 64 * AT_KS * 2 + 64 * AT_VS * 2;
__device__ __forceinline__ void ph_attn(const Params& p, unsigned char* smem, int bid, int nblk) {
    const int tid = otid(), wid = tid >> 6, lane = tid & 63, q = lane & 31, h = lane >> 5;
    for (int u = bid; u < 2048 + 128; u += nblk) {
        int b, hd, q0, nkeys;
        if (u < 2048) { b = u >> 8; hd = (u >> 5) & 7; q0 = CTX + (u & 31) * 128; nkeys = PB; }
        else { const int v = u - 2048; b = v >> 4; hd = (v >> 1) & 7; q0 = (v & 1) * 128; nkeys = CTX; }
        const size_t rq = (size_t)b * PB + q0 + wid * 32 + q;
        bf16x8 qf[6];
#pragma unroll
        for (int s = 0; s < 6; ++s) qf[s] = *(const bf16x8*)(p.Q16 + rq * 768 + hd * 96 + 16 * s + 8 * h);
        f32x16 o[2];
#pragma unroll
        for (int i = 0; i < 16; ++i) { o[0][i] = 0.f; o[1][i] = 0.f; }
        float m = -1e30f, l = 0.f;
        const int ntiles = nkeys / 64;
        const bf16_t* Kg = p.K16 + (size_t)b * PB * 768 + hd * 96;
        const bf16_t* Vg = p.V16 + (size_t)b * PB * 512 + hd * 64;
        u32x4 rk[3], rv[2];
        auto gload = [&](int t) {
#pragma unroll
            for (int i = 0; i < 3; ++i) { const int id = tid + 256 * i, key = id / 12, ch = id % 12; rk[i] = *(const u32x4*)(Kg + (size_t)(t * 64 + key) * 768 + ch * 8); }
#pragma unroll
            for (int i = 0; i < 2; ++i) { const int id = tid + 256 * i, key = id >> 3, dch = id & 7; rv[i] = *(const u32x4*)(Vg + (size_t)(t * 64 + key) * 512 + dch * 8); }
        };
        auto lstore = [&](int buf) {
            bf16_t* Ks = (bf16_t*)(smem + buf * AT_BUF); bf16_t* Vt = Ks + 64 * AT_KS;
#pragma unroll
            for (int i = 0; i < 3; ++i) { const int id = tid + 256 * i, key = id / 12, ch = id % 12; *(u32x4*)(Ks + key * AT_KS + ch * 8) = rk[i]; }
#pragma unroll
            for (int i = 0; i < 2; ++i) {
                const int id = tid + 256 * i, key = id >> 3, dch = id & 7;
#pragma unroll
                for (int e = 0; e < 4; ++e) { Vt[(dch * 8 + 2 * e) * AT_VS + key] = (bf16_t)(rv[i][e] & 0xffffu); Vt[(dch * 8 + 2 * e + 1) * AT_VS + key] = (bf16_t)(rv[i][e] >> 16); }
            }
        };
        __syncthreads();
        gload(0); lstore(0);
        __syncthreads();
        for (int t = 0; t < ntiles; ++t) {
            if (t + 1 < ntiles) gload(t + 1);
            const bf16_t* Ks = (const bf16_t*)(smem + (t & 1) * AT_BUF); const bf16_t* Vt = Ks + 64 * AT_KS;
            f32x16 sa[2];
#pragma unroll
            for (int kb = 0; kb < 2; ++kb) {
#pragma unroll
                for (int i = 0; i < 16; ++i) sa[kb][i] = 0.f;
#pragma unroll
                for (int s = 0; s < 6; ++s) {
                    const bf16x8 kf = *(const bf16x8*)(Ks + (kb * 32 + q) * AT_KS + 16 * s + 8 * h);
                    sa[kb] = __builtin_amdgcn_mfma_f32_32x32x16_bf16(kf, qf[s], sa[kb], 0, 0, 0);
                }
            }
            float mx = sa[0][0];
#pragma unroll
            for (int i = 1; i < 16; ++i) mx = fmaxf(mx, sa[0][i]);
#pragma unroll
            for (int i = 0; i < 16; ++i) mx = fmaxf(mx, sa[1][i]);
            mx = fmaxf(mx, __shfl_xor(mx, 32));
            const float mn = fmaxf(m, mx), al = __builtin_amdgcn_exp2f(m - mn);
            m = mn;
            float ps = 0.f;
#pragma unroll
            for (int kb = 0; kb < 2; ++kb)
#pragma unroll
                for (int i = 0; i < 16; ++i) { const float e = __builtin_amdgcn_exp2f(sa[kb][i] - mn); sa[kb][i] = e; ps += e; }
            l = l * al + ps;
#pragma unroll
            for (int i = 0; i < 16; ++i) { o[0][i] *= al; o[1][i] *= al; }
#pragma unroll
            for (int kb = 0; kb < 2; ++kb)
#pragma unroll
                for (int s2 = 0; s2 < 2; ++s2) {
                    u32x4 pw;
#pragma unroll
                    for (int e = 0; e < 4; ++e) pw[e] = pack2(sa[kb][8 * s2 + 2 * e], sa[kb][8 * s2 + 2 * e + 1]);
                    const bf16x8 pf = __builtin_bit_cast(bf16x8, pw);
                    const int base = kb * 32 + 16 * s2;
#pragma unroll
                    for (int db = 0; db < 2; ++db) {
                        const bf16_t* vp = Vt + (db * 32 + q) * AT_VS + base + 4 * h;
                        const u32x2 v0 = *(const u32x2*)vp, v1 = *(const u32x2*)(vp + 8);
                        const bf16x8 vf = __builtin_bit_cast(bf16x8, (u32x4){v0[0], v0[1], v1[0], v1[1]});
                        o[db] = __builtin_amdgcn_mfma_f32_32x32x16_bf16(vf, pf, o[db], 0, 0, 0);
                    }
                }
            if (t + 1 < ntiles) lstore((t + 1) & 1);
            __syncthreads();
        }
        l += __shfl_xor(l, 32);
        const float il = 1.0f / l;
#pragma unroll
        for (int db = 0; db < 2; ++db)
#pragma unroll
            for (int gq = 0; gq < 4; ++gq) {
                const int d = db * 32 + 8 * gq + 4 * h;
                *(u32x2*)(p.A16 + rq * D + hd * 64 + d) = (u32x2){pack2(o[db][4 * gq] * il, o[db][4 * gq + 1] * il), pack2(o[db][4 * gq + 2] * il, o[db][4 * gq + 3] * il)};
            }
    }
}

constexpr size_t GLA_KS_BYTES = (size_t)NB * 4 * 68 * 2 * 8192 * 2;
constexpr int GL_S = 72;
__device__ __forceinline__ void gla_cum(const Params& p, size_t row0, int hd, int dir, float* sga, float* spart, float (&c)[16], float& T) {
    const int tid = otid(), d = tid & 63, part = tid >> 6;
    {
        const int j = tid >> 2, g4 = tid & 3;
        const u32x2 w = *(const u32x2*)(p.P + (row0 + j) * EV_IN + C_GAF + dir * 16 + g4 * 4);
        sga[j * 16 + g4 * 4 + 0] = __uint_as_float(w[0] << 16); sga[j * 16 + g4 * 4 + 1] = __uint_as_float(w[0] & 0xffff0000u);
        sga[j * 16 + g4 * 4 + 2] = __uint_as_float(w[1] << 16); sga[j * 16 + g4 * 4 + 3] = __uint_as_float(w[1] & 0xffff0000u);
    }
    __syncthreads();
    float wc[16];
    const float* wa = p.ev_gla_wa2 + (size_t)dir * 16 * 256 + hd * 64 + d;
#pragma unroll
    for (int g = 0; g < 16; ++g) wc[g] = wa[g * 256];
    const float bias = p.ev_gla_ba[dir * 256 + hd * 64 + d];
    float lv[16]; float run = 0.f;
#pragma unroll
    for (int jj = 0; jj < 16; ++jj) {
        const int j = part * 16 + jj;
        float z = bias;
#pragma unroll
        for (int g = 0; g < 16; g += 4) { const f32x4 a = *(const f32x4*)(sga + j * 16 + g); z += a[0] * wc[g] + a[1] * wc[g + 1] + a[2] * wc[g + 2] + a[3] * wc[g + 3]; }
        const float ls = (fminf(z, 0.f) - log1pf(expf(-fabsf(z)))) * (1.0f / 16.0f);
        lv[jj] = ls; run += ls; c[jj] = run;
    }
    spart[part * 64 + d] = run;
    __syncthreads();
    float off = 0.f; T = 0.f;
#pragma unroll
    for (int pp = 0; pp < 4; ++pp) { const float v = spart[pp * 64 + d]; T += v; if (pp < part) off += v; }
#pragma unroll
    for (int jj = 0; jj < 16; ++jj) c[jj] = dir == 0 ? off + c[jj] : T - (off + c[jj]) + lv[jj];
}
__device__ __forceinline__ void gla_stage_vt(const Params& p, size_t row0, int hd, bf16_t* Vt) {
    const int tid = otid();
#pragma unroll
    for (int i = 0; i < 4; ++i) {
        const int id = tid + 256 * i, j = id >> 4, ech = id & 15;
        const u32x4 w = *(const u32x4*)(p.P + (row0 + j) * EV_IN + C_GV + hd * 128 + ech * 8);
#pragma unroll
        for (int e = 0; e < 4; ++e) { Vt[(ech * 8 + 2 * e) * GL_S + j] = (bf16_t)(w[e] & 0xffffu); Vt[(ech * 8 + 2 * e + 1) * GL_S + j] = (bf16_t)(w[e] >> 16); }
    }
}
__device__ __forceinline__ void ph_gla_a(const Params& p, unsigned char* smem) {
    bf16_t* kwT = (bf16_t*)smem; bf16_t* Vt = kwT + 64 * GL_S; float* sga = (float*)(Vt + 128 * GL_S); float* spart = sga + 1024;
    bf16_t* KS = (bf16_t*)p.G; float* DEC = (float*)(p.G + GLA_KS_BYTES);
    const int tid = otid(), lane = tid & 63, wid = tid >> 6, fr = lane & 15, fq = lane >> 4, d = tid & 63, part = tid >> 6;
    for (int u = blockIdx.x; u < NB * 4 * 68; u += gridDim.x) {
        const int b = u / 272, hd = (u / 68) & 3, ci = u % 68;
        const size_t row0 = (size_t)b * PB + ci * 64;
        __syncthreads();
        gla_stage_vt(p, row0, hd, Vt);
        for (int dir = 0; dir < 2; ++dir) {
            float c[16], T;
            gla_cum(p, row0, hd, dir, sga, spart, c, T);
            unsigned kw[8];
#pragma unroll
            for (int jj = 0; jj < 16; jj += 2) {
                const float k0 = bf2f(p.P[(row0 + part * 16 + jj) * EV_IN + C_GK + hd * 64 + d]), k1 = bf2f(p.P[(row0 + part * 16 + jj + 1) * EV_IN + C_GK + hd * 64 + d]);
                kw[jj >> 1] = pack2(k0 * expf(T - c[jj]), k1 * expf(T - c[jj + 1]));
            }
            *(u32x4*)(kwT + d * GL_S + part * 16) = (u32x4){kw[0], kw[1], kw[2], kw[3]};
            *(u32x4*)(kwT + d * GL_S + part * 16 + 8) = (u32x4){kw[4], kw[5], kw[6], kw[7]};
            if (part == 0) DEC[((size_t)u * 2 + dir) * 64 + d] = expf(T);
            __syncthreads();
            f32x4 acc[8];
#pragma unroll
            for (int et = 0; et < 8; ++et) acc[et] = (f32x4){0.f, 0.f, 0.f, 0.f};
#pragma unroll
            for (int s = 0; s < 2; ++s) {
                const bf16x8 a = *(const bf16x8*)(kwT + (16 * wid + fr) * GL_S + 32 * s + 8 * fq);
#pragma unroll
                for (int et = 0; et < 8; ++et) {
                    const bf16x8 bq = *(const bf16x8*)(Vt + (16 * et + fr) * GL_S + 32 * s + 8 * fq);
                    acc[et] = __builtin_amdgcn_mfma_f32_16x16x32_bf16(a, bq, acc[et], 0, 0, 0);
                }
            }
#pragma unroll
            for (int et = 0; et < 8; ++et)
                *(u32x2*)(KS + (((size_t)u * 2 + dir) * 128 + 16 * et + fr) * 64 + 16 * wid + 4 * fq) = (u32x2){pack2(acc[et][0], acc[et][1]), pack2(acc[et][2], acc[et][3])};
            __syncthreads();
        }
    }
}
__device__ __forceinline__ void ph_gla_b(const Params& p) {
    unsigned* KS32 = (unsigned*)p.G; const float* DEC = (const float*)(p.G + GLA_KS_BYTES);
    for (int gid = blockIdx.x * 256 + threadIdx.x; gid < 64 * 4096; gid += gridDim.x * 256) {
        const int seq = gid >> 12, pi = gid & 4095, dir = seq & 1, bh = seq >> 1, d = (2 * pi) & 63;
        float s0 = 0.f, s1 = 0.f;
#pragma unroll 4
        for (int step = 0; step < 68; ++step) {
            const int ci = dir == 0 ? step : (step < 4 ? 3 - step : 71 - step);
            const size_t ud = ((size_t)bh * 68 + ci) * 2 + dir;
            const unsigned w = KS32[ud * 4096 + pi];
            const float dc0 = DEC[ud * 64 + d], dc1 = DEC[ud * 64 + d + 1];
            KS32[ud * 4096 + pi] = pack2(s0, s1);
            s0 = dc0 * s0 + __uint_as_float(w << 16); s1 = dc1 * s1 + __uint_as_float(w & 0xffff0000u);
        }
    }
}
__device__ __forceinline__ void ph_gla_c(const Params& p, unsigned char* smem) {
    bf16_t* qs = (bf16_t*)smem; bf16_t* ks = qs + 64 * GL_S; bf16_t* Vt = ks + 64 * GL_S; float* sga = (float*)(Vt + 128 * GL_S); float* spart = sga + 1024;
    const bf16_t* KS = (const bf16_t*)p.G;
    const int tid = otid(), lane = tid & 63, wid = tid >> 6, fr = lane & 15, fq = lane >> 4, d = tid & 63, part = tid >> 6;
    for (int u = blockIdx.x; u < NB * 4 * 68; u += gridDim.x) {
        const int b = u / 272, hd = (u / 68) & 3, ci = u % 68;
        const size_t row0 = (size_t)b * PB + ci * 64;
        const int i = 16 * wid + fr;
        __syncthreads();
        gla_stage_vt(p, row0, hd, Vt);
        f32x4 oacc[8], pt[4];
#pragma unroll
        for (int et = 0; et < 8; ++et) oacc[et] = (f32x4){0.f, 0.f, 0.f, 0.f};
#pragma unroll
        for (int jt = 0; jt < 4; ++jt) pt[jt] = (f32x4){0.f, 0.f, 0.f, 0.f};
        for (int dir = 0; dir < 2; ++dir) {
            float c[16], T;
            gla_cum(p, row0, hd, dir, sga, spart, c, T);
#pragma unroll
            for (int jj = 0; jj < 16; ++jj) {
                const size_t ro = (row0 + part * 16 + jj) * EV_IN + hd * 64 + d;
                qs[(part * 16 + jj) * GL_S + d] = f2bf(bf2f(p.P[ro + C_GQ]) * 0.125f * expf(c[jj]));
                ks[(part * 16 + jj) * GL_S + d] = f2bf(bf2f(p.P[ro + C_GK]) * expf(-c[jj]));
            }
            __syncthreads();
            bf16x8 qf[2];
#pragma unroll
            for (int s = 0; s < 2; ++s) qf[s] = *(const bf16x8*)(qs + i * GL_S + 32 * s + 8 * fq);
#pragma unroll
            for (int jt = 0; jt < 4; ++jt) {
                f32x4 t = (f32x4){0.f, 0.f, 0.f, 0.f};
#pragma unroll
                for (int s = 0; s < 2; ++s) { const bf16x8 a = *(const bf16x8*)(ks + (16 * jt + fr) * GL_S + 32 * s + 8 * fq); t = __builtin_amdgcn_mfma_f32_16x16x32_bf16(a, qf[s], t, 0, 0, 0); }
#pragma unroll
                for (int rg = 0; rg < 4; ++rg) { const int j = 16 * jt + 4 * fq + rg; const bool keep = dir == 0 ? (j <= i) : (j >= i); pt[jt][rg] += keep ? t[rg] : 0.f; }
            }
            const bf16_t* Sg = KS + ((size_t)u * 2 + dir) * 8192;
#pragma unroll
            for (int et = 0; et < 8; ++et) {
#pragma unroll
                for (int s = 0; s < 2; ++s) { const bf16x8 a = *(const bf16x8*)(Sg + (16 * et + fr) * 64 + 32 * s + 8 * fq); oacc[et] = __builtin_amdgcn_mfma_f32_16x16x32_bf16(a, qf[s], oacc[et], 0, 0, 0); }
                if ((et & 3) == 3) __builtin_amdgcn_sched_barrier(0);
            }
            __syncthreads();
        }
#pragma unroll
        for (int k2 = 0; k2 < 2; ++k2) {
            const u32x4 pw = (u32x4){pack2(pt[2 * k2][0], pt[2 * k2][1]), pack2(pt[2 * k2][2], pt[2 * k2][3]), pack2(pt[2 * k2 + 1][0], pt[2 * k2 + 1][1]), pack2(pt[2 * k2 + 1][2], pt[2 * k2 + 1][3])};
            const bf16x8 pf = __builtin_bit_cast(bf16x8, pw);
#pragma unroll
            for (int et = 0; et < 8; ++et) {
                const bf16_t* vp = Vt + (16 * et + fr) * GL_S + 32 * k2 + 4 * fq;
                const u32x2 v0 = *(const u32x2*)vp, v1 = *(const u32x2*)(vp + 16);
                const bf16x8 vf = __builtin_bit_cast(bf16x8, (u32x4){v0[0], v0[1], v1[0], v1[1]});
                oacc[et] = __builtin_amdgcn_mfma_f32_16x16x32_bf16(vf, pf, oacc[et], 0, 0, 0);
            }
        }
        float ss = 0.f;
#pragma unroll
        for (int et = 0; et < 8; ++et) ss += oacc[et][0] * oacc[et][0] + oacc[et][1] * oacc[et][1] + oacc[et][2] * oacc[et][2] + oacc[et][3] * oacc[et][3];
        ss += __shfl_xor(ss, 16); ss += __shfl_xor(ss, 32);
        const float rs = rsqrtf(ss * (1.0f / 128.0f) + LN_EPS);
        const size_t r = row0 + i;
#pragma unroll
        for (int et = 0; et < 8; ++et) {
            const int e = 16 * et + 4 * fq;
            const u32x2 gw = *(const u32x2*)(p.P + r * EV_IN + C_GG + hd * 128 + e);
            const f32x4 nr = *(const f32x4*)(p.ev_gla_norm + hd * 128 + e);
            const float g0 = __uint_as_float(gw[0] << 16), g1 = __uint_as_float(gw[0] & 0xffff0000u), g2 = __uint_as_float(gw[1] << 16), g3 = __uint_as_float(gw[1] & 0xffff0000u);
            *(u32x2*)(p.A16 + r * D + 512 + hd * 128 + e) = (u32x2){pack2(oacc[et][0] * rs * nr[0] * silu_f(g0), oacc[et][1] * rs * nr[1] * silu_f(g1)),
                                                                   pack2(oacc[et][2] * rs * nr[2] * silu_f(g2), oacc[et][3] * rs * nr[3] * silu_f(g3))};
        }
    }
}

__device__ __forceinline__ void ph_ln_mod(const Params& p, int layer, int lnidx, int lat_only) {
    const int tid_ = otid(), wid = tid_ >> 6, lane = tid_ & 63;
    const int nrows = lat_only ? NB * SEQ : R;
    const float* g = p.ln_g + (size_t)(layer * 2 + lnidx) * D; const float* bb = p.ln_b + (size_t)(layer * 2 + lnidx) * D;
    for (int u = blockIdx.x; u < nrows / 4; u += gridDim.x) {
        const int rr = u * 4 + wid, r = lat_only ? (rr >> 12) * PB + CTX + (rr & 4095) : rr;
        float* hrow = p.H + (size_t)r * D;
        f32x4 v[4]; float s = 0.f;
#pragma unroll
        for (int q = 0; q < 4; ++q) { v[q] = *(const f32x4*)(hrow + q * 256 + lane * 4); s += v[q][0] + v[q][1] + v[q][2] + v[q][3]; }
        const float mu = wave_sum(s) * (1.0f / 1024.0f);
        float ss = 0.f;
#pragma unroll
        for (int q = 0; q < 4; ++q) { v[q] = v[q] - mu; ss += v[q][0] * v[q][0] + v[q][1] * v[q][1] + v[q][2] * v[q][2] + v[q][3] * v[q][3]; }
        const float rstd = rsqrtf(wave_sum(ss) * (1.0f / 1024.0f) + LN_EPS);
        const float* md = p.mod + ((size_t)layer * 9 + mod_row(r)) * 6144;
#pragma unroll
        for (int q = 0; q < 4; ++q) {
            const int c = q * 256 + lane * 4;
            const f32x4 h = v[q] * rstd * *(const f32x4*)(g + c) + *(const f32x4*)(bb + c);
            *(f32x4*)(hrow + c) = h;
            const f32x4 a = h * (1.0f + *(const f32x4*)(md + 4 * 1024 + c)) + *(const f32x4*)(md + 3 * 1024 + c);
            *(u32x2*)(p.A16 + (size_t)r * D + c) = (u32x2){pack2(a[0], a[1]), pack2(a[2], a[3])};
        }
    }
}

constexpr int SC_KS = 136;
__device__ __forceinline__ void ph_scores(const Params& p, int layer, int lat_only, unsigned char* smem) {
    bf16_t* ksl = (bf16_t*)smem;
    const bf16_t* QP = p.P; float* T = (float*)p.G;
    const int tid = otid(), lane = tid & 63, wid = tid >> 6, q = lane & 31, h = lane >> 5;
    const RowMap rm{lat_only};
    const int nunits = rm.ntiles() * 8;
    for (int u = blockIdx.x; u < nunits; u += gridDim.x) {
        const int tile = u >> 3, half = (u >> 2) & 1, hp = u & 3;
        const size_t r = (size_t)rm.row0(tile) + 32 * wid + q;
        __syncthreads();
        const bf16_t* kk = p.wt_k + ((size_t)layer * 2 + half) * 16384;
#pragma unroll
        for (int i = 0; i < 8; ++i) { const int id = tid + 256 * i, key = id >> 4, ch = id & 15; *(u32x4*)(ksl + key * SC_KS + ch * 8) = *(const u32x4*)(kk + key * 128 + ch * 8); }
        __syncthreads();
        for (int hh = 0; hh < 2; ++hh) {
            const int hd = hp * 2 + hh;
            bf16x8 qf[8];
#pragma unroll
            for (int s = 0; s < 8; ++s) qf[s] = *(const bf16x8*)(QP + r * 2048 + hd * 256 + half * 128 + 16 * s + 8 * h);
            float top[16];
#pragma unroll
            for (int t = 0; t < 16; ++t) top[t] = -3.0e38f;
#pragma unroll 1
            for (int kb = 0; kb < 4; ++kb) {
                f32x16 sa;
#pragma unroll
                for (int i = 0; i < 16; ++i) sa[i] = 0.f;
#pragma unroll
                for (int s = 0; s < 8; ++s) {
                    const bf16x8 kf = *(const bf16x8*)(ksl + (kb * 32 + q) * SC_KS + 16 * s + 8 * h);
                    sa = __builtin_amdgcn_mfma_f32_32x32x16_bf16(kf, qf[s], sa, 0, 0, 0);
                }
#pragma unroll
                for (int rg = 0; rg < 16; ++rg) {
                    const unsigned key = (unsigned)(kb * 32 + (rg & 3) + 8 * (rg >> 2) + 4 * h);
                    float xv = __uint_as_float((__float_as_uint(sa[rg]) & ~127u) | key);
#pragma unroll
                    for (int t = 0; t < 16; ++t) { const float hi = fmaxf(top[t], xv); xv = fminf(top[t], xv); top[t] = hi; }
                }
            }
            float mrg[8];
#pragma unroll
            for (int i = 0; i < 8; ++i) mrg[i] = fmaxf(top[i], __shfl_xor(top[15 - i], 32));
            float* dst = T + ((r * 8 + hd) * 2 + half) * 16 + 8 * h;
            *(f32x4*)dst = (f32x4){mrg[0], mrg[1], mrg[2], mrg[3]}; *(f32x4*)(dst + 4) = (f32x4){mrg[4], mrg[5], mrg[6], mrg[7]};
        }
    }
}

__device__ __forceinline__ void ph_combine(const Params& p, int lat_only) {
    const float* T = (const float*)p.G;
    int* EIDX = (int*)(p.G + (size_t)R * 8 * 2 * 16 * 4);
    float* EG = (float*)(p.G + (size_t)R * 8 * 2 * 16 * 4 + (size_t)R * 8 * 16 * 4);
    const int nrows = lat_only ? NB * SEQ : R;
    for (int g = blockIdx.x * 256 + threadIdx.x; g < nrows * 8; g += gridDim.x * 256) {
        const int rr = g >> 3, hd = g & 7, r = lat_only ? (rr >> 12) * PB + CTX + (rr & 4095) : rr;
        const float* t = T + ((size_t)r * 8 + hd) * 32;
        float t2[16];
#pragma unroll
        for (int i = 0; i < 16; ++i) t2[i] = __uint_as_float(__float_as_uint(t[16 + i]) & ~127u);
        float top[16];
#pragma unroll
        for (int k = 0; k < 16; ++k) top[k] = -3.0e38f;
        for (int i = 0; i < 16; ++i) {
            const float t1i = __uint_as_float(__float_as_uint(t[i]) & ~127u);
#pragma unroll
            for (int j = 0; j < 16; ++j) {
                float xv = __uint_as_float((__float_as_uint(t1i + t2[j]) & ~255u) | (unsigned)(i * 16 + j));
#pragma unroll
                for (int k = 0; k < 16; ++k) { const float hi = fmaxf(top[k], xv); xv = fminf(top[k], xv); top[k] = hi; }
            }
        }
        float e[16], sum = 0.f; const float mx = __uint_as_float(__float_as_uint(top[0]) & ~255u);
#pragma unroll
        for (int k = 0; k < 16; ++k) { e[k] = expf(__uint_as_float(__float_as_uint(top[k]) & ~255u) - mx); sum += e[k]; }
        const float inv = 1.0f / sum;
#pragma unroll
        for (int k = 0; k < 16; ++k) {
            const unsigned code = __float_as_uint(top[k]) & 255u, i = code >> 4, j = code & 15;
            const unsigned i1 = __float_as_uint(t[i]) & 127u, i2 = __float_as_uint(t[16 + j]) & 127u;
            EIDX[((size_t)r * 8 + hd) * 16 + k] = (int)(i1 * 128 + i2);
            EG[((size_t)r * 8 + hd) * 16 + k] = e[k] * inv;
        }
    }
}

__device__ __forceinline__ void ph_gather_ln(const Params& p, int layer, int lat_only) {
    const int tid_ = otid(), wid = tid_ >> 6, lane = tid_ & 63;
    const int* EIDX = (const int*)(p.G + (size_t)R * 8 * 2 * 16 * 4);
    const float* EG = (const float*)(p.G + (size_t)R * 8 * 2 * 16 * 4 + (size_t)R * 8 * 16 * 4);
    const float* U = p.peer_u + (size_t)layer * PEER_N * D; const float* V = p.peer_v + (size_t)layer * PEER_N * D;
    const float* g = p.ln_g + (size_t)(layer * 2 + 1) * D; const float* bb = p.ln_b + (size_t)(layer * 2 + 1) * D;
    const int nrows = lat_only ? NB * SEQ : R;
    for (int u = blockIdx.x; u < nrows / 4; u += gridDim.x) {
        const int rr = u * 4 + wid, r = lat_only ? (rr >> 12) * PB + CTX + (rr & 4095) : rr;
        f32x4 hm[4], acc[4];
#pragma unroll
        for (int q = 0; q < 4; ++q) {
            const u32x2 w = *(const u32x2*)(p.A16 + (size_t)r * D + q * 256 + lane * 4);
            hm[q] = (f32x4){__uint_as_float(w[0] << 16), __uint_as_float(w[0] & 0xffff0000u), __uint_as_float(w[1] << 16), __uint_as_float(w[1] & 0xffff0000u)};
            acc[q] = (f32x4){0.f, 0.f, 0.f, 0.f};
        }
        for (int e0 = 0; e0 < 128; e0 += 2) {
            const int ea = EIDX[(size_t)r * 128 + e0], eb = EIDX[(size_t)r * 128 + e0 + 1];
            const float ga = EG[(size_t)r * 128 + e0], gb = EG[(size_t)r * 128 + e0 + 1];
            f32x4 ua[4], ub[4];
#pragma unroll
            for (int q = 0; q < 4; ++q) { ua[q] = *(const f32x4*)(U + (size_t)ea * D + q * 256 + lane * 4); ub[q] = *(const f32x4*)(U + (size_t)eb * D + q * 256 + lane * 4); }
            float da = 0.f, db = 0.f;
#pragma unroll
            for (int q = 0; q < 4; ++q) { da += hm[q][0] * ua[q][0] + hm[q][1] * ua[q][1] + hm[q][2] * ua[q][2] + hm[q][3] * ua[q][3]; db += hm[q][0] * ub[q][0] + hm[q][1] * ub[q][1] + hm[q][2] * ub[q][2] + hm[q][3] * ub[q][3]; }
            da = wave_sum(da); db = wave_sum(db);
            const float wa = ga * gelu_f(da), wb = gb * gelu_f(db);
#pragma unroll
            for (int q = 0; q < 4; ++q) {
                acc[q] += wa * *(const f32x4*)(V + (size_t)ea * D + q * 256 + lane * 4);
                acc[q] += wb * *(const f32x4*)(V + (size_t)eb * D + q * 256 + lane * 4);
            }
        }
        const float* md = p.mod + ((size_t)layer * 9 + mod_row(r)) * 6144;
        float* hrow = p.H + (size_t)r * D;
        f32x4 v[4]; float s = 0.f;
#pragma unroll
        for (int q = 0; q < 4; ++q) { const int c = q * 256 + lane * 4; v[q] = ALPHA * *(const f32x4*)(hrow + c) + *(const f32x4*)(md + 5 * 1024 + c) * acc[q]; s += v[q][0] + v[q][1] + v[q][2] + v[q][3]; }
        const float mu = wave_sum(s) * (1.0f / 1024.0f);
        float ss = 0.f;
#pragma unroll
        for (int q = 0; q < 4; ++q) { v[q] = v[q] - mu; ss += v[q][0] * v[q][0] + v[q][1] * v[q][1] + v[q][2] * v[q][2] + v[q][3] * v[q][3]; }
        const float rstd = rsqrtf(wave_sum(ss) * (1.0f / 1024.0f) + LN_EPS);
        if (layer == 0) {
            const float* md1 = p.mod + ((size_t)1 * 9 + mod_row(r)) * 6144;
#pragma unroll
            for (int q = 0; q < 4; ++q) {
                const int c = q * 256 + lane * 4;
                const f32x4 h = v[q] * rstd * *(const f32x4*)(g + c) + *(const f32x4*)(bb + c);
                *(f32x4*)(hrow + c) = h;
                const f32x4 a = h * (1.0f + *(const f32x4*)(md1 + 1024 + c)) + *(const f32x4*)(md1 + c);
                *(u32x2*)(p.A16 + (size_t)r * D + c) = (u32x2){pack2(a[0], a[1]), pack2(a[2], a[3])};
            }
        } else {
            float* orow = p.out + (size_t)rr * D;
#pragma unroll
            for (int q = 0; q < 4; ++q) { const int c = q * 256 + lane * 4; *(f32x4*)(orow + c) = v[q] * rstd * *(const f32x4*)(g + c) + *(const f32x4*)(bb + c); }
        }
    }
}

__device__ __forceinline__ void ph_convert_uv(const Params& p, int layer) {
    const float* src0 = p.peer_u + (size_t)layer * PEER_N * D;
    const float* src1 = p.peer_v + (size_t)layer * PEER_N * D;
    const int n8 = PEER_N * D / 8;
    for (int i = blockIdx.x * 256 + threadIdx.x; i < n8; i += gridDim.x * 256) {
        const f32x4 a = *(const f32x4*)(src0 + (size_t)i * 8), b = *(const f32x4*)(src0 + (size_t)i * 8 + 4);
        *(u32x4*)(p.P + (size_t)i * 8) = (u32x4){pack2(a[0], a[1]), pack2(a[2], a[3]), pack2(b[0], b[1]), pack2(b[2], b[3])};
        const f32x4 c = *(const f32x4*)(src1 + (size_t)i * 8), d = *(const f32x4*)(src1 + (size_t)i * 8 + 4);
        *(u32x4*)(p.P + (size_t)PEER_N * D + (size_t)i * 8) = (u32x4){pack2(c[0], c[1]), pack2(c[2], c[3]), pack2(d[0], d[1]), pack2(d[2], d[3])};
    }
}

__device__ __forceinline__ void ph_gather_mfma(const Params& p, int layer, int lat_only, unsigned char* smem) {
    const int tid = otid(), wid = tid >> 6, lane = tid & 63, c = lane & 15, g = lane >> 4;
    bf16_t* hs = (bf16_t*)(smem + wid * 3072);
    int* se = (int*)(smem + wid * 3072 + 2048);
    float* sw = (float*)(smem + wid * 3072 + 2560);
    const int* EIDX = (const int*)(p.G + (size_t)R * 8 * 2 * 16 * 4);
    const float* EG = (const float*)(p.G + (size_t)R * 8 * 2 * 16 * 4 + (size_t)R * 8 * 16 * 4);
    const bf16_t* U = p.P; const bf16_t* V = p.P + (size_t)PEER_N * D;
    const float* gam = p.ln_g + (size_t)(layer * 2 + 1) * D; const float* bet = p.ln_b + (size_t)(layer * 2 + 1) * D;
    const int nrows = lat_only ? NB * SEQ : R;
    for (int u = blockIdx.x; u < nrows / 4; u += gridDim.x) {
        const int rr = u * 4 + wid, r = lat_only ? (rr >> 12) * PB + CTX + (rr & 4095) : rr;
        __syncthreads();
        *(u32x4*)(hs + lane * 8) = *(const u32x4*)(p.A16 + (size_t)r * D + lane * 8);
        *(u32x4*)(hs + 512 + lane * 8) = *(const u32x4*)(p.A16 + (size_t)r * D + 512 + lane * 8);
        se[lane] = EIDX[(size_t)r * 128 + lane]; se[64 + lane] = EIDX[(size_t)r * 128 + 64 + lane];
        sw[lane] = EG[(size_t)r * 128 + lane]; sw[64 + lane] = EG[(size_t)r * 128 + 64 + lane];
        __syncthreads();
        for (int hd = 0; hd < 8; ++hd) {
            f32x4 dacc = (f32x4){0.f, 0.f, 0.f, 0.f};
            const bf16_t* urow = U + (size_t)se[hd * 16 + c] * D + g * 8;
#pragma unroll 16
            for (int s = 0; s < 32; ++s) {
                const bf16x8 bq = *(const bf16x8*)(urow + s * 32);
                const bf16x8 aq = *(const bf16x8*)(hs + s * 32 + g * 8);
                dacc = __builtin_amdgcn_mfma_f32_16x16x32_bf16(aq, bq, dacc, 0, 0, 0);
            }
            const float wv = sw[hd * 16 + c] * gelu_f(dacc[0]);
            if (g == 0) sw[hd * 16 + c] = wv;
        }
        __syncthreads();
        f32x4 oacc[8];
#pragma unroll
        for (int blk = 0; blk < 8; ++blk) oacc[blk] = (f32x4){0.f, 0.f, 0.f, 0.f};
#pragma unroll 2
        for (int it = 0; it < 32; ++it) {
            const int e = se[4 * it + g];
            const float wv = sw[4 * it + g];
            const unsigned wb = (unsigned)f2bf(wv) << (16 * (c & 1));
            u32x4 aw;
#pragma unroll
            for (int q = 0; q < 4; ++q) aw[q] = (c < 8 && (c >> 1) == q) ? wb : 0u;
            const bf16x8 aq = __builtin_bit_cast(bf16x8, aw);
            const bf16_t* vrow = V + (size_t)e * D + c * 8;
#pragma unroll
            for (int blk = 0; blk < 8; ++blk) {
                const bf16x8 bq = *(const bf16x8*)(vrow + blk * 128);
                oacc[blk] = __builtin_amdgcn_mfma_f32_16x16x32_bf16(aq, bq, oacc[blk], 0, 0, 0);
            }
        }
        const float* md = p.mod + ((size_t)layer * 9 + mod_row(r)) * 6144;
        float* hrow = p.H + (size_t)r * D;
        const bool act = g < 2;
        f32x4 v[8]; float s = 0.f;
#pragma unroll
        for (int blk = 0; blk < 8; ++blk) {
            const int n = 128 * blk + 8 * c + 4 * (g & 1);
            v[blk] = ALPHA * *(const f32x4*)(hrow + n) + *(const f32x4*)(md + 5 * 1024 + n) * oacc[blk];
            if (!act) v[blk] = (f32x4){0.f, 0.f, 0.f, 0.f};
            s += v[blk][0] + v[blk][1] + v[blk][2] + v[blk][3];
        }
        const float mu = wave_sum(s) * (1.0f / 1024.0f);
        float ss = 0.f;
#pragma unroll
        for (int blk = 0; blk < 8; ++blk) { v[blk] = v[blk] - mu; if (act) ss += v[blk][0] * v[blk][0] + v[blk][1] * v[blk][1] + v[blk][2] * v[blk][2] + v[blk][3] * v[blk][3]; }
        const float rstd = rsqrtf(wave_sum(ss) * (1.0f / 1024.0f) + LN_EPS);
        if (act) {
            if (layer == 0) {
                const float* md1 = p.mod + ((size_t)1 * 9 + mod_row(r)) * 6144;
#pragma unroll
                for (int blk = 0; blk < 8; ++blk) {
                    const int n = 128 * blk + 8 * c + 4 * g;
                    const f32x4 h = v[blk] * rstd * *(const f32x4*)(gam + n) + *(const f32x4*)(bet + n);
                    *(f32x4*)(hrow + n) = h;
                    const f32x4 a = h * (1.0f + *(const f32x4*)(md1 + 1024 + n)) + *(const f32x4*)(md1 + n);
                    *(u32x2*)(p.A16 + (size_t)r * D + n) = (u32x2){pack2(a[0], a[1]), pack2(a[2], a[3])};
                }
            } else {
                float* orow = p.out + (size_t)rr * D;
#pragma unroll
                for (int blk = 0; blk < 8; ++blk) { const int n = 128 * blk + 8 * c + 4 * g; *(f32x4*)(orow + n) = v[blk] * rstd * *(const f32x4*)(gam + n) + *(const f32x4*)(bet + n); }
            }
        }
    }
}

constexpr int RG_ZS = 136;
constexpr size_t RG_SUM_BYTES = (size_t)NB * 34 * 2 * RGW * 2 * 4;
__device__ __forceinline__ void rg_stage_z(const Params& p, int b, int c34, int n, bf16_t* zc) {
    const int tid = otid(), k2 = tid & 63, tq = tid >> 6, ch = n * 128 + 2 * k2;
    const int lo = c34 < 2 ? 0 : CTX, hi = c34 < 2 ? CTX : PB, p0 = c34 * 128 + 32 * tq;
    float w0[4], w1[4];
#pragma unroll
    for (int tap = 0; tap < 4; ++tap) { w0[tap] = p.od_conv_w[tap * RGW + ch]; w1[tap] = p.od_conv_w[tap * RGW + ch + 1]; }
    const float b0 = p.od_conv_b[ch], b1 = p.od_conv_b[ch + 1];
    const bf16_t* base = p.P + (size_t)b * PB * 2560 + RGW + ch;
    auto ld = [&](int pp, float& a, float& c) { if (pp >= lo && pp < hi) { const unsigned w = *(const unsigned*)(base + (size_t)pp * 2560); a = __uint_as_float(w << 16); c = __uint_as_float(w & 0xffff0000u); } else { a = 0.f; c = 0.f; } };
    float am2, cm2, am1, cm1, a0, c0, ap1, cp1;
    ld(p0 - 2, am2, cm2); ld(p0 - 1, am1, cm1); ld(p0, a0, c0);
#pragma unroll 4
    for (int t = 0; t < 32; ++t) {
        ld(p0 + t + 1, ap1, cp1);
        const float y0 = b0 + w0[0] * am2 + w0[1] * am1 + w0[2] * a0 + w0[3] * ap1;
        const float y1 = b1 + w1[0] * cm2 + w1[1] * cm1 + w1[2] * c0 + w1[3] * cp1;
        *(unsigned*)(zc + (32 * tq + t) * RG_ZS + 2 * k2) = pack2(y0, y1);
        am2 = am1; cm2 = cm1; am1 = a0; cm1 = c0; a0 = ap1; c0 = cp1;
    }
}
__device__ __forceinline__ float gelu_fast(float v) {
    const float av = fabsf(v), t = __builtin_amdgcn_rcpf(av * 0.2316418882f + 1.0f);
    float q = t * 0.5307027145f + (-0.7265760135f); q = q * t + 0.7107068705f; q = q * t + (-0.142248368f); q = q * t + 0.127414796f; q = q * t;
    const float e = __builtin_amdgcn_exp2f(v * v * (-0.72134752044f));
    const float m = v * (q * e);
    return v < 0.f ? m : v - m;
}
struct RgCtx { bf16x8 wr[4], wi[4]; float br, bi, coef; };
__device__ __forceinline__ void rg_ctx_load(const Params& p, int n, int cl, int dir, RgCtx& c) {
    const int lane = otid() & 63, fr = lane & 15, fq = lane >> 4, ch = n * 128 + cl + fr;
    const bf16_t* gr = p.wt_gate + ((size_t)(dir * 2 + 0) * 10 + n) * 16384 + (size_t)(cl + fr) * 128 + 8 * fq;
    const bf16_t* gi = p.wt_gate + ((size_t)(dir * 2 + 1) * 10 + n) * 16384 + (size_t)(cl + fr) * 128 + 8 * fq;
#pragma unroll
    for (int s = 0; s < 4; ++s) { c.wr[s] = *(const bf16x8*)(gr + 32 * s); c.wi[s] = *(const bf16x8*)(gi + 32 * s); }
    c.br = p.od_gate_b[(dir * 2 + 0) * RGW + ch]; c.bi = p.od_gate_b[(dir * 2 + 1) * RGW + ch];
    const float lam = p.od_lambda[dir * RGW + ch];
    c.coef = -8.0f * (fmaxf(-lam, 0.f) + log1pf(expf(-fabsf(lam)))) * 1.4426950408889634f;
}
__device__ __forceinline__ void rg_tile(const bf16_t* zc, int mt, int cl, const RgCtx& c, f32x4& a4, f32x4& x4) {
    const int lane = otid() & 63, fr = lane & 15, fq = lane >> 4;
    f32x4 r = (f32x4){0.f, 0.f, 0.f, 0.f}, ig = (f32x4){0.f, 0.f, 0.f, 0.f};
#pragma unroll
    for (int s = 0; s < 4; ++s) {
        const bf16x8 a = *(const bf16x8*)(zc + (16 * mt + fr) * RG_ZS + 32 * s + 8 * fq);
        r = __builtin_amdgcn_mfma_f32_16x16x32_bf16(a, c.wr[s], r, 0, 0, 0);
        ig = __builtin_amdgcn_mfma_f32_16x16x32_bf16(a, c.wi[s], ig, 0, 0, 0);
    }
#pragma unroll
    for (int rg = 0; rg < 4; ++rg) {
        const float rr = __builtin_amdgcn_rcpf(1.0f + __builtin_amdgcn_exp2f(-1.4426950408889634f * (r[rg] + c.br)));
        const float ii = __builtin_amdgcn_rcpf(1.0f + __builtin_amdgcn_exp2f(-1.4426950408889634f * (ig[rg] + c.bi)));
        const float a = __builtin_amdgcn_exp2f(c.coef * rr);
        const float z = bf2f(zc[(16 * mt + 4 * fq + rg) * RG_ZS + cl + fr]);
        a4[rg] = a; x4[rg] = sqrtf((1.0f - a) * (1.0f + a)) * ii * z;
    }
}
template <int DIR> __device__ __forceinline__ void rg_sum_dir(const Params& p, const bf16_t* zc, int b, int c34, int n, int cl, float* SUM) {
    const int lane = otid() & 63, fr = lane & 15, fq = lane >> 4;
    RgCtx c; rg_ctx_load(p, n, cl, DIR, c);
    float h = 0.f, pt = 1.f;
#pragma unroll 2
    for (int m2 = 0; m2 < 8; ++m2) {
        const int mt = DIR == 0 ? m2 : 7 - m2;
        f32x4 a, x; rg_tile(zc, mt, cl, c, a, x);
        const float P4 = a[0] * a[1] * a[2] * a[3];
        const float B4 = DIR == 0 ? ((x[0] * a[1] + x[1]) * a[2] + x[2]) * a[3] + x[3] : ((x[3] * a[2] + x[2]) * a[1] + x[1]) * a[0] + x[0];
#pragma unroll
        for (int g2 = 0; g2 < 4; ++g2) {
            const int gs = DIR == 0 ? g2 : 3 - g2;
            const float Pg = __shfl(P4, 16 * gs + fr), Bg = __shfl(B4, 16 * gs + fr);
            h = Pg * h + Bg; pt *= Pg;
        }
    }
    if (fq == 0) { float* dst = SUM + ((((size_t)b * 34 + c34) * 2 + DIR) * RGW + n * 128 + cl + fr) * 2; dst[0] = pt; dst[1] = h; }
}
__device__ __forceinline__ void ph_rg_a(const Params& p, unsigned char* smem) {
    bf16_t* zc = (bf16_t*)smem;
    float* SUM = (float*)p.G;
    const int wid = otid() >> 6;
    for (int u = blockIdx.x; u < NB * 34 * 10; u += gridDim.x) {
        const int b = u / 340, c34 = (u / 10) % 34, n = u % 10;
        __syncthreads();
        rg_stage_z(p, b, c34, n, zc);
        __syncthreads();
        for (int nt = 0; nt < 2; ++nt) {
            const int cl = 32 * wid + 16 * nt;
            rg_sum_dir<0>(p, zc, b, c34, n, cl, SUM);
            rg_sum_dir<1>(p, zc, b, c34, n, cl, SUM);
        }
    }
}
__device__ __forceinline__ void ph_rg_b(const Params& p) {
    const float* SUM = (const float*)p.G; float* HIN = (float*)(p.G + RG_SUM_BYTES);
    for (int gid = blockIdx.x * 256 + threadIdx.x; gid < NB * 2 * RGW; gid += gridDim.x * 256) {
        const int ch = gid % RGW, dir = (gid / RGW) & 1, b = gid / (2 * RGW);
        float h = 0.f;
#pragma unroll 2
        for (int step = 0; step < 34; ++step) {
            const int c34 = dir == 0 ? step : (step < 2 ? 1 - step : 35 - step);
            const size_t o = (((size_t)b * 34 + c34) * 2 + dir) * RGW + ch;
            HIN[o] = h;
            h = SUM[o * 2] * h + SUM[o * 2 + 1];
        }
    }
}
template <int DIR> __device__ __forceinline__ void rg_apply_dir(const Params& p, const bf16_t* zc, bf16_t* yf, int b, int c34, int n, int cl, const float* HIN) {
    const int lane = otid() & 63, fr = lane & 15, fq = lane >> 4, ch = n * 128 + cl + fr;
    RgCtx c; rg_ctx_load(p, n, cl, DIR, c);
    float h = HIN[(((size_t)b * 34 + c34) * 2 + DIR) * RGW + ch];
#pragma unroll 2
    for (int m2 = 0; m2 < 8; ++m2) {
        const int mt = DIR == 0 ? m2 : 7 - m2;
        f32x4 a, x; rg_tile(zc, mt, cl, c, a, x);
        const float P4 = a[0] * a[1] * a[2] * a[3];
        const float B4 = DIR == 0 ? ((x[0] * a[1] + x[1]) * a[2] + x[2]) * a[3] + x[3] : ((x[3] * a[2] + x[2]) * a[1] + x[1]) * a[0] + x[0];
        float hin = 0.f;
#pragma unroll
        for (int g2 = 0; g2 < 4; ++g2) {
            const int gs = DIR == 0 ? g2 : 3 - g2;
            const float Pg = __shfl(P4, 16 * gs + fr), Bg = __shfl(B4, 16 * gs + fr);
            if (fq == gs) hin = h;
            h = Pg * h + Bg;
        }
        f32x4 y;
        if (DIR == 0) {
            y[0] = a[0] * hin + x[0]; y[1] = a[1] * y[0] + x[1]; y[2] = a[2] * y[1] + x[2]; y[3] = a[3] * y[2] + x[3];
#pragma unroll
            for (int rg = 0; rg < 4; ++rg) yf[(16 * mt + 4 * fq + rg) * 16 + fr] = f2bf(y[rg]);
        } else {
            y[3] = a[3] * hin + x[3]; y[2] = a[2] * y[3] + x[2]; y[1] = a[1] * y[2] + x[1]; y[0] = a[0] * y[1] + x[0];
#pragma unroll
            for (int rg = 0; rg < 4; ++rg) {
                bf16_t* pb = p.P + ((size_t)b * PB + c34 * 128 + 16 * mt + 4 * fq + rg) * 2560 + ch;
                *pb = f2bf(gelu_fast(bf2f(*pb)) * (y[rg] + bf2f(yf[(16 * mt + 4 * fq + rg) * 16 + fr])));
            }
        }
    }
}
__device__ __forceinline__ void ph_rg_c(const Params& p, unsigned char* smem) {
    bf16_t* zc = (bf16_t*)smem;
    const float* HIN = (const float*)(p.G + RG_SUM_BYTES);
    const int wid = otid() >> 6;
    bf16_t* yf = (bf16_t*)(smem + 128 * RG_ZS * 2) + wid * 2048;
    for (int u = blockIdx.x; u < NB * 32 * 10; u += gridDim.x) {
        const int b = u / 320, c34 = 2 + (u / 10) % 32, n = u % 10;
        __syncthreads();
        rg_stage_z(p, b, c34, n, zc);
        __syncthreads();
        for (int nt = 0; nt < 2; ++nt) {
            const int cl = 32 * wid + 16 * nt;
            rg_apply_dir<0>(p, zc, yf, b, c34, n, cl, HIN);
            rg_apply_dir<1>(p, zc, yf, b, c34, n, cl, HIN);
        }
    }
}

#define SMEM_DECL __shared__ __attribute__((aligned(16))) unsigned char smem[65536]
__global__ void __launch_bounds__(256) k_prologue(Params p) { SMEM_DECL; ph_prologue(p, smem); }
__global__ void __launch_bounds__(256) k_modulate0(Params p) { ph_modulate0(p); }
__global__ void __launch_bounds__(256) k_gemm_ev_in(Params p) { SMEM_DECL; gemm_phase(p.A16, D, p.wt_ev_in, 1024, EV_IN, RowMap{0}, EpiBf16{p.P, EV_IN, EV_IN}, smem); }
__global__ void __launch_bounds__(256) k_rowpost(Params p) { ph_rowpost(p); }
__global__ void __launch_bounds__(256) k_gemm_q(Params p) { SMEM_DECL; gemm_phase(p.P + C_CQ, EV_IN, p.wt_uq, 384, 768, RowMap{0}, EpiQ{p.Q16, p.rsq, p.rope_cos, p.rope_sin}, smem); }
__global__ void __launch_bounds__(256) k_gemm_kv(Params p) { SMEM_DECL; gemm_phase(p.P + C_CKV, EV_IN, p.wt_ukv, 256, 1024, RowMap{0}, EpiKV{p.K16, p.V16, p.rsq + R}, smem); }
__global__ void __launch_bounds__(256) k_gemm_ev_out(Params p) { SMEM_DECL; gemm_phase(p.A16, D, p.wt_ev_out, 1024, 1024, RowMap{0}, EpiResid{p.x, p.ctx, p.mod, p.H, 0}, smem); }
__global__ void __launch_bounds__(256) k_ln_mod(Params p, int layer, int lat_only) { ph_ln_mod(p, layer, 0, lat_only); }
__global__ void __launch_bounds__(256) k_gemm_pq(Params p, int layer, int lat_only) { SMEM_DECL; gemm_phase(p.A16, D, p.wt_pq + (size_t)layer * 2048 * 1024, 1024, 2048, RowMap{lat_only}, EpiBf16{p.P, 2048, 2048}, smem); }
__global__ void __launch_bounds__(256) k_combine(Params p, int lat_only) { ph_combine(p, lat_only); }
__global__ void __launch_bounds__(256) k_gather(Params p, int layer, int lat_only) { ph_gather_ln(p, layer, lat_only); }
__global__ void __launch_bounds__(256) k_gemm_od_in(Params p) { SMEM_DECL; gemm_phase(p.A16, D, p.wt_od_in, 1024, 2560, RowMap{0}, EpiBf16{p.P, 2560, 2560}, smem); }
__global__ void __launch_bounds__(256) k_gemm_od_out(Params p) { SMEM_DECL; gemm_phase(p.P, 2560, p.wt_od_out, 1280, 1024, RowMap{1}, EpiResid{p.x, p.ctx, p.mod, p.H, 1}, smem); }

__global__ void __launch_bounds__(256, 2) k_mega(Params p) {
    SMEM_DECL;
    cg::grid_group grid = cg::this_grid();
    ph_prologue(p, smem); grid.sync();
    ph_modulate0(p); grid.sync();
    gemm_phase(p.A16, D, p.wt_ev_in, 1024, EV_IN, RowMap{0}, EpiBf16{p.P, EV_IN, EV_IN}, smem); grid.sync();
    ph_rowpost(p); ph_gla_a(p, smem); grid.sync();
    gemm_phase(p.P + C_CQ, EV_IN, p.wt_uq, 384, 768, RowMap{0}, EpiQ{p.Q16, p.rsq, p.rope_cos, p.rope_sin}, smem);
    gemm_phase(p.P + C_CKV, EV_IN, p.wt_ukv, 256, 1024, RowMap{0}, EpiKV{p.K16, p.V16, p.rsq + R}, smem); ph_gla_b(p); grid.sync();
    ph_gla_c(p, smem); ph_attn(p, smem, blockIdx.x, gridDim.x); grid.sync();
    gemm_phase(p.A16, D, p.wt_ev_out, 1024, 1024, RowMap{0}, EpiResid{p.x, p.ctx, p.mod, p.H, 0}, smem); grid.sync();
    ph_ln_mod(p, 0, 0, 0); grid.sync();
    gemm_phase(p.A16, D, p.wt_pq, 1024, 2048, RowMap{0}, EpiBf16{p.P, 2048, 2048}, smem); grid.sync();
    ph_scores(p, 0, 0, smem); grid.sync();
    ph_combine(p, 0); ph_convert_uv(p, 0); grid.sync();
    ph_gather_mfma(p, 0, 0, smem); grid.sync();
    gemm_phase(p.A16, D, p.wt_od_in, 1024, 2560, RowMap{0}, EpiBf16{p.P, 2560, 2560}, smem); grid.sync();
    ph_rg_a(p, smem); grid.sync();
    ph_rg_b(p); grid.sync();
    ph_rg_c(p, smem); grid.sync();
    gemm_phase(p.P, 2560, p.wt_od_out, 1280, 1024, RowMap{1}, EpiResid{p.x, p.ctx, p.mod, p.H, 1}, smem); grid.sync();
    ph_ln_mod(p, 1, 0, 1); grid.sync();
    gemm_phase(p.A16, D, p.wt_pq + (size_t)2048 * 1024, 1024, 2048, RowMap{1}, EpiBf16{p.P, 2048, 2048}, smem); grid.sync();
    ph_scores(p, 1, 1, smem); grid.sync();
    ph_combine(p, 1); ph_convert_uv(p, 1); grid.sync();
    ph_gather_mfma(p, 1, 1, smem);
}

extern "C" void kernel_launch(void* const* d_in, const int* in_sizes, int n_in, void* d_out, int out_size, void* d_ws, size_t ws_size, hipStream_t stream) {
    Params p{};
    const float** f = (const float**)d_in;
    p.x = f[0]; p.c = f[1]; p.ctx = f[2]; p.c_ctx = f[3]; p.mod_w = f[4]; p.mod_b = f[5]; p.ln_g = f[6]; p.ln_b = f[7];
    p.ev_w_in = f[8]; p.ev_q_norm = f[9]; p.ev_kv_norm = f[10]; p.ev_w_uq = f[11]; p.ev_w_ukv = f[12]; p.ev_gla_wa2 = f[13]; p.ev_gla_ba = f[14]; p.ev_gla_norm = f[15]; p.ev_w_out = f[16];
    p.od_w_in = f[17]; p.od_conv_w = f[18]; p.od_conv_b = f[19]; p.od_gate_w = f[20]; p.od_gate_b = f[21]; p.od_lambda = f[22]; p.od_w_out = f[23];
    p.peer_wq = f[24]; p.peer_k1 = f[25]; p.peer_k2 = f[26]; p.peer_u = f[27]; p.peer_v = f[28];
    p.out = (float*)d_out;
    unsigned char* w = (unsigned char*)d_ws; size_t off = 0;
    auto take = [&](size_t bytes) { unsigned char* r = w + off; off += (bytes + 255) & ~(size_t)255; return r; };
    p.wt_ev_in = (bf16_t*)take((size_t)EV_IN * 1024 * 2); p.wt_uq = (bf16_t*)take(768 * 384 * 2); p.wt_ukv = (bf16_t*)take(1024 * 256 * 2);
    p.wt_ev_out = (bf16_t*)take(1024 * 1024 * 2); p.wt_od_in = (bf16_t*)take(2560 * 1024 * 2); p.wt_gate = (bf16_t*)take(40 * 16384 * 2);
    p.wt_od_out = (bf16_t*)take(1024 * 1280 * 2); p.wt_pq = (bf16_t*)take((size_t)2 * 2048 * 1024 * 2); p.wt_k = (bf16_t*)take(4 * 16384 * 2);
    p.mod = (float*)take(2 * 9 * 6144 * 4); p.rope_cos = (float*)take(SEQ * 16 * 4); p.rope_sin = (float*)take(SEQ * 16 * 4); p.rsq = (float*)take((size_t)2 * R * 4);
    p.H = (float*)take((size_t)R * D * 4);
    p.Q16 = (bf16_t*)p.H; p.K16 = p.Q16 + (size_t)R * 768; p.V16 = p.K16 + (size_t)R * 768;
    p.A16 = (bf16_t*)take((size_t)R * D * 2);
    p.P = (bf16_t*)take((size_t)R * 2560 * 2);
    p.G = take((size_t)94371840);
    if (off > ws_size) { fprintf(stderr, "workspace too small: need %zu have %zu\n", off, ws_size); return; }
    static int grid_blocks = 0;
    if (!grid_blocks) {
        int dev = 0, cus = 0, per_cu = 0;
        (void)hipGetDevice(&dev);
        (void)hipDeviceGetAttribute(&cus, hipDeviceAttributeMultiprocessorCount, dev);
        (void)hipOccupancyMaxActiveBlocksPerMultiprocessor(&per_cu, k_mega, 256, 0);
        if (per_cu > 2) per_cu = 2;
        if (per_cu < 1) per_cu = 1;
        grid_blocks = cus * per_cu;
    }
    void* args[] = {&p};
    hipError_t e = hipLaunchCooperativeKernel((void*)k_mega, dim3(grid_blocks), dim3(256), args, 0, stream);
    if (e != hipSuccess) fprintf(stderr, "cooperative launch failed: %s (grid %d)\n", hipGetErrorString(e), grid_blocks);
}
__global__ void __launch_bounds__(256) k_gather2(Params p, int layer, int lat_only) { SMEM_DECL; ph_gather_mfma(p, layer, lat_only, smem); }
__global__ void __launch_bounds__(256) k_rga(Params p) { SMEM_DECL; ph_rg_a(p, smem); }
__global__ void __launch_bounds__(256) k_rgc(Params p) { SMEM_DECL; ph_rg_c(p, smem); }
__global__ void __launch_bounds__(256) k_glaa(Params p) { SMEM_DECL; ph_gla_a(p, smem); }
__global__ void __launch_bounds__(256) k_glac(Params p) { SMEM_DECL; ph_gla_c(p, smem); }
__global__ void __launch_bounds__(256) k_attn2(Params p) { SMEM_DECL; ph_attn(p, smem, blockIdx.x, gridDim.x); }
```

```cpp
#include <hip/hip_runtime.h>
#include <hip/hip_cooperative_groups.h>
#include <cstdio>
#include <cstdint>

namespace cg = cooperative_groups;
typedef unsigned short bf16_t;
typedef short bf16x8 __attribute__((ext_vector_type(8)));
typedef float f32x4 __attribute__((ext_vector_type(4)));
typedef float f32x16 __attribute__((ext_vector_type(16)));
typedef unsigned u32x4 __attribute__((ext_vector_type(4)));
typedef unsigned u32x2 __attribute__((ext_vector_type(2)));

constexpr int D = 1024, NB = 8, SEQ = 4096, CTX = 256, PB = SEQ + CTX  , R = NB * PB  ;
constexpr int EV_IN = 2240, RGW = 1280;
constexpr int C_CQ = 0, C_CKV = 384, C_KPE = 640, C_GQ = 672, C_GK = 928, C_GV = 1184, C_GG = 1696, C_GAF = 2208;
constexpr float LN_EPS = 1e-6f, ALPHA = 1.41421356237f, MLA_SCALE = 0.10206207261596577f  ;
constexpr int PEER_N = 16384;

struct Params {
    const float *x, *c, *ctx, *c_ctx, *mod_w, *mod_b, *ln_g, *ln_b;
    const float *ev_w_in, *ev_q_norm, *ev_kv_norm, *ev_w_uq, *ev_w_ukv, *ev_gla_wa2, *ev_gla_ba, *ev_gla_norm, *ev_w_out;
    const float *od_w_in, *od_conv_w, *od_conv_b, *od_gate_w, *od_gate_b, *od_lambda, *od_w_out;
    const float *peer_wq, *peer_k1, *peer_k2, *peer_u, *peer_v;
    float* out;
    bf16_t *wt_ev_in, *wt_uq, *wt_ukv, *wt_ev_out, *wt_od_in, *wt_gate, *wt_od_out, *wt_pq, *wt_k;
    float *mod, *rope_cos, *rope_sin, *rsq;
    float* H; bf16_t *Q16, *K16, *V16;
    bf16_t* A16; bf16_t* P; unsigned char* G;
    unsigned* bar;
};

__device__ __forceinline__ bf16_t f2bf(float f) { unsigned u = __float_as_uint(f); u += 0x7fffu + ((u >> 16) & 1u); return (bf16_t)(u >> 16); }
__device__ __forceinline__ float bf2f(bf16_t h) { return __uint_as_float(((unsigned)h) << 16); }
__device__ __forceinline__ unsigned pack2(float a, float b) { unsigned r; asm volatile("v_cvt_pk_bf16_f32 %0, %1, %2" : "=v"(r) : "v"(a), "v"(b)); return r; }
__device__ __forceinline__ float silu_f(float x) { return x / (1.0f + expf(-x)); }
__device__ __forceinline__ float sigmoid_f(float x) { return 1.0f / (1.0f + expf(-x)); }
__device__ __forceinline__ float gelu_f(float x) { return 0.5f * x * (1.0f + erff(x * 0.70710678118654752f)); }
__device__ __forceinline__ float wave_sum(float v) {
#pragma unroll
    for (int o = 32; o > 0; o >>= 1) v += __shfl_xor(v, o);
    return v;
}
__device__ __forceinline__ int otid() { int t = threadIdx.x; asm volatile("" : "+v"(t)); return t; }
__device__ __forceinline__ int mod_row(int r) { const int b = r / PB, p = r - b * PB; return p < CTX ? 8 : b; }
__device__ __forceinline__ const float* in_row(const Params& P_, int r) {
    const int b = r / PB, p = r - b * PB;
    return p < CTX ? P_.ctx + ((size_t)b * CTX + p) * D : P_.x + ((size_t)b * SEQ + (p - CTX)) * D;
}

__device__ __forceinline__ void tconv_tile(const float* __restrict__ W, int K, int N, bf16_t* __restrict__ Wt, const float* __restrict__ rowscale, int tile, float* sm) {
    const int ntn = N / 64, tk = tile / ntn, tn = tile % ntn, tid = threadIdx.x;
#pragma unroll
    for (int i = 0; i < 4; ++i) {
        const int k = (tid >> 4) + 16 * i;
        f32x4 v = *(const f32x4*)(W + (size_t)(tk * 64 + k) * N + tn * 64 + (tid & 15) * 4);
        const float s = rowscale ? rowscale[tk * 64 + k] : 1.0f;
#pragma unroll
        for (int q = 0; q < 4; ++q) sm[k * 65 + (tid & 15) * 4 + q] = v[q] * s;
    }
    __syncthreads();
    const int n = tid >> 2, kc = tid & 3;
    unsigned w[8];
#pragma unroll
    for (int kk = 0; kk < 8; ++kk) w[kk] = pack2(sm[(kc * 16 + 2 * kk) * 65 + n], sm[(kc * 16 + 2 * kk + 1) * 65 + n]);
    bf16_t* dst = Wt + (size_t)(tn * 64 + n) * K + tk * 64 + kc * 16;
    *(u32x4*)dst = (u32x4){w[0], w[1], w[2], w[3]};
    *(u32x4*)(dst + 8) = (u32x4){w[4], w[5], w[6], w[7]};
    __syncthreads();
}
__device__ __forceinline__ void tconv_all(const float* W, int K, int N, bf16_t* Wt, const float* rowscale, float* sm) {
    const int nt = (K / 64) * (N / 64);
    for (int t = blockIdx.x; t < nt; t += gridDim.x) tconv_tile(W, K, N, Wt, rowscale, t, sm);
}

__device__ __forceinline__ void ph_prologue(const Params& p, unsigned char* smem) {
    float* sm = (float*)smem;
    tconv_all(p.ev_w_in, 1024, EV_IN, p.wt_ev_in, nullptr, sm);
    tconv_all(p.ev_w_uq, 384, 768, p.wt_uq, p.ev_q_norm, sm);
    tconv_all(p.ev_w_ukv, 256, 1024, p.wt_ukv, p.ev_kv_norm, sm);
    tconv_all(p.ev_w_out, 1024, 1024, p.wt_ev_out, nullptr, sm);
    tconv_all(p.od_w_in, 1024, 2560, p.wt_od_in, nullptr, sm);
    for (int g = 0; g < 40; ++g) tconv_all(p.od_gate_w + (size_t)g * 16384, 128, 128, p.wt_gate + (size_t)g * 16384, nullptr, sm);
    tconv_all(p.od_w_out, 1280, 1024, p.wt_od_out, nullptr, sm);
    for (int l = 0; l < 2; ++l) tconv_all(p.peer_wq + (size_t)l * 1024 * 2048, 1024, 2048, p.wt_pq + (size_t)l * 1024 * 2048, nullptr, sm);
    for (int i = blockIdx.x * 256 + threadIdx.x; i < 2 * 2 * 16384; i += gridDim.x * 256) {
        const int l = i / 32768, h = (i / 16384) & 1, e = i & 16383;
        p.wt_k[i] = f2bf((h ? p.peer_k2 : p.peer_k1)[(size_t)l * 16384 + e]);
    }
    for (int i = blockIdx.x * 256 + threadIdx.x; i < SEQ * 16; i += gridDim.x * 256) {
        const int s = i >> 4, f = i & 15;
        const float pos = (float)(f < 8 ? (s >> 6) : (s & 63));
        const float inv = powf(10000.0f, -(float)(f & 7) / 8.0f);
        const float ang = pos * inv;
        p.rope_cos[i] = cosf(ang); p.rope_sin[i] = sinf(ang);
    }
    float* sc = sm;
    for (int u = blockIdx.x; u < 2 * 96; u += gridDim.x) {
        const int l = u / 96, c0 = (u % 96) * 64, tid = threadIdx.x;
        __syncthreads();
        for (int i = tid; i < 9 * 1024; i += 256) { const int rr = i >> 10, k = i & 1023; sc[i] = silu_f(rr < 8 ? p.c[rr * 1024 + k] : p.c_ctx[k]); }
        __syncthreads();
        const int col = c0 + (tid & 63), kq = tid >> 6;
        float acc[9];
#pragma unroll
        for (int rr = 0; rr < 9; ++rr) acc[rr] = 0.f;
        const float* w = p.mod_w + (size_t)l * 1024 * 6144 + col;
        for (int k = kq * 256; k < kq * 256 + 256; ++k) {
            const float wv = w[(size_t)k * 6144];
#pragma unroll
            for (int rr = 0; rr < 9; ++rr) acc[rr] += sc[rr * 1024 + k] * wv;
        }
        __syncthreads();
        float* red = sm + 9 * 1024;
#pragma unroll
        for (int rr = 0; rr < 9; ++rr) red[(kq * 9 + rr) * 64 + (tid & 63)] = acc[rr];
        __syncthreads();
        for (int i = tid; i < 9 * 64; i += 256) {
            const int rr = i >> 6, cc = i & 63;
            const float s = red[(0 * 9 + rr) * 64 + cc] + red[(1 * 9 + rr) * 64 + cc] + red[(2 * 9 + rr) * 64 + cc] + red[(3 * 9 + rr) * 64 + cc];
            p.mod[((size_t)l * 9 + rr) * 6144 + c0 + cc] = s + p.mod_b[l * 6144 + c0 + cc];
        }
    }
}

__device__ __forceinline__ void ph_modulate0(const Params& p) {
    const int tid_ = otid(), wid = tid_ >> 6, lane = tid_ & 63;
    for (int u = blockIdx.x; u < R / 4; u += gridDim.x) {
        const int r = u * 4 + wid;
        const float* src = in_row(p, r);
        const float* md = p.mod + (size_t)(0 * 9 + mod_row(r)) * 6144;
#pragma unroll
        for (int q = 0; q < 4; ++q) {
            const int c = q * 256 + lane * 4;
            const f32x4 h = *(const f32x4*)(src + c), sh = *(const f32x4*)(md + c), scl = *(const f32x4*)(md + 1024 + c);
            const f32x4 v = h * (1.0f + scl) + sh;
            *(u32x2*)(p.A16 + (size_t)r * D + c) = (u32x2){pack2(v[0], v[1]), pack2(v[2], v[3])};
        }
    }
}

constexpr int GBK = 64, GLDS = 72  ;
struct RowMap { int lat_only; __device__ __forceinline__ int ntiles() const { return lat_only ? 256 : 272; }
    __device__ __forceinline__ int row0(int t) const { return lat_only ? (t >> 5) * PB + CTX + (t & 31) * 128 : t * 128; } };

template <class Epi>
__device__ __forceinline__ void gemm_phase(const bf16_t* __restrict__ A, int lda, const bf16_t* __restrict__ Bt, int K, int N, RowMap rm, const Epi& epi, unsigned char* smem) {
    bf16_t* sA = (bf16_t*)smem; bf16_t* sB = sA + 128 * GLDS;
    const int tid = otid(), lane = tid & 63, wid = tid >> 6, wm = wid >> 1, wn = wid & 1, fr = lane & 15, fq = lane >> 4;
    const int ntn = (N + 127) / 128, nunits = rm.ntiles() * ntn, nk = K / GBK;
    for (int u = blockIdx.x; u < nunits; u += gridDim.x) {
        const int tm = u / ntn, tn = u % ntn, m0 = rm.row0(tm), n0 = tn * 128;
        f32x4 acc[4][4];
#pragma unroll
        for (int i = 0; i < 4; ++i)
#pragma unroll
            for (int j = 0; j < 4; ++j) acc[i][j] = (f32x4){0.f, 0.f, 0.f, 0.f};
        u32x4 ra[4], rb[4];
        auto gload = [&](int kt) {
#pragma unroll
            for (int i = 0; i < 4; ++i) {
                const int id = tid + 256 * i, row = id >> 3, ch = id & 7;
                ra[i] = *(const u32x4*)(A + (size_t)(m0 + row) * lda + kt * GBK + ch * 8);
                int brow = n0 + row; brow = brow < N ? brow : N - 1;
                rb[i] = *(const u32x4*)(Bt + (size_t)brow * K + kt * GBK + ch * 8);
            }
        };
        auto lstore = [&]() {
#pragma unroll
            for (int i = 0; i < 4; ++i) {
                const int id = tid + 256 * i, row = id >> 3, ch = id & 7;
                *(u32x4*)(sA + row * GLDS + ch * 8) = ra[i];
                *(u32x4*)(sB + row * GLDS + ch * 8) = rb[i];
            }
        };
        gload(0);
        __syncthreads();
        lstore();
        __syncthreads();
        for (int kt = 0; kt < nk; ++kt) {
            if (kt + 1 < nk) gload(kt + 1);
#pragma unroll
            for (int ks = 0; ks < 2; ++ks) {
                bf16x8 af[4], bfr[4];
#pragma unroll
                for (int i = 0; i < 4; ++i) af[i] = *(const bf16x8*)(sA + (wm * 64 + i * 16 + fr) * GLDS + ks * 32 + fq * 8);
#pragma unroll
                for (int j = 0; j < 4; ++j) bfr[j] = *(const bf16x8*)(sB + (wn * 64 + j * 16 + fr) * GLDS + ks * 32 + fq * 8);
#pragma unroll
                for (int i = 0; i < 4; ++i)
#pragma unroll
                    for (int j = 0; j < 4; ++j) acc[i][j] = __builtin_amdgcn_mfma_f32_16x16x32_bf16(bfr[j], af[i], acc[i][j], 0, 0, 0);
            }
            __syncthreads();
            if (kt + 1 < nk) { lstore(); __syncthreads(); }
        }
        epi(acc, m0 + wm * 64, n0 + wn * 64, fr, fq);
    }
}

struct EpiBf16 {
    bf16_t* C; int ldc, N;
    __device__ __forceinline__ void operator()(const f32x4 (&acc)[4][4], int mb, int nb, int fr, int fq) const {
#pragma unroll
        for (int i = 0; i < 4; ++i)
#pragma unroll
            for (int j = 0; j < 4; ++j) {
                const int m = mb + i * 16 + fr, n = nb + j * 16 + 4 * fq;
                if (n < N) *(u32x2*)(C + (size_t)m * ldc + n) = (u32x2){pack2(acc[i][j][0], acc[i][j][1]), pack2(acc[i][j][2], acc[i][j][3])};
            }
    }
};
struct EpiQ {
    bf16_t* Q; const float *rsq, *rc, *rs;
    __device__ __forceinline__ void operator()(const f32x4 (&acc)[4][4], int mb, int nb, int fr, int fq) const {
#pragma unroll
        for (int i = 0; i < 4; ++i) {
            const int m = mb + i * 16 + fr, b = m / PB, pp = m - b * PB;
            const float sc = rsq[m] * (MLA_SCALE * 1.4426950408889634f);
#pragma unroll
            for (int j = 0; j < 4; j += 2) {
                const int n = nb + j * 16 + 4 * fq;
                f32x4 v0 = acc[i][j] * sc, v1 = acc[i][j + 1] * sc;
                const int d = n % 96;
                if (d >= 64 && pp >= CTX) {
                    const int s = pp - CTX, f = (d - 64) + 0;
                    const f32x4 cs = *(const f32x4*)(rc + s * 16 + f), sn = *(const f32x4*)(rs + s * 16 + f);
                    const f32x4 o0 = v0 * cs - v1 * sn, o1 = v0 * sn + v1 * cs; v0 = o0; v1 = o1;
                }
                *(u32x2*)(Q + (size_t)m * 768 + n) = (u32x2){pack2(v0[0], v0[1]), pack2(v0[2], v0[3])};
                *(u32x2*)(Q + (size_t)m * 768 + n + 16) = (u32x2){pack2(v1[0], v1[1]), pack2(v1[2], v1[3])};
            }
        }
    }
};
struct EpiKV {
    bf16_t *Kd, *Vd; const float* rsq;
    __device__ __forceinline__ void operator()(const f32x4 (&acc)[4][4], int mb, int nb, int fr, int fq) const {
#pragma unroll
        for (int i = 0; i < 4; ++i) {
            const int m = mb + i * 16 + fr; const float sc = rsq[m];
#pragma unroll
            for (int j = 0; j < 4; ++j) {
                const int n = nb + j * 16 + 4 * fq, hd = n >> 7, d = n & 127;
                const f32x4 v = acc[i][j] * sc;
                bf16_t* dst = d < 64 ? Kd + (size_t)m * 768 + hd * 96 + d : Vd + (size_t)m * 512 + hd * 64 + (d - 64);
                *(u32x2*)dst = (u32x2){pack2(v[0], v[1]), pack2(v[2], v[3])};
            }
        }
    }
};
struct EpiResid {
    const float *x, *ctx, *mod; float* H; int layer;
    __device__ __forceinline__ void operator()(const f32x4 (&acc)[4][4], int mb, int nb, int fr, int fq) const {
#pragma unroll
        for (int i = 0; i < 4; ++i) {
            const int m = mb + i * 16 + fr, b = m / PB, pp = m - b * PB;
            const float* hin = layer == 0 ? (pp < CTX ? ctx + ((size_t)b * CTX + pp) * D : x + ((size_t)b * SEQ + (pp - CTX)) * D) : H + (size_t)m * D;
            const float* gate = mod + ((size_t)layer * 9 + (pp < CTX ? 8 : b)) * 6144 + 2 * 1024;
#pragma unroll
            for (int j = 0; j < 4; ++j) {
                const int n = nb + j * 16 + 4 * fq;
                const f32x4 h = *(const f32x4*)(hin + n), g = *(const f32x4*)(gate + n);
                *(f32x4*)(H + (size_t)m * D + n) = ALPHA * h + g * acc[i][j];
            }
        }
    }
};

__device__ __forceinline__ void ph_rowpost(const Params& p) {
    const int tid_ = otid(), wid = tid_ >> 6, lane = tid_ & 63;
    for (int u = blockIdx.x; u < R / 4; u += gridDim.x) {
        const int r = u * 4 + wid, b = r / PB, pp = r - b * PB;
        const bf16_t* row = p.P + (size_t)r * EV_IN;
        float sq = 0.f, skv = 0.f;
#pragma unroll
        for (int i = 0; i < 10; ++i) { const float v = bf2f(row[lane + 64 * i]); if (i < 6) sq += v * v; else skv += v * v; }
        sq = wave_sum(sq); skv = wave_sum(skv);
        if (lane == 0) { p.rsq[r] = rsqrtf(sq / 384.0f + LN_EPS); p.rsq[R + r] = rsqrtf(skv / 256.0f + LN_EPS); }
        if (lane < 16) {
            float x1 = bf2f(row[C_KPE + lane]), x2 = bf2f(row[C_KPE + 16 + lane]);
            if (pp >= CTX) { const int s = pp - CTX; const float cs = p.rope_cos[s * 16 + lane], sn = p.rope_sin[s * 16 + lane];
                const float o1 = x1 * cs - x2 * sn, o2 = x1 * sn + x2 * cs; x1 = o1; x2 = o2; }
            const bf16_t b1 = f2bf(x1), b2 = f2bf(x2);
#pragma unroll
            for (int hd = 0; hd < 8; ++hd) { p.K16[(size_t)r * 768 + hd * 96 + 64 + lane] = b1; p.K16[(size_t)r * 768 + hd * 96 + 80 + lane] = b2; }
        }
    }
}

constexpr int AT_KS = 104, AT_VS = 68, AT_BUF = 64 * AT_KS * 2 + 64 * AT_VS * 2;
__device__ __forceinline__ void ph_attn(const Params& p, unsigned char* smem, int bid, int nblk) {
    const int tid = otid(), wid = tid >> 6, lane = tid & 63, q = lane & 31, h = lane >> 5;
    for (int u = bid; u < 2048 + 128; u += nblk) {
        int b, hd, q0, nkeys;
        if (u < 2048) { b = u >> 8; hd = (u >> 5) & 7; q0 = CTX + (u & 31) * 128; nkeys = PB; }
        else { const int v = u - 2048; b = v >> 4; hd = (v >> 1) & 7; q0 = (v & 1) * 128; nkeys = CTX; }
        const size_t rq = (size_t)b * PB + q0 + wid * 32 + q;
        bf16x8 qf[6];
#pragma unroll
        for (int s = 0; s < 6; ++s) qf[s] = *(const bf16x8*)(p.Q16 + rq * 768 + hd * 96 + 16 * s + 8 * h);
        f32x16 o[2];
#pragma unroll
        for (int i = 0; i < 16; ++i) { o[0][i] = 0.f; o[1][i] = 0.f; }
        float m = -1e30f, l = 0.f;
        const int ntiles = nkeys / 64;
        const bf16_t* Kg = p.K16 + (size_t)b * PB * 768 + hd * 96;
        const bf16_t* Vg = p.V16 + (size_t)b * PB * 512 + hd * 64;
        u32x4 rk[3], rv[2];
        auto gload = [&](int t) {
#pragma unroll
            for (int i = 0; i < 3; ++i) { const int id = tid + 256 * i, key = id / 12, ch = id % 12; rk[i] = *(const u32x4*)(Kg + (size_t)(t * 64 + key) * 768 + ch * 8); }
#pragma unroll
            for (int i = 0; i < 2; ++i) { const int id = tid + 256 * i, key = id >> 3, dch = id & 7; rv[i] = *(const u32x4*)(Vg + (size_t)(t * 64 + key) * 512 + dch * 8); }
        };
        auto lstore = [&](int buf) {
            bf16_t* Ks = (bf16_t*)(smem + buf * AT_BUF); bf16_t* Vt = Ks + 64 * AT_KS;
#pragma unroll
            for (int i = 0; i < 3; ++i) { const int id = tid + 256 * i, key = id / 12, ch = id % 12; *(u32x4*)(Ks + key * AT_KS + ch * 8) = rk[i]; }
#pragma unroll
            for (int i = 0; i < 2; ++i) {
                const int id = tid + 256 * i, key = id >> 3, dch = id & 7;
#pragma unroll
                for (int e = 0; e < 4; ++e) { Vt[(dch * 8 + 2 * e) * AT_VS + key] = (bf16_t)(rv[i][e] & 0xffffu); Vt[(dch * 8 + 2 * e + 1) * AT_VS + key] = (bf16_t)(rv[i][e] >> 16); }
            }
        };
        __syncthreads();
        gload(0); lstore(0);
        __syncthreads();
        for (int t = 0; t < ntiles; ++t) {
            if (t + 1 < ntiles) gload(t + 1);
            const bf16_t* Ks = (const bf16_t*)(smem + (t & 1) * AT_BUF); const bf16_t* Vt = Ks + 64 * AT_KS;
            f32x16 sa[2];
#pragma unroll
            for (int kb = 0; kb < 2; ++kb) {
#pragma unroll
                for (int i = 0; i < 16; ++i) sa[kb][i] = 0.f;
#pragma unroll
                for (int s = 0; s < 6; ++s) {
                    const bf16x8 kf = *(const bf16x8*)(Ks + (kb * 32 + q) * AT_KS + 16 * s + 8 * h);
                    sa[kb] = __builtin_amdgcn_mfma_f32_32x32x16_bf16(kf, qf[s], sa[kb], 0, 0, 0);
                }
            }
            float mx = sa[0][0];
#pragma unroll
            for (int i = 1; i < 16; ++i) mx = fmaxf(mx, sa[0][i]);
#pragma unroll
            for (int i = 0; i < 16; ++i) mx = fmaxf(mx, sa[1][i]);
            mx = fmaxf(mx, __shfl_xor(mx, 32));
            const float mn = fmaxf(m, mx), al = __builtin_amdgcn_exp2f(m - mn);
            m = mn;
            float ps = 0.f;
#pragma unroll
            for (int kb = 0; kb < 2; ++kb)
#pragma unroll
                for (int i = 0; i < 16; ++i) { const float e = __builtin_amdgcn_exp2f(sa[kb][i] - mn); sa[kb][i] = e; ps += e; }
            l = l * al + ps;
#pragma unroll
            for (int i = 0; i < 16; ++i) { o[0][i] *= al; o[1][i] *= al; }
#pragma unroll
            for (int kb = 0; kb < 2; ++kb)
#pragma unroll
                for (int s2 = 0; s2 < 2; ++s2) {
                    u32x4 pw;
#pragma unroll
                    for (int e = 0; e < 4; ++e) pw[e] = pack2(sa[kb][8 * s2 + 2 * e], sa[kb][8 * s2 + 2 * e + 1]);
                    const bf16x8 pf = __builtin_bit_cast(bf16x8, pw);
                    const int base = kb * 32 + 16 * s2;
#pragma unroll
                    for (int db = 0; db < 2; ++db) {
                        const bf16_t* vp = Vt + (db * 32 + q) * AT_VS + base + 4 * h;
                        const u32x2 v0 = *(const u32x2*)vp, v1 = *(const u32x2*)(vp + 8);
                        const bf16x8 vf = __builtin_bit_cast(bf16x8, (u32x4){v0[0], v0[1], v1[0], v1[1]});
                        o[db] = __builtin_amdgcn_mfma_f32_32x32x16_bf16(vf, pf, o[db], 0, 0, 0);
                    }
                }
            if (t + 1 < ntiles) lstore((t + 1) & 1);
            __syncthreads();
        }
        l += __shfl_xor(l, 32);
        const float il = 1.0f / l;
#pragma unroll
        for (int db = 0; db < 2; ++db)
#pragma unroll
            for (int gq = 0; gq < 4; ++gq) {
                const int d = db * 32 + 8 * gq + 4 * h;
                *(u32x2*)(p.A16 + rq * D + hd * 64 + d) = (u32x2){pack2(o[db][4 * gq] * il, o[db][4 * gq + 1] * il), pack2(o[db][4 * gq + 2] * il, o[db][4 * gq + 3] * il)};
            }
    }
}

constexpr size_t GLA_KS_BYTES = (size_t)NB * 4 * 68 * 2 * 8192 * 2;
constexpr int GL_S = 72;
__device__ __forceinline__ void gla_cum(const Params& p, size_t row0, int hd, int dir, float* sga, float* spart, float (&c)[16], float& T) {
    const int tid = otid(), d = tid & 63, part = tid >> 6;
    {
        const int j = tid >> 2, g4 = tid & 3;
        const u32x2 w = *(const u32x2*)(p.P + (row0 + j) * EV_IN + C_GAF + dir * 16 + g4 * 4);
        sga[j * 16 + g4 * 4 + 0] = __uint_as_float(w[0] << 16); sga[j * 16 + g4 * 4 + 1] = __uint_as_float(w[0] & 0xffff0000u);
        sga[j * 16 + g4 * 4 + 2] = __uint_as_float(w[1] << 16); sga[j * 16 + g4 * 4 + 3] = __uint_as_float(w[1] & 0xffff0000u);
    }
    __syncthreads();
    float wc[16];
    const float* wa = p.ev_gla_wa2 + (size_t)dir * 16 * 256 + hd * 64 + d;
#pragma unroll
    for (int g = 0; g < 16; ++g) wc[g] = wa[g * 256];
    const float bias = p.ev_gla_ba[dir * 256 + hd * 64 + d];
    float lv[16]; float run = 0.f;
#pragma unroll
    for (int jj = 0; jj < 16; ++jj) {
        const int j = part * 16 + jj;
        float z = bias;
#pragma unroll
        for (int g = 0; g < 16; g += 4) { const f32x4 a = *(const f32x4*)(sga + j * 16 + g); z += a[0] * wc[g] + a[1] * wc[g + 1] + a[2] * wc[g + 2] + a[3] * wc[g + 3]; }
        const float ls = (fminf(z, 0.f) - log1pf(expf(-fabsf(z)))) * (1.0f / 16.0f);
        lv[jj] = ls; run += ls; c[jj] = run;
    }
    spart[part * 64 + d] = run;
    __syncthreads();
    float off = 0.f; T = 0.f;
#pragma unroll
    for (int pp = 0; pp < 4; ++pp) { const float v = spart[pp * 64 + d]; T += v; if (pp < part) off += v; }
#pragma unroll
    for (int jj = 0; jj < 16; ++jj) c[jj] = dir == 0 ? off + c[jj] : T - (off + c[jj]) + lv[jj];
}
__device__ __forceinline__ void gla_stage_vt(const Params& p, size_t row0, int hd, bf16_t* Vt) {
    const int tid = otid();
#pragma unroll
    for (int i = 0; i < 4; ++i) {
        const int id = tid + 256 * i, j = id >> 4, ech = id & 15;
        const u32x4 w = *(const u32x4*)(p.P + (row0 + j) * EV_IN + C_GV + hd * 128 + ech * 8);
#pragma unroll
        for (int e = 0; e < 4; ++e) { Vt[(ech * 8 + 2 * e) * GL_S + j] = (bf16_t)(w[e] & 0xffffu); Vt[(ech * 8 + 2 * e + 1) * GL_S + j] = (bf16_t)(w[e] >> 16); }
    }
}
__device__ __forceinline__ void ph_gla_a(const Params& p, unsigned char* smem) {
    bf16_t* kwT = (bf16_t*)smem; bf16_t* Vt = kwT + 64 * GL_S; float* sga = (float*)(Vt + 128 * GL_S); float* spart = sga + 1024;
    bf16_t* KS = (bf16_t*)p.G; float* DEC = (float*)(p.G + GLA_KS_BYTES);
    const int tid = otid(), lane = tid & 63, wid = tid >> 6, fr = lane & 15, fq = lane >> 4, d = tid & 63, part = tid >> 6;
    for (int u = blockIdx.x; u < NB * 4 * 68; u += gridDim.x) {
        const int b = u / 272, hd = (u / 68) & 3, ci = u % 68;
        const size_t row0 = (size_t)b * PB + ci * 64;
        __syncthreads();
        gla_stage_vt(p, row0, hd, Vt);
        for (int dir = 0; dir < 2; ++dir) {
            float c[16], T;
            gla_cum(p, row0, hd, dir, sga, spart, c, T);
            unsigned kw[8];
#pragma unroll
            for (int jj = 0; jj < 16; jj += 2) {
                const float k0 = bf2f(p.P[(row0 + part * 16 + jj) * EV_IN + C_GK + hd * 64 + d]), k1 = bf2f(p.P[(row0 + part * 16 + jj + 1) * EV_IN + C_GK + hd * 64 + d]);
                kw[jj >> 1] = pack2(k0 * expf(T - c[jj]), k1 * expf(T - c[jj + 1]));
            }
            *(u32x4*)(kwT + d * GL_S + part * 16) = (u32x4){kw[0], kw[1], kw[2], kw[3]};
            *(u32x4*)(kwT + d * GL_S + part * 16 + 8) = (u32x4){kw[4], kw[5], kw[6], kw[7]};
            if (part == 0) DEC[((size_t)u * 2 + dir) * 64 + d] = expf(T);
            __syncthreads();
            f32x4 acc[8];
#pragma unroll
            for (int et = 0; et < 8; ++et) acc[et] = (f32x4){0.f, 0.f, 0.f, 0.f};
#pragma unroll
            for (int s = 0; s < 2; ++s) {
                const bf16x8 a = *(const bf16x8*)(kwT + (16 * wid + fr) * GL_S + 32 * s + 8 * fq);
#pragma unroll
                for (int et = 0; et < 8; ++et) {
                    const bf16x8 bq = *(const bf16x8*)(Vt + (16 * et + fr) * GL_S + 32 * s + 8 * fq);
                    acc[et] = __builtin_amdgcn_mfma_f32_16x16x32_bf16(a, bq, acc[et], 0, 0, 0);
                }
            }
#pragma unroll
            for (int et = 0; et < 8; ++et)
                *(u32x2*)(KS + (((size_t)u * 2 + dir) * 128 + 16 * et + fr) * 64 + 16 * wid + 4 * fq) = (u32x2){pack2(acc[et][0], acc[et][1]), pack2(acc[et][2], acc[et][3])};
            __syncthreads();
        }
    }
}
__device__ __forceinline__ void ph_gla_b(const Params& p) {
    unsigned* KS32 = (unsigned*)p.G; const float* DEC = (const float*)(p.G + GLA_KS_BYTES);
    for (int gid = blockIdx.x * 256 + threadIdx.x; gid < 64 * 4096; gid += gridDim.x * 256) {
        const int seq = gid >> 12, pi = gid & 4095, dir = seq & 1, bh = seq >> 1, d = (2 * pi) & 63;
        float s0 = 0.f, s1 = 0.f;
#pragma unroll 4
        for (int step = 0; step < 68; ++step) {
            const int ci = dir == 0 ? step : (step < 4 ? 3 - step : 71 - step);
            const size_t ud = ((size_t)bh * 68 + ci) * 2 + dir;
            const unsigned w = KS32[ud * 4096 + pi];
            const float dc0 = DEC[ud * 64 + d], dc1 = DEC[ud * 64 + d + 1];
            KS32[ud * 4096 + pi] = pack2(s0, s1);
            s0 = dc0 * s0 + __uint_as_float(w << 16); s1 = dc1 * s1 + __uint_as_float(w & 0xffff0000u);
        }
    }
}
__device__ __forceinline__ void ph_gla_c(const Params& p, unsigned char* smem) {
    bf16_t* qs = (bf16_t*)smem; bf16_t* ks = qs + 64 * GL_S; bf16_t* Vt = ks + 64 * GL_S; float* sga = (float*)(Vt + 128 * GL_S); float* spart = sga + 1024;
    const bf16_t* KS = (const bf16_t*)p.G;
    const int tid = otid(), lane = tid & 63, wid = tid >> 6, fr = lane & 15, fq = lane >> 4, d = tid & 63, part = tid >> 6;
    for (int u = blockIdx.x; u < NB * 4 * 68; u += gridDim.x) {
        const int b = u / 272, hd = (u / 68) & 3, ci = u % 68;
        const size_t row0 = (size_t)b * PB + ci * 64;
        const int i = 16 * wid + fr;
        __syncthreads();
        gla_stage_vt(p, row0, hd, Vt);
        f32x4 oacc[8], pt[4];
#pragma unroll
        for (int et = 0; et < 8; ++et) oacc[et] = (f32x4){0.f, 0.f, 0.f, 0.f};
#pragma unroll
        for (int jt = 0; jt < 4; ++jt) pt[jt] = (f32x4){0.f, 0.f, 0.f, 0.f};
        for (int dir = 0; dir < 2; ++dir) {
            float c[16], T;
            gla_cum(p, row0, hd, dir, sga, spart, c, T);
#pragma unroll
            for (int jj = 0; jj < 16; ++jj) {
                const size_t ro = (row0 + part * 16 + jj) * EV_IN + hd * 64 + d;
                qs[(part * 16 + jj) * GL_S + d] = f2bf(bf2f(p.P[ro + C_GQ]) * 0.125f * expf(c[jj]));
                ks[(part * 16 + jj) * GL_S + d] = f2bf(bf2f(p.P[ro + C_GK]) * expf(-c[jj]));
            }
            __syncthreads();
            bf16x8 qf[2];
#pragma unroll
            for (int s = 0; s < 2; ++s) qf[s] = *(const bf16x8*)(qs + i * GL_S + 32 * s + 8 * fq);
#pragma unroll
            for (int jt = 0; jt < 4; ++jt) {
                f32x4 t = (f32x4){0.f, 0.f, 0.f, 0.f};
#pragma unroll
                for (int s = 0; s < 2; ++s) { const bf16x8 a = *(const bf16x8*)(ks + (16 * jt + fr) * GL_S + 32 * s + 8 * fq); t = __builtin_amdgcn_mfma_f32_16x16x32_bf16(a, qf[s], t, 0, 0, 0); }
#pragma unroll
                for (int rg = 0; rg < 4; ++rg) { const int j = 16 * jt + 4 * fq + rg; const bool keep = dir == 0 ? (j <= i) : (j >= i); pt[jt][rg] += keep ? t[rg] : 0.f; }
            }
            const bf16_t* Sg = KS + ((size_t)u * 2 + dir) * 8192;
#pragma unroll
            for (int et = 0; et < 8; ++et) {
#pragma unroll
                for (int s = 0; s < 2; ++s) { const bf16x8 a = *(const bf16x8*)(Sg + (16 * et + fr) * 64 + 32 * s + 8 * fq); oacc[et] = __builtin_amdgcn_mfma_f32_16x16x32_bf16(a, qf[s], oacc[et], 0, 0, 0); }
                if ((et & 3) == 3) __builtin_amdgcn_sched_barrier(0);
            }
            __syncthreads();
        }
#pragma unroll
        for (int k2 = 0; k2 < 2; ++k2) {
            const u32x4 pw = (u32x4){pack2(pt[2 * k2][0], pt[2 * k2][1]), pack2(pt[2 * k2][2], pt[2 * k2][3]), pack2(pt[2 * k2 + 1][0], pt[2 * k2 + 1][1]), pack2(pt[2 * k2 + 1][2], pt[2 * k2 + 1][3])};
            const bf16x8 pf = __builtin_bit_cast(bf16x8, pw);
#pragma unroll
            for (int et = 0; et < 8; ++et) {
                const bf16_t* vp = Vt + (16 * et + fr) * GL_S + 32 * k2 + 4 * fq;
                const u32x2 v0 = *(const u32x2*)vp, v1 = *(const u32x2*)(vp + 16);
                const bf16x8 vf = __builtin_bit_cast(bf16x8, (u32x4){v0[0], v0[1], v1[0], v1[1]});
                oacc[et] = __builtin_amdgcn_mfma_f32_16x16x32_bf16(vf, pf, oacc[et], 0, 0, 0);
            }
        }
        float ss = 0.f;
#pragma unroll
        for (int et = 0; et < 8; ++et) ss += oacc[et][0] * oacc[et][0] + oacc[et][1] * oacc[et][1] + oacc[et][2] * oacc[et][2] + oacc[et][3] * oacc[et][3];
        ss += __shfl_xor(ss, 16); ss += __shfl_xor(ss, 32);
        const float rs = rsqrtf(ss * (1.0f / 128.0f) + LN_EPS);
        const size_t r = row0 + i;
#pragma unroll
        for (int et = 0; et < 8; ++et) {
            const int e = 16 * et + 4 * fq;
            const u32x2 gw = *(const u32x2*)(p.P + r * EV_IN + C_GG + hd * 128 + e);
            const f32x4 nr = *(const f32x4*)(p.ev_gla_norm + hd * 128 + e);
            const float g0 = __uint_as_float(gw[0] << 16), g1 = __uint_as_float(gw[0] & 0xffff0000u), g2 = __uint_as_float(gw[1] << 16), g3 = __uint_as_float(gw[1] & 0xffff0000u);
            *(u32x2*)(p.A16 + r * D + 512 + hd * 128 + e) = (u32x2){pack2(oacc[et][0] * rs * nr[0] * silu_f(g0), oacc[et][1] * rs * nr[1] * silu_f(g1)),
                                                                   pack2(oacc[et][2] * rs * nr[2] * silu_f(g2), oacc[et][3] * rs * nr[3] * silu_f(g3))};
        }
    }
}

__device__ __forceinline__ void ph_ln_mod(const Params& p, int layer, int lnidx, int lat_only) {
    const int tid_ = otid(), wid = tid_ >> 6, lane = tid_ & 63;
    const int nrows = lat_only ? NB * SEQ : R;
    const float* g = p.ln_g + (size_t)(layer * 2 + lnidx) * D; const float* bb = p.ln_b + (size_t)(layer * 2 + lnidx) * D;
    for (int u = blockIdx.x; u < nrows / 4; u += gridDim.x) {
        const int rr = u * 4 + wid, r = lat_only ? (rr >> 12) * PB + CTX + (rr & 4095) : rr;
        float* hrow = p.H + (size_t)r * D;
        f32x4 v[4]; float s = 0.f;
#pragma unroll
        for (int q = 0; q < 4; ++q) { v[q] = *(const f32x4*)(hrow + q * 256 + lane * 4); s += v[q][0] + v[q][1] + v[q][2] + v[q][3]; }
        const float mu = wave_sum(s) * (1.0f / 1024.0f);
        float ss = 0.f;
#pragma unroll
        for (int q = 0; q < 4; ++q) { v[q] = v[q] - mu; ss += v[q][0] * v[q][0] + v[q][1] * v[q][1] + v[q][2] * v[q][2] + v[q][3] * v[q][3]; }
        const float rstd = rsqrtf(wave_sum(ss) * (1.0f / 1024.0f) + LN_EPS);
        const float* md = p.mod + ((size_t)layer * 9 + mod_row(r)) * 6144;
#pragma unroll
        for (int q = 0; q < 4; ++q) {
            const int c = q * 256 + lane * 4;
            const f32x4 h = v[q] * rstd * *(const f32x4*)(g + c) + *(const f32x4*)(bb + c);
            *(f32x4*)(hrow + c) = h;
            const f32x4 a = h * (1.0f + *(const f32x4*)(md + 4 * 1024 + c)) + *(const f32x4*)(md + 3 * 1024 + c);
            *(u32x2*)(p.A16 + (size_t)r * D + c) = (u32x2){pack2(a[0], a[1]), pack2(a[2], a[3])};
        }
    }
}

constexpr int SC_KS = 136;
__device__ __forceinline__ void ph_scores(const Params& p, int layer, int lat_only, unsigned char* smem) {
    bf16_t* ksl = (bf16_t*)smem;
    const bf16_t* QP = p.P; float* T = (float*)p.G;
    const int tid = otid(), lane = tid & 63, wid = tid >> 6, q = lane & 31, h = lane >> 5;
    const RowMap rm{lat_only};
    const int nunits = rm.ntiles() * 8;
    for (int u = blockIdx.x; u < nunits; u += gridDim.x) {
        const int tile = u >> 3, half = (u >> 2) & 1, hp = u & 3;
        const size_t r = (size_t)rm.row0(tile) + 32 * wid + q;
        __syncthreads();
        const bf16_t* kk = p.wt_k + ((size_t)layer * 2 + half) * 16384;
#pragma unroll
        for (int i = 0; i < 8; ++i) { const int id = tid + 256 * i, key = id >> 4, ch = id & 15; *(u32x4*)(ksl + key * SC_KS + ch * 8) = *(const u32x4*)(kk + key * 128 + ch * 8); }
        __syncthreads();
        for (int hh = 0; hh < 2; ++hh) {
            const int hd = hp * 2 + hh;
            bf16x8 qf[8];
#pragma unroll
            for (int s = 0; s < 8; ++s) qf[s] = *(const bf16x8*)(QP + r * 2048 + hd * 256 + half * 128 + 16 * s + 8 * h);
            float top[16];
#pragma unroll
            for (int t = 0; t < 16; ++t) top[t] = -3.0e38f;
#pragma unroll 1
            for (int kb = 0; kb < 4; ++kb) {
                f32x16 sa;
#pragma unroll
                for (int i = 0; i < 16; ++i) sa[i] = 0.f;
#pragma unroll
                for (int s = 0; s < 8; ++s) {
                    const bf16x8 kf = *(const bf16x8*)(ksl + (kb * 32 + q) * SC_KS + 16 * s + 8 * h);
                    sa = __builtin_amdgcn_mfma_f32_32x32x16_bf16(kf, qf[s], sa, 0, 0, 0);
                }
#pragma unroll
                for (int rg = 0; rg < 16; ++rg) {
                    const unsigned key = (unsigned)(kb * 32 + (rg & 3) + 8 * (rg >> 2) + 4 * h);
                    float xv = __uint_as_float((__float_as_uint(sa[rg]) & ~127u) | key);
#pragma unroll
                    for (int t = 0; t < 16; ++t) { const float hi = fmaxf(top[t], xv); xv = fminf(top[t], xv); top[t] = hi; }
                }
            }
            float mrg[8];
#pragma unroll
            for (int i = 0; i < 8; ++i) mrg[i] = fmaxf(top[i], __shfl_xor(top[15 - i], 32));
            float* dst = T + ((r * 8 + hd) * 2 + half) * 16 + 8 * h;
            *(f32x4*)dst = (f32x4){mrg[0], mrg[1], mrg[2], mrg[3]}; *(f32x4*)(dst + 4) = (f32x4){mrg[4], mrg[5], mrg[6], mrg[7]};
        }
    }
}

__device__ __forceinline__ void ph_combine(const Params& p, int lat_only) {
    const float* T = (const float*)p.G;
    int* EIDX = (int*)(p.G + (size_t)R * 8 * 2 * 16 * 4);
    float* EG = (float*)(p.G + (size_t)R * 8 * 2 * 16 * 4 + (size_t)R * 8 * 16 * 4);
    const int nrows = lat_only ? NB * SEQ : R;
    for (int g = blockIdx.x * 256 + threadIdx.x; g < nrows * 8; g += gridDim.x * 256) {
        const int rr = g >> 3, hd = g & 7, r = lat_only ? (rr >> 12) * PB + CTX + (rr & 4095) : rr;
        const float* t = T + ((size_t)r * 8 + hd) * 32;
        float t2[16];
#pragma unroll
        for (int i = 0; i < 16; ++i) t2[i] = __uint_as_float(__float_as_uint(t[16 + i]) & ~127u);
        float top[16];
#pragma unroll
        for (int k = 0; k < 16; ++k) top[k] = -3.0e38f;
        for (int i = 0; i < 16; ++i) {
            const float t1i = __uint_as_float(__float_as_uint(t[i]) & ~127u);
#pragma unroll
            for (int j = 0; j < 16; ++j) {
                float xv = __uint_as_float((__float_as_uint(t1i + t2[j]) & ~255u) | (unsigned)(i * 16 + j));
#pragma unroll
                for (int k = 0; k < 16; ++k) { const float hi = fmaxf(top[k], xv); xv = fminf(top[k], xv); top[k] = hi; }
            }
        }
        float e[16], sum = 0.f; const float mx = __uint_as_float(__float_as_uint(top[0]) & ~255u);
#pragma unroll
        for (int k = 0; k < 16; ++k) { e[k] = expf(__uint_as_float(__float_as_uint(top[k]) & ~255u) - mx); sum += e[k]; }
        const float inv = 1.0f / sum;
#pragma unroll
        for (int k = 0; k < 16; ++k) {
            const unsigned code = __float_as_uint(top[k]) & 255u, i = code >> 4, j = code & 15;
            const unsigned i1 = __float_as_uint(t[i]) & 127u, i2 = __float_as_uint(t[16 + j]) & 127u;
            EIDX[((size_t)r * 8 + hd) * 16 + k] = (int)(i1 * 128 + i2);
            EG[((size_t)r * 8 + hd) * 16 + k] = e[k] * inv;
        }
    }
}

__device__ __forceinline__ void ph_gather_ln(const Params& p, int layer, int lat_only) {
    const int tid_ = otid(), wid = tid_ >> 6, lane = tid_ & 63;
    const int* EIDX = (const int*)(p.G + (size_t)R * 8 * 2 * 16 * 4);
    const float* EG = (const float*)(p.G + (size_t)R * 8 * 2 * 16 * 4 + (size_t)R * 8 * 16 * 4);
    const float* U = p.peer_u + (size_t)layer * PEER_N * D; const float* V = p.peer_v + (size_t)layer * PEER_N * D;
    const float* g = p.ln_g + (size_t)(layer * 2 + 1) * D; const float* bb = p.ln_b + (size_t)(layer * 2 + 1) * D;
    const int nrows = lat_only ? NB * SEQ : R;
    for (int u = blockIdx.x; u < nrows / 4; u += gridDim.x) {
        const int rr = u * 4 + wid, r = lat_only ? (rr >> 12) * PB + CTX + (rr & 4095) : rr;
        f32x4 hm[4], acc[4];
#pragma unroll
        for (int q = 0; q < 4; ++q) {
            const u32x2 w = *(const u32x2*)(p.A16 + (size_t)r * D + q * 256 + lane * 4);
            hm[q] = (f32x4){__uint_as_float(w[0] << 16), __uint_as_float(w[0] & 0xffff0000u), __uint_as_float(w[1] << 16), __uint_as_float(w[1] & 0xffff0000u)};
            acc[q] = (f32x4){0.f, 0.f, 0.f, 0.f};
        }
        for (int e0 = 0; e0 < 128; e0 += 2) {
            const int ea = EIDX[(size_t)r * 128 + e0], eb = EIDX[(size_t)r * 128 + e0 + 1];
            const float ga = EG[(size_t)r * 128 + e0], gb = EG[(size_t)r * 128 + e0 + 1];
            f32x4 ua[4], ub[4];
#pragma unroll
            for (int q = 0; q < 4; ++q) { ua[q] = *(const f32x4*)(U + (size_t)ea * D + q * 256 + lane * 4); ub[q] = *(const f32x4*)(U + (size_t)eb * D + q * 256 + lane * 4); }
            float da = 0.f, db = 0.f;
#pragma unroll
            for (int q = 0; q < 4; ++q) { da += hm[q][0] * ua[q][0] + hm[q][1] * ua[q][1] + hm[q][2] * ua[q][2] + hm[q][3] * ua[q][3]; db += hm[q][0] * ub[q][0] + hm[q][1] * ub[q][1] + hm[q][2] * ub[q][2] + hm[q][3] * ub[q][3]; }
            da = wave_sum(da); db = wave_sum(db);
            const float wa = ga * gelu_f(da), wb = gb * gelu_f(db);
#pragma unroll
            for (int q = 0; q < 4; ++q) {
                acc[q] += wa * *(const f32x4*)(V + (size_t)ea * D + q * 256 + lane * 4);
                acc[q] += wb * *(const f32x4*)(V + (size_t)eb * D + q * 256 + lane * 4);
            }
        }
        const float* md = p.mod + ((size_t)layer * 9 + mod_row(r)) * 6144;
        float* hrow = p.H + (size_t)r * D;
        f32x4 v[4]; float s = 0.f;
#pragma unroll
        for (int q = 0; q < 4; ++q) { const int c = q * 256 + lane * 4; v[q] = ALPHA * *(const f32x4*)(hrow + c) + *(const f32x4*)(md + 5 * 1024 + c) * acc[q]; s += v[q][0] + v[q][1] + v[q][2] + v[q][3]; }
        const float mu = wave_sum(s) * (1.0f / 1024.0f);
        float ss = 0.f;
#pragma unroll
        for (int q = 0; q < 4; ++q) { v[q] = v[q] - mu; ss += v[q][0] * v[q][0] + v[q][1] * v[q][1] + v[q][2] * v[q][2] + v[q][3] * v[q][3]; }
        const float rstd = rsqrtf(wave_sum(ss) * (1.0f / 1024.0f) + LN_EPS);
        if (layer == 0) {
            const float* md1 = p.mod + ((size_t)1 * 9 + mod_row(r)) * 6144;
#pragma unroll
            for (int q = 0; q < 4; ++q) {
                const int c = q * 256 + lane * 4;
                const f32x4 h = v[q] * rstd * *(const f32x4*)(g + c) + *(const f32x4*)(bb + c);
                *(f32x4*)(hrow + c) = h;
                const f32x4 a = h * (1.0f + *(const f32x4*)(md1 + 1024 + c)) + *(const f32x4*)(md1 + c);
                *(u32x2*)(p.A16 + (size_t)r * D + c) = (u32x2){pack2(a[0], a[1]), pack2(a[2], a[3])};
            }
        } else {
            float* orow = p.out + (size_t)rr * D;
#pragma unroll
            for (int q = 0; q < 4; ++q) { const int c = q * 256 + lane * 4; *(f32x4*)(orow + c) = v[q] * rstd * *(const f32x4*)(g + c) + *(const f32x4*)(bb + c); }
        }
    }
}

__device__ __forceinline__ void ph_convert_uv(const Params& p, int layer) {
    const float* src0 = p.peer_u + (size_t)layer * PEER_N * D;
    const float* src1 = p.peer_v + (size_t)layer * PEER_N * D;
    const int n8 = PEER_N * D / 8;
    for (int i = blockIdx.x * 256 + threadIdx.x; i < n8; i += gridDim.x * 256) {
        const f32x4 a = *(const f32x4*)(src0 + (size_t)i * 8), b = *(const f32x4*)(src0 + (size_t)i * 8 + 4);
        *(u32x4*)(p.P + (size_t)i * 8) = (u32x4){pack2(a[0], a[1]), pack2(a[2], a[3]), pack2(b[0], b[1]), pack2(b[2], b[3])};
        const f32x4 c = *(const f32x4*)(src1 + (size_t)i * 8), d = *(const f32x4*)(src1 + (size_t)i * 8 + 4);
        *(u32x4*)(p.P + (size_t)PEER_N * D + (size_t)i * 8) = (u32x4){pack2(c[0], c[1]), pack2(c[2], c[3]), pack2(d[0], d[1]), pack2(d[2], d[3])};
    }
}

__device__ __forceinline__ void ph_gather_mfma(const Params& p, int layer, int lat_only, unsigned char* smem) {
    const int tid = otid(), wid = tid >> 6, lane = tid & 63, c = lane & 15, g = lane >> 4;
    bf16_t* hs = (bf16_t*)(smem + wid * 3072);
    int* se = (int*)(smem + wid * 3072 + 2048);
    float* sw = (float*)(smem + wid * 3072 + 2560);
    const int* EIDX = (const int*)(p.G + (size_t)R * 8 * 2 * 16 * 4);
    const float* EG = (const float*)(p.G + (size_t)R * 8 * 2 * 16 * 4 + (size_t)R * 8 * 16 * 4);
    const bf16_t* U = p.P; const bf16_t* V = p.P + (size_t)PEER_N * D;
    const float* gam = p.ln_g + (size_t)(layer * 2 + 1) * D; const float* bet = p.ln_b + (size_t)(layer * 2 + 1) * D;
    const int nrows = lat_only ? NB * SEQ : R;
    for (int u = blockIdx.x; u < nrows / 4; u += gridDim.x) {
        const int rr = u * 4 + wid, r = lat_only ? (rr >> 12) * PB + CTX + (rr & 4095) : rr;
        __syncthreads();
        *(u32x4*)(hs + lane * 8) = *(const u32x4*)(p.A16 + (size_t)r * D + lane * 8);
        *(u32x4*)(hs + 512 + lane * 8) = *(const u32x4*)(p.A16 + (size_t)r * D + 512 + lane * 8);
        se[lane] = EIDX[(size_t)r * 128 + lane]; se[64 + lane] = EIDX[(size_t)r * 128 + 64 + lane];
        sw[lane] = EG[(size_t)r * 128 + lane]; sw[64 + lane] = EG[(size_t)r * 128 + 64 + lane];
        __syncthreads();
        for (int hd = 0; hd < 8; ++hd) {
            f32x4 dacc = (f32x4){0.f, 0.f, 0.f, 0.f};
            const bf16_t* urow = U + (size_t)se[hd * 16 + c] * D + g * 8;
#pragma unroll 16
            for (int s = 0; s < 32; ++s) {
                const bf16x8 bq = *(const bf16x8*)(urow + s * 32);
                const bf16x8 aq = *(const bf16x8*)(hs + s * 32 + g * 8);
                dacc = __builtin_amdgcn_mfma_f32_16x16x32_bf16(aq, bq, dacc, 0, 0, 0);
            }
            const float wv = sw[hd * 16 + c] * gelu_f(dacc[0]);
            if (g == 0) sw[hd * 16 + c] = wv;
        }
        __syncthreads();
        f32x4 oacc[8];
#pragma unroll
        for (int blk = 0; blk < 8; ++blk) oacc[blk] = (f32x4){0.f, 0.f, 0.f, 0.f};
#pragma unroll 2
        for (int it = 0; it < 32; ++it) {
            const int e = se[4 * it + g];
            const float wv = sw[4 * it + g];
            const unsigned wb = (unsigned)f2bf(wv) << (16 * (c & 1));
            u32x4 aw;
#pragma unroll
            for (int q = 0; q < 4; ++q) aw[q] = (c < 8 && (c >> 1) == q) ? wb : 0u;
            const bf16x8 aq = __builtin_bit_cast(bf16x8, aw);
            const bf16_t* vrow = V + (size_t)e * D + c * 8;
#pragma unroll
            for (int blk = 0; blk < 8; ++blk) {
                const bf16x8 bq = *(const bf16x8*)(vrow + blk * 128);
                oacc[blk] = __builtin_amdgcn_mfma_f32_16x16x32_bf16(aq, bq, oacc[blk], 0, 0, 0);
            }
        }
        const float* md = p.mod + ((size_t)layer * 9 + mod_row(r)) * 6144;
        float* hrow = p.H + (size_t)r * D;
        const bool act = g < 2;
        f32x4 v[8]; float s = 0.f;
#pragma unroll
        for (int blk = 0; blk < 8; ++blk) {
            const int n = 128 * blk + 8 * c + 4 * (g & 1);
            v[blk] = ALPHA * *(const f32x4*)(hrow + n) + *(const f32x4*)(md + 5 * 1024 + n) * oacc[blk];
            if (!act) v[blk] = (f32x4){0.f, 0.f, 0.f, 0.f};
            s += v[blk][0] + v[blk][1] + v[blk][2] + v[blk][3];
        }
        const float mu = wave_sum(s) * (1.0f / 1024.0f);
        float ss = 0.f;
#pragma unroll
        for (int blk = 0; blk < 8; ++blk) { v[blk] = v[blk] - mu; if (act) ss += v[blk][0] * v[blk][0] + v[blk][1] * v[blk][1] + v[blk][2] * v[blk][2] + v[blk][3] * v[blk][3]; }
        const float rstd = rsqrtf(wave_sum(ss) * (1.0f / 1024.0f) + LN_EPS);
        if (act) {
            if (layer == 0) {
                const float* md1 = p.mod + ((size_t)1 * 9 + mod_row(r)) * 6144;
#pragma unroll
                for (int blk = 0; blk < 8; ++blk) {
                    const int n = 128 * blk + 8 * c + 4 * g;
                    const f32x4 h = v[blk] * rstd * *(const f32x4*)(gam + n) + *(const f32x4*)(bet + n);
                    *(f32x4*)(hrow + n) = h;
                    const f32x4 a = h * (1.0f + *(const f32x4*)(md1 + 1024 + n)) + *(const f32x4*)(md1 + n);
                    *(u32x2*)(p.A16 + (size_t)r * D + n) = (u32x2){pack2(a[0], a[1]), pack2(a[2], a[3])};
                }
            } else {
                float* orow = p.out + (size_t)rr * D;
#pragma unroll
                for (int blk = 0; blk < 8; ++blk) { const int n = 128 * blk + 8 * c + 4 * g; *(f32x4*)(orow + n) = v[blk] * rstd * *(const f32x4*)(gam + n) + *(const f32x4*)(bet + n); }
            }
        }
    }
}

constexpr int RG_ZS = 136;
constexpr size_t RG_SUM_BYTES = (size_t)NB * 34 * 2 * RGW * 2 * 4;
__device__ __forceinline__ void rg_stage_z(const Params& p, int b, int c34, int n, bf16_t* zc) {
    const int tid = otid(), k2 = tid & 63, tq = tid >> 6, ch = n * 128 + 2 * k2;
    const int lo = c34 < 2 ? 0 : CTX, hi = c34 < 2 ? CTX : PB, p0 = c34 * 128 + 32 * tq;
    float w0[4], w1[4];
#pragma unroll
    for (int tap = 0; tap < 4; ++tap) { w0[tap] = p.od_conv_w[tap * RGW + ch]; w1[tap] = p.od_conv_w[tap * RGW + ch + 1]; }
    const float b0 = p.od_conv_b[ch], b1 = p.od_conv_b[ch + 1];
    const bf16_t* base = p.P + (size_t)b * PB * 2560 + RGW + ch;
    auto ld = [&](int pp, float& a, float& c) { if (pp >= lo && pp < hi) { const unsigned w = *(const unsigned*)(base + (size_t)pp * 2560); a = __uint_as_float(w << 16); c = __uint_as_float(w & 0xffff0000u); } else { a = 0.f; c = 0.f; } };
    float am2, cm2, am1, cm1, a0, c0, ap1, cp1;
    ld(p0 - 2, am2, cm2); ld(p0 - 1, am1, cm1); ld(p0, a0, c0);
#pragma unroll 4
    for (int t = 0; t < 32; ++t) {
        ld(p0 + t + 1, ap1, cp1);
        const float y0 = b0 + w0[0] * am2 + w0[1] * am1 + w0[2] * a0 + w0[3] * ap1;
        const float y1 = b1 + w1[0] * cm2 + w1[1] * cm1 + w1[2] * c0 + w1[3] * cp1;
        *(unsigned*)(zc + (32 * tq + t) * RG_ZS + 2 * k2) = pack2(y0, y1);
        am2 = am1; cm2 = cm1; am1 = a0; cm1 = c0; a0 = ap1; c0 = cp1;
    }
}
__device__ __forceinline__ float gelu_fast(float v) {
    const float av = fabsf(v), t = __builtin_amdgcn_rcpf(av * 0.2316418882f + 1.0f);
    float q = t * 0.5307027145f + (-0.7265760135f); q = q * t + 0.7107068705f; q = q * t + (-0.142248368f); q = q * t + 0.127414796f; q = q * t;
    const float e = __builtin_amdgcn_exp2f(v * v * (-0.72134752044f));
    const float m = v * (q * e);
    return v < 0.f ? m : v - m;
}
struct RgCtx { bf16x8 wr[4], wi[4]; float br, bi, coef; };
__device__ __forceinline__ void rg_ctx_load(const Params& p, int n, int cl, int dir, RgCtx& c) {
    const int lane = otid() & 63, fr = lane & 15, fq = lane >> 4, ch = n * 128 + cl + fr;
    const bf16_t* gr = p.wt_gate + ((size_t)(dir * 2 + 0) * 10 + n) * 16384 + (size_t)(cl + fr) * 128 + 8 * fq;
    const bf16_t* gi = p.wt_gate + ((size_t)(dir * 2 + 1) * 10 + n) * 16384 + (size_t)(cl + fr) * 128 + 8 * fq;
#pragma unroll
    for (int s = 0; s < 4; ++s) { c.wr[s] = *(const bf16x8*)(gr + 32 * s); c.wi[s] = *(const bf16x8*)(gi + 32 * s); }
    c.br = p.od_gate_b[(dir * 2 + 0) * RGW + ch]; c.bi = p.od_gate_b[(dir * 2 + 1) * RGW + ch];
    const float lam = p.od_lambda[dir * RGW + ch];
    c.coef = -8.0f * (fmaxf(-lam, 0.f) + log1pf(expf(-fabsf(lam)))) * 1.4426950408889634f;
}
__device__ __forceinline__ void rg_tile(const bf16_t* zc, int mt, int cl, const RgCtx& c, f32x4& a4, f32x4& x4) {
    const int lane = otid() & 63, fr = lane & 15, fq = lane >> 4;
    f32x4 r = (f32x4){0.f, 0.f, 0.f, 0.f}, ig = (f32x4){0.f, 0.f, 0.f, 0.f};
#pragma unroll
    for (int s = 0; s < 4; ++s) {
        const bf16x8 a = *(const bf16x8*)(zc + (16 * mt + fr) * RG_ZS + 32 * s + 8 * fq);
        r = __builtin_amdgcn_mfma_f32_16x16x32_bf16(a, c.wr[s], r, 0, 0, 0);
        ig = __builtin_amdgcn_mfma_f32_16x16x32_bf16(a, c.wi[s], ig, 0, 0, 0);
    }
#pragma unroll
    for (int rg = 0; rg < 4; ++rg) {
        const float rr = __builtin_amdgcn_rcpf(1.0f + __builtin_amdgcn_exp2f(-1.4426950408889634f * (r[rg] + c.br)));
        const float ii = __builtin_amdgcn_rcpf(1.0f + __builtin_amdgcn_exp2f(-1.4426950408889634f * (ig[rg] + c.bi)));
        const float a = __builtin_amdgcn_exp2f(c.coef * rr);
        const float z = bf2f(zc[(16 * mt + 4 * fq + rg) * RG_ZS + cl + fr]);
        a4[rg] = a; x4[rg] = sqrtf((1.0f - a) * (1.0f + a)) * ii * z;
    }
}
template <int DIR> __device__ __forceinline__ void rg_sum_dir(const Params& p, const bf16_t* zc, int b, int c34, int n, int cl, float* SUM) {
    const int lane = otid() & 63, fr = lane & 15, fq = lane >> 4;
    RgCtx c; rg_ctx_load(p, n, cl, DIR, c);
    float h = 0.f, pt = 1.f;
#pragma unroll 2
    for (int m2 = 0; m2 < 8; ++m2) {
        const int mt = DIR == 0 ? m2 : 7 - m2;
        f32x4 a, x; rg_tile(zc, mt, cl, c, a, x);
        const float P4 = a[0] * a[1] * a[2] * a[3];
        const float B4 = DIR == 0 ? ((x[0] * a[1] + x[1]) * a[2] + x[2]) * a[3] + x[3] : ((x[3] * a[2] + x[2]) * a[1] + x[1]) * a[0] + x[0];
#pragma unroll
        for (int g2 = 0; g2 < 4; ++g2) {
            const int gs = DIR == 0 ? g2 : 3 - g2;
            const float Pg = __shfl(P4, 16 * gs + fr), Bg = __shfl(B4, 16 * gs + fr);
            h = Pg * h + Bg; pt *= Pg;
        }
    }
    if (fq == 0) { float* dst = SUM + ((((size_t)b * 34 + c34) * 2 + DIR) * RGW + n * 128 + cl + fr) * 2; dst[0] = pt; dst[1] = h; }
}
__device__ __forceinline__ void ph_rg_a(const Params& p, unsigned char* smem) {
    bf16_t* zc = (bf16_t*)smem;
    float* SUM = (float*)p.G;
    const int wid = otid() >> 6;
    for (int u = blockIdx.x; u < NB * 34 * 10; u += gridDim.x) {
        const int b = u / 340, c34 = (u / 10) % 34, n = u % 10;
        __syncthreads();
        rg_stage_z(p, b, c34, n, zc);
        __syncthreads();
        for (int nt = 0; nt < 2; ++nt) {
            const int cl = 32 * wid + 16 * nt;
            rg_sum_dir<0>(p, zc, b, c34, n, cl, SUM);
            rg_sum_dir<1>(p, zc, b, c34, n, cl, SUM);
        }
    }
}
__device__ __forceinline__ void ph_rg_b(const Params& p) {
    const float* SUM = (const float*)p.G; float* HIN = (float*)(p.G + RG_SUM_BYTES);
    for (int gid = blockIdx.x * 256 + threadIdx.x; gid < NB * 2 * RGW; gid += gridDim.x * 256) {
        const int ch = gid % RGW, dir = (gid / RGW) & 1, b = gid / (2 * RGW);
        float h = 0.f;
#pragma unroll 2
        for (int step = 0; step < 34; ++step) {
            const int c34 = dir == 0 ? step : (step < 2 ? 1 - step : 35 - step);
            const size_t o = (((size_t)b * 34 + c34) * 2 + dir) * RGW + ch;
            HIN[o] = h;
            h = SUM[o * 2] * h + SUM[o * 2 + 1];
        }
    }
}
template <int DIR> __device__ __forceinline__ void rg_apply_dir(const Params& p, const bf16_t* zc, bf16_t* yf, int b, int c34, int n, int cl, const float* HIN) {
    const int lane = otid() & 63, fr = lane & 15, fq = lane >> 4, ch = n * 128 + cl + fr;
    RgCtx c; rg_ctx_load(p, n, cl, DIR, c);
    float h = HIN[(((size_t)b * 34 + c34) * 2 + DIR) * RGW + ch];
#pragma unroll 2
    for (int m2 = 0; m2 < 8; ++m2) {
        const int mt = DIR == 0 ? m2 : 7 - m2;
        f32x4 a, x; rg_tile(zc, mt, cl, c, a, x);
        const float P4 = a[0] * a[1] * a[2] * a[3];
        const float B4 = DIR == 0 ? ((x[0] * a[1] + x[1]) * a[2] + x[2]) * a[3] + x[3] : ((x[3] * a[2] + x[2]) * a[1] + x[1]) * a[0] + x[0];
        float hin = 0.f;
#pragma unroll
        for (int g2 = 0; g2 < 4; ++g2) {
            const int gs = DIR == 0 ? g2 : 3 - g2;
            const float Pg = __shfl(P4, 16 * gs + fr), Bg = __shfl(B4, 16 * gs + fr);
            if (fq == gs) hin = h;
            h = Pg * h + Bg;
        }
        f32x4 y;
        if (DIR == 0) {
            y[0] = a[0] * hin + x[0]; y[1] = a[1] * y[0] + x[1]; y[2] = a[2] * y[1] + x[2]; y[3] = a[3] * y[2] + x[3];
#pragma unroll
            for (int rg = 0; rg < 4; ++rg) yf[(16 * mt + 4 * fq + rg) * 16 + fr] = f2bf(y[rg]);
        } else {
            y[3] = a[3] * hin + x[3]; y[2] = a[2] * y[3] + x[2]; y[1] = a[1] * y[2] + x[1]; y[0] = a[0] * y[1] + x[0];
#pragma unroll
            for (int rg = 0; rg < 4; ++rg) {
                bf16_t* pb = p.P + ((size_t)b * PB + c34 * 128 + 16 * mt + 4 * fq + rg) * 2560 + ch;
                *pb = f2bf(gelu_fast(bf2f(*pb)) * (y[rg] + bf2f(yf[(16 * mt + 4 * fq + rg) * 16 + fr])));
            }
        }
    }
}
__device__ __forceinline__ void ph_rg_c(const Params& p, unsigned char* smem) {
    bf16_t* zc = (bf16_t*)smem;
    const float* HIN = (const float*)(p.G + RG_SUM_BYTES);
    const int wid = otid() >> 6;
    bf16_t* yf = (bf16_t*)(smem + 128 * RG_ZS * 2) + wid * 2048;
    for (int u = blockIdx.x; u < NB * 32 * 10; u += gridDim.x) {
        const int b = u / 320, c34 = 2 + (u / 10) % 32, n = u % 10;
        __syncthreads();
        rg_stage_z(p, b, c34, n, zc);
        __syncthreads();
        for (int nt = 0; nt < 2; ++nt) {
            const int cl = 32 * wid + 16 * nt;
            rg_apply_dir<0>(p, zc, yf, b, c34, n, cl, HIN);
            rg_apply_dir<1>(p, zc, yf, b, c34, n, cl, HIN);
        }
    }
}

#define XB_TMO      128
#define XB_XCNT(j)  (256  + 64 * (j))
#define XB_XSUB(j)  (1280 + 64 * (j))
#define XB_XGEN(j)  (2304 + 64 * (j))
#define XB_TOP      3328
#define XB_TOPGEN   3392
#define XCD_BAR_WORDS 3456
#define XB_SPIN_CAP (1u << 22)
#define LAS __attribute__((address_space(3)))
__device__ __forceinline__ unsigned xb_ld(unsigned* p) { return __hip_atomic_load(p, __ATOMIC_RELAXED, __HIP_MEMORY_SCOPE_AGENT); }
__device__ __forceinline__ unsigned xb_add(unsigned* p, unsigned v) { return __hip_atomic_fetch_add(p, v, __ATOMIC_RELAXED, __HIP_MEMORY_SCOPE_AGENT); }
__device__ __forceinline__ unsigned xb_xcc_id() { return (unsigned)__builtin_amdgcn_s_getreg((3 << 11) | 20) & 0xFu; }
#define XB_SPIN(cond, bar) do { unsigned _sp = 0; while (cond) { __builtin_amdgcn_s_sleep(1); \
    if ((++_sp & 255u) == 0u) { if (xb_ld(&(bar)[XB_TMO])) break; if (_sp > XB_SPIN_CAP) { atomicAdd(&(bar)[XB_TMO], 1u); break; } } } } while (0)
struct XcdBarrier { unsigned* bar; unsigned x; volatile LAS unsigned* st; };
__device__ __forceinline__ XcdBarrier xcd_barrier_post(unsigned* bar, volatile LAS unsigned* st) {
    XcdBarrier b; b.bar = bar; b.x = xb_xcc_id(); b.st = st;
    if (threadIdx.x == 0) (void)xb_add(&bar[XB_XCNT(b.x)], 1u);
    return b;
}
__device__ __forceinline__ void xcd_barrier_complete(unsigned* bar, unsigned x, unsigned& nloc, unsigned& nx) {
    const unsigned G = gridDim.x * gridDim.y * gridDim.z;
    unsigned sum, cnt, mine, sp = 0u;
    for (;;) {
        sum = 0u; cnt = 0u; mine = 0u;
#pragma unroll
        for (unsigned j = 0; j < 16; ++j) { const unsigned c = xb_ld(&bar[XB_XCNT(j)]); sum += c; cnt += (c > 0u) ? 1u : 0u; mine = (j == x) ? c : mine; }
        if (sum == G) break;
        __builtin_amdgcn_s_sleep(1);
        if ((++sp & 255u) == 0u) { if (xb_ld(&bar[XB_TMO])) break; if (sp > XB_SPIN_CAP) { atomicAdd(&bar[XB_TMO], 1u); break; } }
    }
    nloc = mine > 0u ? mine : 1u; nx = cnt > 0u ? cnt : 1u;
}
__device__ __forceinline__ void xcd_barrier(const XcdBarrier& b) {
    asm volatile("s_waitcnt vmcnt(0)" ::: "memory");
    __syncthreads();
    if (threadIdx.x == 0) {
        unsigned* bar = b.bar;
        __builtin_amdgcn_s_waitcnt(0);
        unsigned nloc = b.st[0], nx = b.st[1];
        if (nloc == 0u) { xcd_barrier_complete(bar, b.x, nloc, nx); b.st[0] = nloc; b.st[1] = nx; }
        const unsigned old = xb_add(&bar[XB_XSUB(b.x)], 1u);
        const unsigned gen = old / nloc;
        if (old + 1u == (gen + 1u) * nloc) {
            __builtin_amdgcn_fence(__ATOMIC_RELEASE, "agent");
            asm volatile("s_waitcnt vmcnt(0)" ::: "memory");
            const unsigned og = xb_add(&bar[XB_TOP], 1u);
            const unsigned tg = og / nx;
            if (og + 1u == (tg + 1u) * nx) xb_add(&bar[XB_TOPGEN], 1u);
            else XB_SPIN(xb_ld(&bar[XB_TOPGEN]) == tg, bar);
            __builtin_amdgcn_fence(__ATOMIC_ACQUIRE, "agent");
            xb_add(&bar[XB_XGEN(b.x)], 1u);
            asm volatile("s_waitcnt vmcnt(0)" ::: "memory");
        } else {
            XB_SPIN(xb_ld(&bar[XB_XGEN(b.x)]) == gen, bar);
            __builtin_amdgcn_fence(__ATOMIC_ACQUIRE, "agent");
            asm volatile("s_waitcnt vmcnt(0)" ::: "memory");
        }
    }
    __syncthreads();
}

#define SMEM_DECL __shared__ __attribute__((aligned(16))) unsigned char smem[65536]
__global__ void __launch_bounds__(256) k_prologue(Params p) { SMEM_DECL; ph_prologue(p, smem); }
__global__ void __launch_bounds__(256) k_modulate0(Params p) { ph_modulate0(p); }
__global__ void __launch_bounds__(256) k_gemm_ev_in(Params p) { SMEM_DECL; gemm_phase(p.A16, D, p.wt_ev_in, 1024, EV_IN, RowMap{0}, EpiBf16{p.P, EV_IN, EV_IN}, smem); }
__global__ void __launch_bounds__(256) k_rowpost(Params p) { ph_rowpost(p); }
__global__ void __launch_bounds__(256) k_gemm_q(Params p) { SMEM_DECL; gemm_phase(p.P + C_CQ, EV_IN, p.wt_uq, 384, 768, RowMap{0}, EpiQ{p.Q16, p.rsq, p.rope_cos, p.rope_sin}, smem); }
__global__ void __launch_bounds__(256) k_gemm_kv(Params p) { SMEM_DECL; gemm_phase(p.P + C_CKV, EV_IN, p.wt_ukv, 256, 1024, RowMap{0}, EpiKV{p.K16, p.V16, p.rsq + R}, smem); }
__global__ void __launch_bounds__(256) k_gemm_ev_out(Params p) { SMEM_DECL; gemm_phase(p.A16, D, p.wt_ev_out, 1024, 1024, RowMap{0}, EpiResid{p.x, p.ctx, p.mod, p.H, 0}, smem); }
__global__ void __launch_bounds__(256) k_ln_mod(Params p, int layer, int lat_only) { ph_ln_mod(p, layer, 0, lat_only); }
__global__ void __launch_bounds__(256) k_gemm_pq(Params p, int layer, int lat_only) { SMEM_DECL; gemm_phase(p.A16, D, p.wt_pq + (size_t)layer * 2048 * 1024, 1024, 2048, RowMap{lat_only}, EpiBf16{p.P, 2048, 2048}, smem); }
__global__ void __launch_bounds__(256) k_combine(Params p, int lat_only) { ph_combine(p, lat_only); }
__global__ void __launch_bounds__(256) k_gather(Params p, int layer, int lat_only) { ph_gather_ln(p, layer, lat_only); }
__global__ void __launch_bounds__(256) k_gemm_od_in(Params p) { SMEM_DECL; gemm_phase(p.A16, D, p.wt_od_in, 1024, 2560, RowMap{0}, EpiBf16{p.P, 2560, 2560}, smem); }
__global__ void __launch_bounds__(256) k_gemm_od_out(Params p) { SMEM_DECL; gemm_phase(p.P, 2560, p.wt_od_out, 1280, 1024, RowMap{1}, EpiResid{p.x, p.ctx, p.mod, p.H, 1}, smem); }

__global__ void __launch_bounds__(256, 2) k_mega(Params p) {
    SMEM_DECL;
    cg::grid_group grid = cg::this_grid();
    volatile LAS unsigned* xst = (volatile LAS unsigned*)(LAS unsigned char*)(smem + 65520);
    if (threadIdx.x == 0) { xst[0] = 0u; xst[1] = 0u; }
    if (blockIdx.x == 0) for (int i = threadIdx.x; i < XCD_BAR_WORDS; i += 256) p.bar[i] = 0u;
    ph_prologue(p, smem); grid.sync();
    const XcdBarrier xb = xcd_barrier_post(p.bar, xst);
    ph_modulate0(p); xcd_barrier(xb);
    gemm_phase(p.A16, D, p.wt_ev_in, 1024, EV_IN, RowMap{0}, EpiBf16{p.P, EV_IN, EV_IN}, smem); xcd_barrier(xb);
    ph_rowpost(p); ph_gla_a(p, smem); xcd_barrier(xb);
    gemm_phase(p.P + C_CQ, EV_IN, p.wt_uq, 384, 768, RowMap{0}, EpiQ{p.Q16, p.rsq, p.rope_cos, p.rope_sin}, smem);
    gemm_phase(p.P + C_CKV, EV_IN, p.wt_ukv, 256, 1024, RowMap{0}, EpiKV{p.K16, p.V16, p.rsq + R}, smem); ph_gla_b(p); xcd_barrier(xb);
    ph_gla_c(p, smem); ph_attn(p, smem, blockIdx.x, gridDim.x); xcd_barrier(xb);
    gemm_phase(p.A16, D, p.wt_ev_out, 1024, 1024, RowMap{0}, EpiResid{p.x, p.ctx, p.mod, p.H, 0}, smem); xcd_barrier(xb);
    ph_ln_mod(p, 0, 0, 0); xcd_barrier(xb);
    gemm_phase(p.A16, D, p.wt_pq, 1024, 2048, RowMap{0}, EpiBf16{p.P, 2048, 2048}, smem); xcd_barrier(xb);
    ph_scores(p, 0, 0, smem); xcd_barrier(xb);
    ph_combine(p, 0); ph_convert_uv(p, 0); xcd_barrier(xb);
    ph_gather_mfma(p, 0, 0, smem); xcd_barrier(xb);
    gemm_phase(p.A16, D, p.wt_od_in, 1024, 2560, RowMap{0}, EpiBf16{p.P, 2560, 2560}, smem); xcd_barrier(xb);
    ph_rg_a(p, smem); xcd_barrier(xb);
    ph_rg_b(p); xcd_barrier(xb);
    ph_rg_c(p, smem); xcd_barrier(xb);
    gemm_phase(p.P, 2560, p.wt_od_out, 1280, 1024, RowMap{1}, EpiResid{p.x, p.ctx, p.mod, p.H, 1}, smem); xcd_barrier(xb);
    ph_ln_mod(p, 1, 0, 1); xcd_barrier(xb);
    gemm_phase(p.A16, D, p.wt_pq + (size_t)2048 * 1024, 1024, 2048, RowMap{1}, EpiBf16{p.P, 2048, 2048}, smem); xcd_barrier(xb);
    ph_scores(p, 1, 1, smem); xcd_barrier(xb);
    ph_combine(p, 1); ph_convert_uv(p, 1); xcd_barrier(xb);
    ph_gather_mfma(p, 1, 1, smem);
}

extern "C" void kernel_launch(void* const* d_in, const int* in_sizes, int n_in, void* d_out, int out_size, void* d_ws, size_t ws_size, hipStream_t stream) {
    Params p{};
    const float** f = (const float**)d_in;
    p.x = f[0]; p.c = f[1]; p.ctx = f[2]; p.c_ctx = f[3]; p.mod_w = f[4]; p.mod_b = f[5]; p.ln_g = f[6]; p.ln_b = f[7];
    p.ev_w_in = f[8]; p.ev_q_norm = f[9]; p.ev_kv_norm = f[10]; p.ev_w_uq = f[11]; p.ev_w_ukv = f[12]; p.ev_gla_wa2 = f[13]; p.ev_gla_ba = f[14]; p.ev_gla_norm = f[15]; p.ev_w_out = f[16];
    p.od_w_in = f[17]; p.od_conv_w = f[18]; p.od_conv_b = f[19]; p.od_gate_w = f[20]; p.od_gate_b = f[21]; p.od_lambda = f[22]; p.od_w_out = f[23];
    p.peer_wq = f[24]; p.peer_k1 = f[25]; p.peer_k2 = f[26]; p.peer_u = f[27]; p.peer_v = f[28];
    p.out = (float*)d_out;
    unsigned char* w = (unsigned char*)d_ws; size_t off = 0;
    auto take = [&](size_t bytes) { unsigned char* r = w + off; off += (bytes + 255) & ~(size_t)255; return r; };
    p.wt_ev_in = (bf16_t*)take((size_t)EV_IN * 1024 * 2); p.wt_uq = (bf16_t*)take(768 * 384 * 2); p.wt_ukv = (bf16_t*)take(1024 * 256 * 2);
    p.wt_ev_out = (bf16_t*)take(1024 * 1024 * 2); p.wt_od_in = (bf16_t*)take(2560 * 1024 * 2); p.wt_gate = (bf16_t*)take(40 * 16384 * 2);
    p.wt_od_out = (bf16_t*)take(1024 * 1280 * 2); p.wt_pq = (bf16_t*)take((size_t)2 * 2048 * 1024 * 2); p.wt_k = (bf16_t*)take(4 * 16384 * 2);
    p.mod = (float*)take(2 * 9 * 6144 * 4); p.rope_cos = (float*)take(SEQ * 16 * 4); p.rope_sin = (float*)take(SEQ * 16 * 4); p.rsq = (float*)take((size_t)2 * R * 4);
    p.H = (float*)take((size_t)R * D * 4);
    p.Q16 = (bf16_t*)p.H; p.K16 = p.Q16 + (size_t)R * 768; p.V16 = p.K16 + (size_t)R * 768;
    p.A16 = (bf16_t*)take((size_t)R * D * 2);
    p.P = (bf16_t*)take((size_t)R * 2560 * 2);
    p.G = take((size_t)94371840);
    p.bar = (unsigned*)take(XCD_BAR_WORDS * 4);
    if (off > ws_size) { fprintf(stderr, "workspace too small: need %zu have %zu\n", off, ws_size); return; }
    static int grid_blocks = 0;
    if (!grid_blocks) {
        int dev = 0, cus = 0, per_cu = 0;
        (void)hipGetDevice(&dev);
        (void)hipDeviceGetAttribute(&cus, hipDeviceAttributeMultiprocessorCount, dev);
        (void)hipOccupancyMaxActiveBlocksPerMultiprocessor(&per_cu, k_mega, 256, 0);
        if (per_cu > 2) per_cu = 2;
        if (per_cu < 1) per_cu = 1;
        grid_blocks = cus * per_cu;
    }
    void* args[] = {&p};
    hipError_t e = hipLaunchCooperativeKernel((void*)k_mega, dim3(grid_blocks), dim3(256), args, 0, stream);
    if (e != hipSuccess) fprintf(stderr, "cooperative launch failed: %s (grid %d)\n", hipGetErrorString(e), grid_blocks);
}
__global__ void __launch_bounds__(256) k_gather2(Params p, int layer, int lat_only) { SMEM_DECL; ph_gather_mfma(p, layer, lat_only, smem); }
__global__ void __launch_bounds__(256) k_rga(Params p) { SMEM_DECL; ph_rg_a(p, smem); }
__global__ void __launch_bounds__(256) k_rgc(Params p) { SMEM_DECL; ph_rg_c(p, smem); }
__global__ void __launch_bounds__(256) k_glaa(Params p) { SMEM_DECL; ph_gla_a(p, smem); }
__global__ void __launch_bounds__(256) k_glac(Params p) { SMEM_DECL; ph_gla_c(p, smem); }
__global__ void __launch_bounds__(256) k_attn2(Params p) { SMEM_DECL; ph_attn(p, smem, blockIdx.x, gridDim.x); }
```

```cpp
#include <hip/hip_runtime.h>
#include <hip/hip_cooperative_groups.h>
#include <cstdio>
#include <cstdint>

namespace cg = cooperative_groups;
typedef unsigned short bf16_t;
typedef short bf16x8 __attribute__((ext_vector_type(8)));
typedef float f32x4 __attribute__((ext_vector_type(4)));
typedef float f32x16 __attribute__((ext_vector_type(16)));
typedef unsigned u32x4 __attribute__((ext_vector_type(4)));
typedef unsigned u32x2 __attribute__((ext_vector_type(2)));

constexpr int D = 1024, NB = 8, SEQ = 4096, CTX = 256, PB = SEQ + CTX  , R = NB * PB  ;
constexpr int EV_IN = 2240, RGW = 1280;
constexpr int C_CQ = 0, C_CKV = 384, C_KPE = 640, C_GQ = 672, C_GK = 928, C_GV = 1184, C_GG = 1696, C_GAF = 2208;
constexpr float LN_EPS = 1e-6f, ALPHA = 1.41421356237f, MLA_SCALE = 0.10206207261596577f  ;
constexpr int PEER_N = 16384;

struct Params {
    const float *x, *c, *ctx, *c_ctx, *mod_w, *mod_b, *ln_g, *ln_b;
    const float *ev_w_in, *ev_q_norm, *ev_kv_norm, *ev_w_uq, *ev_w_ukv, *ev_gla_wa2, *ev_gla_ba, *ev_gla_norm, *ev_w_out;
    const float *od_w_in, *od_conv_w, *od_conv_b, *od_gate_w, *od_gate_b, *od_lambda, *od_w_out;
    const float *peer_wq, *peer_k1, *peer_k2, *peer_u, *peer_v;
    float* out;
    bf16_t *wt_ev_in, *wt_uq, *wt_ukv, *wt_ev_out, *wt_od_in, *wt_gate, *wt_od_out, *wt_pq, *wt_k;
    float *mod, *rope_cos, *rope_sin, *rsq;
    float* H; bf16_t *Q16, *K16, *V16;
    bf16_t* A16; bf16_t* P; unsigned char* G;
    unsigned* bar;
};

__device__ __forceinline__ bf16_t f2bf(float f) { unsigned u = __float_as_uint(f); u += 0x7fffu + ((u >> 16) & 1u); return (bf16_t)(u >> 16); }
__device__ __forceinline__ float bf2f(bf16_t h) { return __uint_as_float(((unsigned)h) << 16); }
__device__ __forceinline__ unsigned pack2(float a, float b) { unsigned r; asm volatile("v_cvt_pk_bf16_f32 %0, %1, %2" : "=v"(r) : "v"(a), "v"(b)); return r; }
__device__ __forceinline__ float silu_f(float x) { return x / (1.0f + expf(-x)); }
__device__ __forceinline__ float sigmoid_f(float x) { return 1.0f / (1.0f + expf(-x)); }
__device__ __forceinline__ float gelu_f(float x) { return 0.5f * x * (1.0f + erff(x * 0.70710678118654752f)); }
__device__ __forceinline__ float wave_sum(float v) {
#pragma unroll
    for (int o = 32; o > 0; o >>= 1) v += __shfl_xor(v, o);
    return v;
}
__device__ __forceinline__ int otid() { int t = threadIdx.x; asm volatile("" : "+v"(t)); return t; }
__device__ __forceinline__ int mod_row(int r) { const int b = r / PB, p = r - b * PB; return p < CTX ? 8 : b; }
__device__ __forceinline__ const float* in_row(const Params& P_, int r) {
    const int b = r / PB, p = r - b * PB;
    return p < CTX ? P_.ctx + ((size_t)b * CTX + p) * D : P_.x + ((size_t)b * SEQ + (p - CTX)) * D;
}

__device__ __forceinline__ void tconv_tile(const float* __restrict__ W, int K, int N, bf16_t* __restrict__ Wt, const float* __restrict__ rowscale, int tile, float* sm) {
    const int ntn = N / 64, tk = tile / ntn, tn = tile % ntn, tid = threadIdx.x;
#pragma unroll
    for (int i = 0; i < 4; ++i) {
        const int k = (tid >> 4) + 16 * i;
        f32x4 v = *(const f32x4*)(W + (size_t)(tk * 64 + k) * N + tn * 64 + (tid & 15) * 4);
        const float s = rowscale ? rowscale[tk * 64 + k] : 1.0f;
#pragma unroll
        for (int q = 0; q < 4; ++q) sm[k * 65 + (tid & 15) * 4 + q] = v[q] * s;
    }
    __syncthreads();
    const int n = tid >> 2, kc = tid & 3;
    unsigned w[8];
#pragma unroll
    for (int kk = 0; kk < 8; ++kk) w[kk] = pack2(sm[(kc * 16 + 2 * kk) * 65 + n], sm[(kc * 16 + 2 * kk + 1) * 65 + n]);
    bf16_t* dst = Wt + (size_t)(tn * 64 + n) * K + tk * 64 + kc * 16;
    *(u32x4*)dst = (u32x4){w[0], w[1], w[2], w[3]};
    *(u32x4*)(dst + 8) = (u32x4){w[4], w[5], w[6], w[7]};
    __syncthreads();
}
__device__ __forceinline__ void tconv_all(const float* W, int K, int N, bf16_t* Wt, const float* rowscale, float* sm) {
    const int nt = (K / 64) * (N / 64);
    for (int t = blockIdx.x; t < nt; t += gridDim.x) tconv_tile(W, K, N, Wt, rowscale, t, sm);
}

__device__ __forceinline__ void ph_prologue(const Params& p, unsigned char* smem) {
    float* sm = (float*)smem;
    tconv_all(p.ev_w_in, 1024, EV_IN, p.wt_ev_in, nullptr, sm);
    tconv_all(p.ev_w_uq, 384, 768, p.wt_uq, p.ev_q_norm, sm);
    tconv_all(p.ev_w_ukv, 256, 1024, p.wt_ukv, p.ev_kv_norm, sm);
    tconv_all(p.ev_w_out, 1024, 1024, p.wt_ev_out, nullptr, sm);
    tconv_all(p.od_w_in, 1024, 2560, p.wt_od_in, nullptr, sm);
    for (int g = 0; g < 40; ++g) tconv_all(p.od_gate_w + (size_t)g * 16384, 128, 128, p.wt_gate + (size_t)g * 16384, nullptr, sm);
    tconv_all(p.od_w_out, 1280, 1024, p.wt_od_out, nullptr, sm);
    for (int l = 0; l < 2; ++l) tconv_all(p.peer_wq + (size_t)l * 1024 * 2048, 1024, 2048, p.wt_pq + (size_t)l * 1024 * 2048, nullptr, sm);
    for (int i = blockIdx.x * 256 + threadIdx.x; i < 2 * 2 * 16384; i += gridDim.x * 256) {
        const int l = i / 32768, h = (i / 16384) & 1, e = i & 16383;
        p.wt_k[i] = f2bf((h ? p.peer_k2 : p.peer_k1)[(size_t)l * 16384 + e]);
    }
    for (int i = blockIdx.x * 256 + threadIdx.x; i < SEQ * 16; i += gridDim.x * 256) {
        const int s = i >> 4, f = i & 15;
        const float pos = (float)(f < 8 ? (s >> 6) : (s & 63));
        const float inv = powf(10000.0f, -(float)(f & 7) / 8.0f);
        const float ang = pos * inv;
        p.rope_cos[i] = cosf(ang); p.rope_sin[i] = sinf(ang);
    }
    float* sc = sm;
    for (int u = blockIdx.x; u < 2 * 96; u += gridDim.x) {
        const int l = u / 96, c0 = (u % 96) * 64, tid = threadIdx.x;
        __syncthreads();
        for (int i = tid; i < 9 * 1024; i += 256) { const int rr = i >> 10, k = i & 1023; sc[i] = silu_f(rr < 8 ? p.c[rr * 1024 + k] : p.c_ctx[k]); }
        __syncthreads();
        const int col = c0 + (tid & 63), kq = tid >> 6;
        float acc[9];
#pragma unroll
        for (int rr = 0; rr < 9; ++rr) acc[rr] = 0.f;
        const float* w = p.mod_w + (size_t)l * 1024 * 6144 + col;
        for (int k = kq * 256; k < kq * 256 + 256; ++k) {
            const float wv = w[(size_t)k * 6144];
#pragma unroll
            for (int rr = 0; rr < 9; ++rr) acc[rr] += sc[rr * 1024 + k] * wv;
        }
        __syncthreads();
        float* red = sm + 9 * 1024;
#pragma unroll
        for (int rr = 0; rr < 9; ++rr) red[(kq * 9 + rr) * 64 + (tid & 63)] = acc[rr];
        __syncthreads();
        for (int i = tid; i < 9 * 64; i += 256) {
            const int rr = i >> 6, cc = i & 63;
            const float s = red[(0 * 9 + rr) * 64 + cc] + red[(1 * 9 + rr) * 64 + cc] + red[(2 * 9 + rr) * 64 + cc] + red[(3 * 9 + rr) * 64 + cc];
            p.mod[((size_t)l * 9 + rr) * 6144 + c0 + cc] = s + p.mod_b[l * 6144 + c0 + cc];
        }
    }
}

__device__ __forceinline__ void ph_modulate0(const Params& p) {
    const int tid_ = otid(), wid = tid_ >> 6, lane = tid_ & 63;
    for (int u = blockIdx.x; u < R / 4; u += gridDim.x) {
        const int r = u * 4 + wid;
        const float* src = in_row(p, r);
        const float* md = p.mod + (size_t)(0 * 9 + mod_row(r)) * 6144;
#pragma unroll
        for (int q = 0; q < 4; ++q) {
            const int c = q * 256 + lane * 4;
            const f32x4 h = *(const f32x4*)(src + c), sh = *(const f32x4*)(md + c), scl = *(const f32x4*)(md + 1024 + c);
            const f32x4 v = h * (1.0f + scl) + sh;
            *(u32x2*)(p.A16 + (size_t)r * D + c) = (u32x2){pack2(v[0], v[1]), pack2(v[2], v[3])};
        }
    }
}

constexpr int GBK = 64, GLDS = 72  ;
struct RowMap { int lat_only; __device__ __forceinline__ int ntiles() const { return lat_only ? 256 : 272; }
    __device__ __forceinline__ int row0(int t) const { return lat_only ? (t >> 5) * PB + CTX + (t & 31) * 128 : t * 128; } };

template <class Epi>
__device__ __forceinline__ void gemm_phase(const bf16_t* __restrict__ A, int lda, const bf16_t* __restrict__ Bt, int K, int N, RowMap rm, const Epi& epi, unsigned char* smem) {
    bf16_t* sA = (bf16_t*)smem; bf16_t* sB = sA + 128 * GLDS;
    const int tid = otid(), lane = tid & 63, wid = tid >> 6, wm = wid >> 1, wn = wid & 1, fr = lane & 15, fq = lane >> 4;
    const int ntn = (N + 127) / 128, nunits = rm.ntiles() * ntn, nk = K / GBK;
    for (int u = blockIdx.x; u < nunits; u += gridDim.x) {
        const int tm = u / ntn, tn = u % ntn, m0 = rm.row0(tm), n0 = tn * 128;
        f32x4 acc[4][4];
#pragma unroll
        for (int i = 0; i < 4; ++i)
#pragma unroll
            for (int j = 0; j < 4; ++j) acc[i][j] = (f32x4){0.f, 0.f, 0.f, 0.f};
        u32x4 ra[4], rb[4];
        auto gload = [&](int kt) {
#pragma unroll
            for (int i = 0; i < 4; ++i) {
                const int id = tid + 256 * i, row = id >> 3, ch = id & 7;
                ra[i] = *(const u32x4*)(A + (size_t)(m0 + row) * lda + kt * GBK + ch * 8);
                int brow = n0 + row; brow = brow < N ? brow : N - 1;
                rb[i] = *(const u32x4*)(Bt + (size_t)brow * K + kt * GBK + ch * 8);
            }
        };
        auto lstore = [&]() {
#pragma unroll
            for (int i = 0; i < 4; ++i) {
                const int id = tid + 256 * i, row = id >> 3, ch = id & 7;
                *(u32x4*)(sA + row * GLDS + ch * 8) = ra[i];
                *(u32x4*)(sB + row * GLDS + ch * 8) = rb[i];
            }
        };
        gload(0);
        __syncthreads();
        lstore();
        __syncthreads();
        for (int kt = 0; kt < nk; ++kt) {
            if (kt + 1 < nk) gload(kt + 1);
#pragma unroll
            for (int ks = 0; ks < 2; ++ks) {
                bf16x8 af[4], bfr[4];
#pragma unroll
                for (int i = 0; i < 4; ++i) af[i] = *(const bf16x8*)(sA + (wm * 64 + i * 16 + fr) * GLDS + ks * 32 + fq * 8);
#pragma unroll
                for (int j = 0; j < 4; ++j) bfr[j] = *(const bf16x8*)(sB + (wn * 64 + j * 16 + fr) * GLDS + ks * 32 + fq * 8);
#pragma unroll
                for (int i = 0; i < 4; ++i)
#pragma unroll
                    for (int j = 0; j < 4; ++j) acc[i][j] = __builtin_amdgcn_mfma_f32_16x16x32_bf16(bfr[j], af[i], acc[i][j], 0, 0, 0);
            }
            __syncthreads();
            if (kt + 1 < nk) { lstore(); __syncthreads(); }
        }
        epi(acc, m0 + wm * 64, n0 + wn * 64, fr, fq);
    }
}

struct EpiBf16 {
    bf16_t* C; int ldc, N;
    __device__ __forceinline__ void operator()(const f32x4 (&acc)[4][4], int mb, int nb, int fr, int fq) const {
#pragma unroll
        for (int i = 0; i < 4; ++i)
#pragma unroll
            for (int j = 0; j < 4; ++j) {
                const int m = mb + i * 16 + fr, n = nb + j * 16 + 4 * fq;
                if (n < N) *(u32x2*)(C + (size_t)m * ldc + n) = (u32x2){pack2(acc[i][j][0], acc[i][j][1]), pack2(acc[i][j][2], acc[i][j][3])};
            }
    }
};
struct EpiQ {
    bf16_t* Q; const float *rsq, *rc, *rs;
    __device__ __forceinline__ void operator()(const f32x4 (&acc)[4][4], int mb, int nb, int fr, int fq) const {
#pragma unroll
        for (int i = 0; i < 4; ++i) {
            const int m = mb + i * 16 + fr, b = m / PB, pp = m - b * PB;
            const float sc = rsq[m] * (MLA_SCALE * 1.4426950408889634f);
#pragma unroll
            for (int j = 0; j < 4; j += 2) {
                const int n = nb + j * 16 + 4 * fq;
                f32x4 v0 = acc[i][j] * sc, v1 = acc[i][j + 1] * sc;
                const int d = n % 96;
                if (d >= 64 && pp >= CTX) {
                    const int s = pp - CTX, f = (d - 64) + 0;
                    const f32x4 cs = *(const f32x4*)(rc + s * 16 + f), sn = *(const f32x4*)(rs + s * 16 + f);
                    const f32x4 o0 = v0 * cs - v1 * sn, o1 = v0 * sn + v1 * cs; v0 = o0; v1 = o1;
                }
                *(u32x2*)(Q + (size_t)m * 768 + n) = (u32x2){pack2(v0[0], v0[1]), pack2(v0[2], v0[3])};
                *(u32x2*)(Q + (size_t)m * 768 + n + 16) = (u32x2){pack2(v1[0], v1[1]), pack2(v1[2], v1[3])};
            }
        }
    }
};
struct EpiKV {
    bf16_t *Kd, *Vd; const float* rsq;
    __device__ __forceinline__ void operator()(const f32x4 (&acc)[4][4], int mb, int nb, int fr, int fq) const {
#pragma unroll
        for (int i = 0; i < 4; ++i) {
            const int m = mb + i * 16 + fr; const float sc = rsq[m];
#pragma unroll
            for (int j = 0; j < 4; ++j) {
                const int n = nb + j * 16 + 4 * fq, hd = n >> 7, d = n & 127;
                const f32x4 v = acc[i][j] * sc;
                bf16_t* dst = d < 64 ? Kd + (size_t)m * 768 + hd * 96 + d : Vd + (size_t)m * 512 + hd * 64 + (d - 64);
                *(u32x2*)dst = (u32x2){pack2(v[0], v[1]), pack2(v[2], v[3])};
            }
        }
    }
};
struct EpiResid {
    const float *x, *ctx, *mod; float* H; int layer;
    __device__ __forceinline__ void operator()(const f32x4 (&acc)[4][4], int mb, int nb, int fr, int fq) const {
#pragma unroll
        for (int i = 0; i < 4; ++i) {
            const int m = mb + i * 16 + fr, b = m / PB, pp = m - b * PB;
            const float* hin = layer == 0 ? (pp < CTX ? ctx + ((size_t)b * CTX + pp) * D : x + ((size_t)b * SEQ + (pp - CTX)) * D) : H + (size_t)m * D;
            const float* gate = mod + ((size_t)layer * 9 + (pp < CTX ? 8 : b)) * 6144 + 2 * 1024;
#pragma unroll
            for (int j = 0; j < 4; ++j) {
                const int n = nb + j * 16 + 4 * fq;
                const f32x4 h = *(const f32x4*)(hin + n), g = *(const f32x4*)(gate + n);
                *(f32x4*)(H + (size_t)m * D + n) = ALPHA * h + g * acc[i][j];
            }
        }
    }
};

__device__ __forceinline__ void ph_rowpost(const Params& p) {
    const int tid_ = otid(), wid = tid_ >> 6, lane = tid_ & 63;
    for (int u = blockIdx.x; u < R / 4; u += gridDim.x) {
        const int r = u * 4 + wid, b = r / PB, pp = r - b * PB;
        const bf16_t* row = p.P + (size_t)r * EV_IN;
        float sq = 0.f, skv = 0.f;
#pragma unroll
        for (int i = 0; i < 10; ++i) { const float v = bf2f(row[lane + 64 * i]); if (i < 6) sq += v * v; else skv += v * v; }
        sq = wave_sum(sq); skv = wave_sum(skv);
        if (lane == 0) { p.rsq[r] = rsqrtf(sq / 384.0f + LN_EPS); p.rsq[R + r] = rsqrtf(skv / 256.0f + LN_EPS); }
        if (lane < 16) {
            float x1 = bf2f(row[C_KPE + lane]), x2 = bf2f(row[C_KPE + 16 + lane]);
            if (pp >= CTX) { const int s = pp - CTX; const float cs = p.rope_cos[s * 16 + lane], sn = p.rope_sin[s * 16 + lane];
                const float o1 = x1 * cs - x2 * sn, o2 = x1 * sn + x2 * cs; x1 = o1; x2 = o2; }
            const bf16_t b1 = f2bf(x1), b2 = f2bf(x2);
#pragma unroll
            for (int hd = 0; hd < 8; ++hd) { p.K16[(size_t)r * 768 + hd * 96 + 64 + lane] = b1; p.K16[(size_t)r * 768 + hd * 96 + 80 + lane] = b2; }
        }
    }
}

constexpr int AT_KS = 104, AT_VS = 68, AT_BUF = 64 * AT_KS * 2 + 64 * AT_VS * 2;
__device__ __forceinline__ void ph_attn(const Params& p, unsigned char* smem, int bid, int nblk) {
    const int tid = otid(), wid = tid >> 6, lane = tid & 63, q = lane & 31, h = lane >> 5;
    for (int u = bid; u < 2048 + 128; u += nblk) {
        int b, hd, q0, nkeys;
        if (u < 2048) { b = u >> 8; hd = (u >> 5) & 7; q0 = CTX + (u & 31) * 128; nkeys = PB; }
        else { const int v = u - 2048; b = v >> 4; hd = (v >> 1) & 7; q0 = (v & 1) * 128; nkeys = CTX; }
        const size_t rq = (size_t)b * PB + q0 + wid * 32 + q;
        bf16x8 qf[6];
#pragma unroll
        for (int s = 0; s < 6; ++s) qf[s] = *(const bf16x8*)(p.Q16 + rq * 768 + hd * 96 + 16 * s + 8 * h);
        f32x16 o[2];
#pragma unroll
        for (int i = 0; i < 16; ++i) { o[0][i] = 0.f; o[1][i] = 0.f; }
        float m = -1e30f, l = 0.f;
        const int ntiles = nkeys / 64;
        const bf16_t* Kg = p.K16 + (size_t)b * PB * 768 + hd * 96;
        const bf16_t* Vg = p.V16 + (size_t)b * PB * 512 + hd * 64;
        u32x4 rk[3], rv[2];
        auto gload = [&](int t) {
#pragma unroll
            for (int i = 0; i < 3; ++i) { const int id = tid + 256 * i, key = id / 12, ch = id % 12; rk[i] = *(const u32x4*)(Kg + (size_t)(t * 64 + key) * 768 + ch * 8); }
#pragma unroll
            for (int i = 0; i < 2; ++i) { const int id = tid + 256 * i, key = id >> 3, dch = id & 7; rv[i] = *(const u32x4*)(Vg + (size_t)(t * 64 + key) * 512 + dch * 8); }
        };
        auto lstore = [&](int buf) {
            bf16_t* Ks = (bf16_t*)(smem + buf * AT_BUF); bf16_t* Vt = Ks + 64 * AT_KS;
#pragma unroll
            for (int i = 0; i < 3; ++i) { const int id = tid + 256 * i, key = id / 12, ch = id % 12; *(u32x4*)(Ks + key * AT_KS + ch * 8) = rk[i]; }
#pragma unroll
            for (int i = 0; i < 2; ++i) {
                const int id = tid + 256 * i, key = id >> 3, dch = id & 7;
#pragma unroll
                for (int e = 0; e < 4; ++e) { Vt[(dch * 8 + 2 * e) * AT_VS + key] = (bf16_t)(rv[i][e] & 0xffffu); Vt[(dch * 8 + 2 * e + 1) * AT_VS + key] = (bf16_t)(rv[i][e] >> 16); }
            }
        };
        __syncthreads();
        gload(0); lstore(0);
        __syncthreads();
        for (int t = 0; t < ntiles; ++t) {
            if (t + 1 < ntiles) gload(t + 1);
            const bf16_t* Ks = (const bf16_t*)(smem + (t & 1) * AT_BUF); const bf16_t* Vt = Ks + 64 * AT_KS;
            f32x16 sa[2];
#pragma unroll
            for (int kb = 0; kb < 2; ++kb) {
#pragma unroll
                for (int i = 0; i < 16; ++i) sa[kb][i] = 0.f;
#pragma unroll
                for (int s = 0; s < 6; ++s) {
                    const bf16x8 kf = *(const bf16x8*)(Ks + (kb * 32 + q) * AT_KS + 16 * s + 8 * h);
                    sa[kb] = __builtin_amdgcn_mfma_f32_32x32x16_bf16(kf, qf[s], sa[kb], 0, 0, 0);
                }
            }
            float mx = sa[0][0];
#pragma unroll
            for (int i = 1; i < 16; ++i) mx = fmaxf(mx, sa[0][i]);
#pragma unroll
            for (int i = 0; i < 16; ++i) mx = fmaxf(mx, sa[1][i]);
            mx = fmaxf(mx, __shfl_xor(mx, 32));
            const float mn = fmaxf(m, mx), al = __builtin_amdgcn_exp2f(m - mn);
            m = mn;
            float ps = 0.f;
#pragma unroll
            for (int kb = 0; kb < 2; ++kb)
#pragma unroll
                for (int i = 0; i < 16; ++i) { const float e = __builtin_amdgcn_exp2f(sa[kb][i] - mn); sa[kb][i] = e; ps += e; }
            l = l * al + ps;
#pragma unroll
            for (int i = 0; i < 16; ++i) { o[0][i] *= al; o[1][i] *= al; }
#pragma unroll
            for (int kb = 0; kb < 2; ++kb)
#pragma unroll
                for (int s2 = 0; s2 < 2; ++s2) {
                    u32x4 pw;
#pragma unroll
                    for (int e = 0; e < 4; ++e) pw[e] = pack2(sa[kb][8 * s2 + 2 * e], sa[kb][8 * s2 + 2 * e + 1]);
                    const bf16x8 pf = __builtin_bit_cast(bf16x8, pw);
                    const int base = kb * 32 + 16 * s2;
#pragma unroll
                    for (int db = 0; db < 2; ++db) {
                        const bf16_t* vp = Vt + (db * 32 + q) * AT_VS + base + 4 * h;
                        const u32x2 v0 = *(const u32x2*)vp, v1 = *(const u32x2*)(vp + 8);
                        const bf16x8 vf = __builtin_bit_cast(bf16x8, (u32x4){v0[0], v0[1], v1[0], v1[1]});
                        o[db] = __builtin_amdgcn_mfma_f32_32x32x16_bf16(vf, pf, o[db], 0, 0, 0);
                    }
                }
            if (t + 1 < ntiles) lstore((t + 1) & 1);
            __syncthreads();
        }
        l += __shfl_xor(l, 32);
        const float il = 1.0f / l;
#pragma unroll
        for (int db = 0; db < 2; ++db)
#pragma unroll
            for (int gq = 0; gq < 4; ++gq) {
                const int d = db * 32 + 8 * gq + 4 * h;
                *(u32x2*)(p.A16 + rq * D + hd * 64 + d) = (u32x2){pack2(o[db][4 * gq] * il, o[db][4 * gq + 1] * il), pack2(o[db][4 * gq + 2] * il, o[db][4 * gq + 3] * il)};
            }
    }
}

constexpr size_t GLA_KS_BYTES = (size_t)NB * 4 * 68 * 2 * 8192 * 2;
constexpr int GL_S = 72;
__device__ __forceinline__ void gla_cum(const Params& p, size_t row0, int hd, int dir, float* sga, float* spart, float (&c)[16], float& T) {
    const int tid = otid(), d = tid & 63, part = tid >> 6;
    {
        const int j = tid >> 2, g4 = tid & 3;
        const u32x2 w = *(const u32x2*)(p.P + (row0 + j) * EV_IN + C_GAF + dir * 16 + g4 * 4);
        sga[j * 16 + g4 * 4 + 0] = __uint_as_float(w[0] << 16); sga[j * 16 + g4 * 4 + 1] = __uint_as_float(w[0] & 0xffff0000u);
        sga[j * 16 + g4 * 4 + 2] = __uint_as_float(w[1] << 16); sga[j * 16 + g4 * 4 + 3] = __uint_as_float(w[1] & 0xffff0000u);
    }
    __syncthreads();
    float wc[16];
    const float* wa = p.ev_gla_wa2 + (size_t)dir * 16 * 256 + hd * 64 + d;
#pragma unroll
    for (int g = 0; g < 16; ++g) wc[g] = wa[g * 256];
    const float bias = p.ev_gla_ba[dir * 256 + hd * 64 + d];
    float lv[16]; float run = 0.f;
#pragma unroll
    for (int jj = 0; jj < 16; ++jj) {
        const int j = part * 16 + jj;
        float z = bias;
#pragma unroll
        for (int g = 0; g < 16; g += 4) { const f32x4 a = *(const f32x4*)(sga + j * 16 + g); z += a[0] * wc[g] + a[1] * wc[g + 1] + a[2] * wc[g + 2] + a[3] * wc[g + 3]; }
        const float ls = (fminf(z, 0.f) - log1pf(expf(-fabsf(z)))) * (1.0f / 16.0f);
        lv[jj] = ls; run += ls; c[jj] = run;
    }
    spart[part * 64 + d] = run;
    __syncthreads();
    float off = 0.f; T = 0.f;
#pragma unroll
    for (int pp = 0; pp < 4; ++pp) { const float v = spart[pp * 64 + d]; T += v; if (pp < part) off += v; }
#pragma unroll
    for (int jj = 0; jj < 16; ++jj) c[jj] = dir == 0 ? off + c[jj] : T - (off + c[jj]) + lv[jj];
}
__device__ __forceinline__ void gla_stage_vt(const Params& p, size_t row0, int hd, bf16_t* Vt) {
    const int tid = otid();
#pragma unroll
    for (int i = 0; i < 4; ++i) {
        const int id = tid + 256 * i, j = id >> 4, ech = id & 15;
        const u32x4 w = *(const u32x4*)(p.P + (row0 + j) * EV_IN + C_GV + hd * 128 + ech * 8);
#pragma unroll
        for (int e = 0; e < 4; ++e) { Vt[(ech * 8 + 2 * e) * GL_S + j] = (bf16_t)(w[e] & 0xffffu); Vt[(ech * 8 + 2 * e + 1) * GL_S + j] = (bf16_t)(w[e] >> 16); }
    }
}
__device__ __forceinline__ void ph_gla_a(const Params& p, unsigned char* smem) {
    bf16_t* kwT = (bf16_t*)smem; bf16_t* Vt = kwT + 64 * GL_S; float* sga = (float*)(Vt + 128 * GL_S); float* spart = sga + 1024;
    bf16_t* KS = (bf16_t*)p.G; float* DEC = (float*)(p.G + GLA_KS_BYTES);
    const int tid = otid(), lane = tid & 63, wid = tid >> 6, fr = lane & 15, fq = lane >> 4, d = tid & 63, part = tid >> 6;
    for (int u = blockIdx.x; u < NB * 4 * 68; u += gridDim.x) {
        const int b = u / 272, hd = (u / 68) & 3, ci = u % 68;
        const size_t row0 = (size_t)b * PB + ci * 64;
        __syncthreads();
        gla_stage_vt(p, row0, hd, Vt);
        for (int dir = 0; dir < 2; ++dir) {
            float c[16], T;
            gla_cum(p, row0, hd, dir, sga, spart, c, T);
            unsigned kw[8];
#pragma unroll
            for (int jj = 0; jj < 16; jj += 2) {
                const float k0 = bf2f(p.P[(row0 + part * 16 + jj) * EV_IN + C_GK + hd * 64 + d]), k1 = bf2f(p.P[(row0 + part * 16 + jj + 1) * EV_IN + C_GK + hd * 64 + d]);
                kw[jj >> 1] = pack2(k0 * expf(T - c[jj]), k1 * expf(T - c[jj + 1]));
            }
            *(u32x4*)(kwT + d * GL_S + part * 16) = (u32x4){kw[0], kw[1], kw[2], kw[3]};
            *(u32x4*)(kwT + d * GL_S + part * 16 + 8) = (u32x4){kw[4], kw[5], kw[6], kw[7]};
            if (part == 0) DEC[((size_t)u * 2 + dir) * 64 + d] = expf(T);
            __syncthreads();
            f32x4 acc[8];
#pragma unroll
            for (int et = 0; et < 8; ++et) acc[et] = (f32x4){0.f, 0.f, 0.f, 0.f};
#pragma unroll
            for (int s = 0; s < 2; ++s) {
                const bf16x8 a = *(const bf16x8*)(kwT + (16 * wid + fr) * GL_S + 32 * s + 8 * fq);
#pragma unroll
                for (int et = 0; et < 8; ++et) {
                    const bf16x8 bq = *(const bf16x8*)(Vt + (16 * et + fr) * GL_S + 32 * s + 8 * fq);
                    acc[et] = __builtin_amdgcn_mfma_f32_16x16x32_bf16(a, bq, acc[et], 0, 0, 0);
                }
            }
#pragma unroll
            for (int et = 0; et < 8; ++et)
                *(u32x2*)(KS + (((size_t)u * 2 + dir) * 128 + 16 * et + fr) * 64 + 16 * wid + 4 * fq) = (u32x2){pack2(acc[et][0], acc[et][1]), pack2(acc[et][2], acc[et][3])};
            __syncthreads();
        }
    }
}
__device__ __forceinline__ void ph_gla_b(const Params& p) {
    unsigned* KS32 = (unsigned*)p.G; const float* DEC = (const float*)(p.G + GLA_KS_BYTES);
    for (int gid = blockIdx.x * 256 + threadIdx.x; gid < 64 * 4096; gid += gridDim.x * 256) {
        const int seq = gid >> 12, pi = gid & 4095, dir = seq & 1, bh = seq >> 1, d = (2 * pi) & 63;
        float s0 = 0.f, s1 = 0.f;
#pragma unroll 4
        for (int step = 0; step < 68; ++step) {
            const int ci = dir == 0 ? step : (step < 4 ? 3 - step : 71 - step);
            const size_t ud = ((size_t)bh * 68 + ci) * 2 + dir;
            const unsigned w = KS32[ud * 4096 + pi];
            const float dc0 = DEC[ud * 64 + d], dc1 = DEC[ud * 64 + d + 1];
            KS32[ud * 4096 + pi] = pack2(s0, s1);
            s0 = dc0 * s0 + __uint_as_float(w << 16); s1 = dc1 * s1 + __uint_as_float(w & 0xffff0000u);
        }
    }
}
__device__ __forceinline__ void ph_gla_c(const Params& p, unsigned char* smem) {
    bf16_t* qs = (bf16_t*)smem; bf16_t* ks = qs + 64 * GL_S; bf16_t* Vt = ks + 64 * GL_S; float* sga = (float*)(Vt + 128 * GL_S); float* spart = sga + 1024;
    const bf16_t* KS = (const bf16_t*)p.G;
    const int tid = otid(), lane = tid & 63, wid = tid >> 6, fr = lane & 15, fq = lane >> 4, d = tid & 63, part = tid >> 6;
    for (int u = blockIdx.x; u < NB * 4 * 68; u += gridDim.x) {
        const int b = u / 272, hd = (u / 68) & 3, ci = u % 68;
        const size_t row0 = (size_t)b * PB + ci * 64;
        const int i = 16 * wid + fr;
        __syncthreads();
        gla_stage_vt(p, row0, hd, Vt);
        f32x4 oacc[8], pt[4];
#pragma unroll
        for (int et = 0; et < 8; ++et) oacc[et] = (f32x4){0.f, 0.f, 0.f, 0.f};
#pragma unroll
        for (int jt = 0; jt < 4; ++jt) pt[jt] = (f32x4){0.f, 0.f, 0.f, 0.f};
        for (int dir = 0; dir < 2; ++dir) {
            float c[16], T;
            gla_cum(p, row0, hd, dir, sga, spart, c, T);
#pragma unroll
            for (int jj = 0; jj < 16; ++jj) {
                const size_t ro = (row0 + part * 16 + jj) * EV_IN + hd * 64 + d;
                qs[(part * 16 + jj) * GL_S + d] = f2bf(bf2f(p.P[ro + C_GQ]) * 0.125f * expf(c[jj]));
                ks[(part * 16 + jj) * GL_S + d] = f2bf(bf2f(p.P[ro + C_GK]) * expf(-c[jj]));
            }
            __syncthreads();
            bf16x8 qf[2];
#pragma unroll
            for (int s = 0; s < 2; ++s) qf[s] = *(const bf16x8*)(qs + i * GL_S + 32 * s + 8 * fq);
#pragma unroll
            for (int jt = 0; jt < 4; ++jt) {
                f32x4 t = (f32x4){0.f, 0.f, 0.f, 0.f};
#pragma unroll
                for (int s = 0; s < 2; ++s) { const bf16x8 a = *(const bf16x8*)(ks + (16 * jt + fr) * GL_S + 32 * s + 8 * fq); t = __builtin_amdgcn_mfma_f32_16x16x32_bf16(a, qf[s], t, 0, 0, 0); }
#pragma unroll
                for (int rg = 0; rg < 4; ++rg) { const int j = 16 * jt + 4 * fq + rg; const bool keep = dir == 0 ? (j <= i) : (j >= i); pt[jt][rg] += keep ? t[rg] : 0.f; }
            }
            const bf16_t* Sg = KS + ((size_t)u * 2 + dir) * 8192;
#pragma unroll
            for (int et = 0; et < 8; ++et) {
#pragma unroll
                for (int s = 0; s < 2; ++s) { const bf16x8 a = *(const bf16x8*)(Sg + (16 * et + fr) * 64 + 32 * s + 8 * fq); oacc[et] = __builtin_amdgcn_mfma_f32_16x16x32_bf16(a, qf[s], oacc[et], 0, 0, 0); }
                if ((et & 3) == 3) __builtin_amdgcn_sched_barrier(0);
            }
            __syncthreads();
        }
#pragma unroll
        for (int k2 = 0; k2 < 2; ++k2) {
            const u32x4 pw = (u32x4){pack2(pt[2 * k2][0], pt[2 * k2][1]), pack2(pt[2 * k2][2], pt[2 * k2][3]), pack2(pt[2 * k2 + 1][0], pt[2 * k2 + 1][1]), pack2(pt[2 * k2 + 1][2], pt[2 * k2 + 1][3])};
            const bf16x8 pf = __builtin_bit_cast(bf16x8, pw);
#pragma unroll
            for (int et = 0; et < 8; ++et) {
                const bf16_t* vp = Vt + (16 * et + fr) * GL_S + 32 * k2 + 4 * fq;
                const u32x2 v0 = *(const u32x2*)vp, v1 = *(const u32x2*)(vp + 16);
                const bf16x8 vf = __builtin_bit_cast(bf16x8, (u32x4){v0[0], v0[1], v1[0], v1[1]});
                oacc[et] = __builtin_amdgcn_mfma_f32_16x16x32_bf16(vf, pf, oacc[et], 0, 0, 0);
            }
        }
        float ss = 0.f;
#pragma unroll
        for (int et = 0; et < 8; ++et) ss += oacc[et][0] * oacc[et][0] + oacc[et][1] * oacc[et][1] + oacc[et][2] * oacc[et][2] + oacc[et][3] * oacc[et][3];
        ss += __shfl_xor(ss, 16); ss += __shfl_xor(ss, 32);
        const float rs = rsqrtf(ss * (1.0f / 128.0f) + LN_EPS);
        const size_t r = row0 + i;
#pragma unroll
        for (int et = 0; et < 8; ++et) {
            const int e = 16 * et + 4 * fq;
            const u32x2 gw = *(const u32x2*)(p.P + r * EV_IN + C_GG + hd * 128 + e);
            const f32x4 nr = *(const f32x4*)(p.ev_gla_norm + hd * 128 + e);
            const float g0 = __uint_as_float(gw[0] << 16), g1 = __uint_as_float(gw[0] & 0xffff0000u), g2 = __uint_as_float(gw[1] << 16), g3 = __uint_as_float(gw[1] & 0xffff0000u);
            *(u32x2*)(p.A16 + r * D + 512 + hd * 128 + e) = (u32x2){pack2(oacc[et][0] * rs * nr[0] * silu_f(g0), oacc[et][1] * rs * nr[1] * silu_f(g1)),
                                                                   pack2(oacc[et][2] * rs * nr[2] * silu_f(g2), oacc[et][3] * rs * nr[3] * silu_f(g3))};
        }
    }
}

__device__ __forceinline__ void ph_ln_mod(const Params& p, int layer, int lnidx, int lat_only) {
    const int tid_ = otid(), wid = tid_ >> 6, lane = tid_ & 63;
    const int nrows = lat_only ? NB * SEQ : R;
    const float* g = p.ln_g + (size_t)(layer * 2 + lnidx) * D; const float* bb = p.ln_b + (size_t)(layer * 2 + lnidx) * D;
    for (int u = blockIdx.x; u < nrows / 4; u += gridDim.x) {
        const int rr = u * 4 + wid, r = lat_only ? (rr >> 12) * PB + CTX + (rr & 4095) : rr;
        float* hrow = p.H + (size_t)r * D;
        f32x4 v[4]; float s = 0.f;
#pragma unroll
        for (int q = 0; q < 4; ++q) { v[q] = *(const f32x4*)(hrow + q * 256 + lane * 4); s += v[q][0] + v[q][1] + v[q][2] + v[q][3]; }
        const float mu = wave_sum(s) * (1.0f / 1024.0f);
        float ss = 0.f;
#pragma unroll
        for (int q = 0; q < 4; ++q) { v[q] = v[q] - mu; ss += v[q][0] * v[q][0] + v[q][1] * v[q][1] + v[q][2] * v[q][2] + v[q][3] * v[q][3]; }
        const float rstd = rsqrtf(wave_sum(ss) * (1.0f / 1024.0f) + LN_EPS);
        const float* md = p.mod + ((size_t)layer * 9 + mod_row(r)) * 6144;
#pragma unroll
        for (int q = 0; q < 4; ++q) {
            const int c = q * 256 + lane * 4;
            const f32x4 h = v[q] * rstd * *(const f32x4*)(g + c) + *(const f32x4*)(bb + c);
            *(f32x4*)(hrow + c) = h;
            const f32x4 a = h * (1.0f + *(const f32x4*)(md + 4 * 1024 + c)) + *(const f32x4*)(md + 3 * 1024 + c);
            *(u32x2*)(p.A16 + (size_t)r * D + c) = (u32x2){pack2(a[0], a[1]), pack2(a[2], a[3])};
        }
    }
}

constexpr int SC_KS = 136;
__device__ __forceinline__ void ph_scores(const Params& p, int layer, int lat_only, unsigned char* smem) {
    bf16_t* ksl = (bf16_t*)smem;
    const bf16_t* QP = p.P; float* T = (float*)p.G;
    const int tid = otid(), lane = tid & 63, wid = tid >> 6, q = lane & 31, h = lane >> 5;
    const RowMap rm{lat_only};
    const int nunits = rm.ntiles() * 8;
    for (int u = blockIdx.x; u < nunits; u += gridDim.x) {
        const int tile = u >> 3, half = (u >> 2) & 1, hp = u & 3;
        const size_t r = (size_t)rm.row0(tile) + 32 * wid + q;
        __syncthreads();
        const bf16_t* kk = p.wt_k + ((size_t)layer * 2 + half) * 16384;
#pragma unroll
        for (int i = 0; i < 8; ++i) { const int id = tid + 256 * i, key = id >> 4, ch = id & 15; *(u32x4*)(ksl + key * SC_KS + ch * 8) = *(const u32x4*)(kk + key * 128 + ch * 8); }
        __syncthreads();
        for (int hh = 0; hh < 2; ++hh) {
            const int hd = hp * 2 + hh;
            bf16x8 qf[8];
#pragma unroll
            for (int s = 0; s < 8; ++s) qf[s] = *(const bf16x8*)(QP + r * 2048 + hd * 256 + half * 128 + 16 * s + 8 * h);
            float top[16];
#pragma unroll
            for (int t = 0; t < 16; ++t) top[t] = -3.0e38f;
#pragma unroll 1
            for (int kb = 0; kb < 4; ++kb) {
                f32x16 sa;
#pragma unroll
                for (int i = 0; i < 16; ++i) sa[i] = 0.f;
#pragma unroll
                for (int s = 0; s < 8; ++s) {
                    const bf16x8 kf = *(const bf16x8*)(ksl + (kb * 32 + q) * SC_KS + 16 * s + 8 * h);
                    sa = __builtin_amdgcn_mfma_f32_32x32x16_bf16(kf, qf[s], sa, 0, 0, 0);
                }
#pragma unroll
                for (int rg = 0; rg < 16; ++rg) {
                    const unsigned key = (unsigned)(kb * 32 + (rg & 3) + 8 * (rg >> 2) + 4 * h);
                    float xv = __uint_as_float((__float_as_uint(sa[rg]) & ~127u) | key);
#pragma unroll
                    for (int t = 0; t < 16; ++t) { const float hi = fmaxf(top[t], xv); xv = fminf(top[t], xv); top[t] = hi; }
                }
            }
            float mrg[8];
#pragma unroll
            for (int i = 0; i < 8; ++i) mrg[i] = fmaxf(top[i], __shfl_xor(top[15 - i], 32));
            float* dst = T + ((r * 8 + hd) * 2 + half) * 16 + 8 * h;
            *(f32x4*)dst = (f32x4){mrg[0], mrg[1], mrg[2], mrg[3]}; *(f32x4*)(dst + 4) = (f32x4){mrg[4], mrg[5], mrg[6], mrg[7]};
        }
    }
}

__device__ __forceinline__ void ph_combine(const Params& p, int lat_only) {
    const float* T = (const float*)p.G;
    int* EIDX = (int*)(p.G + (size_t)R * 8 * 2 * 16 * 4);
    float* EG = (float*)(p.G + (size_t)R * 8 * 2 * 16 * 4 + (size_t)R * 8 * 16 * 4);
    const int nrows = lat_only ? NB * SEQ : R;
    for (int g = blockIdx.x * 256 + threadIdx.x; g < nrows * 8; g += gridDim.x * 256) {
        const int rr = g >> 3, hd = g & 7, r = lat_only ? (rr >> 12) * PB + CTX + (rr & 4095) : rr;
        const float* t = T + ((size_t)r * 8 + hd) * 32;
        float t2[16];
#pragma unroll
        for (int i = 0; i < 16; ++i) t2[i] = __uint_as_float(__float_as_uint(t[16 + i]) & ~127u);
        float top[16];
#pragma unroll
        for (int k = 0; k < 16; ++k) top[k] = -3.0e38f;
        for (int i = 0; i < 16; ++i) {
            const float t1i = __uint_as_float(__float_as_uint(t[i]) & ~127u);
#pragma unroll
            for (int j = 0; j < 16; ++j) {
                float xv = __uint_as_float((__float_as_uint(t1i + t2[j]) & ~255u) | (unsigned)(i * 16 + j));
#pragma unroll
                for (int k = 0; k < 16; ++k) { const float hi = fmaxf(top[k], xv); xv = fminf(top[k], xv); top[k] = hi; }
            }
        }
        float e[16], sum = 0.f; const float mx = __uint_as_float(__float_as_uint(top[0]) & ~255u);
#pragma unroll
        for (int k = 0; k < 16; ++k) { e[k] = expf(__uint_as_float(__float_as_uint(top[k]) & ~255u) - mx); sum += e[k]; }
        const float inv = 1.0f / sum;
#pragma unroll
        for (int k = 0; k < 16; ++k) {
            const unsigned code = __float_as_uint(top[k]) & 255u, i = code >> 4, j = code & 15;
            const unsigned i1 = __float_as_uint(t[i]) & 127u, i2 = __float_as_uint(t[16 + j]) & 127u;
            EIDX[((size_t)r * 8 + hd) * 16 + k] = (int)(i1 * 128 + i2);
            EG[((size_t)r * 8 + hd) * 16 + k] = e[k] * inv;
        }
    }
}

__device__ __forceinline__ void ph_gather_ln(const Params& p, int layer, int lat_only) {
    const int tid_ = otid(), wid = tid_ >> 6, lane = tid_ & 63;
    const int* EIDX = (const int*)(p.G + (size_t)R * 8 * 2 * 16 * 4);
    const float* EG = (const float*)(p.G + (size_t)R * 8 * 2 * 16 * 4 + (size_t)R * 8 * 16 * 4);
    const float* U = p.peer_u + (size_t)layer * PEER_N * D; const float* V = p.peer_v + (size_t)layer * PEER_N * D;
    const float* g = p.ln_g + (size_t)(layer * 2 + 1) * D; const float* bb = p.ln_b + (size_t)(layer * 2 + 1) * D;
    const int nrows = lat_only ? NB * SEQ : R;
    for (int u = blockIdx.x; u < nrows / 4; u += gridDim.x) {
        const int rr = u * 4 + wid, r = lat_only ? (rr >> 12) * PB + CTX + (rr & 4095) : rr;
        f32x4 hm[4], acc[4];
#pragma unroll
        for (int q = 0; q < 4; ++q) {
            const u32x2 w = *(const u32x2*)(p.A16 + (size_t)r * D + q * 256 + lane * 4);
            hm[q] = (f32x4){__uint_as_float(w[0] << 16), __uint_as_float(w[0] & 0xffff0000u), __uint_as_float(w[1] << 16), __uint_as_float(w[1] & 0xffff0000u)};
            acc[q] = (f32x4){0.f, 0.f, 0.f, 0.f};
        }
        for (int e0 = 0; e0 < 128; e0 += 2) {
            const int ea = EIDX[(size_t)r * 128 + e0], eb = EIDX[(size_t)r * 128 + e0 + 1];
            const float ga = EG[(size_t)r * 128 + e0], gb = EG[(size_t)r * 128 + e0 + 1];
            f32x4 ua[4], ub[4];
#pragma unroll
            for (int q = 0; q < 4; ++q) { ua[q] = *(const f32x4*)(U + (size_t)ea * D + q * 256 + lane * 4); ub[q] = *(const f32x4*)(U + (size_t)eb * D + q * 256 + lane * 4); }
            float da = 0.f, db = 0.f;
#pragma unroll
            for (int q = 0; q < 4; ++q) { da += hm[q][0] * ua[q][0] + hm[q][1] * ua[q][1] + hm[q][2] * ua[q][2] + hm[q][3] * ua[q][3]; db += hm[q][0] * ub[q][0] + hm[q][1] * ub[q][1] + hm[q][2] * ub[q][2] + hm[q][3] * ub[q][3]; }
            da = wave_sum(da); db = wave_sum(db);
            const float wa = ga * gelu_f(da), wb = gb * gelu_f(db);
#pragma unroll
            for (int q = 0; q < 4; ++q) {
                acc[q] += wa * *(const f32x4*)(V + (size_t)ea * D + q * 256 + lane * 4);
                acc[q] += wb * *(const f32x4*)(V + (size_t)eb * D + q * 256 + lane * 4);
            }
        }
        const float* md = p.mod + ((size_t)layer * 9 + mod_row(r)) * 6144;
        float* hrow = p.H + (size_t)r * D;
        f32x4 v[4]; float s = 0.f;
#pragma unroll
        for (int q = 0; q < 4; ++q) { const int c = q * 256 + lane * 4; v[q] = ALPHA * *(const f32x4*)(hrow + c) + *(const f32x4*)(md + 5 * 1024 + c) * acc[q]; s += v[q][0] + v[q][1] + v[q][2] + v[q][3]; }
        const float mu = wave_sum(s) * (1.0f / 1024.0f);
        float ss = 0.f;
#pragma unroll
        for (int q = 0; q < 4; ++q) { v[q] = v[q] - mu; ss += v[q][0] * v[q][0] + v[q][1] * v[q][1] + v[q][2] * v[q][2] + v[q][3] * v[q][3]; }
        const float rstd = rsqrtf(wave_sum(ss) * (1.0f / 1024.0f) + LN_EPS);
        if (layer == 0) {
            const float* md1 = p.mod + ((size_t)1 * 9 + mod_row(r)) * 6144;
#pragma unroll
            for (int q = 0; q < 4; ++q) {
                const int c = q * 256 + lane * 4;
                const f32x4 h = v[q] * rstd * *(const f32x4*)(g + c) + *(const f32x4*)(bb + c);
                *(f32x4*)(hrow + c) = h;
                const f32x4 a = h * (1.0f + *(const f32x4*)(md1 + 1024 + c)) + *(const f32x4*)(md1 + c);
                *(u32x2*)(p.A16 + (size_t)r * D + c) = (u32x2){pack2(a[0], a[1]), pack2(a[2], a[3])};
            }
        } else {
            float* orow = p.out + (size_t)rr * D;
#pragma unroll
            for (int q = 0; q < 4; ++q) { const int c = q * 256 + lane * 4; *(f32x4*)(orow + c) = v[q] * rstd * *(const f32x4*)(g + c) + *(const f32x4*)(bb + c); }
        }
    }
}

constexpr size_t UV8_BYTES = (size_t)PEER_N * D;
__device__ __forceinline__ float wave_max(float v) {
#pragma unroll
    for (int o = 32; o > 0; o >>= 1) v = fmaxf(v, __shfl_xor(v, o));
    return v;
}
__device__ __forceinline__ unsigned cvt4_fp8(float a, float b, float c, float d) {
    int pk = __builtin_amdgcn_cvt_pk_fp8_f32(a, b, 0, false);
    pk = __builtin_amdgcn_cvt_pk_fp8_f32(c, d, pk, true);
    return (unsigned)pk;
}
__device__ __forceinline__ void ph_convert_uv(const Params& p, int layer) {
    const int tid = otid(), lane = tid & 63, gw = blockIdx.x * 4 + (tid >> 6), nw = gridDim.x * 4;
    unsigned char* T8 = (unsigned char*)p.P;
    float* sinv = (float*)(T8 + 2 * UV8_BYTES);
    for (int row = gw; row < 2 * PEER_N; row += nw) {
        const float* src = (row < PEER_N ? p.peer_u + ((size_t)layer * PEER_N + row) * D : p.peer_v + ((size_t)layer * PEER_N + (row - PEER_N)) * D) + lane * 16;
        f32x4 v[4]; float am = 0.f;
#pragma unroll
        for (int q = 0; q < 4; ++q) { v[q] = *(const f32x4*)(src + 4 * q); am = fmaxf(am, fmaxf(fmaxf(fabsf(v[q][0]), fabsf(v[q][1])), fmaxf(fabsf(v[q][2]), fabsf(v[q][3])))); }
        am = wave_max(am);
        const float sc = am > 0.f ? 224.0f / am : 1.0f;
        u32x4 w;
#pragma unroll
        for (int q = 0; q < 4; ++q) w[q] = cvt4_fp8(v[q][0] * sc, v[q][1] * sc, v[q][2] * sc, v[q][3] * sc);
        *(u32x4*)(T8 + (size_t)row * D + lane * 16) = w;
        if (lane == 0) sinv[row] = 1.0f / sc;
    }
}

__device__ __forceinline__ void ph_gather_mfma(const Params& p, int layer, int lat_only, unsigned char* smem) {
    const int tid = otid(), wid = tid >> 6, lane = tid & 63, c = lane & 15, g = lane >> 4;
    unsigned char* hs = smem + wid * 2048;
    int* se = (int*)(smem + wid * 2048 + 1024);
    float* sw = (float*)(smem + wid * 2048 + 1536);
    const int* EIDX = (const int*)(p.G + (size_t)R * 8 * 2 * 16 * 4);
    const float* EG = (const float*)(p.G + (size_t)R * 8 * 2 * 16 * 4 + (size_t)R * 8 * 16 * 4);
    const unsigned char* U8 = (const unsigned char*)p.P; const unsigned char* V8 = U8 + UV8_BYTES;
    const float* su_inv = (const float*)(U8 + 2 * UV8_BYTES); const float* sv_inv = su_inv + PEER_N;
    const float* gam = p.ln_g + (size_t)(layer * 2 + 1) * D; const float* bet = p.ln_b + (size_t)(layer * 2 + 1) * D;
    const int nrows = lat_only ? NB * SEQ : R;
    for (int u = blockIdx.x; u < nrows / 4; u += gridDim.x) {
        const int rr = u * 4 + wid, r = lat_only ? (rr >> 12) * PB + CTX + (rr & 4095) : rr;
        __syncthreads();
        float inv_sh;
        {
            const u32x4 w0 = *(const u32x4*)(p.A16 + (size_t)r * D + lane * 16), w1 = *(const u32x4*)(p.A16 + (size_t)r * D + lane * 16 + 8);
            float hv[16];
#pragma unroll
            for (int e = 0; e < 4; ++e) { hv[2 * e] = __uint_as_float(w0[e] << 16); hv[2 * e + 1] = __uint_as_float(w0[e] & 0xffff0000u); hv[8 + 2 * e] = __uint_as_float(w1[e] << 16); hv[8 + 2 * e + 1] = __uint_as_float(w1[e] & 0xffff0000u); }
            float am = 0.f;
#pragma unroll
            for (int e = 0; e < 16; ++e) am = fmaxf(am, fabsf(hv[e]));
            am = wave_max(am);
            const float sh = am > 0.f ? 224.0f / am : 1.0f; inv_sh = 1.0f / sh;
            *(u32x4*)(hs + lane * 16) = (u32x4){cvt4_fp8(hv[0] * sh, hv[1] * sh, hv[2] * sh, hv[3] * sh), cvt4_fp8(hv[4] * sh, hv[5] * sh, hv[6] * sh, hv[7] * sh),
                                                cvt4_fp8(hv[8] * sh, hv[9] * sh, hv[10] * sh, hv[11] * sh), cvt4_fp8(hv[12] * sh, hv[13] * sh, hv[14] * sh, hv[15] * sh)};
        }
        se[lane] = EIDX[(size_t)r * 128 + lane]; se[64 + lane] = EIDX[(size_t)r * 128 + 64 + lane];
        sw[lane] = EG[(size_t)r * 128 + lane]; sw[64 + lane] = EG[(size_t)r * 128 + 64 + lane];
        __syncthreads();
        for (int hd = 0; hd < 8; ++hd) {
            f32x4 dacc = (f32x4){0.f, 0.f, 0.f, 0.f};
            const int e = se[hd * 16 + c];
            const unsigned char* urow = U8 + (size_t)e * D + g * 16;
#pragma unroll
            for (int s2 = 0; s2 < 16; ++s2) {
                const u32x4 bq = *(const u32x4*)(urow + s2 * 64);
                const u32x4 aq = *(const u32x4*)(hs + s2 * 64 + g * 16);
                dacc = __builtin_amdgcn_mfma_f32_16x16x32_fp8_fp8((long)(((unsigned long long)aq[1] << 32) | aq[0]), (long)(((unsigned long long)bq[1] << 32) | bq[0]), dacc, 0, 0, 0);
                dacc = __builtin_amdgcn_mfma_f32_16x16x32_fp8_fp8((long)(((unsigned long long)aq[3] << 32) | aq[2]), (long)(((unsigned long long)bq[3] << 32) | bq[2]), dacc, 0, 0, 0);
            }
            const float wv = sw[hd * 16 + c] * gelu_f(dacc[0] * inv_sh * su_inv[e]) * sv_inv[e];
            if (g == 0) sw[hd * 16 + c] = wv;
        }
        __syncthreads();
        const float wmax = wave_max(fmaxf(fabsf(sw[lane]), fabsf(sw[64 + lane])));
        const float wsc = wmax > 0.f ? 224.0f / wmax : 1.0f, inv_wsc = 1.0f / wsc;
        f32x4 oacc[8];
#pragma unroll
        for (int blk = 0; blk < 8; ++blk) oacc[blk] = (f32x4){0.f, 0.f, 0.f, 0.f};
#pragma unroll 2
        for (int it = 0; it < 32; ++it) {
            const int e = se[4 * it + g];
            const unsigned w8 = (unsigned)__builtin_amdgcn_cvt_pk_fp8_f32(sw[4 * it + g] * wsc, 0.f, 0, false) & 0xffu;
            const unsigned long long a64 = c < 8 ? ((unsigned long long)w8 << (8 * c)) : 0ull;
            const unsigned char* vrow = V8 + (size_t)e * D + c * 16;
#pragma unroll
            for (int b2 = 0; b2 < 4; ++b2) {
                const u32x4 bq = *(const u32x4*)(vrow + b2 * 256);
                oacc[2 * b2] = __builtin_amdgcn_mfma_f32_16x16x32_fp8_fp8((long)a64, (long)(((unsigned long long)bq[1] << 32) | bq[0]), oacc[2 * b2], 0, 0, 0);
                oacc[2 * b2 + 1] = __builtin_amdgcn_mfma_f32_16x16x32_fp8_fp8((long)a64, (long)(((unsigned long long)bq[3] << 32) | bq[2]), oacc[2 * b2 + 1], 0, 0, 0);
            }
        }
#pragma unroll
        for (int blk = 0; blk < 8; ++blk) oacc[blk] = oacc[blk] * inv_wsc;
        const float* md = p.mod + ((size_t)layer * 9 + mod_row(r)) * 6144;
        float* hrow = p.H + (size_t)r * D;
        const bool act = g < 2;
        f32x4 v[8]; float s = 0.f;
#pragma unroll
        for (int blk = 0; blk < 8; ++blk) {
            const int n = 256 * (blk >> 1) + 16 * c + 8 * (blk & 1) + 4 * (g & 1);
            v[blk] = ALPHA * *(const f32x4*)(hrow + n) + *(const f32x4*)(md + 5 * 1024 + n) * oacc[blk];
            if (!act) v[blk] = (f32x4){0.f, 0.f, 0.f, 0.f};
            s += v[blk][0] + v[blk][1] + v[blk][2] + v[blk][3];
        }
        const float mu = wave_sum(s) * (1.0f / 1024.0f);
        float ss = 0.f;
#pragma unroll
        for (int blk = 0; blk < 8; ++blk) { v[blk] = v[blk] - mu; if (act) ss += v[blk][0] * v[blk][0] + v[blk][1] * v[blk][1] + v[blk][2] * v[blk][2] + v[blk][3] * v[blk][3]; }
        const float rstd = rsqrtf(wave_sum(ss) * (1.0f / 1024.0f) + LN_EPS);
        if (act) {
            if (layer == 0) {
                const float* md1 = p.mod + ((size_t)1 * 9 + mod_row(r)) * 6144;
#pragma unroll
                for (int blk = 0; blk < 8; ++blk) {
                    const int n = 256 * (blk >> 1) + 16 * c + 8 * (blk & 1) + 4 * g;
                    const f32x4 h = v[blk] * rstd * *(const f32x4*)(gam + n) + *(const f32x4*)(bet + n);
                    *(f32x4*)(hrow + n) = h;
                    const f32x4 a = h * (1.0f + *(const f32x4*)(md1 + 1024 + n)) + *(const f32x4*)(md1 + n);
                    *(u32x2*)(p.A16 + (size_t)r * D + n) = (u32x2){pack2(a[0], a[1]), pack2(a[2], a[3])};
                }
            } else {
                float* orow = p.out + (size_t)rr * D;
#pragma unroll
                for (int blk = 0; blk < 8; ++blk) { const int n = 256 * (blk >> 1) + 16 * c + 8 * (blk & 1) + 4 * g; *(f32x4*)(orow + n) = v[blk] * rstd * *(const f32x4*)(gam + n) + *(const f32x4*)(bet + n); }
            }
        }
    }
}

constexpr int RG_ZS = 136;
constexpr size_t RG_SUM_BYTES = (size_t)NB * 34 * 2 * RGW * 2 * 4;
__device__ __forceinline__ void rg_stage_z(const Params& p, int b, int c34, int n, bf16_t* zc) {
    const int tid = otid(), k2 = tid & 63, tq = tid >> 6, ch = n * 128 + 2 * k2;
    const int lo = c34 < 2 ? 0 : CTX, hi = c34 < 2 ? CTX : PB, p0 = c34 * 128 + 32 * tq;
    float w0[4], w1[4];
#pragma unroll
    for (int tap = 0; tap < 4; ++tap) { w0[tap] = p.od_conv_w[tap * RGW + ch]; w1[tap] = p.od_conv_w[tap * RGW + ch + 1]; }
    const float b0 = p.od_conv_b[ch], b1 = p.od_conv_b[ch + 1];
    const bf16_t* base = p.P + (size_t)b * PB * 2560 + RGW + ch;
    auto ld = [&](int pp, float& a, float& c) { if (pp >= lo && pp < hi) { const unsigned w = *(const unsigned*)(base + (size_t)pp * 2560); a = __uint_as_float(w << 16); c = __uint_as_float(w & 0xffff0000u); } else { a = 0.f; c = 0.f; } };
    float am2, cm2, am1, cm1, a0, c0, ap1, cp1;
    ld(p0 - 2, am2, cm2); ld(p0 - 1, am1, cm1); ld(p0, a0, c0);
#pragma unroll 4
    for (int t = 0; t < 32; ++t) {
        ld(p0 + t + 1, ap1, cp1);
        const float y0 = b0 + w0[0] * am2 + w0[1] * am1 + w0[2] * a0 + w0[3] * ap1;
        const float y1 = b1 + w1[0] * cm2 + w1[1] * cm1 + w1[2] * c0 + w1[3] * cp1;
        *(unsigned*)(zc + (32 * tq + t) * RG_ZS + 2 * k2) = pack2(y0, y1);
        am2 = am1; cm2 = cm1; am1 = a0; cm1 = c0; a0 = ap1; c0 = cp1;
    }
}
__device__ __forceinline__ float gelu_fast(float v) {
    const float av = fabsf(v), t = __builtin_amdgcn_rcpf(av * 0.2316418882f + 1.0f);
    float q = t * 0.5307027145f + (-0.7265760135f); q = q * t + 0.7107068705f; q = q * t + (-0.142248368f); q = q * t + 0.127414796f; q = q * t;
    const float e = __builtin_amdgcn_exp2f(v * v * (-0.72134752044f));
    const float m = v * (q * e);
    return v < 0.f ? m : v - m;
}
struct RgCtx { bf16x8 wr[4], wi[4]; float br, bi, coef; };
__device__ __forceinline__ void rg_ctx_load(const Params& p, int n, int cl, int dir, RgCtx& c) {
    const int lane = otid() & 63, fr = lane & 15, fq = lane >> 4, ch = n * 128 + cl + fr;
    const bf16_t* gr = p.wt_gate + ((size_t)(dir * 2 + 0) * 10 + n) * 16384 + (size_t)(cl + fr) * 128 + 8 * fq;
    const bf16_t* gi = p.wt_gate + ((size_t)(dir * 2 + 1) * 10 + n) * 16384 + (size_t)(cl + fr) * 128 + 8 * fq;
#pragma unroll
    for (int s = 0; s < 4; ++s) { c.wr[s] = *(const bf16x8*)(gr + 32 * s); c.wi[s] = *(const bf16x8*)(gi + 32 * s); }
    c.br = p.od_gate_b[(dir * 2 + 0) * RGW + ch]; c.bi = p.od_gate_b[(dir * 2 + 1) * RGW + ch];
    const float lam = p.od_lambda[dir * RGW + ch];
    c.coef = -8.0f * (fmaxf(-lam, 0.f) + log1pf(expf(-fabsf(lam)))) * 1.4426950408889634f;
}
__device__ __forceinline__ void rg_tile(const bf16_t* zc, int mt, int cl, const RgCtx& c, f32x4& a4, f32x4& x4) {
    const int lane = otid() & 63, fr = lane & 15, fq = lane >> 4;
    f32x4 r = (f32x4){0.f, 0.f, 0.f, 0.f}, ig = (f32x4){0.f, 0.f, 0.f, 0.f};
#pragma unroll
    for (int s = 0; s < 4; ++s) {
        const bf16x8 a = *(const bf16x8*)(zc + (16 * mt + fr) * RG_ZS + 32 * s + 8 * fq);
        r = __builtin_amdgcn_mfma_f32_16x16x32_bf16(a, c.wr[s], r, 0, 0, 0);
        ig = __builtin_amdgcn_mfma_f32_16x16x32_bf16(a, c.wi[s], ig, 0, 0, 0);
    }
#pragma unroll
    for (int rg = 0; rg < 4; ++rg) {
        const float rr = __builtin_amdgcn_rcpf(1.0f + __builtin_amdgcn_exp2f(-1.4426950408889634f * (r[rg] + c.br)));
        const float ii = __builtin_amdgcn_rcpf(1.0f + __builtin_amdgcn_exp2f(-1.4426950408889634f * (ig[rg] + c.bi)));
        const float a = __builtin_amdgcn_exp2f(c.coef * rr);
        const float z = bf2f(zc[(16 * mt + 4 * fq + rg) * RG_ZS + cl + fr]);
        a4[rg] = a; x4[rg] = sqrtf((1.0f - a) * (1.0f + a)) * ii * z;
    }
}
template <int DIR> __device__ __forceinline__ void rg_sum_dir(const Params& p, const bf16_t* zc, int b, int c34, int n, int cl, float* SUM) {
    const int lane = otid() & 63, fr = lane & 15, fq = lane >> 4;
    RgCtx c; rg_ctx_load(p, n, cl, DIR, c);
    float h = 0.f, pt = 1.f;
#pragma unroll 2
    for (int m2 = 0; m2 < 8; ++m2) {
        const int mt = DIR == 0 ? m2 : 7 - m2;
        f32x4 a, x; rg_tile(zc, mt, cl, c, a, x);
        const float P4 = a[0] * a[1] * a[2] * a[3];
        const float B4 = DIR == 0 ? ((x[0] * a[1] + x[1]) * a[2] + x[2]) * a[3] + x[3] : ((x[3] * a[2] + x[2]) * a[1] + x[1]) * a[0] + x[0];
#pragma unroll
        for (int g2 = 0; g2 < 4; ++g2) {
            const int gs = DIR == 0 ? g2 : 3 - g2;
            const float Pg = __shfl(P4, 16 * gs + fr), Bg = __shfl(B4, 16 * gs + fr);
            h = Pg * h + Bg; pt *= Pg;
        }
    }
    if (fq == 0) { float* dst = SUM + ((((size_t)b * 34 + c34) * 2 + DIR) * RGW + n * 128 + cl + fr) * 2; dst[0] = pt; dst[1] = h; }
}
__device__ __forceinline__ void ph_rg_a(const Params& p, unsigned char* smem) {
    bf16_t* zc = (bf16_t*)smem;
    float* SUM = (float*)p.G;
    const int wid = otid() >> 6;
    for (int u = blockIdx.x; u < NB * 34 * 10; u += gridDim.x) {
        const int b = u / 340, c34 = (u / 10) % 34, n = u % 10;
        __syncthreads();
        rg_stage_z(p, b, c34, n, zc);
        __syncthreads();
        for (int nt = 0; nt < 2; ++nt) {
            const int cl = 32 * wid + 16 * nt;
            rg_sum_dir<0>(p, zc, b, c34, n, cl, SUM);
            rg_sum_dir<1>(p, zc, b, c34, n, cl, SUM);
        }
    }
}
__device__ __forceinline__ void ph_rg_b(const Params& p) {
    const float* SUM = (const float*)p.G; float* HIN = (float*)(p.G + RG_SUM_BYTES);
    for (int gid = blockIdx.x * 256 + threadIdx.x; gid < NB * 2 * RGW; gid += gridDim.x * 256) {
        const int ch = gid % RGW, dir = (gid / RGW) & 1, b = gid / (2 * RGW);
        float h = 0.f;
#pragma unroll 2
        for (int step = 0; step < 34; ++step) {
            const int c34 = dir == 0 ? step : (step < 2 ? 1 - step : 35 - step);
            const size_t o = (((size_t)b * 34 + c34) * 2 + dir) * RGW + ch;
            HIN[o] = h;
            h = SUM[o * 2] * h + SUM[o * 2 + 1];
        }
    }
}
template <int DIR> __device__ __forceinline__ void rg_apply_dir(const Params& p, const bf16_t* zc, bf16_t* yf, int b, int c34, int n, int cl, const float* HIN) {
    const int lane = otid() & 63, fr = lane & 15, fq = lane >> 4, ch = n * 128 + cl + fr;
    RgCtx c; rg_ctx_load(p, n, cl, DIR, c);
    float h = HIN[(((size_t)b * 34 + c34) * 2 + DIR) * RGW + ch];
#pragma unroll 2
    for (int m2 = 0; m2 < 8; ++m2) {
        const int mt = DIR == 0 ? m2 : 7 - m2;
        f32x4 a, x; rg_tile(zc, mt, cl, c, a, x);
        const float P4 = a[0] * a[1] * a[2] * a[3];
        const float B4 = DIR == 0 ? ((x[0] * a[1] + x[1]) * a[2] + x[2]) * a[3] + x[3] : ((x[3] * a[2] + x[2]) * a[1] + x[1]) * a[0] + x[0];
        float hin = 0.f;
#pragma unroll
        for (int g2 = 0; g2 < 4; ++g2) {
            const int gs = DIR == 0 ? g2 : 3 - g2;
            const float Pg = __shfl(P4, 16 * gs + fr), Bg = __shfl(B4, 16 * gs + fr);
            if (fq == gs) hin = h;
            h = Pg * h + Bg;
        }
        f32x4 y;
        if (DIR == 0) {
            y[0] = a[0] * hin + x[0]; y[1] = a[1] * y[0] + x[1]; y[2] = a[2] * y[1] + x[2]; y[3] = a[3] * y[2] + x[3];
#pragma unroll
            for (int rg = 0; rg < 4; ++rg) yf[(16 * mt + 4 * fq + rg) * 16 + fr] = f2bf(y[rg]);
        } else {
            y[3] = a[3] * hin + x[3]; y[2] = a[2] * y[3] + x[2]; y[1] = a[1] * y[2] + x[1]; y[0] = a[0] * y[1] + x[0];
#pragma unroll
            for (int rg = 0; rg < 4; ++rg) {
                bf16_t* pb = p.P + ((size_t)b * PB + c34 * 128 + 16 * mt + 4 * fq + rg) * 2560 + ch;
                *pb = f2bf(gelu_fast(bf2f(*pb)) * (y[rg] + bf2f(yf[(16 * mt + 4 * fq + rg) * 16 + fr])));
            }
        }
    }
}
__device__ __forceinline__ void ph_rg_c(const Params& p, unsigned char* smem) {
    bf16_t* zc = (bf16_t*)smem;
    const float* HIN = (const float*)(p.G + RG_SUM_BYTES);
    const int wid = otid() >> 6;
    bf16_t* yf = (bf16_t*)(smem + 128 * RG_ZS * 2) + wid * 2048;
    for (int u = blockIdx.x; u < NB * 32 * 10; u += gridDim.x) {
        const int b = u / 320, c34 = 2 + (u / 10) % 32, n = u % 10;
        __syncthreads();
        rg_stage_z(p, b, c34, n, zc);
        __syncthreads();
        for (int nt = 0; nt < 2; ++nt) {
            const int cl = 32 * wid + 16 * nt;
            rg_apply_dir<0>(p, zc, yf, b, c34, n, cl, HIN);
            rg_apply_dir<1>(p, zc, yf, b, c34, n, cl, HIN);
        }
    }
}

#define XB_TMO      128
#define XB_XCNT(j)  (256  + 64 * (j))
#define XB_XSUB(j)  (1280 + 64 * (j))
#define XB_XGEN(j)  (2304 + 64 * (j))
#define XB_TOP      3328
#define XB_TOPGEN   3392
#define XCD_BAR_WORDS 3456
#define XB_SPIN_CAP (1u << 22)
#define LAS __attribute__((address_space(3)))
__device__ __forceinline__ unsigned xb_ld(unsigned* p) { return __hip_atomic_load(p, __ATOMIC_RELAXED, __HIP_MEMORY_SCOPE_AGENT); }
__device__ __forceinline__ unsigned xb_add(unsigned* p, unsigned v) { return __hip_atomic_fetch_add(p, v, __ATOMIC_RELAXED, __HIP_MEMORY_SCOPE_AGENT); }
__device__ __forceinline__ unsigned xb_xcc_id() { return (unsigned)__builtin_amdgcn_s_getreg((3 << 11) | 20) & 0xFu; }
#define XB_SPIN(cond, bar) do { unsigned _sp = 0; while (cond) { __builtin_amdgcn_s_sleep(1); \
    if ((++_sp & 255u) == 0u) { if (xb_ld(&(bar)[XB_TMO])) break; if (_sp > XB_SPIN_CAP) { atomicAdd(&(bar)[XB_TMO], 1u); break; } } } } while (0)
struct XcdBarrier { unsigned* bar; unsigned x; volatile LAS unsigned* st; };
__device__ __forceinline__ XcdBarrier xcd_barrier_post(unsigned* bar, volatile LAS unsigned* st) {
    XcdBarrier b; b.bar = bar; b.x = xb_xcc_id(); b.st = st;
    if (threadIdx.x == 0) (void)xb_add(&bar[XB_XCNT(b.x)], 1u);
    return b;
}
__device__ __forceinline__ void xcd_barrier_complete(unsigned* bar, unsigned x, unsigned& nloc, unsigned& nx) {
    const unsigned G = gridDim.x * gridDim.y * gridDim.z;
    unsigned sum, cnt, mine, sp = 0u;
    for (;;) {
        sum = 0u; cnt = 0u; mine = 0u;
#pragma unroll
        for (unsigned j = 0; j < 16; ++j) { const unsigned c = xb_ld(&bar[XB_XCNT(j)]); sum += c; cnt += (c > 0u) ? 1u : 0u; mine = (j == x) ? c : mine; }
        if (sum == G) break;
        __builtin_amdgcn_s_sleep(1);
        if ((++sp & 255u) == 0u) { if (xb_ld(&bar[XB_TMO])) break; if (sp > XB_SPIN_CAP) { atomicAdd(&bar[XB_TMO], 1u); break; } }
    }
    nloc = mine > 0u ? mine : 1u; nx = cnt > 0u ? cnt : 1u;
}
__device__ __forceinline__ void xcd_barrier(const XcdBarrier& b) {
    asm volatile("s_waitcnt vmcnt(0)" ::: "memory");
    __syncthreads();
    if (threadIdx.x == 0) {
        unsigned* bar = b.bar;
        __builtin_amdgcn_s_waitcnt(0);
        unsigned nloc = b.st[0], nx = b.st[1];
        if (nloc == 0u) { xcd_barrier_complete(bar, b.x, nloc, nx); b.st[0] = nloc; b.st[1] = nx; }
        const unsigned old = xb_add(&bar[XB_XSUB(b.x)], 1u);
        const unsigned gen = old / nloc;
        if (old + 1u == (gen + 1u) * nloc) {
            __builtin_amdgcn_fence(__ATOMIC_RELEASE, "agent");
            asm volatile("s_waitcnt vmcnt(0)" ::: "memory");
            const unsigned og = xb_add(&bar[XB_TOP], 1u);
            const unsigned tg = og / nx;
            if (og + 1u == (tg + 1u) * nx) xb_add(&bar[XB_TOPGEN], 1u);
            else XB_SPIN(xb_ld(&bar[XB_TOPGEN]) == tg, bar);
            __builtin_amdgcn_fence(__ATOMIC_ACQUIRE, "agent");
            xb_add(&bar[XB_XGEN(b.x)], 1u);
            asm volatile("s_waitcnt vmcnt(0)" ::: "memory");
        } else {
            XB_SPIN(xb_ld(&bar[XB_XGEN(b.x)]) == gen, bar);
            __builtin_amdgcn_fence(__ATOMIC_ACQUIRE, "agent");
            asm volatile("s_waitcnt vmcnt(0)" ::: "memory");
        }
    }
    __syncthreads();
}

#define SMEM_DECL __shared__ __attribute__((aligned(16))) unsigned char smem[65536]
__global__ void __launch_bounds__(256) k_prologue(Params p) { SMEM_DECL; ph_prologue(p, smem); }
__global__ void __launch_bounds__(256) k_modulate0(Params p) { ph_modulate0(p); }
__global__ void __launch_bounds__(256) k_gemm_ev_in(Params p) { SMEM_DECL; gemm_phase(p.A16, D, p.wt_ev_in, 1024, EV_IN, RowMap{0}, EpiBf16{p.P, EV_IN, EV_IN}, smem); }
__global__ void __launch_bounds__(256) k_rowpost(Params p) { ph_rowpost(p); }
__global__ void __launch_bounds__(256) k_gemm_q(Params p) { SMEM_DECL; gemm_phase(p.P + C_CQ, EV_IN, p.wt_uq, 384, 768, RowMap{0}, EpiQ{p.Q16, p.rsq, p.rope_cos, p.rope_sin}, smem); }
__global__ void __launch_bounds__(256) k_gemm_kv(Params p) { SMEM_DECL; gemm_phase(p.P + C_CKV, EV_IN, p.wt_ukv, 256, 1024, RowMap{0}, EpiKV{p.K16, p.V16, p.rsq + R}, smem); }
__global__ void __launch_bounds__(256) k_gemm_ev_out(Params p) { SMEM_DECL; gemm_phase(p.A16, D, p.wt_ev_out, 1024, 1024, RowMap{0}, EpiResid{p.x, p.ctx, p.mod, p.H, 0}, smem); }
__global__ void __launch_bounds__(256) k_ln_mod(Params p, int layer, int lat_only) { ph_ln_mod(p, layer, 0, lat_only); }
__global__ void __launch_bounds__(256) k_gemm_pq(Params p, int layer, int lat_only) { SMEM_DECL; gemm_phase(p.A16, D, p.wt_pq + (size_t)layer * 2048 * 1024, 1024, 2048, RowMap{lat_only}, EpiBf16{p.P, 2048, 2048}, smem); }
__global__ void __launch_bounds__(256) k_combine(Params p, int lat_only) { ph_combine(p, lat_only); }
__global__ void __launch_bounds__(256) k_gather(Params p, int layer, int lat_only) { ph_gather_ln(p, layer, lat_only); }
__global__ void __launch_bounds__(256) k_gemm_od_in(Params p) { SMEM_DECL; gemm_phase(p.A16, D, p.wt_od_in, 1024, 2560, RowMap{0}, EpiBf16{p.P, 2560, 2560}, smem); }
__global__ void __launch_bounds__(256) k_gemm_od_out(Params p) { SMEM_DECL; gemm_phase(p.P, 2560, p.wt_od_out, 1280, 1024, RowMap{1}, EpiResid{p.x, p.ctx, p.mod, p.H, 1}, smem); }

__global__ void __launch_bounds__(256, 2) k_mega(Params p) {
    SMEM_DECL;
    cg::grid_group grid = cg::this_grid();
    volatile LAS unsigned* xst = (volatile LAS unsigned*)(LAS unsigned char*)(smem + 65520);
    if (threadIdx.x == 0) { xst[0] = 0u; xst[1] = 0u; }
    if (blockIdx.x == 0) for (int i = threadIdx.x; i < XCD_BAR_WORDS; i += 256) p.bar[i] = 0u;
    ph_prologue(p, smem); grid.sync();
    const XcdBarrier xb = xcd_barrier_post(p.bar, xst);
    ph_modulate0(p); xcd_barrier(xb);
    gemm_phase(p.A16, D, p.wt_ev_in, 1024, EV_IN, RowMap{0}, EpiBf16{p.P, EV_IN, EV_IN}, smem); xcd_barrier(xb);
    ph_rowpost(p); ph_gla_a(p, smem); xcd_barrier(xb);
    gemm_phase(p.P + C_CQ, EV_IN, p.wt_uq, 384, 768, RowMap{0}, EpiQ{p.Q16, p.rsq, p.rope_cos, p.rope_sin}, smem);
    gemm_phase(p.P + C_CKV, EV_IN, p.wt_ukv, 256, 1024, RowMap{0}, EpiKV{p.K16, p.V16, p.rsq + R}, smem); ph_gla_b(p); xcd_barrier(xb);
    ph_gla_c(p, smem); ph_attn(p, smem, blockIdx.x, gridDim.x); xcd_barrier(xb);
    gemm_phase(p.A16, D, p.wt_ev_out, 1024, 1024, RowMap{0}, EpiResid{p.x, p.ctx, p.mod, p.H, 0}, smem); xcd_barrier(xb);
    ph_ln_mod(p, 0, 0, 0); xcd_barrier(xb);
    gemm_phase(p.A16, D, p.wt_pq, 1024, 2048, RowMap{0}, EpiBf16{p.P, 2048, 2048}, smem); xcd_barrier(xb);
    ph_scores(p, 0, 0, smem); xcd_barrier(xb);
    ph_combine(p, 0); ph_convert_uv(p, 0); xcd_barrier(xb);
    ph_gather_mfma(p, 0, 0, smem); xcd_barrier(xb);
    gemm_phase(p.A16, D, p.wt_od_in, 1024, 2560, RowMap{0}, EpiBf16{p.P, 2560, 2560}, smem); xcd_barrier(xb);
    ph_rg_a(p, smem); xcd_barrier(xb);
    ph_rg_b(p); xcd_barrier(xb);
    ph_rg_c(p, smem); xcd_barrier(xb);
    gemm_phase(p.P, 2560, p.wt_od_out, 1280, 1024, RowMap{1}, EpiResid{p.x, p.ctx, p.mod, p.H, 1}, smem); xcd_barrier(xb);
    ph_ln_mod(p, 1, 0, 1); xcd_barrier(xb);
    gemm_phase(p.A16, D, p.wt_pq + (size_t)2048 * 1024, 1024, 2048, RowMap{1}, EpiBf16{p.P, 2048, 2048}, smem); xcd_barrier(xb);
    ph_scores(p, 1, 1, smem); xcd_barrier(xb);
    ph_combine(p, 1); ph_convert_uv(p, 1); xcd_barrier(xb);
    ph_gather_mfma(p, 1, 1, smem);
}

extern "C" void kernel_launch(void* const* d_in, const int* in_sizes, int n_in, void* d_out, int out_size, void* d_ws, size_t ws_size, hipStream_t stream) {
    Params p{};
    const float** f = (const float**)d_in;
    p.x = f[0]; p.c = f[1]; p.ctx = f[2]; p.c_ctx = f[3]; p.mod_w = f[4]; p.mod_b = f[5]; p.ln_g = f[6]; p.ln_b = f[7];
    p.ev_w_in = f[8]; p.ev_q_norm = f[9]; p.ev_kv_norm = f[10]; p.ev_w_uq = f[11]; p.ev_w_ukv = f[12]; p.ev_gla_wa2 = f[13]; p.ev_gla_ba = f[14]; p.ev_gla_norm = f[15]; p.ev_w_out = f[16];
    p.od_w_in = f[17]; p.od_conv_w = f[18]; p.od_conv_b = f[19]; p.od_gate_w = f[20]; p.od_gate_b = f[21]; p.od_lambda = f[22]; p.od_w_out = f[23];
    p.peer_wq = f[24]; p.peer_k1 = f[25]; p.peer_k2 = f[26]; p.peer_u = f[27]; p.peer_v = f[28];
    p.out = (float*)d_out;
    unsigned char* w = (unsigned char*)d_ws; size_t off = 0;
    auto take = [&](size_t bytes) { unsigned char* r = w + off; off += (bytes + 255) & ~(size_t)255; return r; };
    p.wt_ev_in = (bf16_t*)take((size_t)EV_IN * 1024 * 2); p.wt_uq = (bf16_t*)take(768 * 384 * 2); p.wt_ukv = (bf16_t*)take(1024 * 256 * 2);
    p.wt_ev_out = (bf16_t*)take(1024 * 1024 * 2); p.wt_od_in = (bf16_t*)take(2560 * 1024 * 2); p.wt_gate = (bf16_t*)take(40 * 16384 * 2);
    p.wt_od_out = (bf16_t*)take(1024 * 1280 * 2); p.wt_pq = (bf16_t*)take((size_t)2 * 2048 * 1024 * 2); p.wt_k = (bf16_t*)take(4 * 16384 * 2);
    p.mod = (float*)take(2 * 9 * 6144 * 4); p.rope_cos = (float*)take(SEQ * 16 * 4); p.rope_sin = (float*)take(SEQ * 16 * 4); p.rsq = (float*)take((size_t)2 * R * 4);
    p.H = (float*)take((size_t)R * D * 4);
    p.Q16 = (bf16_t*)p.H; p.K16 = p.Q16 + (size_t)R * 768; p.V16 = p.K16 + (size_t)R * 768;
    p.A16 = (bf16_t*)take((size_t)R * D * 2);
    p.P = (bf16_t*)take((size_t)R * 2560 * 2);
    p.G = take((size_t)94371840);
    p.bar = (unsigned*)take(XCD_BAR_WORDS * 4);
    if (off > ws_size) { fprintf(stderr, "workspace too small: need %zu have %zu\n", off, ws_size); return; }
    static int grid_blocks = 0;
    if (!grid_blocks) {
        int dev = 0, cus = 0, per_cu = 0;
        (void)hipGetDevice(&dev);
        (void)hipDeviceGetAttribute(&cus, hipDeviceAttributeMultiprocessorCount, dev);
        (void)hipOccupancyMaxActiveBlocksPerMultiprocessor(&per_cu, k_mega, 256, 0);
        if (per_cu > 2) per_cu = 2;
        if (per_cu < 1) per_cu = 1;
        grid_blocks = cus * per_cu;
    }
    void* args[] = {&p};
    hipError_t e = hipLaunchCooperativeKernel((void*)k_mega, dim3(grid_blocks), dim3(256), args, 0, stream);
    if (e != hipSuccess) fprintf(stderr, "cooperative launch failed: %s (grid %d)\n", hipGetErrorString(e), grid_blocks);
}
__global__ void __launch_bounds__(256) k_gather2(Params p, int layer, int lat_only) { SMEM_DECL; ph_gather_mfma(p, layer, lat_only, smem); }
__global__ void __launch_bounds__(256) k_rga(Params p) { SMEM_DECL; ph_rg_a(p, smem); }
__global__ void __launch_bounds__(256) k_rgc(Params p) { SMEM_DECL; ph_rg_c(p, smem); }
__global__ void __launch_bounds__(256) k_glaa(Params p) { SMEM_DECL; ph_gla_a(p, smem); }
__global__ void __launch_bounds__(256) k_glac(Params p) { SMEM_DECL; ph_gla_c(p, smem); }
__global__ void __launch_bounds__(256) k_attn2(Params p) { SMEM_DECL; ph_attn(p, smem, blockIdx.x, gridDim.x); }
```

```cpp
#include <hip/hip_runtime.h>
#include <hip/hip_cooperative_groups.h>
#include <cstdio>
#include <cstdint>

namespace cg = cooperative_groups;
typedef unsigned short bf16_t;
typedef short bf16x8 __attribute__((ext_vector_type(8)));
typedef float f32x4 __attribute__((ext_vector_type(4)));
typedef float f32x16 __attribute__((ext_vector_type(16)));
typedef unsigned u32x4 __attribute__((ext_vector_type(4)));
typedef unsigned u32x2 __attribute__((ext_vector_type(2)));

constexpr int D = 1024, NB = 8, SEQ = 4096, CTX = 256, PB = SEQ + CTX  , R = NB * PB  ;
constexpr int EV_IN = 2240, RGW = 1280;
constexpr int C_CQ = 0, C_CKV = 384, C_KPE = 640, C_GQ = 672, C_GK = 928, C_GV = 1184, C_GG = 1696, C_GAF = 2208;
constexpr float LN_EPS = 1e-6f, ALPHA = 1.41421356237f, MLA_SCALE = 0.10206207261596577f  ;
constexpr int PEER_N = 16384;

struct Params {
    const float *x, *c, *ctx, *c_ctx, *mod_w, *mod_b, *ln_g, *ln_b;
    const float *ev_w_in, *ev_q_norm, *ev_kv_norm, *ev_w_uq, *ev_w_ukv, *ev_gla_wa2, *ev_gla_ba, *ev_gla_norm, *ev_w_out;
    const float *od_w_in, *od_conv_w, *od_conv_b, *od_gate_w, *od_gate_b, *od_lambda, *od_w_out;
    const float *peer_wq, *peer_k1, *peer_k2, *peer_u, *peer_v;
    float* out;
    bf16_t *wt_ev_in, *wt_uq, *wt_ukv, *wt_ev_out, *wt_od_in, *wt_gate, *wt_od_out, *wt_pq, *wt_k;
    float *mod, *rope_cos, *rope_sin, *rsq;
    float* H; bf16_t *Q16, *K16, *V16;
    bf16_t* A16; bf16_t* P; unsigned char* G;
    unsigned* bar;
};

__device__ __forceinline__ bf16_t f2bf(float f) { unsigned u = __float_as_uint(f); u += 0x7fffu + ((u >> 16) & 1u); return (bf16_t)(u >> 16); }
__device__ __forceinline__ float bf2f(bf16_t h) { return __uint_as_float(((unsigned)h) << 16); }
__device__ __forceinline__ unsigned pack2(float a, float b) { unsigned r; asm volatile("v_cvt_pk_bf16_f32 %0, %1, %2" : "=v"(r) : "v"(a), "v"(b)); return r; }
__device__ __forceinline__ float silu_f(float x) { return x / (1.0f + expf(-x)); }
__device__ __forceinline__ float sigmoid_f(float x) { return 1.0f / (1.0f + expf(-x)); }
__device__ __forceinline__ float gelu_f(float x) { return 0.5f * x * (1.0f + erff(x * 0.70710678118654752f)); }
__device__ __forceinline__ float wave_sum(float v) {
#pragma unroll
    for (int o = 32; o > 0; o >>= 1) v += __shfl_xor(v, o);
    return v;
}
__device__ __forceinline__ int otid() { int t = threadIdx.x; asm volatile("" : "+v"(t)); return t; }
__device__ __forceinline__ int mod_row(int r) { const int b = r / PB, p = r - b * PB; return p < CTX ? 8 : b; }
__device__ __forceinline__ const float* in_row(const Params& P_, int r) {
    const int b = r / PB, p = r - b * PB;
    return p < CTX ? P_.ctx + ((size_t)b * CTX + p) * D : P_.x + ((size_t)b * SEQ + (p - CTX)) * D;
}

__device__ __forceinline__ void tconv_tile(const float* __restrict__ W, int K, int N, bf16_t* __restrict__ Wt, const float* __restrict__ rowscale, int tile, float* sm) {
    const int ntn = N / 64, tk = tile / ntn, tn = tile % ntn, tid = threadIdx.x;
#pragma unroll
    for (int i = 0; i < 4; ++i) {
        const int k = (tid >> 4) + 16 * i;
        f32x4 v = *(const f32x4*)(W + (size_t)(tk * 64 + k) * N + tn * 64 + (tid & 15) * 4);
        const float s = rowscale ? rowscale[tk * 64 + k] : 1.0f;
#pragma unroll
        for (int q = 0; q < 4; ++q) sm[k * 65 + (tid & 15) * 4 + q] = v[q] * s;
    }
    __syncthreads();
    const int n = tid >> 2, kc = tid & 3;
    unsigned w[8];
#pragma unroll
    for (int kk = 0; kk < 8; ++kk) w[kk] = pack2(sm[(kc * 16 + 2 * kk) * 65 + n], sm[(kc * 16 + 2 * kk + 1) * 65 + n]);
    bf16_t* dst = Wt + (size_t)(tn * 64 + n) * K + tk * 64 + kc * 16;
    *(u32x4*)dst = (u32x4){w[0], w[1], w[2], w[3]};
    *(u32x4*)(dst + 8) = (u32x4){w[4], w[5], w[6], w[7]};
    __syncthreads();
}
__device__ __forceinline__ void tconv_all(const float* W, int K, int N, bf16_t* Wt, const float* rowscale, float* sm) {
    const int nt = (K / 64) * (N / 64);
    for (int t = blockIdx.x; t < nt; t += gridDim.x) tconv_tile(W, K, N, Wt, rowscale, t, sm);
}

__device__ __forceinline__ void ph_prologue(const Params& p, unsigned char* smem) {
    float* sm = (float*)smem;
    tconv_all(p.ev_w_in, 1024, EV_IN, p.wt_ev_in, nullptr, sm);
    tconv_all(p.ev_w_uq, 384, 768, p.wt_uq, p.ev_q_norm, sm);
    tconv_all(p.ev_w_ukv, 256, 1024, p.wt_ukv, p.ev_kv_norm, sm);
    tconv_all(p.ev_w_out, 1024, 1024, p.wt_ev_out, nullptr, sm);
    tconv_all(p.od_w_in, 1024, 2560, p.wt_od_in, nullptr, sm);
    for (int g = 0; g < 40; ++g) tconv_all(p.od_gate_w + (size_t)g * 16384, 128, 128, p.wt_gate + (size_t)g * 16384, nullptr, sm);
    tconv_all(p.od_w_out, 1280, 1024, p.wt_od_out, nullptr, sm);
    for (int l = 0; l < 2; ++l) tconv_all(p.peer_wq + (size_t)l * 1024 * 2048, 1024, 2048, p.wt_pq + (size_t)l * 1024 * 2048, nullptr, sm);
    for (int i = blockIdx.x * 256 + threadIdx.x; i < 2 * 2 * 16384; i += gridDim.x * 256) {
        const int l = i / 32768, h = (i / 16384) & 1, e = i & 16383;
        p.wt_k[i] = f2bf((h ? p.peer_k2 : p.peer_k1)[(size_t)l * 16384 + e]);
    }
    for (int i = blockIdx.x * 256 + threadIdx.x; i < SEQ * 16; i += gridDim.x * 256) {
        const int s = i >> 4, f = i & 15;
        const float pos = (float)(f < 8 ? (s >> 6) : (s & 63));
        const float inv = powf(10000.0f, -(float)(f & 7) / 8.0f);
        const float ang = pos * inv;
        p.rope_cos[i] = cosf(ang); p.rope_sin[i] = sinf(ang);
    }
    float* sc = sm;
    for (int u = blockIdx.x; u < 2 * 96; u += gridDim.x) {
        const int l = u / 96, c0 = (u % 96) * 64, tid = threadIdx.x;
        __syncthreads();
        for (int i = tid; i < 9 * 1024; i += 256) { const int rr = i >> 10, k = i & 1023; sc[i] = silu_f(rr < 8 ? p.c[rr * 1024 + k] : p.c_ctx[k]); }
        __syncthreads();
        const int col = c0 + (tid & 63), kq = tid >> 6;
        float acc[9];
#pragma unroll
        for (int rr = 0; rr < 9; ++rr) acc[rr] = 0.f;
        const float* w = p.mod_w + (size_t)l * 1024 * 6144 + col;
        for (int k = kq * 256; k < kq * 256 + 256; ++k) {
            const float wv = w[(size_t)k * 6144];
#pragma unroll
            for (int rr = 0; rr < 9; ++rr) acc[rr] += sc[rr * 1024 + k] * wv;
        }
        __syncthreads();
        float* red = sm + 9 * 1024;
#pragma unroll
        for (int rr = 0; rr < 9; ++rr) red[(kq * 9 + rr) * 64 + (tid & 63)] = acc[rr];
        __syncthreads();
        for (int i = tid; i < 9 * 64; i += 256) {
            const int rr = i >> 6, cc = i & 63;
            const float s = red[(0 * 9 + rr) * 64 + cc] + red[(1 * 9 + rr) * 64 + cc] + red[(2 * 9 + rr) * 64 + cc] + red[(3 * 9 + rr) * 64 + cc];
            p.mod[((size_t)l * 9 + rr) * 6144 + c0 + cc] = s + p.mod_b[l * 6144 + c0 + cc];
        }
    }
}

__device__ __forceinline__ void ph_modulate0(const Params& p) {
    const int tid_ = otid(), wid = tid_ >> 6, lane = tid_ & 63;
    for (int u = blockIdx.x; u < R / 4; u += gridDim.x) {
        const int r = u * 4 + wid;
        const float* src = in_row(p, r);
        const float* md = p.mod + (size_t)(0 * 9 + mod_row(r)) * 6144;
#pragma unroll
        for (int q = 0; q < 4; ++q) {
            const int c = q * 256 + lane * 4;
            const f32x4 h = *(const f32x4*)(src + c), sh = *(const f32x4*)(md + c), scl = *(const f32x4*)(md + 1024 + c);
            const f32x4 v = h * (1.0f + scl) + sh;
            *(u32x2*)(p.A16 + (size_t)r * D + c) = (u32x2){pack2(v[0], v[1]), pack2(v[2], v[3])};
        }
    }
}

constexpr int GBK = 64, GLDS = 72  ;
struct RowMap { int lat_only; __device__ __forceinline__ int ntiles() const { return lat_only ? 256 : 272; }
    __device__ __forceinline__ int row0(int t) const { return lat_only ? (t >> 5) * PB + CTX + (t & 31) * 128 : t * 128; } };

template <class Epi>
__device__ __forceinline__ void gemm_phase(const bf16_t* __restrict__ A, int lda, const bf16_t* __restrict__ Bt, int K, int N, RowMap rm, const Epi& epi, unsigned char* smem) {
    bf16_t* sA = (bf16_t*)smem; bf16_t* sB = sA + 128 * GLDS;
    const int tid = otid(), lane = tid & 63, wid = tid >> 6, wm = wid >> 1, wn = wid & 1, fr = lane & 15, fq = lane >> 4;
    const int ntn = (N + 127) / 128, nunits = rm.ntiles() * ntn, nk = K / GBK;
    for (int u = blockIdx.x; u < nunits; u += gridDim.x) {
        const int tm = u / ntn, tn = u % ntn, m0 = rm.row0(tm), n0 = tn * 128;
        f32x4 acc[4][4];
#pragma unroll
        for (int i = 0; i < 4; ++i)
#pragma unroll
            for (int j = 0; j < 4; ++j) acc[i][j] = (f32x4){0.f, 0.f, 0.f, 0.f};
        u32x4 ra[4], rb[4];
        auto gload = [&](int kt) {
#pragma unroll
            for (int i = 0; i < 4; ++i) {
                const int id = tid + 256 * i, row = id >> 3, ch = id & 7;
                ra[i] = *(const u32x4*)(A + (size_t)(m0 + row) * lda + kt * GBK + ch * 8);
                int brow = n0 + row; brow = brow < N ? brow : N - 1;
                rb[i] = *(const u32x4*)(Bt + (size_t)brow * K + kt * GBK + ch * 8);
            }
        };
        auto lstore = [&]() {
#pragma unroll
            for (int i = 0; i < 4; ++i) {
                const int id = tid + 256 * i, row = id >> 3, ch = id & 7;
                *(u32x4*)(sA + row * GLDS + ch * 8) = ra[i];
                *(u32x4*)(sB + row * GLDS + ch * 8) = rb[i];
            }
        };
        gload(0);
        __syncthreads();
        lstore();
        __syncthreads();
        for (int kt = 0; kt < nk; ++kt) {
            if (kt + 1 < nk) gload(kt + 1);
#pragma unroll
            for (int ks = 0; ks < 2; ++ks) {
                bf16x8 af[4], bfr[4];
#pragma unroll
                for (int i = 0; i < 4; ++i) af[i] = *(const bf16x8*)(sA + (wm * 64 + i * 16 + fr) * GLDS + ks * 32 + fq * 8);
#pragma unroll
                for (int j = 0; j < 4; ++j) bfr[j] = *(const bf16x8*)(sB + (wn * 64 + j * 16 + fr) * GLDS + ks * 32 + fq * 8);
#pragma unroll
                for (int i = 0; i < 4; ++i)
#pragma unroll
                    for (int j = 0; j < 4; ++j) acc[i][j] = __builtin_amdgcn_mfma_f32_16x16x32_bf16(bfr[j], af[i], acc[i][j], 0, 0, 0);
            }
            __syncthreads();
            if (kt + 1 < nk) { lstore(); __syncthreads(); }
        }
        epi(acc, m0 + wm * 64, n0 + wn * 64, fr, fq);
    }
}

struct EpiBf16 {
    bf16_t* C; int ldc, N;
    __device__ __forceinline__ void operator()(const f32x4 (&acc)[4][4], int mb, int nb, int fr, int fq) const {
#pragma unroll
        for (int i = 0; i < 4; ++i)
#pragma unroll
            for (int j = 0; j < 4; ++j) {
                const int m = mb + i * 16 + fr, n = nb + j * 16 + 4 * fq;
                if (n < N) *(u32x2*)(C + (size_t)m * ldc + n) = (u32x2){pack2(acc[i][j][0], acc[i][j][1]), pack2(acc[i][j][2], acc[i][j][3])};
            }
    }
};
struct EpiQ {
    bf16_t* Q; const float *rsq, *rc, *rs;
    __device__ __forceinline__ void operator()(const f32x4 (&acc)[4][4], int mb, int nb, int fr, int fq) const {
#pragma unroll
        for (int i = 0; i < 4; ++i) {
            const int m = mb + i * 16 + fr, b = m / PB, pp = m - b * PB;
            const float sc = rsq[m] * (MLA_SCALE * 1.4426950408889634f);
#pragma unroll
            for (int j = 0; j < 4; j += 2) {
                const int n = nb + j * 16 + 4 * fq;
                f32x4 v0 = acc[i][j] * sc, v1 = acc[i][j + 1] * sc;
                const int d = n % 96;
                if (d >= 64 && pp >= CTX) {
                    const int s = pp - CTX, f = (d - 64) + 0;
                    const f32x4 cs = *(const f32x4*)(rc + s * 16 + f), sn = *(const f32x4*)(rs + s * 16 + f);
                    const f32x4 o0 = v0 * cs - v1 * sn, o1 = v0 * sn + v1 * cs; v0 = o0; v1 = o1;
                }
                *(u32x2*)(Q + (size_t)m * 768 + n) = (u32x2){pack2(v0[0], v0[1]), pack2(v0[2], v0[3])};
                *(u32x2*)(Q + (size_t)m * 768 + n + 16) = (u32x2){pack2(v1[0], v1[1]), pack2(v1[2], v1[3])};
            }
        }
    }
};
struct EpiKV {
    bf16_t *Kd, *Vd; const float* rsq;
    __device__ __forceinline__ void operator()(const f32x4 (&acc)[4][4], int mb, int nb, int fr, int fq) const {
#pragma unroll
        for (int i = 0; i < 4; ++i) {
            const int m = mb + i * 16 + fr; const float sc = rsq[m];
#pragma unroll
            for (int j = 0; j < 4; ++j) {
                const int n = nb + j * 16 + 4 * fq, hd = n >> 7, d = n & 127;
                const f32x4 v = acc[i][j] * sc;
                bf16_t* dst = d < 64 ? Kd + (size_t)m * 768 + hd * 96 + d : Vd + (size_t)m * 512 + hd * 64 + (d - 64);
                *(u32x2*)dst = (u32x2){pack2(v[0], v[1]), pack2(v[2], v[3])};
            }
        }
    }
};
struct EpiResid {
    const float *x, *ctx, *mod; float* H; int layer;
    __device__ __forceinline__ void operator()(const f32x4 (&acc)[4][4], int mb, int nb, int fr, int fq) const {
#pragma unroll
        for (int i = 0; i < 4; ++i) {
            const int m = mb + i * 16 + fr, b = m / PB, pp = m - b * PB;
            const float* hin = layer == 0 ? (pp < CTX ? ctx + ((size_t)b * CTX + pp) * D : x + ((size_t)b * SEQ + (pp - CTX)) * D) : H + (size_t)m * D;
            const float* gate = mod + ((size_t)layer * 9 + (pp < CTX ? 8 : b)) * 6144 + 2 * 1024;
#pragma unroll
            for (int j = 0; j < 4; ++j) {
                const int n = nb + j * 16 + 4 * fq;
                const f32x4 h = *(const f32x4*)(hin + n), g = *(const f32x4*)(gate + n);
                *(f32x4*)(H + (size_t)m * D + n) = ALPHA * h + g * acc[i][j];
            }
        }
    }
};

__device__ __forceinline__ void ph_rowpost(const Params& p) {
    const int tid_ = otid(), wid = tid_ >> 6, lane = tid_ & 63;
    for (int u = blockIdx.x; u < R / 4; u += gridDim.x) {
        const int r = u * 4 + wid, b = r / PB, pp = r - b * PB;
        const bf16_t* row = p.P + (size_t)r * EV_IN;
        float sq = 0.f, skv = 0.f;
#pragma unroll
        for (int i = 0; i < 10; ++i) { const float v = bf2f(row[lane + 64 * i]); if (i < 6) sq += v * v; else skv += v * v; }
        sq = wave_sum(sq); skv = wave_sum(skv);
        if (lane == 0) { p.rsq[r] = rsqrtf(sq / 384.0f + LN_EPS); p.rsq[R + r] = rsqrtf(skv / 256.0f + LN_EPS); }
        if (lane < 16) {
            float x1 = bf2f(row[C_KPE + lane]), x2 = bf2f(row[C_KPE + 16 + lane]);
            if (pp >= CTX) { const int s = pp - CTX; const float cs = p.rope_cos[s * 16 + lane], sn = p.rope_sin[s * 16 + lane];
                const float o1 = x1 * cs - x2 * sn, o2 = x1 * sn + x2 * cs; x1 = o1; x2 = o2; }
            const bf16_t b1 = f2bf(x1), b2 = f2bf(x2);
#pragma unroll
            for (int hd = 0; hd < 8; ++hd) { p.K16[(size_t)r * 768 + hd * 96 + 64 + lane] = b1; p.K16[(size_t)r * 768 + hd * 96 + 80 + lane] = b2; }
        }
    }
}

constexpr int AT_KS = 104, AT_VS = 68, AT_BUF = 64 * AT_KS * 2 + 64 * AT_VS * 2;
__device__ __forceinline__ void ph_attn(const Params& p, unsigned char* smem, int bid, int nblk) {
    const int tid = otid(), wid = tid >> 6, lane = tid & 63, q = lane & 31, h = lane >> 5;
    for (int u = bid; u < 2048 + 128; u += nblk) {
        int b, hd, q0, nkeys;
        if (u < 2048) { b = u >> 8; hd = (u >> 5) & 7; q0 = CTX + (u & 31) * 128; nkeys = PB; }
        else { const int v = u - 2048; b = v >> 4; hd = (v >> 1) & 7; q0 = (v & 1) * 128; nkeys = CTX; }
        const size_t rq = (size_t)b * PB + q0 + wid * 32 + q;
        bf16x8 qf[6];
#pragma unroll
        for (int s = 0; s < 6; ++s) qf[s] = *(const bf16x8*)(p.Q16 + rq * 768 + hd * 96 + 16 * s + 8 * h);
        f32x16 o[2];
#pragma unroll
        for (int i = 0; i < 16; ++i) { o[0][i] = 0.f; o[1][i] = 0.f; }
        float m = -1e30f, l = 0.f;
        const int ntiles = nkeys / 64;
        const bf16_t* Kg = p.K16 + (size_t)b * PB * 768 + hd * 96;
        const bf16_t* Vg = p.V16 + (size_t)b * PB * 512 + hd * 64;
        u32x4 rk[3], rv[2];
        auto gload = [&](int t) {
#pragma unroll
            for (int i = 0; i < 3; ++i) { const int id = tid + 256 * i, key = id / 12, ch = id % 12; rk[i] = *(const u32x4*)(Kg + (size_t)(t * 64 + key) * 768 + ch * 8); }
#pragma unroll
            for (int i = 0; i < 2; ++i) { const int id = tid + 256 * i, key = id >> 3, dch = id & 7; rv[i] = *(const u32x4*)(Vg + (size_t)(t * 64 + key) * 512 + dch * 8); }
        };
        auto lstore = [&](int buf) {
            bf16_t* Ks = (bf16_t*)(smem + buf * AT_BUF); bf16_t* Vt = Ks + 64 * AT_KS;
#pragma unroll
            for (int i = 0; i < 3; ++i) { const int id = tid + 256 * i, key = id / 12, ch = id % 12; *(u32x4*)(Ks + key * AT_KS + ch * 8) = rk[i]; }
#pragma unroll
            for (int i = 0; i < 2; ++i) {
                const int id = tid + 256 * i, key = id >> 3, dch = id & 7;
#pragma unroll
                for (int e = 0; e < 4; ++e) { Vt[(dch * 8 + 2 * e) * AT_VS + key] = (bf16_t)(rv[i][e] & 0xffffu); Vt[(dch * 8 + 2 * e + 1) * AT_VS + key] = (bf16_t)(rv[i][e] >> 16); }
            }
        };
        __syncthreads();
        gload(0); lstore(0);
        __syncthreads();
        for (int t = 0; t < ntiles; ++t) {
            if (t + 1 < ntiles) gload(t + 1);
            const bf16_t* Ks = (const bf16_t*)(smem + (t & 1) * AT_BUF); const bf16_t* Vt = Ks + 64 * AT_KS;
            f32x16 sa[2];
#pragma unroll
            for (int kb = 0; kb < 2; ++kb) {
#pragma unroll
                for (int i = 0; i < 16; ++i) sa[kb][i] = 0.f;
#pragma unroll
                for (int s = 0; s < 6; ++s) {
                    const bf16x8 kf = *(const bf16x8*)(Ks + (kb * 32 + q) * AT_KS + 16 * s + 8 * h);
                    sa[kb] = __builtin_amdgcn_mfma_f32_32x32x16_bf16(kf, qf[s], sa[kb], 0, 0, 0);
                }
            }
            float mx = sa[0][0];
#pragma unroll
            for (int i = 1; i < 16; ++i) mx = fmaxf(mx, sa[0][i]);
#pragma unroll
            for (int i = 0; i < 16; ++i) mx = fmaxf(mx, sa[1][i]);
            mx = fmaxf(mx, __shfl_xor(mx, 32));
            const float mn = fmaxf(m, mx), al = __builtin_amdgcn_exp2f(m - mn);
            m = mn;
            float ps = 0.f;
#pragma unroll
            for (int kb = 0; kb < 2; ++kb)
#pragma unroll
                for (int i = 0; i < 16; ++i) { const float e = __builtin_amdgcn_exp2f(sa[kb][i] - mn); sa[kb][i] = e; ps += e; }
            l = l * al + ps;
#pragma unroll
            for (int i = 0; i < 16; ++i) { o[0][i] *= al; o[1][i] *= al; }
#pragma unroll
            for (int kb = 0; kb < 2; ++kb)
#pragma unroll
                for (int s2 = 0; s2 < 2; ++s2) {
                    u32x4 pw;
#pragma unroll
                    for (int e = 0; e < 4; ++e) pw[e] = pack2(sa[kb][8 * s2 + 2 * e], sa[kb][8 * s2 + 2 * e + 1]);
                    const bf16x8 pf = __builtin_bit_cast(bf16x8, pw);
                    const int base = kb * 32 + 16 * s2;
#pragma unroll
                    for (int db = 0; db < 2; ++db) {
                        const bf16_t* vp = Vt + (db * 32 + q) * AT_VS + base + 4 * h;
                        const u32x2 v0 = *(const u32x2*)vp, v1 = *(const u32x2*)(vp + 8);
                        const bf16x8 vf = __builtin_bit_cast(bf16x8, (u32x4){v0[0], v0[1], v1[0], v1[1]});
                        o[db] = __builtin_amdgcn_mfma_f32_32x32x16_bf16(vf, pf, o[db], 0, 0, 0);
                    }
                }
            if (t + 1 < ntiles) lstore((t + 1) & 1);
            __syncthreads();
        }
        l += __shfl_xor(l, 32);
        const float il = 1.0f / l;
#pragma unroll
        for (int db = 0; db < 2; ++db)
#pragma unroll
            for (int gq = 0; gq < 4; ++gq) {
                const int d = db * 32 + 8 * gq + 4 * h;
                *(u32x2*)(p.A16 + rq * D + hd * 64 + d) = (u32x2){pack2(o[db][4 * gq] * il, o[db][4 * gq + 1] * il), pack2(o[db][4 * gq + 2] * il, o[db][4 * gq + 3] * il)};
            }
    }
}

constexpr size_t GLA_KS_BYTES = (size_t)NB * 4 * 68 * 2 * 8192 * 2;
constexpr int GL_S = 72;
__device__ __forceinline__ void gla_cum(const Params& p, size_t row0, int hd, int dir, float* sga, float* spart, float (&c)[16], float& T) {
    const int tid = otid(), d = tid & 63, part = tid >> 6;
    {
        const int j = tid >> 2, g4 = tid & 3;
        const u32x2 w = *(const u32x2*)(p.P + (row0 + j) * EV_IN + C_GAF + dir * 16 + g4 * 4);
        sga[j * 16 + g4 * 4 + 0] = __uint_as_float(w[0] << 16); sga[j * 16 + g4 * 4 + 1] = __uint_as_float(w[0] & 0xffff0000u);
        sga[j * 16 + g4 * 4 + 2] = __uint_as_float(w[1] << 16); sga[j * 16 + g4 * 4 + 3] = __uint_as_float(w[1] & 0xffff0000u);
    }
    __syncthreads();
    float wc[16];
    const float* wa = p.ev_gla_wa2 + (size_t)dir * 16 * 256 + hd * 64 + d;
#pragma unroll
    for (int g = 0; g < 16; ++g) wc[g] = wa[g * 256];
    const float bias = p.ev_gla_ba[dir * 256 + hd * 64 + d];
    float lv[16]; float run = 0.f;
#pragma unroll
    for (int jj = 0; jj < 16; ++jj) {
        const int j = part * 16 + jj;
        float z = bias;
#pragma unroll
        for (int g = 0; g < 16; g += 4) { const f32x4 a = *(const f32x4*)(sga + j * 16 + g); z += a[0] * wc[g] + a[1] * wc[g + 1] + a[2] * wc[g + 2] + a[3] * wc[g + 3]; }
        const float ls = (fminf(z, 0.f) - log1pf(expf(-fabsf(z)))) * (1.0f / 16.0f);
        lv[jj] = ls; run += ls; c[jj] = run;
    }
    spart[part * 64 + d] = run;
    __syncthreads();
    float off = 0.f; T = 0.f;
#pragma unroll
    for (int pp = 0; pp < 4; ++pp) { const float v = spart[pp * 64 + d]; T += v; if (pp < part) off += v; }
#pragma unroll
    for (int jj = 0; jj < 16; ++jj) c[jj] = dir == 0 ? off + c[jj] : T - (off + c[jj]) + lv[jj];
}
__device__ __forceinline__ void gla_stage_vt(const Params& p, size_t row0, int hd, bf16_t* Vt) {
    const int tid = otid();
#pragma unroll
    for (int i = 0; i < 4; ++i) {
        const int id = tid + 256 * i, j = id >> 4, ech = id & 15;
        const u32x4 w = *(const u32x4*)(p.P + (row0 + j) * EV_IN + C_GV + hd * 128 + ech * 8);
#pragma unroll
        for (int e = 0; e < 4; ++e) { Vt[(ech * 8 + 2 * e) * GL_S + j] = (bf16_t)(w[e] & 0xffffu); Vt[(ech * 8 + 2 * e + 1) * GL_S + j] = (bf16_t)(w[e] >> 16); }
    }
}
__device__ __forceinline__ void ph_gla_a(const Params& p, unsigned char* smem) {
    bf16_t* kwT = (bf16_t*)smem; bf16_t* Vt = kwT + 64 * GL_S; float* sga = (float*)(Vt + 128 * GL_S); float* spart = sga + 1024;
    bf16_t* KS = (bf16_t*)p.G; float* DEC = (float*)(p.G + GLA_KS_BYTES);
    const int tid = otid(), lane = tid & 63, wid = tid >> 6, fr = lane & 15, fq = lane >> 4, d = tid & 63, part = tid >> 6;
    for (int u = blockIdx.x; u < NB * 4 * 68; u += gridDim.x) {
        const int b = u / 272, hd = (u / 68) & 3, ci = u % 68;
        const size_t row0 = (size_t)b * PB + ci * 64;
        __syncthreads();
        gla_stage_vt(p, row0, hd, Vt);
        for (int dir = 0; dir < 2; ++dir) {
            float c[16], T;
            gla_cum(p, row0, hd, dir, sga, spart, c, T);
            unsigned kw[8];
#pragma unroll
            for (int jj = 0; jj < 16; jj += 2) {
                const float k0 = bf2f(p.P[(row0 + part * 16 + jj) * EV_IN + C_GK + hd * 64 + d]), k1 = bf2f(p.P[(row0 + part * 16 + jj + 1) * EV_IN + C_GK + hd * 64 + d]);
                kw[jj >> 1] = pack2(k0 * expf(T - c[jj]), k1 * expf(T - c[jj + 1]));
            }
            *(u32x4*)(kwT + d * GL_S + part * 16) = (u32x4){kw[0], kw[1], kw[2], kw[3]};
            *(u32x4*)(kwT + d * GL_S + part * 16 + 8) = (u32x4){kw[4], kw[5], kw[6], kw[7]};
            if (part == 0) DEC[((size_t)u * 2 + dir) * 64 + d] = expf(T);
            __syncthreads();
            f32x4 acc[8];
#pragma unroll
            for (int et = 0; et < 8; ++et) acc[et] = (f32x4){0.f, 0.f, 0.f, 0.f};
#pragma unroll
            for (int s = 0; s < 2; ++s) {
                const bf16x8 a = *(const bf16x8*)(kwT + (16 * wid + fr) * GL_S + 32 * s + 8 * fq);
#pragma unroll
                for (int et = 0; et < 8; ++et) {
                    const bf16x8 bq = *(const bf16x8*)(Vt + (16 * et + fr) * GL_S + 32 * s + 8 * fq);
                    acc[et] = __builtin_amdgcn_mfma_f32_16x16x32_bf16(a, bq, acc[et], 0, 0, 0);
                }
            }
#pragma unroll
            for (int et = 0; et < 8; ++et)
                *(u32x2*)(KS + (((size_t)u * 2 + dir) * 128 + 16 * et + fr) * 64 + 16 * wid + 4 * fq) = (u32x2){pack2(acc[et][0], acc[et][1]), pack2(acc[et][2], acc[et][3])};
            __syncthreads();
        }
    }
}
__device__ __forceinline__ void ph_gla_b(const Params& p) {
    unsigned* KS32 = (unsigned*)p.G; const float* DEC = (const float*)(p.G + GLA_KS_BYTES);
    for (int gid = blockIdx.x * 256 + threadIdx.x; gid < 64 * 4096; gid += gridDim.x * 256) {
        const int seq = gid >> 12, pi = gid & 4095, dir = seq & 1, bh = seq >> 1, d = (2 * pi) & 63;
        float s0 = 0.f, s1 = 0.f;
#pragma unroll 4
        for (int step = 0; step < 68; ++step) {
            const int ci = dir == 0 ? step : (step < 4 ? 3 - step : 71 - step);
            const size_t ud = ((size_t)bh * 68 + ci) * 2 + dir;
            const unsigned w = KS32[ud * 4096 + pi];
            const float dc0 = DEC[ud * 64 + d], dc1 = DEC[ud * 64 + d + 1];
            KS32[ud * 4096 + pi] = pack2(s0, s1);
            s0 = dc0 * s0 + __uint_as_float(w << 16); s1 = dc1 * s1 + __uint_as_float(w & 0xffff0000u);
        }
    }
}
__device__ __forceinline__ void ph_gla_c(const Params& p, unsigned char* smem) {
    bf16_t* qs = (bf16_t*)smem; bf16_t* ks = qs + 64 * GL_S; bf16_t* Vt = ks + 64 * GL_S; float* sga = (float*)(Vt + 128 * GL_S); float* spart = sga + 1024;
    const bf16_t* KS = (const bf16_t*)p.G;
    const int tid = otid(), lane = tid & 63, wid = tid >> 6, fr = lane & 15, fq = lane >> 4, d = tid & 63, part = tid >> 6;
    for (int u = blockIdx.x; u < NB * 4 * 68; u += gridDim.x) {
        const int b = u / 272, hd = (u / 68) & 3, ci = u % 68;
        const size_t row0 = (size_t)b * PB + ci * 64;
        const int i = 16 * wid + fr;
        __syncthreads();
        gla_stage_vt(p, row0, hd, Vt);
        f32x4 oacc[8], pt[4];
#pragma unroll
        for (int et = 0; et < 8; ++et) oacc[et] = (f32x4){0.f, 0.f, 0.f, 0.f};
#pragma unroll
        for (int jt = 0; jt < 4; ++jt) pt[jt] = (f32x4){0.f, 0.f, 0.f, 0.f};
        for (int dir = 0; dir < 2; ++dir) {
            float c[16], T;
            gla_cum(p, row0, hd, dir, sga, spart, c, T);
#pragma unroll
            for (int jj = 0; jj < 16; ++jj) {
                const size_t ro = (row0 + part * 16 + jj) * EV_IN + hd * 64 + d;
                qs[(part * 16 + jj) * GL_S + d] = f2bf(bf2f(p.P[ro + C_GQ]) * 0.125f * expf(c[jj]));
                ks[(part * 16 + jj) * GL_S + d] = f2bf(bf2f(p.P[ro + C_GK]) * expf(-c[jj]));
            }
            __syncthreads();
            bf16x8 qf[2];
#pragma unroll
            for (int s = 0; s < 2; ++s) qf[s] = *(const bf16x8*)(qs + i * GL_S + 32 * s + 8 * fq);
#pragma unroll
            for (int jt = 0; jt < 4; ++jt) {
                f32x4 t = (f32x4){0.f, 0.f, 0.f, 0.f};
#pragma unroll
                for (int s = 0; s < 2; ++s) { const bf16x8 a = *(const bf16x8*)(ks + (16 * jt + fr) * GL_S + 32 * s + 8 * fq); t = __builtin_amdgcn_mfma_f32_16x16x32_bf16(a, qf[s], t, 0, 0, 0); }
#pragma unroll
                for (int rg = 0; rg < 4; ++rg) { const int j = 16 * jt + 4 * fq + rg; const bool keep = dir == 0 ? (j <= i) : (j >= i); pt[jt][rg] += keep ? t[rg] : 0.f; }
            }
            const bf16_t* Sg = KS + ((size_t)u * 2 + dir) * 8192;
#pragma unroll
            for (int et = 0; et < 8; ++et) {
#pragma unroll
                for (int s = 0; s < 2; ++s) { const bf16x8 a = *(const bf16x8*)(Sg + (16 * et + fr) * 64 + 32 * s + 8 * fq); oacc[et] = __builtin_amdgcn_mfma_f32_16x16x32_bf16(a, qf[s], oacc[et], 0, 0, 0); }
                if ((et & 3) == 3) __builtin_amdgcn_sched_barrier(0);
            }
            __syncthreads();
        }
#pragma unroll
        for (int k2 = 0; k2 < 2; ++k2) {
            const u32x4 pw = (u32x4){pack2(pt[2 * k2][0], pt[2 * k2][1]), pack2(pt[2 * k2][2], pt[2 * k2][3]), pack2(pt[2 * k2 + 1][0], pt[2 * k2 + 1][1]), pack2(pt[2 * k2 + 1][2], pt[2 * k2 + 1][3])};
            const bf16x8 pf = __builtin_bit_cast(bf16x8, pw);
#pragma unroll
            for (int et = 0; et < 8; ++et) {
                const bf16_t* vp = Vt + (16 * et + fr) * GL_S + 32 * k2 + 4 * fq;
                const u32x2 v0 = *(const u32x2*)vp, v1 = *(const u32x2*)(vp + 16);
                const bf16x8 vf = __builtin_bit_cast(bf16x8, (u32x4){v0[0], v0[1], v1[0], v1[1]});
                oacc[et] = __builtin_amdgcn_mfma_f32_16x16x32_bf16(vf, pf, oacc[et], 0, 0, 0);
            }
        }
        float ss = 0.f;
#pragma unroll
        for (int et = 0; et < 8; ++et) ss += oacc[et][0] * oacc[et][0] + oacc[et][1] * oacc[et][1] + oacc[et][2] * oacc[et][2] + oacc[et][3] * oacc[et][3];
        ss += __shfl_xor(ss, 16); ss += __shfl_xor(ss, 32);
        const float rs = rsqrtf(ss * (1.0f / 128.0f) + LN_EPS);
        const size_t r = row0 + i;
#pragma unroll
        for (int et = 0; et < 8; ++et) {
            const int e = 16 * et + 4 * fq;
            const u32x2 gw = *(const u32x2*)(p.P + r * EV_IN + C_GG + hd * 128 + e);
            const f32x4 nr = *(const f32x4*)(p.ev_gla_norm + hd * 128 + e);
            const float g0 = __uint_as_float(gw[0] << 16), g1 = __uint_as_float(gw[0] & 0xffff0000u), g2 = __uint_as_float(gw[1] << 16), g3 = __uint_as_float(gw[1] & 0xffff0000u);
            *(u32x2*)(p.A16 + r * D + 512 + hd * 128 + e) = (u32x2){pack2(oacc[et][0] * rs * nr[0] * silu_f(g0), oacc[et][1] * rs * nr[1] * silu_f(g1)),
                                                                   pack2(oacc[et][2] * rs * nr[2] * silu_f(g2), oacc[et][3] * rs * nr[3] * silu_f(g3))};
        }
    }
}

__device__ __forceinline__ void ph_ln_mod(const Params& p, int layer, int lnidx, int lat_only) {
    const int tid_ = otid(), wid = tid_ >> 6, lane = tid_ & 63;
    const int nrows = lat_only ? NB * SEQ : R;
    const float* g = p.ln_g + (size_t)(layer * 2 + lnidx) * D; const float* bb = p.ln_b + (size_t)(layer * 2 + lnidx) * D;
    for (int u = blockIdx.x; u < nrows / 4; u += gridDim.x) {
        const int rr = u * 4 + wid, r = lat_only ? (rr >> 12) * PB + CTX + (rr & 4095) : rr;
        float* hrow = p.H + (size_t)r * D;
        f32x4 v[4]; float s = 0.f;
#pragma unroll
        for (int q = 0; q < 4; ++q) { v[q] = *(const f32x4*)(hrow + q * 256 + lane * 4); s += v[q][0] + v[q][1] + v[q][2] + v[q][3]; }
        const float mu = wave_sum(s) * (1.0f / 1024.0f);
        float ss = 0.f;
#pragma unroll
        for (int q = 0; q < 4; ++q) { v[q] = v[q] - mu; ss += v[q][0] * v[q][0] + v[q][1] * v[q][1] + v[q][2] * v[q][2] + v[q][3] * v[q][3]; }
        const float rstd = rsqrtf(wave_sum(ss) * (1.0f / 1024.0f) + LN_EPS);
        const float* md = p.mod + ((size_t)layer * 9 + mod_row(r)) * 6144;
#pragma unroll
        for (int q = 0; q < 4; ++q) {
            const int c = q * 256 + lane * 4;
            const f32x4 h = v[q] * rstd * *(const f32x4*)(g + c) + *(const f32x4*)(bb + c);
            *(f32x4*)(hrow + c) = h;
            const f32x4 a = h * (1.0f + *(const f32x4*)(md + 4 * 1024 + c)) + *(const f32x4*)(md + 3 * 1024 + c);
            *(u32x2*)(p.A16 + (size_t)r * D + c) = (u32x2){pack2(a[0], a[1]), pack2(a[2], a[3])};
        }
    }
}

constexpr int SC_KS = 136;
__device__ __forceinline__ void ph_scores(const Params& p, int layer, int lat_only, unsigned char* smem) {
    bf16_t* ksl = (bf16_t*)smem;
    const bf16_t* QP = p.P; float* T = (float*)p.G;
    const int tid = otid(), lane = tid & 63, wid = tid >> 6, q = lane & 31, h = lane >> 5;
    const RowMap rm{lat_only};
    const int nunits = rm.ntiles() * 8;
    for (int u = blockIdx.x; u < nunits; u += gridDim.x) {
        const int tile = u >> 3, half = (u >> 2) & 1, hp = u & 3;
        const size_t r = (size_t)rm.row0(tile) + 32 * wid + q;
        __syncthreads();
        const bf16_t* kk = p.wt_k + ((size_t)layer * 2 + half) * 16384;
#pragma unroll
        for (int i = 0; i < 8; ++i) { const int id = tid + 256 * i, key = id >> 4, ch = id & 15; *(u32x4*)(ksl + key * SC_KS + ch * 8) = *(const u32x4*)(kk + key * 128 + ch * 8); }
        __syncthreads();
        for (int hh = 0; hh < 2; ++hh) {
            const int hd = hp * 2 + hh;
            bf16x8 qf[8];
#pragma unroll
            for (int s = 0; s < 8; ++s) qf[s] = *(const bf16x8*)(QP + r * 2048 + hd * 256 + half * 128 + 16 * s + 8 * h);
            float top[16];
#pragma unroll
            for (int t = 0; t < 16; ++t) top[t] = -3.0e38f;
#pragma unroll 1
            for (int kb = 0; kb < 4; ++kb) {
                f32x16 sa;
#pragma unroll
                for (int i = 0; i < 16; ++i) sa[i] = 0.f;
#pragma unroll
                for (int s = 0; s < 8; ++s) {
                    const bf16x8 kf = *(const bf16x8*)(ksl + (kb * 32 + q) * SC_KS + 16 * s + 8 * h);
                    sa = __builtin_amdgcn_mfma_f32_32x32x16_bf16(kf, qf[s], sa, 0, 0, 0);
                }
#pragma unroll
                for (int rg = 0; rg < 16; ++rg) {
                    const unsigned key = (unsigned)(kb * 32 + (rg & 3) + 8 * (rg >> 2) + 4 * h);
                    float xv = __uint_as_float((__float_as_uint(sa[rg]) & ~127u) | key);
#pragma unroll
                    for (int t = 0; t < 16; ++t) { const float hi = fmaxf(top[t], xv); xv = fminf(top[t], xv); top[t] = hi; }
                }
            }
            float mrg[8];
#pragma unroll
            for (int i = 0; i < 8; ++i) mrg[i] = fmaxf(top[i], __shfl_xor(top[15 - i], 32));
            float* dst = T + ((r * 8 + hd) * 2 + half) * 16 + 8 * h;
            *(f32x4*)dst = (f32x4){mrg[0], mrg[1], mrg[2], mrg[3]}; *(f32x4*)(dst + 4) = (f32x4){mrg[4], mrg[5], mrg[6], mrg[7]};
        }
    }
}

__device__ __forceinline__ void ph_combine(const Params& p, int lat_only) {
    const float* T = (const float*)p.G;
    int* EIDX = (int*)(p.G + (size_t)R * 8 * 2 * 16 * 4);
    float* EG = (float*)(p.G + (size_t)R * 8 * 2 * 16 * 4 + (size_t)R * 8 * 16 * 4);
    const int nrows = lat_only ? NB * SEQ : R;
    for (int g = blockIdx.x * 256 + threadIdx.x; g < nrows * 8; g += gridDim.x * 256) {
        const int rr = g >> 3, hd = g & 7, r = lat_only ? (rr >> 12) * PB + CTX + (rr & 4095) : rr;
        const float* t = T + ((size_t)r * 8 + hd) * 32;
        float t2[16];
#pragma unroll
        for (int i = 0; i < 16; ++i) t2[i] = __uint_as_float(__float_as_uint(t[16 + i]) & ~127u);
        float top[16];
#pragma unroll
        for (int k = 0; k < 16; ++k) top[k] = -3.0e38f;
        for (int i = 0; i < 16; ++i) {
            const float t1i = __uint_as_float(__float_as_uint(t[i]) & ~127u);
#pragma unroll
            for (int j = 0; j < 16; ++j) {
                float xv = __uint_as_float((__float_as_uint(t1i + t2[j]) & ~255u) | (unsigned)(i * 16 + j));
#pragma unroll
                for (int k = 0; k < 16; ++k) { const float hi = fmaxf(top[k], xv); xv = fminf(top[k], xv); top[k] = hi; }
            }
        }
        float e[16], sum = 0.f; const float mx = __uint_as_float(__float_as_uint(top[0]) & ~255u);
#pragma unroll
        for (int k = 0; k < 16; ++k) { e[k] = expf(__uint_as_float(__float_as_uint(top[k]) & ~255u) - mx); sum += e[k]; }
        const float inv = 1.0f / sum;
#pragma unroll
        for (int k = 0; k < 16; ++k) {
            const unsigned code = __float_as_uint(top[k]) & 255u, i = code >> 4, j = code & 15;
            const unsigned i1 = __float_as_uint(t[i]) & 127u, i2 = __float_as_uint(t[16 + j]) & 127u;
            EIDX[((size_t)r * 8 + hd) * 16 + k] = (int)(i1 * 128 + i2);
            EG[((size_t)r * 8 + hd) * 16 + k] = e[k] * inv;
        }
    }
}

__device__ __forceinline__ void ph_gather_ln(const Params& p, int layer, int lat_only) {
    const int tid_ = otid(), wid = tid_ >> 6, lane = tid_ & 63;
    const int* EIDX = (const int*)(p.G + (size_t)R * 8 * 2 * 16 * 4);
    const float* EG = (const float*)(p.G + (size_t)R * 8 * 2 * 16 * 4 + (size_t)R * 8 * 16 * 4);
    const float* U = p.peer_u + (size_t)layer * PEER_N * D; const float* V = p.peer_v + (size_t)layer * PEER_N * D;
    const float* g = p.ln_g + (size_t)(layer * 2 + 1) * D; const float* bb = p.ln_b + (size_t)(layer * 2 + 1) * D;
    const int nrows = lat_only ? NB * SEQ : R;
    for (int u = blockIdx.x; u < nrows / 4; u += gridDim.x) {
        const int rr = u * 4 + wid, r = lat_only ? (rr >> 12) * PB + CTX + (rr & 4095) : rr;
        f32x4 hm[4], acc[4];
#pragma unroll
        for (int q = 0; q < 4; ++q) {
            const u32x2 w = *(const u32x2*)(p.A16 + (size_t)r * D + q * 256 + lane * 4);
            hm[q] = (f32x4){__uint_as_float(w[0] << 16), __uint_as_float(w[0] & 0xffff0000u), __uint_as_float(w[1] << 16), __uint_as_float(w[1] & 0xffff0000u)};
            acc[q] = (f32x4){0.f, 0.f, 0.f, 0.f};
        }
        for (int e0 = 0; e0 < 128; e0 += 2) {
            const int ea = EIDX[(size_t)r * 128 + e0], eb = EIDX[(size_t)r * 128 + e0 + 1];
            const float ga = EG[(size_t)r * 128 + e0], gb = EG[(size_t)r * 128 + e0 + 1];
            f32x4 ua[4], ub[4];
#pragma unroll
            for (int q = 0; q < 4; ++q) { ua[q] = *(const f32x4*)(U + (size_t)ea * D + q * 256 + lane * 4); ub[q] = *(const f32x4*)(U + (size_t)eb * D + q * 256 + lane * 4); }
            float da = 0.f, db = 0.f;
#pragma unroll
            for (int q = 0; q < 4; ++q) { da += hm[q][0] * ua[q][0] + hm[q][1] * ua[q][1] + hm[q][2] * ua[q][2] + hm[q][3] * ua[q][3]; db += hm[q][0] * ub[q][0] + hm[q][1] * ub[q][1] + hm[q][2] * ub[q][2] + hm[q][3] * ub[q][3]; }
            da = wave_sum(da); db = wave_sum(db);
            const float wa = ga * gelu_f(da), wb = gb * gelu_f(db);
#pragma unroll
            for (int q = 0; q < 4; ++q) {
                acc[q] += wa * *(const f32x4*)(V + (size_t)ea * D + q * 256 + lane * 4);
                acc[q] += wb * *(const f32x4*)(V + (size_t)eb * D + q * 256 + lane * 4);
            }
        }
        const float* md = p.mod + ((size_t)layer * 9 + mod_row(r)) * 6144;
        float* hrow = p.H + (size_t)r * D;
        f32x4 v[4]; float s = 0.f;
#pragma unroll
        for (int q = 0; q < 4; ++q) { const int c = q * 256 + lane * 4; v[q] = ALPHA * *(const f32x4*)(hrow + c) + *(const f32x4*)(md + 5 * 1024 + c) * acc[q]; s += v[q][0] + v[q][1] + v[q][2] + v[q][3]; }
        const float mu = wave_sum(s) * (1.0f / 1024.0f);
        float ss = 0.f;
#pragma unroll
        for (int q = 0; q < 4; ++q) { v[q] = v[q] - mu; ss += v[q][0] * v[q][0] + v[q][1] * v[q][1] + v[q][2] * v[q][2] + v[q][3] * v[q][3]; }
        const float rstd = rsqrtf(wave_sum(ss) * (1.0f / 1024.0f) + LN_EPS);
        if (layer == 0) {
            const float* md1 = p.mod + ((size_t)1 * 9 + mod_row(r)) * 6144;
#pragma unroll
            for (int q = 0; q < 4; ++q) {
                const int c = q * 256 + lane * 4;
                const f32x4 h = v[q] * rstd * *(const f32x4*)(g + c) + *(const f32x4*)(bb + c);
                *(f32x4*)(hrow + c) = h;
                const f32x4 a = h * (1.0f + *(const f32x4*)(md1 + 1024 + c)) + *(const f32x4*)(md1 + c);
                *(u32x2*)(p.A16 + (size_t)r * D + c) = (u32x2){pack2(a[0], a[1]), pack2(a[2], a[3])};
            }
        } else {
            float* orow = p.out + (size_t)rr * D;
#pragma unroll
            for (int q = 0; q < 4; ++q) { const int c = q * 256 + lane * 4; *(f32x4*)(orow + c) = v[q] * rstd * *(const f32x4*)(g + c) + *(const f32x4*)(bb + c); }
        }
    }
}

__device__ __forceinline__ float gelu_fast(float v);
constexpr size_t UV8_BYTES = (size_t)PEER_N * D;
__device__ __forceinline__ float wave_max(float v) {
#pragma unroll
    for (int o = 32; o > 0; o >>= 1) v = fmaxf(v, __shfl_xor(v, o));
    return v;
}
__device__ __forceinline__ unsigned cvt4_fp8(float a, float b, float c, float d) {
    int pk = __builtin_amdgcn_cvt_pk_fp8_f32(a, b, 0, false);
    pk = __builtin_amdgcn_cvt_pk_fp8_f32(c, d, pk, true);
    return (unsigned)pk;
}
__device__ __forceinline__ void ph_convert_uv(const Params& p, int layer) {
    const int tid = otid(), lane = tid & 63, gw = blockIdx.x * 4 + (tid >> 6), nw = gridDim.x * 4;
    unsigned char* T8 = (unsigned char*)p.P;
    float* sinv = (float*)(T8 + 2 * UV8_BYTES);
    for (int row = gw; row < 2 * PEER_N; row += nw) {
        const float* src = (row < PEER_N ? p.peer_u + ((size_t)layer * PEER_N + row) * D : p.peer_v + ((size_t)layer * PEER_N + (row - PEER_N)) * D) + lane * 16;
        f32x4 v[4]; float am = 0.f;
#pragma unroll
        for (int q = 0; q < 4; ++q) { v[q] = *(const f32x4*)(src + 4 * q); am = fmaxf(am, fmaxf(fmaxf(fabsf(v[q][0]), fabsf(v[q][1])), fmaxf(fabsf(v[q][2]), fabsf(v[q][3])))); }
        am = wave_max(am);
        const float sc = am > 0.f ? 224.0f / am : 1.0f;
        u32x4 w;
#pragma unroll
        for (int q = 0; q < 4; ++q) w[q] = cvt4_fp8(v[q][0] * sc, v[q][1] * sc, v[q][2] * sc, v[q][3] * sc);
        *(u32x4*)(T8 + (size_t)(row >= PEER_N) * UV8_BYTES + (size_t)(lane >> 3) * (PEER_N * 128) + (size_t)(row & (PEER_N - 1)) * 128 + (lane & 7) * 16) = w;
        if (lane == 0) sinv[row] = 1.0f / sc;
    }
}

__device__ __forceinline__ void ph_gather_mfma(const Params& p, int layer, int lat_only, unsigned char* smem) {
    const int tid = otid(), wid = tid >> 6, lane = tid & 63, c = lane & 15, g = lane >> 4;
    unsigned char* hs = smem + wid * 2048;
    int* se = (int*)(smem + wid * 2048 + 1024);
    float* sw = (float*)(smem + wid * 2048 + 1536);
    const int* EIDX = (const int*)(p.G + (size_t)R * 8 * 2 * 16 * 4);
    const float* EG = (const float*)(p.G + (size_t)R * 8 * 2 * 16 * 4 + (size_t)R * 8 * 16 * 4);
    const unsigned char* U8 = (const unsigned char*)p.P; const unsigned char* V8 = U8 + UV8_BYTES;
    const float* su_inv = (const float*)(U8 + 2 * UV8_BYTES); const float* sv_inv = su_inv + PEER_N;
    const float* gam = p.ln_g + (size_t)(layer * 2 + 1) * D; const float* bet = p.ln_b + (size_t)(layer * 2 + 1) * D;
    const int nrows = lat_only ? NB * SEQ : R;
    for (int u = blockIdx.x; u < nrows / 4; u += gridDim.x) {
        const int rr = u * 4 + wid, r = lat_only ? (rr >> 12) * PB + CTX + (rr & 4095) : rr;
        __syncthreads();
        float inv_sh;
        {
            const u32x4 w0 = *(const u32x4*)(p.A16 + (size_t)r * D + lane * 16), w1 = *(const u32x4*)(p.A16 + (size_t)r * D + lane * 16 + 8);
            float hv[16];
#pragma unroll
            for (int e = 0; e < 4; ++e) { hv[2 * e] = __uint_as_float(w0[e] << 16); hv[2 * e + 1] = __uint_as_float(w0[e] & 0xffff0000u); hv[8 + 2 * e] = __uint_as_float(w1[e] << 16); hv[8 + 2 * e + 1] = __uint_as_float(w1[e] & 0xffff0000u); }
            float am = 0.f;
#pragma unroll
            for (int e = 0; e < 16; ++e) am = fmaxf(am, fabsf(hv[e]));
            am = wave_max(am);
            const float sh = am > 0.f ? 224.0f / am : 1.0f; inv_sh = 1.0f / sh;
            *(u32x4*)(hs + lane * 16) = (u32x4){cvt4_fp8(hv[0] * sh, hv[1] * sh, hv[2] * sh, hv[3] * sh), cvt4_fp8(hv[4] * sh, hv[5] * sh, hv[6] * sh, hv[7] * sh),
                                                cvt4_fp8(hv[8] * sh, hv[9] * sh, hv[10] * sh, hv[11] * sh), cvt4_fp8(hv[12] * sh, hv[13] * sh, hv[14] * sh, hv[15] * sh)};
        }
        se[lane] = EIDX[(size_t)r * 128 + lane]; se[64 + lane] = EIDX[(size_t)r * 128 + 64 + lane];
        sw[lane] = EG[(size_t)r * 128 + lane]; sw[64 + lane] = EG[(size_t)r * 128 + 64 + lane];
        __syncthreads();
#pragma unroll 2
        for (int hd = 0; hd < 8; ++hd) {
            f32x4 dacc = (f32x4){0.f, 0.f, 0.f, 0.f};
            const int e = se[hd * 16 + c];
            const unsigned char* urow = U8 + (size_t)e * D + g * 16;
#pragma unroll
            for (int s2 = 0; s2 < 16; ++s2) {
                const u32x4 bq = *(const u32x4*)(urow + s2 * 64);
                const u32x4 aq = *(const u32x4*)(hs + s2 * 64 + g * 16);
                dacc = __builtin_amdgcn_mfma_f32_16x16x32_fp8_fp8((long)(((unsigned long long)aq[1] << 32) | aq[0]), (long)(((unsigned long long)bq[1] << 32) | bq[0]), dacc, 0, 0, 0);
                dacc = __builtin_amdgcn_mfma_f32_16x16x32_fp8_fp8((long)(((unsigned long long)aq[3] << 32) | aq[2]), (long)(((unsigned long long)bq[3] << 32) | bq[2]), dacc, 0, 0, 0);
            }
            const float wv = sw[hd * 16 + c] * gelu_fast(dacc[0] * inv_sh * su_inv[e]) * sv_inv[e];
            if (g == 0) sw[hd * 16 + c] = wv;
        }
        __syncthreads();
        const float wmax = wave_max(fmaxf(fabsf(sw[lane]), fabsf(sw[64 + lane])));
        const float wsc = wmax > 0.f ? 224.0f / wmax : 1.0f, inv_wsc = 1.0f / wsc;
        f32x4 oacc[8];
#pragma unroll
        for (int blk = 0; blk < 8; ++blk) oacc[blk] = (f32x4){0.f, 0.f, 0.f, 0.f};
#pragma unroll 4
        for (int it = 0; it < 32; ++it) {
            const int e = se[4 * it + g];
            const unsigned w8 = (unsigned)__builtin_amdgcn_cvt_pk_fp8_f32(sw[4 * it + g] * wsc, 0.f, 0, false) & 0xffu;
            const unsigned long long a64 = c < 8 ? ((unsigned long long)w8 << (8 * c)) : 0ull;
            const unsigned char* vrow = V8 + (size_t)e * D + c * 16;
#pragma unroll
            for (int b2 = 0; b2 < 4; ++b2) {
                const u32x4 bq = *(const u32x4*)(vrow + b2 * 256);
                oacc[2 * b2] = __builtin_amdgcn_mfma_f32_16x16x32_fp8_fp8((long)a64, (long)(((unsigned long long)bq[1] << 32) | bq[0]), oacc[2 * b2], 0, 0, 0);
                oacc[2 * b2 + 1] = __builtin_amdgcn_mfma_f32_16x16x32_fp8_fp8((long)a64, (long)(((unsigned long long)bq[3] << 32) | bq[2]), oacc[2 * b2 + 1], 0, 0, 0);
            }
        }
#pragma unroll
        for (int blk = 0; blk < 8; ++blk) oacc[blk] = oacc[blk] * inv_wsc;
        const float* md = p.mod + ((size_t)layer * 9 + mod_row(r)) * 6144;
        float* hrow = p.H + (size_t)r * D;
        const bool act = g < 2;
        f32x4 v[8]; float s = 0.f;
#pragma unroll
        for (int blk = 0; blk < 8; ++blk) {
            const int n = 256 * (blk >> 1) + 16 * c + 8 * (blk & 1) + 4 * (g & 1);
            v[blk] = ALPHA * *(const f32x4*)(hrow + n) + *(const f32x4*)(md + 5 * 1024 + n) * oacc[blk];
            if (!act) v[blk] = (f32x4){0.f, 0.f, 0.f, 0.f};
            s += v[blk][0] + v[blk][1] + v[blk][2] + v[blk][3];
        }
        const float mu = wave_sum(s) * (1.0f / 1024.0f);
        float ss = 0.f;
#pragma unroll
        for (int blk = 0; blk < 8; ++blk) { v[blk] = v[blk] - mu; if (act) ss += v[blk][0] * v[blk][0] + v[blk][1] * v[blk][1] + v[blk][2] * v[blk][2] + v[blk][3] * v[blk][3]; }
        const float rstd = rsqrtf(wave_sum(ss) * (1.0f / 1024.0f) + LN_EPS);
        if (act) {
            if (layer == 0) {
                const float* md1 = p.mod + ((size_t)1 * 9 + mod_row(r)) * 6144;
#pragma unroll
                for (int blk = 0; blk < 8; ++blk) {
                    const int n = 256 * (blk >> 1) + 16 * c + 8 * (blk & 1) + 4 * g;
                    const f32x4 h = v[blk] * rstd * *(const f32x4*)(gam + n) + *(const f32x4*)(bet + n);
                    *(f32x4*)(hrow + n) = h;
                    const f32x4 a = h * (1.0f + *(const f32x4*)(md1 + 1024 + n)) + *(const f32x4*)(md1 + n);
                    *(u32x2*)(p.A16 + (size_t)r * D + n) = (u32x2){pack2(a[0], a[1]), pack2(a[2], a[3])};
                }
            } else {
                float* orow = p.out + (size_t)rr * D;
#pragma unroll
                for (int blk = 0; blk < 8; ++blk) { const int n = 256 * (blk >> 1) + 16 * c + 8 * (blk & 1) + 4 * g; *(f32x4*)(orow + n) = v[blk] * rstd * *(const f32x4*)(gam + n) + *(const f32x4*)(bet + n); }
            }
        }
    }
}

constexpr int GT_TW = 17;
__device__ __forceinline__ long mk64(unsigned lo, unsigned hi) { return (long)(((unsigned long long)hi << 32) | lo); }
__device__ __forceinline__ void ph_gather_sliced(const Params& p, int layer, int lat_only, unsigned char* smem) {
    const int tid = otid(), wid = tid >> 6, lane = tid & 63, c = lane & 15, g = lane >> 4;
    float* part = (float*)smem + wid * (GT_TW * 128);
    float* tsc = (float*)smem + 4 * GT_TW * 128 + wid * (2 * GT_TW);
    unsigned short* sid = (unsigned short*)(smem + 4 * GT_TW * 128 * 4 + 4 * 2 * GT_TW * 4) + wid * (GT_TW * 128);
    const int* EIDX = (const int*)(p.G + (size_t)R * 8 * 2 * 16 * 4);
    const float* EG = (const float*)(p.G + (size_t)R * 8 * 2 * 16 * 4 + (size_t)R * 8 * 16 * 4);
    const unsigned char* U8 = (const unsigned char*)p.P; const unsigned char* V8 = U8 + UV8_BYTES;
    const float* su_inv = (const float*)(U8 + 2 * UV8_BYTES); const float* sv_inv = su_inv + PEER_N;
    const float* gam = p.ln_g + (size_t)(layer * 2 + 1) * D; const float* bet = p.ln_b + (size_t)(layer * 2 + 1) * D;
    const int ntok = lat_only ? NB * SEQ : R;
    const int per_round = gridDim.x * 4 * GT_TW;
    for (int base = 0; base < ntok; base += per_round) {
        const int t0 = base + (blockIdx.x * 4 + wid) * GT_TW;
        int nt = ntok - t0; nt = nt < 0 ? 0 : (nt > GT_TW ? GT_TW : nt);
        auto rowof = [&](int j) { const int rr = t0 + j; return lat_only ? (rr >> 12) * PB + CTX + (rr & 4095) : rr; };
        for (int j = 0; j < nt; ++j) {
            const size_t r = rowof(j);
            const u32x4 w0 = *(const u32x4*)(p.A16 + r * D + lane * 16), w1 = *(const u32x4*)(p.A16 + r * D + lane * 16 + 8);
            const int i0 = EIDX[r * 128 + lane], i1 = EIDX[r * 128 + 64 + lane];
            float hv[16];
#pragma unroll
            for (int e = 0; e < 4; ++e) { hv[2 * e] = __uint_as_float(w0[e] << 16); hv[2 * e + 1] = __uint_as_float(w0[e] & 0xffff0000u); hv[8 + 2 * e] = __uint_as_float(w1[e] << 16); hv[8 + 2 * e + 1] = __uint_as_float(w1[e] & 0xffff0000u); }
            float am = 0.f;
#pragma unroll
            for (int e = 0; e < 16; ++e) am = fmaxf(am, fabsf(hv[e]));
            am = wave_max(am);
            const float sh = am > 0.f ? 224.0f / am : 1.0f;
            if (lane == 0) tsc[j] = 1.0f / sh;
            *(u32x4*)((unsigned char*)(p.A16 + r * D) + lane * 16) = (u32x4){cvt4_fp8(hv[0] * sh, hv[1] * sh, hv[2] * sh, hv[3] * sh), cvt4_fp8(hv[4] * sh, hv[5] * sh, hv[6] * sh, hv[7] * sh),
                                                                             cvt4_fp8(hv[8] * sh, hv[9] * sh, hv[10] * sh, hv[11] * sh), cvt4_fp8(hv[12] * sh, hv[13] * sh, hv[14] * sh, hv[15] * sh)};
            part[j * 128 + lane] = 0.f; part[j * 128 + 64 + lane] = 0.f;
            sid[j * 128 + lane] = (unsigned short)i0; sid[j * 128 + 64 + lane] = (unsigned short)i1;
        }
        asm volatile("s_waitcnt vmcnt(0) lgkmcnt(0)" ::: "memory");
        for (int sl = 0; sl < 8; ++sl) {
            u32x4 aA[2], bA[8], aB[2], bB[8];
            auto issue = [&](int q, u32x4 (&a)[2], u32x4 (&b)[8]) {
                const int j = q >> 1, h0 = (q & 1) * 4;
                const size_t r = rowof(j);
                const unsigned char* hrow = (const unsigned char*)(p.A16 + r * D) + sl * 128 + g * 16;
                a[0] = *(const u32x4*)hrow; a[1] = *(const u32x4*)(hrow + 64);
#pragma unroll
                for (int hh = 0; hh < 4; ++hh) { const unsigned char* ur = U8 + (size_t)sl * (PEER_N * 128) + (size_t)sid[j * 128 + (h0 + hh) * 16 + (lane >> 2)] * 128 + (lane & 3) * 16; b[2 * hh] = *(const u32x4*)ur; b[2 * hh + 1] = *(const u32x4*)(ur + 64); }
            };
            const int bsrc = (4 * c + g) * 4;
            auto compute = [&](int q, const u32x4 (&a)[2], const u32x4 (&b)[8]) {
                const int j = q >> 1, h0 = (q & 1) * 4;
#pragma unroll
                for (int hh = 0; hh < 4; ++hh) {
                    unsigned t[8];
#pragma unroll
                    for (int e = 0; e < 4; ++e) { t[e] = (unsigned)__builtin_amdgcn_ds_bpermute(bsrc, (int)b[2 * hh][e]); t[4 + e] = (unsigned)__builtin_amdgcn_ds_bpermute(bsrc, (int)b[2 * hh + 1][e]); }
                    f32x4 dacc = (f32x4){0.f, 0.f, 0.f, 0.f};
                    dacc = __builtin_amdgcn_mfma_f32_16x16x32_fp8_fp8(mk64(a[0][0], a[0][1]), mk64(t[0], t[1]), dacc, 0, 0, 0);
                    dacc = __builtin_amdgcn_mfma_f32_16x16x32_fp8_fp8(mk64(a[0][2], a[0][3]), mk64(t[2], t[3]), dacc, 0, 0, 0);
                    dacc = __builtin_amdgcn_mfma_f32_16x16x32_fp8_fp8(mk64(a[1][0], a[1][1]), mk64(t[4], t[5]), dacc, 0, 0, 0);
                    dacc = __builtin_amdgcn_mfma_f32_16x16x32_fp8_fp8(mk64(a[1][2], a[1][3]), mk64(t[6], t[7]), dacc, 0, 0, 0);
                    if (g == 0) part[j * 128 + (h0 + hh) * 16 + c] += dacc[0];
                }
            };
            const int nq = 2 * nt;
            if (nq > 0) issue(0, aA, bA);
            for (int q = 0; q < nq; q += 2) {
                issue(q + 1, aB, bB);
                compute(q, aA, bA);
                issue(q + 2 < nq ? q + 2 : q, aA, bA);
                compute(q + 1, aB, bB);
            }
        }
        for (int j = 0; j < nt; ++j) {
            const size_t r = rowof(j);
            const float ish = tsc[j];
            float wv[2];
#pragma unroll
            for (int q = 0; q < 2; ++q) {
                const int x = q * 64 + lane, e = sid[j * 128 + x];
                wv[q] = EG[r * 128 + x] * gelu_fast(part[j * 128 + x] * ish * su_inv[e]) * sv_inv[e];
            }
            const float wm = wave_max(fmaxf(fabsf(wv[0]), fabsf(wv[1])));
            const float wsc = wm > 0.f ? 224.0f / wm : 1.0f;
            if (lane == 0) tsc[GT_TW + j] = 1.0f / wsc;
            unsigned char* w8b = (unsigned char*)(part + j * 128);
            w8b[lane] = (unsigned char)(__builtin_amdgcn_cvt_pk_fp8_f32(wv[0] * wsc, 0.f, 0, false) & 0xff);
            w8b[64 + lane] = (unsigned char)(__builtin_amdgcn_cvt_pk_fp8_f32(wv[1] * wsc, 0.f, 0, false) & 0xff);
        }
        asm volatile("s_waitcnt lgkmcnt(0)" ::: "memory");
        for (int sl = 0; sl < 8; ++sl) {
            u32x2 vA[16], vB[16]; f32x4 hA; f32x4 oacc;
            auto issue = [&](int q, u32x2 (&v)[16]) {
                const int j = q >> 1, i0 = (q & 1) * 16;
#pragma unroll
                for (int it = 0; it < 16; ++it) v[it] = *(const u32x2*)(V8 + (size_t)sl * (PEER_N * 128) + (size_t)sid[j * 128 + 4 * (i0 + it) + g] * 128 + c * 8);
            };
            const unsigned shl = 8 * (c & 3), mlo = c < 4 ? 0xffffffffu : 0u, mhi = (c >= 4 && c < 8) ? 0xffffffffu : 0u;
            auto compute = [&](int q, const u32x2 (&v)[16]) {
                const int j = q >> 1, i0 = (q & 1) * 16;
                const unsigned char* w8b = (const unsigned char*)(part + j * 128);
                if (i0 == 0) oacc = (f32x4){0.f, 0.f, 0.f, 0.f};
#pragma unroll
                for (int it = 0; it < 16; ++it) {
                    const unsigned ws = (unsigned)w8b[4 * (i0 + it) + g] << shl;
                    oacc = __builtin_amdgcn_mfma_f32_16x16x32_fp8_fp8(mk64(ws & mlo, ws & mhi), mk64(v[it][0], v[it][1]), oacc, 0, 0, 0);
                }
            };
            auto finish = [&](int j) {
                const size_t r = rowof(j);
                const float iws = tsc[GT_TW + j];
                if (g < 2) {
                    const int n = sl * 128 + 8 * c + 4 * g;
                    const float* md = p.mod + ((size_t)layer * 9 + mod_row((int)r)) * 6144 + 5 * 1024;
                    *(f32x4*)(p.H + r * D + n) = ALPHA * hA + *(const f32x4*)(md + n) * (oacc * iws);
                }
            };
            const int nq = 2 * nt;
            if (nq > 0) issue(0, vA);
            for (int q = 0; q < nq; q += 2) {
                const int j = q >> 1;
                hA = *(const f32x4*)(p.H + (size_t)rowof(j) * D + sl * 128 + 8 * c + 4 * (g & 1));
                issue(q + 1, vB);
                compute(q, vA);
                issue(q + 2 < nq ? q + 2 : q, vA);
                compute(q + 1, vB);
                finish(j);
            }
        }
        asm volatile("s_waitcnt vmcnt(0)" ::: "memory");
        for (int j = 0; j < nt; ++j) {
            const size_t r = rowof(j);
            float* hrow = p.H + r * D;
            f32x4 v[4]; float s = 0.f;
#pragma unroll
            for (int q = 0; q < 4; ++q) { v[q] = *(const f32x4*)(hrow + q * 256 + lane * 4); s += v[q][0] + v[q][1] + v[q][2] + v[q][3]; }
            const float mu = wave_sum(s) * (1.0f / 1024.0f);
            float ss = 0.f;
#pragma unroll
            for (int q = 0; q < 4; ++q) { v[q] = v[q] - mu; ss += v[q][0] * v[q][0] + v[q][1] * v[q][1] + v[q][2] * v[q][2] + v[q][3] * v[q][3]; }
            const float rstd = rsqrtf(wave_sum(ss) * (1.0f / 1024.0f) + LN_EPS);
            if (layer == 0) {
                const float* md1 = p.mod + ((size_t)1 * 9 + mod_row((int)r)) * 6144;
#pragma unroll
                for (int q = 0; q < 4; ++q) {
                    const int n = q * 256 + lane * 4;
                    const f32x4 h = v[q] * rstd * *(const f32x4*)(gam + n) + *(const f32x4*)(bet + n);
                    *(f32x4*)(hrow + n) = h;
                    const f32x4 a = h * (1.0f + *(const f32x4*)(md1 + 1024 + n)) + *(const f32x4*)(md1 + n);
                    *(u32x2*)(p.A16 + r * D + n) = (u32x2){pack2(a[0], a[1]), pack2(a[2], a[3])};
                }
            } else {
                float* orow = p.out + (size_t)(t0 + j) * D;
#pragma unroll
                for (int q = 0; q < 4; ++q) { const int n = q * 256 + lane * 4; *(f32x4*)(orow + n) = v[q] * rstd * *(const f32x4*)(gam + n) + *(const f32x4*)(bet + n); }
            }
        }
    }
}

constexpr int RG_ZS = 136;
constexpr size_t RG_SUM_BYTES = (size_t)NB * 34 * 2 * RGW * 2 * 4;
__device__ __forceinline__ void rg_stage_z(const Params& p, int b, int c34, int n, bf16_t* zc) {
    const int tid = otid(), k2 = tid & 63, tq = tid >> 6, ch = n * 128 + 2 * k2;
    const int lo = c34 < 2 ? 0 : CTX, hi = c34 < 2 ? CTX : PB, p0 = c34 * 128 + 32 * tq;
    float w0[4], w1[4];
#pragma unroll
    for (int tap = 0; tap < 4; ++tap) { w0[tap] = p.od_conv_w[tap * RGW + ch]; w1[tap] = p.od_conv_w[tap * RGW + ch + 1]; }
    const float b0 = p.od_conv_b[ch], b1 = p.od_conv_b[ch + 1];
    const bf16_t* base = p.P + (size_t)b * PB * 2560 + RGW + ch;
    auto ld = [&](int pp, float& a, float& c) { if (pp >= lo && pp < hi) { const unsigned w = *(const unsigned*)(base + (size_t)pp * 2560); a = __uint_as_float(w << 16); c = __uint_as_float(w & 0xffff0000u); } else { a = 0.f; c = 0.f; } };
    float am2, cm2, am1, cm1, a0, c0, ap1, cp1;
    ld(p0 - 2, am2, cm2); ld(p0 - 1, am1, cm1); ld(p0, a0, c0);
#pragma unroll 4
    for (int t = 0; t < 32; ++t) {
        ld(p0 + t + 1, ap1, cp1);
        const float y0 = b0 + w0[0] * am2 + w0[1] * am1 + w0[2] * a0 + w0[3] * ap1;
        const float y1 = b1 + w1[0] * cm2 + w1[1] * cm1 + w1[2] * c0 + w1[3] * cp1;
        *(unsigned*)(zc + (32 * tq + t) * RG_ZS + 2 * k2) = pack2(y0, y1);
        am2 = am1; cm2 = cm1; am1 = a0; cm1 = c0; a0 = ap1; c0 = cp1;
    }
}
__device__ __forceinline__ float gelu_fast(float v) {
    const float av = fabsf(v), t = __builtin_amdgcn_rcpf(av * 0.2316418882f + 1.0f);
    float q = t * 0.5307027145f + (-0.7265760135f); q = q * t + 0.7107068705f; q = q * t + (-0.142248368f); q = q * t + 0.127414796f; q = q * t;
    const float e = __builtin_amdgcn_exp2f(v * v * (-0.72134752044f));
    const float m = v * (q * e);
    return v < 0.f ? m : v - m;
}
struct RgCtx { bf16x8 wr[4], wi[4]; float br, bi, coef; };
__device__ __forceinline__ void rg_ctx_load(const Params& p, int n, int cl, int dir, RgCtx& c) {
    const int lane = otid() & 63, fr = lane & 15, fq = lane >> 4, ch = n * 128 + cl + fr;
    const bf16_t* gr = p.wt_gate + ((size_t)(dir * 2 + 0) * 10 + n) * 16384 + (size_t)(cl + fr) * 128 + 8 * fq;
    const bf16_t* gi = p.wt_gate + ((size_t)(dir * 2 + 1) * 10 + n) * 16384 + (size_t)(cl + fr) * 128 + 8 * fq;
#pragma unroll
    for (int s = 0; s < 4; ++s) { c.wr[s] = *(const bf16x8*)(gr + 32 * s); c.wi[s] = *(const bf16x8*)(gi + 32 * s); }
    c.br = p.od_gate_b[(dir * 2 + 0) * RGW + ch]; c.bi = p.od_gate_b[(dir * 2 + 1) * RGW + ch];
    const float lam = p.od_lambda[dir * RGW + ch];
    c.coef = -8.0f * (fmaxf(-lam, 0.f) + log1pf(expf(-fabsf(lam)))) * 1.4426950408889634f;
}
__device__ __forceinline__ void rg_tile(const bf16_t* zc, int mt, int cl, const RgCtx& c, f32x4& a4, f32x4& x4) {
    const int lane = otid() & 63, fr = lane & 15, fq = lane >> 4;
    f32x4 r = (f32x4){0.f, 0.f, 0.f, 0.f}, ig = (f32x4){0.f, 0.f, 0.f, 0.f};
#pragma unroll
    for (int s = 0; s < 4; ++s) {
        const bf16x8 a = *(const bf16x8*)(zc + (16 * mt + fr) * RG_ZS + 32 * s + 8 * fq);
        r = __builtin_amdgcn_mfma_f32_16x16x32_bf16(a, c.wr[s], r, 0, 0, 0);
        ig = __builtin_amdgcn_mfma_f32_16x16x32_bf16(a, c.wi[s], ig, 0, 0, 0);
    }
#pragma unroll
    for (int rg = 0; rg < 4; ++rg) {
        const float rr = __builtin_amdgcn_rcpf(1.0f + __builtin_amdgcn_exp2f(-1.4426950408889634f * (r[rg] + c.br)));
        const float ii = __builtin_amdgcn_rcpf(1.0f + __builtin_amdgcn_exp2f(-1.4426950408889634f * (ig[rg] + c.bi)));
        const float a = __builtin_amdgcn_exp2f(c.coef * rr);
        const float z = bf2f(zc[(16 * mt + 4 * fq + rg) * RG_ZS + cl + fr]);
        a4[rg] = a; x4[rg] = sqrtf((1.0f - a) * (1.0f + a)) * ii * z;
    }
}
template <int DIR> __device__ __forceinline__ void rg_sum_dir(const Params& p, const bf16_t* zc, int b, int c34, int n, int cl, float* SUM) {
    const int lane = otid() & 63, fr = lane & 15, fq = lane >> 4;
    RgCtx c; rg_ctx_load(p, n, cl, DIR, c);
    float h = 0.f, pt = 1.f;
#pragma unroll 2
    for (int m2 = 0; m2 < 8; ++m2) {
        const int mt = DIR == 0 ? m2 : 7 - m2;
        f32x4 a, x; rg_tile(zc, mt, cl, c, a, x);
        const float P4 = a[0] * a[1] * a[2] * a[3];
        const float B4 = DIR == 0 ? ((x[0] * a[1] + x[1]) * a[2] + x[2]) * a[3] + x[3] : ((x[3] * a[2] + x[2]) * a[1] + x[1]) * a[0] + x[0];
#pragma unroll
        for (int g2 = 0; g2 < 4; ++g2) {
            const int gs = DIR == 0 ? g2 : 3 - g2;
            const float Pg = __shfl(P4, 16 * gs + fr), Bg = __shfl(B4, 16 * gs + fr);
            h = Pg * h + Bg; pt *= Pg;
        }
    }
    if (fq == 0) { float* dst = SUM + ((((size_t)b * 34 + c34) * 2 + DIR) * RGW + n * 128 + cl + fr) * 2; dst[0] = pt; dst[1] = h; }
}
__device__ __forceinline__ void ph_rg_a(const Params& p, unsigned char* smem) {
    bf16_t* zc = (bf16_t*)smem;
    float* SUM = (float*)p.G;
    const int wid = otid() >> 6;
    for (int u = blockIdx.x; u < NB * 34 * 10; u += gridDim.x) {
        const int b = u / 340, c34 = (u / 10) % 34, n = u % 10;
        __syncthreads();
        rg_stage_z(p, b, c34, n, zc);
        __syncthreads();
        for (int nt = 0; nt < 2; ++nt) {
            const int cl = 32 * wid + 16 * nt;
            rg_sum_dir<0>(p, zc, b, c34, n, cl, SUM);
            rg_sum_dir<1>(p, zc, b, c34, n, cl, SUM);
        }
    }
}
__device__ __forceinline__ void ph_rg_b(const Params& p) {
    const float* SUM = (const float*)p.G; float* HIN = (float*)(p.G + RG_SUM_BYTES);
    for (int gid = blockIdx.x * 256 + threadIdx.x; gid < NB * 2 * RGW; gid += gridDim.x * 256) {
        const int ch = gid % RGW, dir = (gid / RGW) & 1, b = gid / (2 * RGW);
        float h = 0.f;
#pragma unroll 2
        for (int step = 0; step < 34; ++step) {
            const int c34 = dir == 0 ? step : (step < 2 ? 1 - step : 35 - step);
            const size_t o = (((size_t)b * 34 + c34) * 2 + dir) * RGW + ch;
            HIN[o] = h;
            h = SUM[o * 2] * h + SUM[o * 2 + 1];
        }
    }
}
template <int DIR> __device__ __forceinline__ void rg_apply_dir(const Params& p, const bf16_t* zc, bf16_t* yf, int b, int c34, int n, int cl, const float* HIN) {
    const int lane = otid() & 63, fr = lane & 15, fq = lane >> 4, ch = n * 128 + cl + fr;
    RgCtx c; rg_ctx_load(p, n, cl, DIR, c);
    float h = HIN[(((size_t)b * 34 + c34) * 2 + DIR) * RGW + ch];
#pragma unroll 2
    for (int m2 = 0; m2 < 8; ++m2) {
        const int mt = DIR == 0 ? m2 : 7 - m2;
        f32x4 a, x; rg_tile(zc, mt, cl, c, a, x);
        const float P4 = a[0] * a[1] * a[2] * a[3];
        const float B4 = DIR == 0 ? ((x[0] * a[1] + x[1]) * a[2] + x[2]) * a[3] + x[3] : ((x[3] * a[2] + x[2]) * a[1] + x[1]) * a[0] + x[0];
        float hin = 0.f;
#pragma unroll
        for (int g2 = 0; g2 < 4; ++g2) {
            const int gs = DIR == 0 ? g2 : 3 - g2;
            const float Pg = __shfl(P4, 16 * gs + fr), Bg = __shfl(B4, 16 * gs + fr);
            if (fq == gs) hin = h;
            h = Pg * h + Bg;
        }
        f32x4 y;
        if (DIR == 0) {
            y[0] = a[0] * hin + x[0]; y[1] = a[1] * y[0] + x[1]; y[2] = a[2] * y[1] + x[2]; y[3] = a[3] * y[2] + x[3];
#pragma unroll
            for (int rg = 0; rg < 4; ++rg) yf[(16 * mt + 4 * fq + rg) * 16 + fr] = f2bf(y[rg]);
        } else {
            y[3] = a[3] * hin + x[3]; y[2] = a[2] * y[3] + x[2]; y[1] = a[1] * y[2] + x[1]; y[0] = a[0] * y[1] + x[0];
#pragma unroll
            for (int rg = 0; rg < 4; ++rg) {
                bf16_t* pb = p.P + ((size_t)b * PB + c34 * 128 + 16 * mt + 4 * fq + rg) * 2560 + ch;
                *pb = f2bf(gelu_fast(bf2f(*pb)) * (y[rg] + bf2f(yf[(16 * mt + 4 * fq + rg) * 16 + fr])));
            }
        }
    }
}
__device__ __forceinline__ void ph_rg_c(const Params& p, unsigned char* smem) {
    bf16_t* zc = (bf16_t*)smem;
    const float* HIN = (const float*)(p.G + RG_SUM_BYTES);
    const int wid = otid() >> 6;
    bf16_t* yf = (bf16_t*)(smem + 128 * RG_ZS * 2) + wid * 2048;
    for (int u = blockIdx.x; u < NB * 32 * 10; u += gridDim.x) {
        const int b = u / 320, c34 = 2 + (u / 10) % 32, n = u % 10;
        __syncthreads();
        rg_stage_z(p, b, c34, n, zc);
        __syncthreads();
        for (int nt = 0; nt < 2; ++nt) {
            const int cl = 32 * wid + 16 * nt;
            rg_apply_dir<0>(p, zc, yf, b, c34, n, cl, HIN);
            rg_apply_dir<1>(p, zc, yf, b, c34, n, cl, HIN);
        }
    }
}

#define XB_TMO      128
#define XB_XCNT(j)  (256  + 64 * (j))
#define XB_XSUB(j)  (1280 + 64 * (j))
#define XB_XGEN(j)  (2304 + 64 * (j))
#define XB_TOP      3328
#define XB_TOPGEN   3392
#define XCD_BAR_WORDS 3456
#define XB_SPIN_CAP (1u << 22)
#define LAS __attribute__((address_space(3)))
__device__ __forceinline__ unsigned xb_ld(unsigned* p) { return __hip_atomic_load(p, __ATOMIC_RELAXED, __HIP_MEMORY_SCOPE_AGENT); }
__device__ __forceinline__ unsigned xb_add(unsigned* p, unsigned v) { return __hip_atomic_fetch_add(p, v, __ATOMIC_RELAXED, __HIP_MEMORY_SCOPE_AGENT); }
__device__ __forceinline__ unsigned xb_xcc_id() { return (unsigned)__builtin_amdgcn_s_getreg((3 << 11) | 20) & 0xFu; }
#define XB_SPIN(cond, bar) do { unsigned _sp = 0; while (cond) { __builtin_amdgcn_s_sleep(1); \
    if ((++_sp & 255u) == 0u) { if (xb_ld(&(bar)[XB_TMO])) break; if (_sp > XB_SPIN_CAP) { atomicAdd(&(bar)[XB_TMO], 1u); break; } } } } while (0)
struct XcdBarrier { unsigned* bar; unsigned x; volatile LAS unsigned* st; };
__device__ __forceinline__ XcdBarrier xcd_barrier_post(unsigned* bar, volatile LAS unsigned* st) {
    XcdBarrier b; b.bar = bar; b.x = xb_xcc_id(); b.st = st;
    if (threadIdx.x == 0) (void)xb_add(&bar[XB_XCNT(b.x)], 1u);
    return b;
}
__device__ __forceinline__ void xcd_barrier_complete(unsigned* bar, unsigned x, unsigned& nloc, unsigned& nx) {
    const unsigned G = gridDim.x * gridDim.y * gridDim.z;
    unsigned sum, cnt, mine, sp = 0u;
    for (;;) {
        sum = 0u; cnt = 0u; mine = 0u;
#pragma unroll
        for (unsigned j = 0; j < 16; ++j) { const unsigned c = xb_ld(&bar[XB_XCNT(j)]); sum += c; cnt += (c > 0u) ? 1u : 0u; mine = (j == x) ? c : mine; }
        if (sum == G) break;
        __builtin_amdgcn_s_sleep(1);
        if ((++sp & 255u) == 0u) { if (xb_ld(&bar[XB_TMO])) break; if (sp > XB_SPIN_CAP) { atomicAdd(&bar[XB_TMO], 1u); break; } }
    }
    nloc = mine > 0u ? mine : 1u; nx = cnt > 0u ? cnt : 1u;
}
__device__ __forceinline__ void xcd_barrier(const XcdBarrier& b) {
    asm volatile("s_waitcnt vmcnt(0)" ::: "memory");
    __syncthreads();
    if (threadIdx.x == 0) {
        unsigned* bar = b.bar;
        __builtin_amdgcn_s_waitcnt(0);
        unsigned nloc = b.st[0], nx = b.st[1];
        if (nloc == 0u) { xcd_barrier_complete(bar, b.x, nloc, nx); b.st[0] = nloc; b.st[1] = nx; }
        const unsigned old = xb_add(&bar[XB_XSUB(b.x)], 1u);
        const unsigned gen = old / nloc;
        if (old + 1u == (gen + 1u) * nloc) {
            __builtin_amdgcn_fence(__ATOMIC_RELEASE, "agent");
            asm volatile("s_waitcnt vmcnt(0)" ::: "memory");
            const unsigned og = xb_add(&bar[XB_TOP], 1u);
            const unsigned tg = og / nx;
            if (og + 1u == (tg + 1u) * nx) xb_add(&bar[XB_TOPGEN], 1u);
            else XB_SPIN(xb_ld(&bar[XB_TOPGEN]) == tg, bar);
            __builtin_amdgcn_fence(__ATOMIC_ACQUIRE, "agent");
            xb_add(&bar[XB_XGEN(b.x)], 1u);
            asm volatile("s_waitcnt vmcnt(0)" ::: "memory");
        } else {
            XB_SPIN(xb_ld(&bar[XB_XGEN(b.x)]) == gen, bar);
            __builtin_amdgcn_fence(__ATOMIC_ACQUIRE, "agent");
            asm volatile("s_waitcnt vmcnt(0)" ::: "memory");
        }
    }
    __syncthreads();
}

#define SMEM_DECL __shared__ __attribute__((aligned(16))) unsigned char smem[65536]
__global__ void __launch_bounds__(256) k_prologue(Params p) { SMEM_DECL; ph_prologue(p, smem); }
__global__ void __launch_bounds__(256) k_modulate0(Params p) { ph_modulate0(p); }
__global__ void __launch_bounds__(256) k_gemm_ev_in(Params p) { SMEM_DECL; gemm_phase(p.A16, D, p.wt_ev_in, 1024, EV_IN, RowMap{0}, EpiBf16{p.P, EV_IN, EV_IN}, smem); }
__global__ void __launch_bounds__(256) k_rowpost(Params p) { ph_rowpost(p); }
__global__ void __launch_bounds__(256) k_gemm_q(Params p) { SMEM_DECL; gemm_phase(p.P + C_CQ, EV_IN, p.wt_uq, 384, 768, RowMap{0}, EpiQ{p.Q16, p.rsq, p.rope_cos, p.rope_sin}, smem); }
__global__ void __launch_bounds__(256) k_gemm_kv(Params p) { SMEM_DECL; gemm_phase(p.P + C_CKV, EV_IN, p.wt_ukv, 256, 1024, RowMap{0}, EpiKV{p.K16, p.V16, p.rsq + R}, smem); }
__global__ void __launch_bounds__(256) k_gemm_ev_out(Params p) { SMEM_DECL; gemm_phase(p.A16, D, p.wt_ev_out, 1024, 1024, RowMap{0}, EpiResid{p.x, p.ctx, p.mod, p.H, 0}, smem); }
__global__ void __launch_bounds__(256) k_ln_mod(Params p, int layer, int lat_only) { ph_ln_mod(p, layer, 0, lat_only); }
__global__ void __launch_bounds__(256) k_gemm_pq(Params p, int layer, int lat_only) { SMEM_DECL; gemm_phase(p.A16, D, p.wt_pq + (size_t)layer * 2048 * 1024, 1024, 2048, RowMap{lat_only}, EpiBf16{p.P, 2048, 2048}, smem); }
__global__ void __launch_bounds__(256) k_combine(Params p, int lat_only) { ph_combine(p, lat_only); }
__global__ void __launch_bounds__(256) k_gather(Params p, int layer, int lat_only) { ph_gather_ln(p, layer, lat_only); }
__global__ void __launch_bounds__(256) k_gemm_od_in(Params p) { SMEM_DECL; gemm_phase(p.A16, D, p.wt_od_in, 1024, 2560, RowMap{0}, EpiBf16{p.P, 2560, 2560}, smem); }
__global__ void __launch_bounds__(256) k_gemm_od_out(Params p) { SMEM_DECL; gemm_phase(p.P, 2560, p.wt_od_out, 1280, 1024, RowMap{1}, EpiResid{p.x, p.ctx, p.mod, p.H, 1}, smem); }

__global__ void __launch_bounds__(256, 2) k_mega(Params p) {
    SMEM_DECL;
    cg::grid_group grid = cg::this_grid();
    volatile LAS unsigned* xst = (volatile LAS unsigned*)(LAS unsigned char*)(smem + 65520);
    if (threadIdx.x == 0) { xst[0] = 0u; xst[1] = 0u; }
    if (blockIdx.x == 0) for (int i = threadIdx.x; i < XCD_BAR_WORDS; i += 256) p.bar[i] = 0u;
    ph_prologue(p, smem); grid.sync();
    const XcdBarrier xb = xcd_barrier_post(p.bar, xst);
    ph_modulate0(p); xcd_barrier(xb);
    gemm_phase(p.A16, D, p.wt_ev_in, 1024, EV_IN, RowMap{0}, EpiBf16{p.P, EV_IN, EV_IN}, smem); xcd_barrier(xb);
    ph_rowpost(p); ph_gla_a(p, smem); xcd_barrier(xb);
    gemm_phase(p.P + C_CQ, EV_IN, p.wt_uq, 384, 768, RowMap{0}, EpiQ{p.Q16, p.rsq, p.rope_cos, p.rope_sin}, smem);
    gemm_phase(p.P + C_CKV, EV_IN, p.wt_ukv, 256, 1024, RowMap{0}, EpiKV{p.K16, p.V16, p.rsq + R}, smem); ph_gla_b(p); xcd_barrier(xb);
    ph_gla_c(p, smem); ph_attn(p, smem, blockIdx.x, gridDim.x); xcd_barrier(xb);
    gemm_phase(p.A16, D, p.wt_ev_out, 1024, 1024, RowMap{0}, EpiResid{p.x, p.ctx, p.mod, p.H, 0}, smem); xcd_barrier(xb);
    ph_ln_mod(p, 0, 0, 0); xcd_barrier(xb);
    gemm_phase(p.A16, D, p.wt_pq, 1024, 2048, RowMap{0}, EpiBf16{p.P, 2048, 2048}, smem); xcd_barrier(xb);
    ph_scores(p, 0, 0, smem); xcd_barrier(xb);
    ph_combine(p, 0); ph_convert_uv(p, 0); xcd_barrier(xb);
    ph_gather_sliced(p, 0, 0, smem); xcd_barrier(xb);
    gemm_phase(p.A16, D, p.wt_od_in, 1024, 2560, RowMap{0}, EpiBf16{p.P, 2560, 2560}, smem); xcd_barrier(xb);
    ph_rg_a(p, smem); xcd_barrier(xb);
    ph_rg_b(p); xcd_barrier(xb);
    ph_rg_c(p, smem); xcd_barrier(xb);
    gemm_phase(p.P, 2560, p.wt_od_out, 1280, 1024, RowMap{1}, EpiResid{p.x, p.ctx, p.mod, p.H, 1}, smem); xcd_barrier(xb);
    ph_ln_mod(p, 1, 0, 1); xcd_barrier(xb);
    gemm_phase(p.A16, D, p.wt_pq + (size_t)2048 * 1024, 1024, 2048, RowMap{1}, EpiBf16{p.P, 2048, 2048}, smem); xcd_barrier(xb);
    ph_scores(p, 1, 1, smem); xcd_barrier(xb);
    ph_combine(p, 1); ph_convert_uv(p, 1); xcd_barrier(xb);
    ph_gather_sliced(p, 1, 1, smem);
}

extern "C" void kernel_launch(void* const* d_in, const int* in_sizes, int n_in, void* d_out, int out_size, void* d_ws, size_t ws_size, hipStream_t stream) {
    Params p{};
    const float** f = (const float**)d_in;
    p.x = f[0]; p.c = f[1]; p.ctx = f[2]; p.c_ctx = f[3]; p.mod_w = f[4]; p.mod_b = f[5]; p.ln_g = f[6]; p.ln_b = f[7];
    p.ev_w_in = f[8]; p.ev_q_norm = f[9]; p.ev_kv_norm = f[10]; p.ev_w_uq = f[11]; p.ev_w_ukv = f[12]; p.ev_gla_wa2 = f[13]; p.ev_gla_ba = f[14]; p.ev_gla_norm = f[15]; p.ev_w_out = f[16];
    p.od_w_in = f[17]; p.od_conv_w = f[18]; p.od_conv_b = f[19]; p.od_gate_w = f[20]; p.od_gate_b = f[21]; p.od_lambda = f[22]; p.od_w_out = f[23];
    p.peer_wq = f[24]; p.peer_k1 = f[25]; p.peer_k2 = f[26]; p.peer_u = f[27]; p.peer_v = f[28];
    p.out = (float*)d_out;
    unsigned char* w = (unsigned char*)d_ws; size_t off = 0;
    auto take = [&](size_t bytes) { unsigned char* r = w + off; off += (bytes + 255) & ~(size_t)255; return r; };
    p.wt_ev_in = (bf16_t*)take((size_t)EV_IN * 1024 * 2); p.wt_uq = (bf16_t*)take(768 * 384 * 2); p.wt_ukv = (bf16_t*)take(1024 * 256 * 2);
    p.wt_ev_out = (bf16_t*)take(1024 * 1024 * 2); p.wt_od_in = (bf16_t*)take(2560 * 1024 * 2); p.wt_gate = (bf16_t*)take(40 * 16384 * 2);
    p.wt_od_out = (bf16_t*)take(1024 * 1280 * 2); p.wt_pq = (bf16_t*)take((size_t)2 * 2048 * 1024 * 2); p.wt_k = (bf16_t*)take(4 * 16384 * 2);
    p.mod = (float*)take(2 * 9 * 6144 * 4); p.rope_cos = (float*)take(SEQ * 16 * 4); p.rope_sin = (float*)take(SEQ * 16 * 4); p.rsq = (float*)take((size_t)2 * R * 4);
    p.H = (float*)take((size_t)R * D * 4);
    p.Q16 = (bf16_t*)p.H; p.K16 = p.Q16 + (size_t)R * 768; p.V16 = p.K16 + (size_t)R * 768;
    p.A16 = (bf16_t*)take((size_t)R * D * 2);
    p.P = (bf16_t*)take((size_t)R * 2560 * 2);
    p.G = take((size_t)94371840);
    p.bar = (unsigned*)take(XCD_BAR_WORDS * 4);
    if (off > ws_size) { fprintf(stderr, "workspace too small: need %zu have %zu\n", off, ws_size); return; }
    static int grid_blocks = 0;
    if (!grid_blocks) {
        int dev = 0, cus = 0, per_cu = 0;
        (void)hipGetDevice(&dev);
        (void)hipDeviceGetAttribute(&cus, hipDeviceAttributeMultiprocessorCount, dev);
        (void)hipOccupancyMaxActiveBlocksPerMultiprocessor(&per_cu, k_mega, 256, 0);
        if (per_cu > 2) per_cu = 2;
        if (per_cu < 1) per_cu = 1;
        grid_blocks = cus * per_cu;
    }
    void* args[] = {&p};
    hipError_t e = hipLaunchCooperativeKernel((void*)k_mega, dim3(grid_blocks), dim3(256), args, 0, stream);
    if (e != hipSuccess) fprintf(stderr, "cooperative launch failed: %s (grid %d)\n", hipGetErrorString(e), grid_blocks);
}
__global__ void __launch_bounds__(256) k_gather2(Params p, int layer, int lat_only) { SMEM_DECL; ph_gather_mfma(p, layer, lat_only, smem); }
__global__ void __launch_bounds__(256) k_rga(Params p) { SMEM_DECL; ph_rg_a(p, smem); }
__global__ void __launch_bounds__(256) k_rgc(Params p) { SMEM_DECL; ph_rg_c(p, smem); }
__global__ void __launch_bounds__(256) k_glaa(Params p) { SMEM_DECL; ph_gla_a(p, smem); }
__global__ void __launch_bounds__(256) k_glac(Params p) { SMEM_DECL; ph_gla_c(p, smem); }
__global__ void __launch_bounds__(256) k_attn2(Params p) { SMEM_DECL; ph_attn(p, smem, blockIdx.x, gridDim.x); }
```

```cpp
#include <hip/hip_runtime.h>
#include <hip/hip_cooperative_groups.h>
#include <cstdio>
#include <cstdint>

namespace cg = cooperative_groups;
typedef unsigned short bf16_t;
typedef short bf16x8 __attribute__((ext_vector_type(8)));
typedef float f32x4 __attribute__((ext_vector_type(4)));
typedef float f32x16 __attribute__((ext_vector_type(16)));
typedef unsigned u32x4 __attribute__((ext_vector_type(4)));
typedef unsigned u32x2 __attribute__((ext_vector_type(2)));

constexpr int D = 1024, NB = 8, SEQ = 4096, CTX = 256, PB = SEQ + CTX  , R = NB * PB  ;
constexpr int EV_IN = 2240, RGW = 1280;
constexpr int C_CQ = 0, C_CKV = 384, C_KPE = 640, C_GQ = 672, C_GK = 928, C_GV = 1184, C_GG = 1696, C_GAF = 2208;
constexpr float LN_EPS = 1e-6f, ALPHA = 1.41421356237f, MLA_SCALE = 0.10206207261596577f  ;
constexpr int PEER_N = 16384;

#ifndef PROBE_MASK
#define PROBE_MASK 0
#endif
struct Params {
    const float *x, *c, *ctx, *c_ctx, *mod_w, *mod_b, *ln_g, *ln_b;
    const float *ev_w_in, *ev_q_norm, *ev_kv_norm, *ev_w_uq, *ev_w_ukv, *ev_gla_wa2, *ev_gla_ba, *ev_gla_norm, *ev_w_out;
    const float *od_w_in, *od_conv_w, *od_conv_b, *od_gate_w, *od_gate_b, *od_lambda, *od_w_out;
    const float *peer_wq, *peer_k1, *peer_k2, *peer_u, *peer_v;
    float* out;
    bf16_t *wt_ev_in, *wt_uq, *wt_ukv, *wt_ev_out, *wt_od_in, *wt_gate, *wt_od_out, *wt_pq, *wt_k;
    float *mod, *rope_cos, *rope_sin, *rsq;
    float* H; bf16_t *Q16, *K16, *V16;
    bf16_t* A16; bf16_t* P; unsigned char* G;
    unsigned* bar;
    int probe, pad_;
};

__device__ __forceinline__ bf16_t f2bf(float f) { unsigned u = __float_as_uint(f); u += 0x7fffu + ((u >> 16) & 1u); return (bf16_t)(u >> 16); }
__device__ __forceinline__ float bf2f(bf16_t h) { return __uint_as_float(((unsigned)h) << 16); }
__device__ __forceinline__ unsigned pack2(float a, float b) { unsigned r; asm volatile("v_cvt_pk_bf16_f32 %0, %1, %2" : "=v"(r) : "v"(a), "v"(b)); return r; }
__device__ __forceinline__ float silu_f(float x) { return x / (1.0f + expf(-x)); }
__device__ __forceinline__ float sigmoid_f(float x) { return 1.0f / (1.0f + expf(-x)); }
__device__ __forceinline__ float gelu_f(float x) { return 0.5f * x * (1.0f + erff(x * 0.70710678118654752f)); }
__device__ __forceinline__ float wave_sum(float v) {
#pragma unroll
    for (int o = 32; o > 0; o >>= 1) v += __shfl_xor(v, o);
    return v;
}
__device__ __forceinline__ int otid() { int t = threadIdx.x; asm volatile("" : "+v"(t)); return t; }
__device__ __forceinline__ int mod_row(int r) { const int b = r / PB, p = r - b * PB; return p < CTX ? 8 : b; }
__device__ __forceinline__ const float* in_row(const Params& P_, int r) {
    const int b = r / PB, p = r - b * PB;
    return p < CTX ? P_.ctx + ((size_t)b * CTX + p) * D : P_.x + ((size_t)b * SEQ + (p - CTX)) * D;
}

__device__ __forceinline__ void tconv_tile(const float* __restrict__ W, int K, int N, bf16_t* __restrict__ Wt, const float* __restrict__ rowscale, int tile, float* sm) {
    const int ntn = N / 64, tk = tile / ntn, tn = tile % ntn, tid = threadIdx.x;
#pragma unroll
    for (int i = 0; i < 4; ++i) {
        const int k = (tid >> 4) + 16 * i;
        f32x4 v = *(const f32x4*)(W + (size_t)(tk * 64 + k) * N + tn * 64 + (tid & 15) * 4);
        const float s = rowscale ? rowscale[tk * 64 + k] : 1.0f;
#pragma unroll
        for (int q = 0; q < 4; ++q) sm[k * 65 + (tid & 15) * 4 + q] = v[q] * s;
    }
    __syncthreads();
    const int n = tid >> 2, kc = tid & 3;
    unsigned w[8];
#pragma unroll
    for (int kk = 0; kk < 8; ++kk) w[kk] = pack2(sm[(kc * 16 + 2 * kk) * 65 + n], sm[(kc * 16 + 2 * kk + 1) * 65 + n]);
    bf16_t* dst = Wt + (size_t)(tn * 64 + n) * K + tk * 64 + kc * 16;
    *(u32x4*)dst = (u32x4){w[0], w[1], w[2], w[3]};
    *(u32x4*)(dst + 8) = (u32x4){w[4], w[5], w[6], w[7]};
    __syncthreads();
}
__device__ __forceinline__ void tconv_all(const float* W, int K, int N, bf16_t* Wt, const float* rowscale, float* sm) {
    const int nt = (K / 64) * (N / 64);
    for (int t = blockIdx.x; t < nt; t += gridDim.x) tconv_tile(W, K, N, Wt, rowscale, t, sm);
}

__device__ __forceinline__ void ph_prologue(const Params& p, unsigned char* smem) {
    float* sm = (float*)smem;
    tconv_all(p.ev_w_in, 1024, EV_IN, p.wt_ev_in, nullptr, sm);
    tconv_all(p.ev_w_uq, 384, 768, p.wt_uq, p.ev_q_norm, sm);
    tconv_all(p.ev_w_ukv, 256, 1024, p.wt_ukv, p.ev_kv_norm, sm);
    tconv_all(p.ev_w_out, 1024, 1024, p.wt_ev_out, nullptr, sm);
    tconv_all(p.od_w_in, 1024, 2560, p.wt_od_in, nullptr, sm);
    for (int g = 0; g < 40; ++g) tconv_all(p.od_gate_w + (size_t)g * 16384, 128, 128, p.wt_gate + (size_t)g * 16384, nullptr, sm);
    tconv_all(p.od_w_out, 1280, 1024, p.wt_od_out, nullptr, sm);
    for (int l = 0; l < 2; ++l) tconv_all(p.peer_wq + (size_t)l * 1024 * 2048, 1024, 2048, p.wt_pq + (size_t)l * 1024 * 2048, nullptr, sm);
    for (int i = blockIdx.x * 256 + threadIdx.x; i < 2 * 2 * 16384; i += gridDim.x * 256) {
        const int l = i / 32768, h = (i / 16384) & 1, e = i & 16383;
        p.wt_k[i] = f2bf((h ? p.peer_k2 : p.peer_k1)[(size_t)l * 16384 + e]);
    }
    for (int i = blockIdx.x * 256 + threadIdx.x; i < SEQ * 16; i += gridDim.x * 256) {
        const int s = i >> 4, f = i & 15;
        const float pos = (float)(f < 8 ? (s >> 6) : (s & 63));
        const float inv = powf(10000.0f, -(float)(f & 7) / 8.0f);
        const float ang = pos * inv;
        p.rope_cos[i] = cosf(ang); p.rope_sin[i] = sinf(ang);
    }
    float* sc = sm;
    for (int u = blockIdx.x; u < 2 * 96; u += gridDim.x) {
        const int l = u / 96, c0 = (u % 96) * 64, tid = threadIdx.x;
        __syncthreads();
        for (int i = tid; i < 9 * 1024; i += 256) { const int rr = i >> 10, k = i & 1023; sc[i] = silu_f(rr < 8 ? p.c[rr * 1024 + k] : p.c_ctx[k]); }
        __syncthreads();
        const int col = c0 + (tid & 63), kq = tid >> 6;
        float acc[9];
#pragma unroll
        for (int rr = 0; rr < 9; ++rr) acc[rr] = 0.f;
        const float* w = p.mod_w + (size_t)l * 1024 * 6144 + col;
        for (int k = kq * 256; k < kq * 256 + 256; ++k) {
            const float wv = w[(size_t)k * 6144];
#pragma unroll
            for (int rr = 0; rr < 9; ++rr) acc[rr] += sc[rr * 1024 + k] * wv;
        }
        __syncthreads();
        float* red = sm + 9 * 1024;
#pragma unroll
        for (int rr = 0; rr < 9; ++rr) red[(kq * 9 + rr) * 64 + (tid & 63)] = acc[rr];
        __syncthreads();
        for (int i = tid; i < 9 * 64; i += 256) {
            const int rr = i >> 6, cc = i & 63;
            const float s = red[(0 * 9 + rr) * 64 + cc] + red[(1 * 9 + rr) * 64 + cc] + red[(2 * 9 + rr) * 64 + cc] + red[(3 * 9 + rr) * 64 + cc];
            p.mod[((size_t)l * 9 + rr) * 6144 + c0 + cc] = s + p.mod_b[l * 6144 + c0 + cc];
        }
    }
}

__device__ __forceinline__ void ph_modulate0(const Params& p) {
    const int tid_ = otid(), wid = tid_ >> 6, lane = tid_ & 63;
    for (int u = blockIdx.x; u < R / 4; u += gridDim.x) {
        const int r = u * 4 + wid;
        const float* src = in_row(p, r);
        const float* md = p.mod + (size_t)(0 * 9 + mod_row(r)) * 6144;
#pragma unroll
        for (int q = 0; q < 4; ++q) {
            const int c = q * 256 + lane * 4;
            const f32x4 h = *(const f32x4*)(src + c), sh = *(const f32x4*)(md + c), scl = *(const f32x4*)(md + 1024 + c);
            const f32x4 v = h * (1.0f + scl) + sh;
            *(u32x2*)(p.A16 + (size_t)r * D + c) = (u32x2){pack2(v[0], v[1]), pack2(v[2], v[3])};
        }
    }
}

constexpr int GBK = 64, GLDS = 64  ;
struct RowMap { int lat_only; __device__ __forceinline__ int ntiles() const { return lat_only ? 256 : 272; }
    __device__ __forceinline__ int row0(int t) const { return lat_only ? (t >> 5) * PB + CTX + (t & 31) * 128 : t * 128; } };

template <class Epi>
__device__ __forceinline__ void gemm_phase(const bf16_t* __restrict__ A, int lda, const bf16_t* __restrict__ Bt, int K, int N, RowMap rm, const Epi& epi, unsigned char* smem) {
    bf16_t* sA = (bf16_t*)smem; bf16_t* sB = sA + 128 * GLDS;
    const int tid = otid(), lane = tid & 63, wid = tid >> 6, wm = wid >> 1, wn = wid & 1, fr = lane & 15, fq = lane >> 4;
    const int ntn = (N + 127) / 128, nunits = rm.ntiles() * ntn, nk = K / GBK;
    for (int u = blockIdx.x; u < nunits; u += gridDim.x) {
        const int tm = u / ntn, tn = u % ntn, m0 = rm.row0(tm), n0 = tn * 128;
        f32x4 acc[4][4];
#pragma unroll
        for (int i = 0; i < 4; ++i)
#pragma unroll
            for (int j = 0; j < 4; ++j) acc[i][j] = (f32x4){0.f, 0.f, 0.f, 0.f};
        u32x4 ra[4], rb[4];
        auto gload = [&](int kt) {
#pragma unroll
            for (int i = 0; i < 4; ++i) {
                const int id = tid + 256 * i, row = id >> 3, ch = id & 7;
                ra[i] = *(const u32x4*)(A + (size_t)(m0 + row) * lda + kt * GBK + ch * 8);
                int brow = n0 + row; brow = brow < N ? brow : N - 1;
                rb[i] = *(const u32x4*)(Bt + (size_t)brow * K + kt * GBK + ch * 8);
            }
        };
        auto lstore = [&]() {
#pragma unroll
            for (int i = 0; i < 4; ++i) {
                const int id = tid + 256 * i, row = id >> 3, ch = id & 7;
                *(u32x4*)(sA + row * GLDS + ((ch ^ (row & 7)) * 8)) = ra[i];
                *(u32x4*)(sB + row * GLDS + ((ch ^ (row & 7)) * 8)) = rb[i];
            }
        };
        gload(0);
        __syncthreads();
        lstore();
        __syncthreads();
        for (int kt = 0; kt < nk; ++kt) {
            if (kt + 1 < nk) gload(kt + 1);
#pragma unroll
            for (int ks = 0; ks < 2; ++ks) {
                bf16x8 af[4], bfr[4];
#pragma unroll
                for (int i = 0; i < 4; ++i) af[i] = *(const bf16x8*)(sA + (wm * 64 + i * 16 + fr) * GLDS + (((ks * 4 + fq) ^ (fr & 7)) * 8));
#pragma unroll
                for (int j = 0; j < 4; ++j) bfr[j] = *(const bf16x8*)(sB + (wn * 64 + j * 16 + fr) * GLDS + (((ks * 4 + fq) ^ (fr & 7)) * 8));
#pragma unroll
                for (int i = 0; i < 4; ++i)
#pragma unroll
                    for (int j = 0; j < 4; ++j) acc[i][j] = __builtin_amdgcn_mfma_f32_16x16x32_bf16(bfr[j], af[i], acc[i][j], 0, 0, 0);
            }
            __syncthreads();
            if (kt + 1 < nk) { lstore(); __syncthreads(); }
        }
        epi(acc, m0 + wm * 64, n0 + wn * 64, fr, fq);
    }
}

struct EpiBf16 {
    bf16_t* C; int ldc, N;
    __device__ __forceinline__ void operator()(const f32x4 (&acc)[4][4], int mb, int nb, int fr, int fq) const {
#pragma unroll
        for (int i = 0; i < 4; ++i)
#pragma unroll
            for (int j = 0; j < 4; ++j) {
                const int m = mb + i * 16 + fr, n = nb + j * 16 + 4 * fq;
                if (n < N) *(u32x2*)(C + (size_t)m * ldc + n) = (u32x2){pack2(acc[i][j][0], acc[i][j][1]), pack2(acc[i][j][2], acc[i][j][3])};
            }
    }
};
struct EpiQ {
    bf16_t* Q; const float *rsq, *rc, *rs;
    __device__ __forceinline__ void operator()(const f32x4 (&acc)[4][4], int mb, int nb, int fr, int fq) const {
#pragma unroll
        for (int i = 0; i < 4; ++i) {
            const int m = mb + i * 16 + fr, b = m / PB, pp = m - b * PB;
            const float sc = rsq[m] * (MLA_SCALE * 1.4426950408889634f);
#pragma unroll
            for (int j = 0; j < 4; j += 2) {
                const int n = nb + j * 16 + 4 * fq;
                f32x4 v0 = acc[i][j] * sc, v1 = acc[i][j + 1] * sc;
                const int d = n % 96;
                if (d >= 64 && pp >= CTX) {
                    const int s = pp - CTX, f = (d - 64) + 0;
                    const f32x4 cs = *(const f32x4*)(rc + s * 16 + f), sn = *(const f32x4*)(rs + s * 16 + f);
                    const f32x4 o0 = v0 * cs - v1 * sn, o1 = v0 * sn + v1 * cs; v0 = o0; v1 = o1;
                }
                *(u32x2*)(Q + (size_t)m * 768 + n) = (u32x2){pack2(v0[0], v0[1]), pack2(v0[2], v0[3])};
                *(u32x2*)(Q + (size_t)m * 768 + n + 16) = (u32x2){pack2(v1[0], v1[1]), pack2(v1[2], v1[3])};
            }
        }
    }
};
struct EpiKV {
    bf16_t *Kd, *Vd; const float* rsq;
    __device__ __forceinline__ void operator()(const f32x4 (&acc)[4][4], int mb, int nb, int fr, int fq) const {
#pragma unroll
        for (int i = 0; i < 4; ++i) {
            const int m = mb + i * 16 + fr; const float sc = rsq[m];
#pragma unroll
            for (int j = 0; j < 4; ++j) {
                const int n = nb + j * 16 + 4 * fq, hd = n >> 7, d = n & 127;
                const f32x4 v = acc[i][j] * sc;
                bf16_t* dst = d < 64 ? Kd + (size_t)m * 768 + hd * 96 + d : Vd + (size_t)m * 512 + hd * 64 + (d - 64);
                *(u32x2*)dst = (u32x2){pack2(v[0], v[1]), pack2(v[2], v[3])};
            }
        }
    }
};
struct EpiResid {
    const float *x, *ctx, *mod; float* H; int layer;
    __device__ __forceinline__ void operator()(const f32x4 (&acc)[4][4], int mb, int nb, int fr, int fq) const {
#pragma unroll
        for (int i = 0; i < 4; ++i) {
            const int m = mb + i * 16 + fr, b = m / PB, pp = m - b * PB;
            const float* hin = layer == 0 ? (pp < CTX ? ctx + ((size_t)b * CTX + pp) * D : x + ((size_t)b * SEQ + (pp - CTX)) * D) : H + (size_t)m * D;
            const float* gate = mod + ((size_t)layer * 9 + (pp < CTX ? 8 : b)) * 6144 + 2 * 1024;
#pragma unroll
            for (int j = 0; j < 4; ++j) {
                const int n = nb + j * 16 + 4 * fq;
                const f32x4 h = *(const f32x4*)(hin + n), g = *(const f32x4*)(gate + n);
                *(f32x4*)(H + (size_t)m * D + n) = ALPHA * h + g * acc[i][j];
            }
        }
    }
};

__device__ __forceinline__ void ph_rowpost(const Params& p) {
    const int tid_ = otid(), wid = tid_ >> 6, lane = tid_ & 63;
    for (int u = blockIdx.x; u < R / 4; u += gridDim.x) {
        const int r = u * 4 + wid, b = r / PB, pp = r - b * PB;
        const bf16_t* row = p.P + (size_t)r * EV_IN;
        float sq = 0.f, skv = 0.f;
#pragma unroll
        for (int i = 0; i < 10; ++i) { const float v = bf2f(row[lane + 64 * i]); if (i < 6) sq += v * v; else skv += v * v; }
        sq = wave_sum(sq); skv = wave_sum(skv);
        if (lane == 0) { p.rsq[r] = rsqrtf(sq / 384.0f + LN_EPS); p.rsq[R + r] = rsqrtf(skv / 256.0f + LN_EPS); }
        if (lane < 16) {
            float x1 = bf2f(row[C_KPE + lane]), x2 = bf2f(row[C_KPE + 16 + lane]);
            if (pp >= CTX) { const int s = pp - CTX; const float cs = p.rope_cos[s * 16 + lane], sn = p.rope_sin[s * 16 + lane];
                const float o1 = x1 * cs - x2 * sn, o2 = x1 * sn + x2 * cs; x1 = o1; x2 = o2; }
            const bf16_t b1 = f2bf(x1), b2 = f2bf(x2);
#pragma unroll
            for (int hd = 0; hd < 8; ++hd) { p.K16[(size_t)r * 768 + hd * 96 + 64 + lane] = b1; p.K16[(size_t)r * 768 + hd * 96 + 80 + lane] = b2; }
        }
    }
}

constexpr int AT_KS = 104, AT_VS = 68, AT_BUF = 64 * AT_KS * 2 + 64 * AT_VS * 2;
__device__ __forceinline__ void ph_attn(const Params& p, unsigned char* smem, int bid, int nblk) {
    const int tid = otid(), wid = tid >> 6, lane = tid & 63, q = lane & 31, h = lane >> 5;
    for (int u = bid; u < 2048 + 128; u += nblk) {
        int b, hd, q0, nkeys;
        if (u < 2048) { b = u >> 8; hd = (u >> 5) & 7; q0 = CTX + (u & 31) * 128; nkeys = PB; }
        else { const int v = u - 2048; b = v >> 4; hd = (v >> 1) & 7; q0 = (v & 1) * 128; nkeys = CTX; }
        const size_t rq = (size_t)b * PB + q0 + wid * 32 + q;
        bf16x8 qf[6];
#pragma unroll
        for (int s = 0; s < 6; ++s) qf[s] = *(const bf16x8*)(p.Q16 + rq * 768 + hd * 96 + 16 * s + 8 * h);
        f32x16 o[2];
#pragma unroll
        for (int i = 0; i < 16; ++i) { o[0][i] = 0.f; o[1][i] = 0.f; }
        float m = -1e30f, l = 0.f;
        const int ntiles = nkeys / 64;
        const bf16_t* Kg = p.K16 + (size_t)b * PB * 768 + hd * 96;
        const bf16_t* Vg = p.V16 + (size_t)b * PB * 512 + hd * 64;
        u32x4 rk[3], rv[2];
        auto gload = [&](int t) {
#pragma unroll
            for (int i = 0; i < 3; ++i) { const int id = tid + 256 * i, key = id / 12, ch = id % 12; rk[i] = *(const u32x4*)(Kg + (size_t)(t * 64 + key) * 768 + ch * 8); }
#pragma unroll
            for (int i = 0; i < 2; ++i) { const int id = tid + 256 * i, key = id >> 3, dch = id & 7; rv[i] = *(const u32x4*)(Vg + (size_t)(t * 64 + key) * 512 + dch * 8); }
        };
        auto lstore = [&](int buf) {
            bf16_t* Ks = (bf16_t*)(smem + buf * AT_BUF); bf16_t* Vt = Ks + 64 * AT_KS;
#pragma unroll
            for (int i = 0; i < 3; ++i) { const int id = tid + 256 * i, key = id / 12, ch = id % 12; *(u32x4*)(Ks + key * AT_KS + ch * 8) = rk[i]; }
#pragma unroll
            for (int i = 0; i < 2; ++i) {
                const int id = tid + 256 * i, key = id >> 3, dch = id & 7;
#pragma unroll
                for (int e = 0; e < 4; ++e) { Vt[(dch * 8 + 2 * e) * AT_VS + key] = (bf16_t)(rv[i][e] & 0xffffu); Vt[(dch * 8 + 2 * e + 1) * AT_VS + key] = (bf16_t)(rv[i][e] >> 16); }
            }
        };
        __syncthreads();
        gload(0); lstore(0);
        __syncthreads();
        for (int t = 0; t < ntiles; ++t) {
            if (t + 1 < ntiles) gload(t + 1);
            const bf16_t* Ks = (const bf16_t*)(smem + (t & 1) * AT_BUF); const bf16_t* Vt = Ks + 64 * AT_KS;
            f32x16 sa[2];
#pragma unroll
            for (int kb = 0; kb < 2; ++kb) {
#pragma unroll
                for (int i = 0; i < 16; ++i) sa[kb][i] = 0.f;
#pragma unroll
                for (int s = 0; s < 6; ++s) {
                    const bf16x8 kf = *(const bf16x8*)(Ks + (kb * 32 + q) * AT_KS + 16 * s + 8 * h);
                    sa[kb] = __builtin_amdgcn_mfma_f32_32x32x16_bf16(kf, qf[s], sa[kb], 0, 0, 0);
                }
            }
            float mx = sa[0][0];
#pragma unroll
            for (int i = 1; i < 16; ++i) mx = fmaxf(mx, sa[0][i]);
#pragma unroll
            for (int i = 0; i < 16; ++i) mx = fmaxf(mx, sa[1][i]);
            mx = fmaxf(mx, __shfl_xor(mx, 32));
            const float mn = fmaxf(m, mx), al = __builtin_amdgcn_exp2f(m - mn);
            m = mn;
            float ps = 0.f;
#pragma unroll
            for (int kb = 0; kb < 2; ++kb)
#pragma unroll
                for (int i = 0; i < 16; ++i) { const float e = __builtin_amdgcn_exp2f(sa[kb][i] - mn); sa[kb][i] = e; ps += e; }
            l = l * al + ps;
#pragma unroll
            for (int i = 0; i < 16; ++i) { o[0][i] *= al; o[1][i] *= al; }
#pragma unroll
            for (int kb = 0; kb < 2; ++kb)
#pragma unroll
                for (int s2 = 0; s2 < 2; ++s2) {
                    u32x4 pw;
#pragma unroll
                    for (int e = 0; e < 4; ++e) pw[e] = pack2(sa[kb][8 * s2 + 2 * e], sa[kb][8 * s2 + 2 * e + 1]);
                    const bf16x8 pf = __builtin_bit_cast(bf16x8, pw);
                    const int base = kb * 32 + 16 * s2;
#pragma unroll
                    for (int db = 0; db < 2; ++db) {
                        const bf16_t* vp = Vt + (db * 32 + q) * AT_VS + base + 4 * h;
                        const u32x2 v0 = *(const u32x2*)vp, v1 = *(const u32x2*)(vp + 8);
                        const bf16x8 vf = __builtin_bit_cast(bf16x8, (u32x4){v0[0], v0[1], v1[0], v1[1]});
                        o[db] = __builtin_amdgcn_mfma_f32_32x32x16_bf16(vf, pf, o[db], 0, 0, 0);
                    }
                }
            if (t + 1 < ntiles) lstore((t + 1) & 1);
            __syncthreads();
        }
        l += __shfl_xor(l, 32);
        const float il = 1.0f / l;
#pragma unroll
        for (int db = 0; db < 2; ++db)
#pragma unroll
            for (int gq = 0; gq < 4; ++gq) {
                const int d = db * 32 + 8 * gq + 4 * h;
                *(u32x2*)(p.A16 + rq * D + hd * 64 + d) = (u32x2){pack2(o[db][4 * gq] * il, o[db][4 * gq + 1] * il), pack2(o[db][4 * gq + 2] * il, o[db][4 * gq + 3] * il)};
            }
    }
}

constexpr size_t GLA_KS_BYTES = (size_t)NB * 4 * 68 * 2 * 8192 * 2;
constexpr int GL_S = 72;
__device__ __forceinline__ void gla_cum(const Params& p, size_t row0, int hd, int dir, float* sga, float* spart, float (&c)[16], float& T) {
    const int tid = otid(), d = tid & 63, part = tid >> 6;
    {
        const int j = tid >> 2, g4 = tid & 3;
        const u32x2 w = *(const u32x2*)(p.P + (row0 + j) * EV_IN + C_GAF + dir * 16 + g4 * 4);
        sga[j * 16 + g4 * 4 + 0] = __uint_as_float(w[0] << 16); sga[j * 16 + g4 * 4 + 1] = __uint_as_float(w[0] & 0xffff0000u);
        sga[j * 16 + g4 * 4 + 2] = __uint_as_float(w[1] << 16); sga[j * 16 + g4 * 4 + 3] = __uint_as_float(w[1] & 0xffff0000u);
    }
    __syncthreads();
    float wc[16];
    const float* wa = p.ev_gla_wa2 + (size_t)dir * 16 * 256 + hd * 64 + d;
#pragma unroll
    for (int g = 0; g < 16; ++g) wc[g] = wa[g * 256];
    const float bias = p.ev_gla_ba[dir * 256 + hd * 64 + d];
    float lv[16]; float run = 0.f;
#pragma unroll
    for (int jj = 0; jj < 16; ++jj) {
        const int j = part * 16 + jj;
        float z = bias;
#pragma unroll
        for (int g = 0; g < 16; g += 4) { const f32x4 a = *(const f32x4*)(sga + j * 16 + g); z += a[0] * wc[g] + a[1] * wc[g + 1] + a[2] * wc[g + 2] + a[3] * wc[g + 3]; }
        const float ls = (fminf(z, 0.f) - log1pf(expf(-fabsf(z)))) * (1.0f / 16.0f);
        lv[jj] = ls; run += ls; c[jj] = run;
    }
    spart[part * 64 + d] = run;
    __syncthreads();
    float off = 0.f; T = 0.f;
#pragma unroll
    for (int pp = 0; pp < 4; ++pp) { const float v = spart[pp * 64 + d]; T += v; if (pp < part) off += v; }
#pragma unroll
    for (int jj = 0; jj < 16; ++jj) c[jj] = dir == 0 ? off + c[jj] : T - (off + c[jj]) + lv[jj];
}
__device__ __forceinline__ void gla_stage_vt(const Params& p, size_t row0, int hd, bf16_t* Vt) {
    const int tid = otid();
#pragma unroll
    for (int i = 0; i < 4; ++i) {
        const int id = tid + 256 * i, j = id >> 4, ech = id & 15;
        const u32x4 w = *(const u32x4*)(p.P + (row0 + j) * EV_IN + C_GV + hd * 128 + ech * 8);
#pragma unroll
        for (int e = 0; e < 4; ++e) { Vt[(ech * 8 + 2 * e) * GL_S + j] = (bf16_t)(w[e] & 0xffffu); Vt[(ech * 8 + 2 * e + 1) * GL_S + j] = (bf16_t)(w[e] >> 16); }
    }
}
__device__ __forceinline__ void ph_gla_a(const Params& p, unsigned char* smem) {
    bf16_t* kwT = (bf16_t*)smem; bf16_t* Vt = kwT + 64 * GL_S; float* sga = (float*)(Vt + 128 * GL_S); float* spart = sga + 1024;
    bf16_t* KS = (bf16_t*)p.G; float* DEC = (float*)(p.G + GLA_KS_BYTES);
    const int tid = otid(), lane = tid & 63, wid = tid >> 6, fr = lane & 15, fq = lane >> 4, d = tid & 63, part = tid >> 6;
    for (int u = blockIdx.x; u < NB * 4 * 68; u += gridDim.x) {
        const int b = u / 272, hd = (u / 68) & 3, ci = u % 68;
        const size_t row0 = (size_t)b * PB + ci * 64;
        __syncthreads();
        gla_stage_vt(p, row0, hd, Vt);
        for (int dir = 0; dir < 2; ++dir) {
            float c[16], T;
            gla_cum(p, row0, hd, dir, sga, spart, c, T);
            unsigned kw[8];
#pragma unroll
            for (int jj = 0; jj < 16; jj += 2) {
                const float k0 = bf2f(p.P[(row0 + part * 16 + jj) * EV_IN + C_GK + hd * 64 + d]), k1 = bf2f(p.P[(row0 + part * 16 + jj + 1) * EV_IN + C_GK + hd * 64 + d]);
                kw[jj >> 1] = pack2(k0 * expf(T - c[jj]), k1 * expf(T - c[jj + 1]));
            }
            *(u32x4*)(kwT + d * GL_S + part * 16) = (u32x4){kw[0], kw[1], kw[2], kw[3]};
            *(u32x4*)(kwT + d * GL_S + part * 16 + 8) = (u32x4){kw[4], kw[5], kw[6], kw[7]};
            if (part == 0) DEC[((size_t)u * 2 + dir) * 64 + d] = expf(T);
            __syncthreads();
            f32x4 acc[8];
#pragma unroll
            for (int et = 0; et < 8; ++et) acc[et] = (f32x4){0.f, 0.f, 0.f, 0.f};
#pragma unroll
            for (int s = 0; s < 2; ++s) {
                const bf16x8 a = *(const bf16x8*)(kwT + (16 * wid + fr) * GL_S + 32 * s + 8 * fq);
#pragma unroll
                for (int et = 0; et < 8; ++et) {
                    const bf16x8 bq = *(const bf16x8*)(Vt + (16 * et + fr) * GL_S + 32 * s + 8 * fq);
                    acc[et] = __builtin_amdgcn_mfma_f32_16x16x32_bf16(a, bq, acc[et], 0, 0, 0);
                }
            }
#pragma unroll
            for (int et = 0; et < 8; ++et)
                *(u32x2*)(KS + (((size_t)u * 2 + dir) * 128 + 16 * et + fr) * 64 + 16 * wid + 4 * fq) = (u32x2){pack2(acc[et][0], acc[et][1]), pack2(acc[et][2], acc[et][3])};
            __syncthreads();
        }
    }
}
__device__ __forceinline__ void ph_gla_b(const Params& p, int dry = 0) {
    unsigned* KS32 = (unsigned*)p.G; const float* DEC = (const float*)(p.G + GLA_KS_BYTES);
    for (int gid = blockIdx.x * 256 + threadIdx.x; gid < 64 * 4096; gid += gridDim.x * 256) {
        const int seq = gid >> 12, pi = gid & 4095, dir = seq & 1, bh = seq >> 1, d = (2 * pi) & 63;
        float s0 = 0.f, s1 = 0.f;
#pragma unroll 4
        for (int step = 0; step < 68; ++step) {
            const int ci = dir == 0 ? step : (step < 4 ? 3 - step : 71 - step);
            const size_t ud = ((size_t)bh * 68 + ci) * 2 + dir;
            const unsigned w = KS32[ud * 4096 + pi];
            const float dc0 = DEC[ud * 64 + d], dc1 = DEC[ud * 64 + d + 1];
            if (!dry) KS32[ud * 4096 + pi] = pack2(s0, s1);
            s0 = dc0 * s0 + __uint_as_float(w << 16); s1 = dc1 * s1 + __uint_as_float(w & 0xffff0000u);
        }
        if (dry) asm volatile("" :: "v"(s0), "v"(s1));
    }
}
__device__ __forceinline__ void ph_gla_c(const Params& p, unsigned char* smem) {
    bf16_t* qs = (bf16_t*)smem; bf16_t* ks = qs + 64 * GL_S; bf16_t* Vt = ks + 64 * GL_S; float* sga = (float*)(Vt + 128 * GL_S); float* spart = sga + 1024;
    const bf16_t* KS = (const bf16_t*)p.G;
    const int tid = otid(), lane = tid & 63, wid = tid >> 6, fr = lane & 15, fq = lane >> 4, d = tid & 63, part = tid >> 6;
    for (int u = blockIdx.x; u < NB * 4 * 68; u += gridDim.x) {
        const int b = u / 272, hd = (u / 68) & 3, ci = u % 68;
        const size_t row0 = (size_t)b * PB + ci * 64;
        const int i = 16 * wid + fr;
        __syncthreads();
        gla_stage_vt(p, row0, hd, Vt);
        f32x4 oacc[8], pt[4];
#pragma unroll
        for (int et = 0; et < 8; ++et) oacc[et] = (f32x4){0.f, 0.f, 0.f, 0.f};
#pragma unroll
        for (int jt = 0; jt < 4; ++jt) pt[jt] = (f32x4){0.f, 0.f, 0.f, 0.f};
        for (int dir = 0; dir < 2; ++dir) {
            float c[16], T;
            gla_cum(p, row0, hd, dir, sga, spart, c, T);
#pragma unroll
            for (int jj = 0; jj < 16; ++jj) {
                const size_t ro = (row0 + part * 16 + jj) * EV_IN + hd * 64 + d;
                qs[(part * 16 + jj) * GL_S + d] = f2bf(bf2f(p.P[ro + C_GQ]) * 0.125f * expf(c[jj]));
                ks[(part * 16 + jj) * GL_S + d] = f2bf(bf2f(p.P[ro + C_GK]) * expf(-c[jj]));
            }
            __syncthreads();
            bf16x8 qf[2];
#pragma unroll
            for (int s = 0; s < 2; ++s) qf[s] = *(const bf16x8*)(qs + i * GL_S + 32 * s + 8 * fq);
#pragma unroll
            for (int jt = 0; jt < 4; ++jt) {
                f32x4 t = (f32x4){0.f, 0.f, 0.f, 0.f};
#pragma unroll
                for (int s = 0; s < 2; ++s) { const bf16x8 a = *(const bf16x8*)(ks + (16 * jt + fr) * GL_S + 32 * s + 8 * fq); t = __builtin_amdgcn_mfma_f32_16x16x32_bf16(a, qf[s], t, 0, 0, 0); }
#pragma unroll
                for (int rg = 0; rg < 4; ++rg) { const int j = 16 * jt + 4 * fq + rg; const bool keep = dir == 0 ? (j <= i) : (j >= i); pt[jt][rg] += keep ? t[rg] : 0.f; }
            }
            const bf16_t* Sg = KS + ((size_t)u * 2 + dir) * 8192;
#pragma unroll
            for (int et = 0; et < 8; ++et) {
#pragma unroll
                for (int s = 0; s < 2; ++s) { const bf16x8 a = *(const bf16x8*)(Sg + (16 * et + fr) * 64 + 32 * s + 8 * fq); oacc[et] = __builtin_amdgcn_mfma_f32_16x16x32_bf16(a, qf[s], oacc[et], 0, 0, 0); }
                if ((et & 3) == 3) __builtin_amdgcn_sched_barrier(0);
            }
            __syncthreads();
        }
#pragma unroll
        for (int k2 = 0; k2 < 2; ++k2) {
            const u32x4 pw = (u32x4){pack2(pt[2 * k2][0], pt[2 * k2][1]), pack2(pt[2 * k2][2], pt[2 * k2][3]), pack2(pt[2 * k2 + 1][0], pt[2 * k2 + 1][1]), pack2(pt[2 * k2 + 1][2], pt[2 * k2 + 1][3])};
            const bf16x8 pf = __builtin_bit_cast(bf16x8, pw);
#pragma unroll
            for (int et = 0; et < 8; ++et) {
                const bf16_t* vp = Vt + (16 * et + fr) * GL_S + 32 * k2 + 4 * fq;
                const u32x2 v0 = *(const u32x2*)vp, v1 = *(const u32x2*)(vp + 16);
                const bf16x8 vf = __builtin_bit_cast(bf16x8, (u32x4){v0[0], v0[1], v1[0], v1[1]});
                oacc[et] = __builtin_amdgcn_mfma_f32_16x16x32_bf16(vf, pf, oacc[et], 0, 0, 0);
            }
        }
        float ss = 0.f;
#pragma unroll
        for (int et = 0; et < 8; ++et) ss += oacc[et][0] * oacc[et][0] + oacc[et][1] * oacc[et][1] + oacc[et][2] * oacc[et][2] + oacc[et][3] * oacc[et][3];
        ss += __shfl_xor(ss, 16); ss += __shfl_xor(ss, 32);
        const float rs = rsqrtf(ss * (1.0f / 128.0f) + LN_EPS);
        const size_t r = row0 + i;
#pragma unroll
        for (int et = 0; et < 8; ++et) {
            const int e = 16 * et + 4 * fq;
            const u32x2 gw = *(const u32x2*)(p.P + r * EV_IN + C_GG + hd * 128 + e);
            const f32x4 nr = *(const f32x4*)(p.ev_gla_norm + hd * 128 + e);
            const float g0 = __uint_as_float(gw[0] << 16), g1 = __uint_as_float(gw[0] & 0xffff0000u), g2 = __uint_as_float(gw[1] << 16), g3 = __uint_as_float(gw[1] & 0xffff0000u);
            *(u32x2*)(p.A16 + r * D + 512 + hd * 128 + e) = (u32x2){pack2(oacc[et][0] * rs * nr[0] * silu_f(g0), oacc[et][1] * rs * nr[1] * silu_f(g1)),
                                                                   pack2(oacc[et][2] * rs * nr[2] * silu_f(g2), oacc[et][3] * rs * nr[3] * silu_f(g3))};
        }
    }
}

__device__ __forceinline__ void ph_ln_mod(const Params& p, int layer, int lnidx, int lat_only, int dry = 0) {
    const int tid_ = otid(), wid = tid_ >> 6, lane = tid_ & 63;
    const int nrows = lat_only ? NB * SEQ : R;
    const float* g = p.ln_g + (size_t)(layer * 2 + lnidx) * D; const float* bb = p.ln_b + (size_t)(layer * 2 + lnidx) * D;
    for (int u = blockIdx.x; u < nrows / 4; u += gridDim.x) {
        const int rr = u * 4 + wid, r = lat_only ? (rr >> 12) * PB + CTX + (rr & 4095) : rr;
        float* hrow = p.H + (size_t)r * D;
        f32x4 v[4]; float s = 0.f;
#pragma unroll
        for (int q = 0; q < 4; ++q) { v[q] = *(const f32x4*)(hrow + q * 256 + lane * 4); s += v[q][0] + v[q][1] + v[q][2] + v[q][3]; }
        const float mu = wave_sum(s) * (1.0f / 1024.0f);
        float ss = 0.f;
#pragma unroll
        for (int q = 0; q < 4; ++q) { v[q] = v[q] - mu; ss += v[q][0] * v[q][0] + v[q][1] * v[q][1] + v[q][2] * v[q][2] + v[q][3] * v[q][3]; }
        const float rstd = rsqrtf(wave_sum(ss) * (1.0f / 1024.0f) + LN_EPS);
        const float* md = p.mod + ((size_t)layer * 9 + mod_row(r)) * 6144;
#pragma unroll
        for (int q = 0; q < 4; ++q) {
            const int c = q * 256 + lane * 4;
            const f32x4 h = v[q] * rstd * *(const f32x4*)(g + c) + *(const f32x4*)(bb + c);
            const f32x4 a = h * (1.0f + *(const f32x4*)(md + 4 * 1024 + c)) + *(const f32x4*)(md + 3 * 1024 + c);
            if (dry) { asm volatile("" :: "v"(a), "v"(h)); continue; }
            *(f32x4*)(hrow + c) = h;
            *(u32x2*)(p.A16 + (size_t)r * D + c) = (u32x2){pack2(a[0], a[1]), pack2(a[2], a[3])};
        }
    }
}

constexpr int SC_KS = 136;
__device__ __forceinline__ void ph_scores(const Params& p, int layer, int lat_only, unsigned char* smem) {
    bf16_t* ksl = (bf16_t*)smem;
    const bf16_t* QP = p.P; float* T = (float*)p.G;
    const int tid = otid(), lane = tid & 63, wid = tid >> 6, q = lane & 31, h = lane >> 5;
    const RowMap rm{lat_only};
    const int nunits = rm.ntiles() * 8;
    for (int u = blockIdx.x; u < nunits; u += gridDim.x) {
        const int tile = u >> 3, half = (u >> 2) & 1, hp = u & 3;
        const size_t r = (size_t)rm.row0(tile) + 32 * wid + q;
        __syncthreads();
        const bf16_t* kk = p.wt_k + ((size_t)layer * 2 + half) * 16384;
#pragma unroll
        for (int i = 0; i < 8; ++i) { const int id = tid + 256 * i, key = id >> 4, ch = id & 15; *(u32x4*)(ksl + key * SC_KS + ch * 8) = *(const u32x4*)(kk + key * 128 + ch * 8); }
        __syncthreads();
        for (int hh = 0; hh < 2; ++hh) {
            const int hd = hp * 2 + hh;
            bf16x8 qf[8];
#pragma unroll
            for (int s = 0; s < 8; ++s) qf[s] = *(const bf16x8*)(QP + r * 2048 + hd * 256 + half * 128 + 16 * s + 8 * h);
            float top[16];
#pragma unroll
            for (int t = 0; t < 16; ++t) top[t] = -3.0e38f;
#pragma unroll 1
            for (int kb = 0; kb < 4; ++kb) {
                f32x16 sa;
#pragma unroll
                for (int i = 0; i < 16; ++i) sa[i] = 0.f;
#pragma unroll
                for (int s = 0; s < 8; ++s) {
                    const bf16x8 kf = *(const bf16x8*)(ksl + (kb * 32 + q) * SC_KS + 16 * s + 8 * h);
                    sa = __builtin_amdgcn_mfma_f32_32x32x16_bf16(kf, qf[s], sa, 0, 0, 0);
                }
#pragma unroll
                for (int rg = 0; rg < 16; ++rg) {
                    const unsigned key = (unsigned)(kb * 32 + (rg & 3) + 8 * (rg >> 2) + 4 * h);
                    float xv = __uint_as_float((__float_as_uint(sa[rg]) & ~127u) | key);
#pragma unroll
                    for (int t = 0; t < 16; ++t) { const float hi = fmaxf(top[t], xv); xv = fminf(top[t], xv); top[t] = hi; }
                }
            }
            float mrg[8];
#pragma unroll
            for (int i = 0; i < 8; ++i) mrg[i] = fmaxf(top[i], __shfl_xor(top[15 - i], 32));
            float* dst = T + ((r * 8 + hd) * 2 + half) * 16 + 8 * h;
            *(f32x4*)dst = (f32x4){mrg[0], mrg[1], mrg[2], mrg[3]}; *(f32x4*)(dst + 4) = (f32x4){mrg[4], mrg[5], mrg[6], mrg[7]};
        }
    }
}

__device__ __forceinline__ void ph_combine(const Params& p, int lat_only) {
    const float* T = (const float*)p.G;
    int* EIDX = (int*)(p.G + (size_t)R * 8 * 2 * 16 * 4);
    float* EG = (float*)(p.G + (size_t)R * 8 * 2 * 16 * 4 + (size_t)R * 8 * 16 * 4);
    const int nrows = lat_only ? NB * SEQ : R;
    for (int g = blockIdx.x * 256 + threadIdx.x; g < nrows * 8; g += gridDim.x * 256) {
        const int rr = g >> 3, hd = g & 7, r = lat_only ? (rr >> 12) * PB + CTX + (rr & 4095) : rr;
        const float* t = T + ((size_t)r * 8 + hd) * 32;
        float t2[16];
#pragma unroll
        for (int i = 0; i < 16; ++i) t2[i] = __uint_as_float(__float_as_uint(t[16 + i]) & ~127u);
        float top[16];
#pragma unroll
        for (int k = 0; k < 16; ++k) top[k] = -3.0e38f;
        for (int i = 0; i < 16; ++i) {
            const float t1i = __uint_as_float(__float_as_uint(t[i]) & ~127u);
#pragma unroll
            for (int j = 0; j < 16; ++j) {
                float xv = __uint_as_float((__float_as_uint(t1i + t2[j]) & ~255u) | (unsigned)(i * 16 + j));
#pragma unroll
                for (int k = 0; k < 16; ++k) { const float hi = fmaxf(top[k], xv); xv = fminf(top[k], xv); top[k] = hi; }
            }
        }
        float e[16], sum = 0.f; const float mx = __uint_as_float(__float_as_uint(top[0]) & ~255u);
#pragma unroll
        for (int k = 0; k < 16; ++k) { e[k] = expf(__uint_as_float(__float_as_uint(top[k]) & ~255u) - mx); sum += e[k]; }
        const float inv = 1.0f / sum;
#pragma unroll
        for (int k = 0; k < 16; ++k) {
            const unsigned code = __float_as_uint(top[k]) & 255u, i = code >> 4, j = code & 15;
            const unsigned i1 = __float_as_uint(t[i]) & 127u, i2 = __float_as_uint(t[16 + j]) & 127u;
            EIDX[((size_t)r * 8 + hd) * 16 + k] = (int)(i1 * 128 + i2);
            EG[((size_t)r * 8 + hd) * 16 + k] = e[k] * inv;
        }
    }
}

__device__ __forceinline__ void ph_gather_ln(const Params& p, int layer, int lat_only) {
    const int tid_ = otid(), wid = tid_ >> 6, lane = tid_ & 63;
    const int* EIDX = (const int*)(p.G + (size_t)R * 8 * 2 * 16 * 4);
    const float* EG = (const float*)(p.G + (size_t)R * 8 * 2 * 16 * 4 + (size_t)R * 8 * 16 * 4);
    const float* U = p.peer_u + (size_t)layer * PEER_N * D; const float* V = p.peer_v + (size_t)layer * PEER_N * D;
    const float* g = p.ln_g + (size_t)(layer * 2 + 1) * D; const float* bb = p.ln_b + (size_t)(layer * 2 + 1) * D;
    const int nrows = lat_only ? NB * SEQ : R;
    for (int u = blockIdx.x; u < nrows / 4; u += gridDim.x) {
        const int rr = u * 4 + wid, r = lat_only ? (rr >> 12) * PB + CTX + (rr & 4095) : rr;
        f32x4 hm[4], acc[4];
#pragma unroll
        for (int q = 0; q < 4; ++q) {
            const u32x2 w = *(const u32x2*)(p.A16 + (size_t)r * D + q * 256 + lane * 4);
            hm[q] = (f32x4){__uint_as_float(w[0] << 16), __uint_as_float(w[0] & 0xffff0000u), __uint_as_float(w[1] << 16), __uint_as_float(w[1] & 0xffff0000u)};
            acc[q] = (f32x4){0.f, 0.f, 0.f, 0.f};
        }
        for (int e0 = 0; e0 < 128; e0 += 2) {
            const int ea = EIDX[(size_t)r * 128 + e0], eb = EIDX[(size_t)r * 128 + e0 + 1];
            const float ga = EG[(size_t)r * 128 + e0], gb = EG[(size_t)r * 128 + e0 + 1];
            f32x4 ua[4], ub[4];
#pragma unroll
            for (int q = 0; q < 4; ++q) { ua[q] = *(const f32x4*)(U + (size_t)ea * D + q * 256 + lane * 4); ub[q] = *(const f32x4*)(U + (size_t)eb * D + q * 256 + lane * 4); }
            float da = 0.f, db = 0.f;
#pragma unroll
            for (int q = 0; q < 4; ++q) { da += hm[q][0] * ua[q][0] + hm[q][1] * ua[q][1] + hm[q][2] * ua[q][2] + hm[q][3] * ua[q][3]; db += hm[q][0] * ub[q][0] + hm[q][1] * ub[q][1] + hm[q][2] * ub[q][2] + hm[q][3] * ub[q][3]; }
            da = wave_sum(da); db = wave_sum(db);
            const float wa = ga * gelu_f(da), wb = gb * gelu_f(db);
#pragma unroll
            for (int q = 0; q < 4; ++q) {
                acc[q] += wa * *(const f32x4*)(V + (size_t)ea * D + q * 256 + lane * 4);
                acc[q] += wb * *(const f32x4*)(V + (size_t)eb * D + q * 256 + lane * 4);
            }
        }
        const float* md = p.mod + ((size_t)layer * 9 + mod_row(r)) * 6144;
        float* hrow = p.H + (size_t)r * D;
        f32x4 v[4]; float s = 0.f;
#pragma unroll
        for (int q = 0; q < 4; ++q) { const int c = q * 256 + lane * 4; v[q] = ALPHA * *(const f32x4*)(hrow + c) + *(const f32x4*)(md + 5 * 1024 + c) * acc[q]; s += v[q][0] + v[q][1] + v[q][2] + v[q][3]; }
        const float mu = wave_sum(s) * (1.0f / 1024.0f);
        float ss = 0.f;
#pragma unroll
        for (int q = 0; q < 4; ++q) { v[q] = v[q] - mu; ss += v[q][0] * v[q][0] + v[q][1] * v[q][1] + v[q][2] * v[q][2] + v[q][3] * v[q][3]; }
        const float rstd = rsqrtf(wave_sum(ss) * (1.0f / 1024.0f) + LN_EPS);
        if (layer == 0) {
            const float* md1 = p.mod + ((size_t)1 * 9 + mod_row(r)) * 6144;
#pragma unroll
            for (int q = 0; q < 4; ++q) {
                const int c = q * 256 + lane * 4;
                const f32x4 h = v[q] * rstd * *(const f32x4*)(g + c) + *(const f32x4*)(bb + c);
                *(f32x4*)(hrow + c) = h;
                const f32x4 a = h * (1.0f + *(const f32x4*)(md1 + 1024 + c)) + *(const f32x4*)(md1 + c);
                *(u32x2*)(p.A16 + (size_t)r * D + c) = (u32x2){pack2(a[0], a[1]), pack2(a[2], a[3])};
            }
        } else {
            float* orow = p.out + (size_t)rr * D;
#pragma unroll
            for (int q = 0; q < 4; ++q) { const int c = q * 256 + lane * 4; *(f32x4*)(orow + c) = v[q] * rstd * *(const f32x4*)(g + c) + *(const f32x4*)(bb + c); }
        }
    }
}

__device__ __forceinline__ float gelu_fast(float v);
constexpr size_t UV8_BYTES = (size_t)PEER_N * D;
constexpr size_t UV8_OFF = (size_t)R * 2048 * 2;
__device__ __forceinline__ float wave_max(float v) {
#pragma unroll
    for (int o = 32; o > 0; o >>= 1) v = fmaxf(v, __shfl_xor(v, o));
    return v;
}
__device__ __forceinline__ unsigned cvt4_fp8(float a, float b, float c, float d) {
    int pk = __builtin_amdgcn_cvt_pk_fp8_f32(a, b, 0, false);
    pk = __builtin_amdgcn_cvt_pk_fp8_f32(c, d, pk, true);
    return (unsigned)pk;
}
__device__ __forceinline__ void ph_convert_uv(const Params& p, int layer) {
    const int tid = otid(), lane = tid & 63, gw = blockIdx.x * 4 + (tid >> 6), nw = gridDim.x * 4;
    unsigned char* T8 = (unsigned char*)p.P + UV8_OFF;
    float* sinv = (float*)(T8 + 2 * UV8_BYTES);
    for (int row = gw; row < 2 * PEER_N; row += nw) {
        const float* src = (row < PEER_N ? p.peer_u + ((size_t)layer * PEER_N + row) * D : p.peer_v + ((size_t)layer * PEER_N + (row - PEER_N)) * D) + lane * 16;
        f32x4 v[4]; float am = 0.f;
#pragma unroll
        for (int q = 0; q < 4; ++q) { v[q] = *(const f32x4*)(src + 4 * q); am = fmaxf(am, fmaxf(fmaxf(fabsf(v[q][0]), fabsf(v[q][1])), fmaxf(fabsf(v[q][2]), fabsf(v[q][3])))); }
        am = wave_max(am);
        const float sc = am > 0.f ? 224.0f / am : 1.0f;
        u32x4 w;
#pragma unroll
        for (int q = 0; q < 4; ++q) w[q] = cvt4_fp8(v[q][0] * sc, v[q][1] * sc, v[q][2] * sc, v[q][3] * sc);
        *(u32x4*)(T8 + (size_t)(row >= PEER_N) * UV8_BYTES + (size_t)(lane >> 3) * (PEER_N * 128) + (size_t)(row & (PEER_N - 1)) * 128 + (lane & 7) * 16) = w;
        if (lane == 0) sinv[row] = 1.0f / sc;
    }
}

__device__ __forceinline__ void ph_gather_mfma(const Params& p, int layer, int lat_only, unsigned char* smem) {
    const int tid = otid(), wid = tid >> 6, lane = tid & 63, c = lane & 15, g = lane >> 4;
    unsigned char* hs = smem + wid * 2048;
    int* se = (int*)(smem + wid * 2048 + 1024);
    float* sw = (float*)(smem + wid * 2048 + 1536);
    const int* EIDX = (const int*)(p.G + (size_t)R * 8 * 2 * 16 * 4);
    const float* EG = (const float*)(p.G + (size_t)R * 8 * 2 * 16 * 4 + (size_t)R * 8 * 16 * 4);
    const unsigned char* U8 = (const unsigned char*)p.P + UV8_OFF; const unsigned char* V8 = U8 + UV8_BYTES;
    const float* su_inv = (const float*)(U8 + 2 * UV8_BYTES); const float* sv_inv = su_inv + PEER_N;
    const float* gam = p.ln_g + (size_t)(layer * 2 + 1) * D; const float* bet = p.ln_b + (size_t)(layer * 2 + 1) * D;
    const int nrows = lat_only ? NB * SEQ : R;
    for (int u = blockIdx.x; u < nrows / 4; u += gridDim.x) {
        const int rr = u * 4 + wid, r = lat_only ? (rr >> 12) * PB + CTX + (rr & 4095) : rr;
        __syncthreads();
        float inv_sh;
        {
            const u32x4 w0 = *(const u32x4*)(p.A16 + (size_t)r * D + lane * 16), w1 = *(const u32x4*)(p.A16 + (size_t)r * D + lane * 16 + 8);
            float hv[16];
#pragma unroll
            for (int e = 0; e < 4; ++e) { hv[2 * e] = __uint_as_float(w0[e] << 16); hv[2 * e + 1] = __uint_as_float(w0[e] & 0xffff0000u); hv[8 + 2 * e] = __uint_as_float(w1[e] << 16); hv[8 + 2 * e + 1] = __uint_as_float(w1[e] & 0xffff0000u); }
            float am = 0.f;
#pragma unroll
            for (int e = 0; e < 16; ++e) am = fmaxf(am, fabsf(hv[e]));
            am = wave_max(am);
            const float sh = am > 0.f ? 224.0f / am : 1.0f; inv_sh = 1.0f / sh;
            *(u32x4*)(hs + lane * 16) = (u32x4){cvt4_fp8(hv[0] * sh, hv[1] * sh, hv[2] * sh, hv[3] * sh), cvt4_fp8(hv[4] * sh, hv[5] * sh, hv[6] * sh, hv[7] * sh),
                                                cvt4_fp8(hv[8] * sh, hv[9] * sh, hv[10] * sh, hv[11] * sh), cvt4_fp8(hv[12] * sh, hv[13] * sh, hv[14] * sh, hv[15] * sh)};
        }
        se[lane] = EIDX[(size_t)r * 128 + lane]; se[64 + lane] = EIDX[(size_t)r * 128 + 64 + lane];
        sw[lane] = EG[(size_t)r * 128 + lane]; sw[64 + lane] = EG[(size_t)r * 128 + 64 + lane];
        __syncthreads();
#pragma unroll 2
        for (int hd = 0; hd < 8; ++hd) {
            f32x4 dacc = (f32x4){0.f, 0.f, 0.f, 0.f};
            const int e = se[hd * 16 + c];
            const unsigned char* urow = U8 + (size_t)e * D + g * 16;
#pragma unroll
            for (int s2 = 0; s2 < 16; ++s2) {
                const u32x4 bq = *(const u32x4*)(urow + s2 * 64);
                const u32x4 aq = *(const u32x4*)(hs + s2 * 64 + g * 16);
                dacc = __builtin_amdgcn_mfma_f32_16x16x32_fp8_fp8((long)(((unsigned long long)aq[1] << 32) | aq[0]), (long)(((unsigned long long)bq[1] << 32) | bq[0]), dacc, 0, 0, 0);
                dacc = __builtin_amdgcn_mfma_f32_16x16x32_fp8_fp8((long)(((unsigned long long)aq[3] << 32) | aq[2]), (long)(((unsigned long long)bq[3] << 32) | bq[2]), dacc, 0, 0, 0);
            }
            const float wv = sw[hd * 16 + c] * gelu_fast(dacc[0] * inv_sh * su_inv[e]) * sv_inv[e];
            if (g == 0) sw[hd * 16 + c] = wv;
        }
        __syncthreads();
        const float wmax = wave_max(fmaxf(fabsf(sw[lane]), fabsf(sw[64 + lane])));
        const float wsc = wmax > 0.f ? 224.0f / wmax : 1.0f, inv_wsc = 1.0f / wsc;
        f32x4 oacc[8];
#pragma unroll
        for (int blk = 0; blk < 8; ++blk) oacc[blk] = (f32x4){0.f, 0.f, 0.f, 0.f};
#pragma unroll 4
        for (int it = 0; it < 32; ++it) {
            const int e = se[4 * it + g];
            const unsigned w8 = (unsigned)__builtin_amdgcn_cvt_pk_fp8_f32(sw[4 * it + g] * wsc, 0.f, 0, false) & 0xffu;
            const unsigned long long a64 = c < 8 ? ((unsigned long long)w8 << (8 * c)) : 0ull;
            const unsigned char* vrow = V8 + (size_t)e * D + c * 16;
#pragma unroll
            for (int b2 = 0; b2 < 4; ++b2) {
                const u32x4 bq = *(const u32x4*)(vrow + b2 * 256);
                oacc[2 * b2] = __builtin_amdgcn_mfma_f32_16x16x32_fp8_fp8((long)a64, (long)(((unsigned long long)bq[1] << 32) | bq[0]), oacc[2 * b2], 0, 0, 0);
                oacc[2 * b2 + 1] = __builtin_amdgcn_mfma_f32_16x16x32_fp8_fp8((long)a64, (long)(((unsigned long long)bq[3] << 32) | bq[2]), oacc[2 * b2 + 1], 0, 0, 0);
            }
        }
#pragma unroll
        for (int blk = 0; blk < 8; ++blk) oacc[blk] = oacc[blk] * inv_wsc;
        const float* md = p.mod + ((size_t)layer * 9 + mod_row(r)) * 6144;
        float* hrow = p.H + (size_t)r * D;
        const bool act = g < 2;
        f32x4 v[8]; float s = 0.f;
#pragma unroll
        for (int blk = 0; blk < 8; ++blk) {
            const int n = 256 * (blk >> 1) + 16 * c + 8 * (blk & 1) + 4 * (g & 1);
            v[blk] = ALPHA * *(const f32x4*)(hrow + n) + *(const f32x4*)(md + 5 * 1024 + n) * oacc[blk];
            if (!act) v[blk] = (f32x4){0.f, 0.f, 0.f, 0.f};
            s += v[blk][0] + v[blk][1] + v[blk][2] + v[blk][3];
        }
        const float mu = wave_sum(s) * (1.0f / 1024.0f);
        float ss = 0.f;
#pragma unroll
        for (int blk = 0; blk < 8; ++blk) { v[blk] = v[blk] - mu; if (act) ss += v[blk][0] * v[blk][0] + v[blk][1] * v[blk][1] + v[blk][2] * v[blk][2] + v[blk][3] * v[blk][3]; }
        const float rstd = rsqrtf(wave_sum(ss) * (1.0f / 1024.0f) + LN_EPS);
        if (act) {
            if (layer == 0) {
                const float* md1 = p.mod + ((size_t)1 * 9 + mod_row(r)) * 6144;
#pragma unroll
                for (int blk = 0; blk < 8; ++blk) {
                    const int n = 256 * (blk >> 1) + 16 * c + 8 * (blk & 1) + 4 * g;
                    const f32x4 h = v[blk] * rstd * *(const f32x4*)(gam + n) + *(const f32x4*)(bet + n);
                    *(f32x4*)(hrow + n) = h;
                    const f32x4 a = h * (1.0f + *(const f32x4*)(md1 + 1024 + n)) + *(const f32x4*)(md1 + n);
                    *(u32x2*)(p.A16 + (size_t)r * D + n) = (u32x2){pack2(a[0], a[1]), pack2(a[2], a[3])};
                }
            } else {
                float* orow = p.out + (size_t)rr * D;
#pragma unroll
                for (int blk = 0; blk < 8; ++blk) { const int n = 256 * (blk >> 1) + 16 * c + 8 * (blk & 1) + 4 * g; *(f32x4*)(orow + n) = v[blk] * rstd * *(const f32x4*)(gam + n) + *(const f32x4*)(bet + n); }
            }
        }
    }
}

constexpr int GT_TW = 17;
__device__ __forceinline__ long mk64(unsigned lo, unsigned hi) { return (long)(((unsigned long long)hi << 32) | lo); }
__device__ __forceinline__ void ph_gather_sliced(const Params& p, int layer, int lat_only, unsigned char* smem) {
    const int tid = otid(), wid = tid >> 6, lane = tid & 63, c = lane & 15, g = lane >> 4;
    float* part = (float*)smem + wid * (GT_TW * 128);
    float* tsc = (float*)smem + 4 * GT_TW * 128 + wid * (2 * GT_TW);
    unsigned short* sid = (unsigned short*)(smem + 4 * GT_TW * 128 * 4 + 4 * 2 * GT_TW * 4) + wid * (GT_TW * 128);
    const int* EIDX = (const int*)(p.G + (size_t)R * 8 * 2 * 16 * 4);
    const float* EG = (const float*)(p.G + (size_t)R * 8 * 2 * 16 * 4 + (size_t)R * 8 * 16 * 4);
    const unsigned char* U8 = (const unsigned char*)p.P + UV8_OFF; const unsigned char* V8 = U8 + UV8_BYTES;
    const float* su_inv = (const float*)(U8 + 2 * UV8_BYTES); const float* sv_inv = su_inv + PEER_N;
    const float* gam = p.ln_g + (size_t)(layer * 2 + 1) * D; const float* bet = p.ln_b + (size_t)(layer * 2 + 1) * D;
    const int ntok = lat_only ? NB * SEQ : R;
    const int per_round = gridDim.x * 4 * GT_TW;
    for (int base = 0; base < ntok; base += per_round) {
        const int t0 = base + (blockIdx.x * 4 + wid) * GT_TW;
        int nt = ntok - t0; nt = nt < 0 ? 0 : (nt > GT_TW ? GT_TW : nt);
        auto rowof = [&](int j) { const int rr = t0 + j; return lat_only ? (rr >> 12) * PB + CTX + (rr & 4095) : rr; };
        for (int j = 0; j < nt; ++j) {
            const size_t r = rowof(j);
            const u32x4 w0 = *(const u32x4*)(p.A16 + r * D + lane * 16), w1 = *(const u32x4*)(p.A16 + r * D + lane * 16 + 8);
            const int i0 = EIDX[r * 128 + lane], i1 = EIDX[r * 128 + 64 + lane];
            float hv[16];
#pragma unroll
            for (int e = 0; e < 4; ++e) { hv[2 * e] = __uint_as_float(w0[e] << 16); hv[2 * e + 1] = __uint_as_float(w0[e] & 0xffff0000u); hv[8 + 2 * e] = __uint_as_float(w1[e] << 16); hv[8 + 2 * e + 1] = __uint_as_float(w1[e] & 0xffff0000u); }
            float am = 0.f;
#pragma unroll
            for (int e = 0; e < 16; ++e) am = fmaxf(am, fabsf(hv[e]));
            am = wave_max(am);
            const float sh = am > 0.f ? 224.0f / am : 1.0f;
            if (lane == 0) tsc[j] = 1.0f / sh;
            *(u32x4*)((unsigned char*)(p.A16 + r * D) + lane * 16) = (u32x4){cvt4_fp8(hv[0] * sh, hv[1] * sh, hv[2] * sh, hv[3] * sh), cvt4_fp8(hv[4] * sh, hv[5] * sh, hv[6] * sh, hv[7] * sh),
                                                                             cvt4_fp8(hv[8] * sh, hv[9] * sh, hv[10] * sh, hv[11] * sh), cvt4_fp8(hv[12] * sh, hv[13] * sh, hv[14] * sh, hv[15] * sh)};
            part[j * 128 + lane] = 0.f; part[j * 128 + 64 + lane] = 0.f;
            sid[j * 128 + lane] = (unsigned short)i0; sid[j * 128 + 64 + lane] = (unsigned short)i1;
        }
        asm volatile("s_waitcnt vmcnt(0) lgkmcnt(0)" ::: "memory");
        for (int rep_ = (p.probe & 1) ? 2 : 1; rep_ > 0; --rep_) {
        if (p.probe & 1) { for (int j = 0; j < nt; ++j) { part[j * 128 + lane] = 0.f; part[j * 128 + 64 + lane] = 0.f; } asm volatile("s_waitcnt lgkmcnt(0)" ::: "memory"); }
        for (int sl = 0; sl < 8; ++sl) {
            u32x4 aA[2], bA[8], aB[2], bB[8];
            auto issue = [&](int q, u32x4 (&a)[2], u32x4 (&b)[8]) {
                const int j = q >> 1, h0 = (q & 1) * 4;
                const size_t r = rowof(j);
                const unsigned char* hrow = (const unsigned char*)(p.A16 + r * D) + sl * 128 + g * 16;
                a[0] = *(const u32x4*)hrow; a[1] = *(const u32x4*)(hrow + 64);
#pragma unroll
                for (int hh = 0; hh < 4; ++hh) { const unsigned char* ur = U8 + (size_t)sl * (PEER_N * 128) + (size_t)sid[j * 128 + (h0 + hh) * 16 + (lane >> 2)] * 128 + (lane & 3) * 16; b[2 * hh] = *(const u32x4*)ur; b[2 * hh + 1] = *(const u32x4*)(ur + 64); }
            };
            const int bsrc = (4 * c + g) * 4;
            auto compute = [&](int q, const u32x4 (&a)[2], const u32x4 (&b)[8]) {
                const int j = q >> 1, h0 = (q & 1) * 4;
#pragma unroll
                for (int hh = 0; hh < 4; ++hh) {
                    unsigned t[8];
#pragma unroll
                    for (int e = 0; e < 4; ++e) { t[e] = (unsigned)__builtin_amdgcn_ds_bpermute(bsrc, (int)b[2 * hh][e]); t[4 + e] = (unsigned)__builtin_amdgcn_ds_bpermute(bsrc, (int)b[2 * hh + 1][e]); }
                    f32x4 dacc = (f32x4){0.f, 0.f, 0.f, 0.f};
                    dacc = __builtin_amdgcn_mfma_f32_16x16x32_fp8_fp8(mk64(a[0][0], a[0][1]), mk64(t[0], t[1]), dacc, 0, 0, 0);
                    dacc = __builtin_amdgcn_mfma_f32_16x16x32_fp8_fp8(mk64(a[0][2], a[0][3]), mk64(t[2], t[3]), dacc, 0, 0, 0);
                    dacc = __builtin_amdgcn_mfma_f32_16x16x32_fp8_fp8(mk64(a[1][0], a[1][1]), mk64(t[4], t[5]), dacc, 0, 0, 0);
                    dacc = __builtin_amdgcn_mfma_f32_16x16x32_fp8_fp8(mk64(a[1][2], a[1][3]), mk64(t[6], t[7]), dacc, 0, 0, 0);
                    if (g == 0) part[j * 128 + (h0 + hh) * 16 + c] += dacc[0];
                }
            };
            const int nq = 2 * nt;
            if (nq > 0) issue(0, aA, bA);
            for (int q = 0; q < nq; q += 2) {
                issue(q + 1, aB, bB);
                compute(q, aA, bA);
                issue(q + 2 < nq ? q + 2 : q, aA, bA);
                compute(q + 1, aB, bB);
            }
        }
        }
        for (int j = 0; j < nt; ++j) {
            const size_t r = rowof(j);
            const float ish = tsc[j];
            float wv[2];
#pragma unroll
            for (int q = 0; q < 2; ++q) {
                const int x = q * 64 + lane, e = sid[j * 128 + x];
                wv[q] = EG[r * 128 + x] * gelu_fast(part[j * 128 + x] * ish * su_inv[e]) * sv_inv[e];
            }
            const float wm = wave_max(fmaxf(fabsf(wv[0]), fabsf(wv[1])));
            const float wsc = wm > 0.f ? 224.0f / wm : 1.0f;
            if (lane == 0) tsc[GT_TW + j] = 1.0f / wsc;
            unsigned char* w8b = (unsigned char*)(part + j * 128);
            w8b[lane] = (unsigned char)(__builtin_amdgcn_cvt_pk_fp8_f32(wv[0] * wsc, 0.f, 0, false) & 0xff);
            w8b[64 + lane] = (unsigned char)(__builtin_amdgcn_cvt_pk_fp8_f32(wv[1] * wsc, 0.f, 0, false) & 0xff);
        }
        asm volatile("s_waitcnt lgkmcnt(0)" ::: "memory");
        for (int rep_ = (p.probe & 2) ? 2 : 1; rep_ > 0; --rep_)
        for (int sl = 0; sl < 8; ++sl) {
            u32x2 vA[16], vB[16]; f32x4 hA; f32x4 oacc;
            auto issue = [&](int q, u32x2 (&v)[16]) {
                const int j = q >> 1, i0 = (q & 1) * 16;
#pragma unroll
                for (int it = 0; it < 16; ++it) v[it] = *(const u32x2*)(V8 + (size_t)sl * (PEER_N * 128) + (size_t)sid[j * 128 + 4 * (i0 + it) + g] * 128 + c * 8);
            };
            const unsigned shl = 8 * (c & 3), mlo = c < 4 ? 0xffffffffu : 0u, mhi = (c >= 4 && c < 8) ? 0xffffffffu : 0u;
            auto compute = [&](int q, const u32x2 (&v)[16]) {
                const int j = q >> 1, i0 = (q & 1) * 16;
                const unsigned char* w8b = (const unsigned char*)(part + j * 128);
                if (i0 == 0) oacc = (f32x4){0.f, 0.f, 0.f, 0.f};
#pragma unroll
                for (int it = 0; it < 16; ++it) {
                    const unsigned ws = (unsigned)w8b[4 * (i0 + it) + g] << shl;
                    oacc = __builtin_amdgcn_mfma_f32_16x16x32_fp8_fp8(mk64(ws & mlo, ws & mhi), mk64(v[it][0], v[it][1]), oacc, 0, 0, 0);
                }
            };
            auto finish = [&](int j) {
                const size_t r = rowof(j);
                const float iws = tsc[GT_TW + j];
                if (rep_ > 1) { asm volatile("" :: "v"(oacc), "v"(hA)); }
                else if (g < 2) {
                    const int n = sl * 128 + 8 * c + 4 * g;
                    const float* md = p.mod + ((size_t)layer * 9 + mod_row((int)r)) * 6144 + 5 * 1024;
                    *(f32x4*)(p.H + r * D + n) = ALPHA * hA + *(const f32x4*)(md + n) * (oacc * iws);
                }
            };
            const int nq = 2 * nt;
            if (nq > 0) issue(0, vA);
            for (int q = 0; q < nq; q += 2) {
                const int j = q >> 1;
                hA = *(const f32x4*)(p.H + (size_t)rowof(j) * D + sl * 128 + 8 * c + 4 * (g & 1));
                issue(q + 1, vB);
                compute(q, vA);
                issue(q + 2 < nq ? q + 2 : q, vA);
                compute(q + 1, vB);
                finish(j);
            }
        }
        asm volatile("s_waitcnt vmcnt(0)" ::: "memory");
        for (int j = 0; j < nt; ++j) {
            const size_t r = rowof(j);
            float* hrow = p.H + r * D;
            f32x4 v[4]; float s = 0.f;
#pragma unroll
            for (int q = 0; q < 4; ++q) { v[q] = *(const f32x4*)(hrow + q * 256 + lane * 4); s += v[q][0] + v[q][1] + v[q][2] + v[q][3]; }
            const float mu = wave_sum(s) * (1.0f / 1024.0f);
            float ss = 0.f;
#pragma unroll
            for (int q = 0; q < 4; ++q) { v[q] = v[q] - mu; ss += v[q][0] * v[q][0] + v[q][1] * v[q][1] + v[q][2] * v[q][2] + v[q][3] * v[q][3]; }
            const float rstd = rsqrtf(wave_sum(ss) * (1.0f / 1024.0f) + LN_EPS);
            if (layer == 0) {
                const float* md1 = p.mod + ((size_t)1 * 9 + mod_row((int)r)) * 6144;
#pragma unroll
                for (int q = 0; q < 4; ++q) {
                    const int n = q * 256 + lane * 4;
                    const f32x4 h = v[q] * rstd * *(const f32x4*)(gam + n) + *(const f32x4*)(bet + n);
                    *(f32x4*)(hrow + n) = h;
                    const f32x4 a = h * (1.0f + *(const f32x4*)(md1 + 1024 + n)) + *(const f32x4*)(md1 + n);
                    *(u32x2*)(p.A16 + r * D + n) = (u32x2){pack2(a[0], a[1]), pack2(a[2], a[3])};
                }
            } else {
                float* orow = p.out + (size_t)(t0 + j) * D;
#pragma unroll
                for (int q = 0; q < 4; ++q) { const int n = q * 256 + lane * 4; *(f32x4*)(orow + n) = v[q] * rstd * *(const f32x4*)(gam + n) + *(const f32x4*)(bet + n); }
            }
        }
    }
}

constexpr int RG_ZS = 136;
constexpr size_t RG_SUM_BYTES = (size_t)NB * 34 * 2 * RGW * 2 * 4;
__device__ __forceinline__ void rg_stage_z(const Params& p, int b, int c34, int n, bf16_t* zc) {
    const int tid = otid(), k2 = tid & 63, tq = tid >> 6, ch = n * 128 + 2 * k2;
    const int lo = c34 < 2 ? 0 : CTX, hi = c34 < 2 ? CTX : PB, p0 = c34 * 128 + 32 * tq;
    float w0[4], w1[4];
#pragma unroll
    for (int tap = 0; tap < 4; ++tap) { w0[tap] = p.od_conv_w[tap * RGW + ch]; w1[tap] = p.od_conv_w[tap * RGW + ch + 1]; }
    const float b0 = p.od_conv_b[ch], b1 = p.od_conv_b[ch + 1];
    const bf16_t* base = p.P + (size_t)b * PB * 2560 + RGW + ch;
    unsigned raw[35];
#pragma unroll
    for (int i = 0; i < 35; ++i) { const int pp = p0 - 2 + i; raw[i] = (pp >= lo && pp < hi) ? *(const unsigned*)(base + (size_t)pp * 2560) : 0u; }
#pragma unroll
    for (int t = 0; t < 32; ++t) {
        const float y0 = b0 + w0[0] * __uint_as_float(raw[t] << 16) + w0[1] * __uint_as_float(raw[t + 1] << 16) + w0[2] * __uint_as_float(raw[t + 2] << 16) + w0[3] * __uint_as_float(raw[t + 3] << 16);
        const float y1 = b1 + w1[0] * __uint_as_float(raw[t] & 0xffff0000u) + w1[1] * __uint_as_float(raw[t + 1] & 0xffff0000u) + w1[2] * __uint_as_float(raw[t + 2] & 0xffff0000u) + w1[3] * __uint_as_float(raw[t + 3] & 0xffff0000u);
        *(unsigned*)(zc + (32 * tq + t) * RG_ZS + 2 * k2) = pack2(y0, y1);
    }
}
__device__ __forceinline__ float gelu_fast(float v) {
    const float av = fabsf(v), t = __builtin_amdgcn_rcpf(av * 0.2316418882f + 1.0f);
    float q = t * 0.5307027145f + (-0.7265760135f); q = q * t + 0.7107068705f; q = q * t + (-0.142248368f); q = q * t + 0.127414796f; q = q * t;
    const float e = __builtin_amdgcn_exp2f(v * v * (-0.72134752044f));
    const float m = v * (q * e);
    return v < 0.f ? m : v - m;
}
struct RgCtx { bf16x8 wr[4], wi[4]; float br, bi, coef; };
__device__ __forceinline__ void rg_ctx_load(const Params& p, int n, int cl, int dir, RgCtx& c) {
    const int lane = otid() & 63, fr = lane & 15, fq = lane >> 4, ch = n * 128 + cl + fr;
    const bf16_t* gr = p.wt_gate + ((size_t)(dir * 2 + 0) * 10 + n) * 16384 + (size_t)(cl + fr) * 128 + 8 * fq;
    const bf16_t* gi = p.wt_gate + ((size_t)(dir * 2 + 1) * 10 + n) * 16384 + (size_t)(cl + fr) * 128 + 8 * fq;
#pragma unroll
    for (int s = 0; s < 4; ++s) { c.wr[s] = *(const bf16x8*)(gr + 32 * s); c.wi[s] = *(const bf16x8*)(gi + 32 * s); }
    c.br = p.od_gate_b[(dir * 2 + 0) * RGW + ch]; c.bi = p.od_gate_b[(dir * 2 + 1) * RGW + ch];
    const float lam = p.od_lambda[dir * RGW + ch];
    c.coef = -8.0f * (fmaxf(-lam, 0.f) + log1pf(expf(-fabsf(lam)))) * 1.4426950408889634f;
}
__device__ __forceinline__ void rg_tile(const bf16_t* zc, int mt, int cl, const RgCtx& c, f32x4& a4, f32x4& x4) {
    const int lane = otid() & 63, fr = lane & 15, fq = lane >> 4;
    f32x4 r = (f32x4){0.f, 0.f, 0.f, 0.f}, ig = (f32x4){0.f, 0.f, 0.f, 0.f};
#pragma unroll
    for (int s = 0; s < 4; ++s) {
        const bf16x8 a = *(const bf16x8*)(zc + (16 * mt + fr) * RG_ZS + 32 * s + 8 * fq);
        r = __builtin_amdgcn_mfma_f32_16x16x32_bf16(a, c.wr[s], r, 0, 0, 0);
        ig = __builtin_amdgcn_mfma_f32_16x16x32_bf16(a, c.wi[s], ig, 0, 0, 0);
    }
#pragma unroll
    for (int rg = 0; rg < 4; ++rg) {
        const float rr = __builtin_amdgcn_rcpf(1.0f + __builtin_amdgcn_exp2f(-1.4426950408889634f * (r[rg] + c.br)));
        const float ii = __builtin_amdgcn_rcpf(1.0f + __builtin_amdgcn_exp2f(-1.4426950408889634f * (ig[rg] + c.bi)));
        const float a = __builtin_amdgcn_exp2f(c.coef * rr);
        const float z = bf2f(zc[(16 * mt + 4 * fq + rg) * RG_ZS + cl + fr]);
        a4[rg] = a; x4[rg] = sqrtf((1.0f - a) * (1.0f + a)) * ii * z;
    }
}
template <int DIR> __device__ __forceinline__ void rg_sum_dir(const Params& p, const bf16_t* zc, int b, int c34, int n, int cl, float* SUM) {
    const int lane = otid() & 63, fr = lane & 15, fq = lane >> 4;
    RgCtx c; rg_ctx_load(p, n, cl, DIR, c);
    float h = 0.f, pt = 1.f;
#pragma unroll 2
    for (int m2 = 0; m2 < 8; ++m2) {
        const int mt = DIR == 0 ? m2 : 7 - m2;
        f32x4 a, x; rg_tile(zc, mt, cl, c, a, x);
        const float P4 = a[0] * a[1] * a[2] * a[3];
        const float B4 = DIR == 0 ? ((x[0] * a[1] + x[1]) * a[2] + x[2]) * a[3] + x[3] : ((x[3] * a[2] + x[2]) * a[1] + x[1]) * a[0] + x[0];
#pragma unroll
        for (int g2 = 0; g2 < 4; ++g2) {
            const int gs = DIR == 0 ? g2 : 3 - g2;
            const float Pg = __shfl(P4, 16 * gs + fr), Bg = __shfl(B4, 16 * gs + fr);
            h = Pg * h + Bg; pt *= Pg;
        }
    }
    if (fq == 0) { float* dst = SUM + ((((size_t)b * 34 + c34) * 2 + DIR) * RGW + n * 128 + cl + fr) * 2; dst[0] = pt; dst[1] = h; }
}
__device__ __forceinline__ void ph_rg_a(const Params& p, unsigned char* smem) {
    bf16_t* zc = (bf16_t*)smem;
    float* SUM = (float*)p.G;
    const int wid = otid() >> 6;
    for (int u = blockIdx.x; u < NB * 34 * 10; u += gridDim.x) {
        const int b = u / 340, c34 = (u / 10) % 34, n = u % 10;
        __syncthreads();
        rg_stage_z(p, b, c34, n, zc);
        __syncthreads();
        for (int nt = 0; nt < 2; ++nt) {
            const int cl = 32 * wid + 16 * nt;
            rg_sum_dir<0>(p, zc, b, c34, n, cl, SUM);
            rg_sum_dir<1>(p, zc, b, c34, n, cl, SUM);
        }
    }
}
__device__ __forceinline__ void ph_rg_b(const Params& p) {
    const float* SUM = (const float*)p.G; float* HIN = (float*)(p.G + RG_SUM_BYTES);
    for (int gid = blockIdx.x * 256 + threadIdx.x; gid < NB * 2 * RGW; gid += gridDim.x * 256) {
        const int ch = gid % RGW, dir = (gid / RGW) & 1, b = gid / (2 * RGW);
        float h = 0.f;
#pragma unroll 2
        for (int step = 0; step < 34; ++step) {
            const int c34 = dir == 0 ? step : (step < 2 ? 1 - step : 35 - step);
            const size_t o = (((size_t)b * 34 + c34) * 2 + dir) * RGW + ch;
            HIN[o] = h;
            h = SUM[o * 2] * h + SUM[o * 2 + 1];
        }
    }
}
template <int DIR> __device__ __forceinline__ void rg_apply_dir(const Params& p, const bf16_t* zc, bf16_t* yf, int b, int c34, int n, int cl, const float* HIN, int dry) {
    const int lane = otid() & 63, fr = lane & 15, fq = lane >> 4, ch = n * 128 + cl + fr;
    RgCtx c; rg_ctx_load(p, n, cl, DIR, c);
    float h = HIN[(((size_t)b * 34 + c34) * 2 + DIR) * RGW + ch];
    bf16_t* pbase = p.P + ((size_t)b * PB + c34 * 128 + 4 * fq) * 2560 + ch;
    bf16_t br_[32];
    if (DIR == 1) {
#pragma unroll
        for (int i = 0; i < 32; ++i) br_[i] = pbase[(size_t)(16 * (i >> 2) + (i & 3)) * 2560];
    }
#pragma unroll
    for (int m2 = 0; m2 < 8; ++m2) {
        const int mt = DIR == 0 ? m2 : 7 - m2;
        f32x4 a, x; rg_tile(zc, mt, cl, c, a, x);
        const float P4 = a[0] * a[1] * a[2] * a[3];
        const float B4 = DIR == 0 ? ((x[0] * a[1] + x[1]) * a[2] + x[2]) * a[3] + x[3] : ((x[3] * a[2] + x[2]) * a[1] + x[1]) * a[0] + x[0];
        float hin = 0.f;
#pragma unroll
        for (int g2 = 0; g2 < 4; ++g2) {
            const int gs = DIR == 0 ? g2 : 3 - g2;
            const float Pg = __shfl(P4, 16 * gs + fr), Bg = __shfl(B4, 16 * gs + fr);
            if (fq == gs) hin = h;
            h = Pg * h + Bg;
        }
        f32x4 y;
        if (DIR == 0) {
            y[0] = a[0] * hin + x[0]; y[1] = a[1] * y[0] + x[1]; y[2] = a[2] * y[1] + x[2]; y[3] = a[3] * y[2] + x[3];
#pragma unroll
            for (int rg = 0; rg < 4; ++rg) yf[(16 * mt + 4 * fq + rg) * 16 + fr] = f2bf(y[rg]);
        } else {
            y[3] = a[3] * hin + x[3]; y[2] = a[2] * y[3] + x[2]; y[1] = a[1] * y[2] + x[1]; y[0] = a[0] * y[1] + x[0];
#pragma unroll
            for (int rg = 0; rg < 4; ++rg) {
                bf16_t* pb = pbase + (size_t)(16 * mt + rg) * 2560;
                const bf16_t ov = f2bf(gelu_fast(bf2f(br_[4 * mt + rg])) * (y[rg] + bf2f(yf[(16 * mt + 4 * fq + rg) * 16 + fr])));
                if (!dry) *pb = ov; else asm volatile("" :: "v"(ov));
            }
        }
    }
}
__device__ __forceinline__ void ph_rg_c(const Params& p, unsigned char* smem, int dry = 0) {
    bf16_t* zc = (bf16_t*)smem;
    const float* HIN = (const float*)(p.G + RG_SUM_BYTES);
    const int wid = otid() >> 6;
    bf16_t* yf = (bf16_t*)(smem + 128 * RG_ZS * 2) + wid * 2048;
    for (int u = blockIdx.x; u < NB * 32 * 10; u += gridDim.x) {
        const int b = u / 320, c34 = 2 + (u / 10) % 32, n = u % 10;
        __syncthreads();
        rg_stage_z(p, b, c34, n, zc);
        __syncthreads();
        for (int nt = 0; nt < 2; ++nt) {
            const int cl = 32 * wid + 16 * nt;
            rg_apply_dir<0>(p, zc, yf, b, c34, n, cl, HIN, dry);
            rg_apply_dir<1>(p, zc, yf, b, c34, n, cl, HIN, dry);
        }
    }
}

#define XB_TMO      128
#define XB_XCNT(j)  (256  + 64 * (j))
#define XB_XSUB(j)  (1280 + 64 * (j))
#define XB_XGEN(j)  (2304 + 64 * (j))
#define XB_TOP      3328
#define XB_TOPGEN   3392
#define XCD_BAR_WORDS 3456
#define XB_SPIN_CAP (1u << 22)
#define LAS __attribute__((address_space(3)))
__device__ __forceinline__ unsigned xb_ld(unsigned* p) { return __hip_atomic_load(p, __ATOMIC_RELAXED, __HIP_MEMORY_SCOPE_AGENT); }
__device__ __forceinline__ unsigned xb_add(unsigned* p, unsigned v) { return __hip_atomic_fetch_add(p, v, __ATOMIC_RELAXED, __HIP_MEMORY_SCOPE_AGENT); }
__device__ __forceinline__ unsigned xb_xcc_id() { return (unsigned)__builtin_amdgcn_s_getreg((3 << 11) | 20) & 0xFu; }
#define XB_SPIN(cond, bar) do { unsigned _sp = 0; while (cond) { __builtin_amdgcn_s_sleep(1); \
    if ((++_sp & 255u) == 0u) { if (xb_ld(&(bar)[XB_TMO])) break; if (_sp > XB_SPIN_CAP) { atomicAdd(&(bar)[XB_TMO], 1u); break; } } } } while (0)
struct XcdBarrier { unsigned* bar; unsigned x; volatile LAS unsigned* st; };
__device__ __forceinline__ XcdBarrier xcd_barrier_post(unsigned* bar, volatile LAS unsigned* st) {
    XcdBarrier b; b.bar = bar; b.x = xb_xcc_id(); b.st = st;
    if (threadIdx.x == 0) (void)xb_add(&bar[XB_XCNT(b.x)], 1u);
    return b;
}
__device__ __forceinline__ void xcd_barrier_complete(unsigned* bar, unsigned x, unsigned& nloc, unsigned& nx) {
    const unsigned G = gridDim.x * gridDim.y * gridDim.z;
    unsigned sum, cnt, mine, sp = 0u;
    for (;;) {
        sum = 0u; cnt = 0u; mine = 0u;
#pragma unroll
        for (unsigned j = 0; j < 16; ++j) { const unsigned c = xb_ld(&bar[XB_XCNT(j)]); sum += c; cnt += (c > 0u) ? 1u : 0u; mine = (j == x) ? c : mine; }
        if (sum == G) break;
        __builtin_amdgcn_s_sleep(1);
        if ((++sp & 255u) == 0u) { if (xb_ld(&bar[XB_TMO])) break; if (sp > XB_SPIN_CAP) { atomicAdd(&bar[XB_TMO], 1u); break; } }
    }
    nloc = mine > 0u ? mine : 1u; nx = cnt > 0u ? cnt : 1u;
}
__device__ __forceinline__ void xcd_barrier(const XcdBarrier& b) {
    asm volatile("s_waitcnt vmcnt(0)" ::: "memory");
    __syncthreads();
    if (threadIdx.x == 0) {
        unsigned* bar = b.bar;
        __builtin_amdgcn_s_waitcnt(0);
        unsigned nloc = b.st[0], nx = b.st[1];
        if (nloc == 0u) { xcd_barrier_complete(bar, b.x, nloc, nx); b.st[0] = nloc; b.st[1] = nx; }
        const unsigned old = xb_add(&bar[XB_XSUB(b.x)], 1u);
        const unsigned gen = old / nloc;
        if (old + 1u == (gen + 1u) * nloc) {
            __builtin_amdgcn_fence(__ATOMIC_RELEASE, "agent");
            asm volatile("s_waitcnt vmcnt(0)" ::: "memory");
            const unsigned og = xb_add(&bar[XB_TOP], 1u);
            const unsigned tg = og / nx;
            if (og + 1u == (tg + 1u) * nx) xb_add(&bar[XB_TOPGEN], 1u);
            else XB_SPIN(xb_ld(&bar[XB_TOPGEN]) == tg, bar);
            __builtin_amdgcn_fence(__ATOMIC_ACQUIRE, "agent");
            xb_add(&bar[XB_XGEN(b.x)], 1u);
            asm volatile("s_waitcnt vmcnt(0)" ::: "memory");
        } else {
            XB_SPIN(xb_ld(&bar[XB_XGEN(b.x)]) == gen, bar);
            __builtin_amdgcn_fence(__ATOMIC_ACQUIRE, "agent");
            asm volatile("s_waitcnt vmcnt(0)" ::: "memory");
        }
    }
    __syncthreads();
}

#define SMEM_DECL __shared__ __attribute__((aligned(16))) unsigned char smem[65536]
__global__ void __launch_bounds__(256) k_prologue(Params p) { SMEM_DECL; ph_prologue(p, smem); }
__global__ void __launch_bounds__(256) k_modulate0(Params p) { ph_modulate0(p); }
__global__ void __launch_bounds__(256) k_gemm_ev_in(Params p) { SMEM_DECL; gemm_phase(p.A16, D, p.wt_ev_in, 1024, EV_IN, RowMap{0}, EpiBf16{p.P, EV_IN, EV_IN}, smem); }
__global__ void __launch_bounds__(256) k_rowpost(Params p) { ph_rowpost(p); }
__global__ void __launch_bounds__(256) k_gemm_q(Params p) { SMEM_DECL; gemm_phase(p.P + C_CQ, EV_IN, p.wt_uq, 384, 768, RowMap{0}, EpiQ{p.Q16, p.rsq, p.rope_cos, p.rope_sin}, smem); }
__global__ void __launch_bounds__(256) k_gemm_kv(Params p) { SMEM_DECL; gemm_phase(p.P + C_CKV, EV_IN, p.wt_ukv, 256, 1024, RowMap{0}, EpiKV{p.K16, p.V16, p.rsq + R}, smem); }
__global__ void __launch_bounds__(256) k_gemm_ev_out(Params p) { SMEM_DECL; gemm_phase(p.A16, D, p.wt_ev_out, 1024, 1024, RowMap{0}, EpiResid{p.x, p.ctx, p.mod, p.H, 0}, smem); }
__global__ void __launch_bounds__(256) k_ln_mod(Params p, int layer, int lat_only) { ph_ln_mod(p, layer, 0, lat_only); }
__global__ void __launch_bounds__(256) k_gemm_pq(Params p, int layer, int lat_only) { SMEM_DECL; gemm_phase(p.A16, D, p.wt_pq + (size_t)layer * 2048 * 1024, 1024, 2048, RowMap{lat_only}, EpiBf16{p.P, 2048, 2048}, smem); }
__global__ void __launch_bounds__(256) k_combine(Params p, int lat_only) { ph_combine(p, lat_only); }
__global__ void __launch_bounds__(256) k_gather(Params p, int layer, int lat_only) { ph_gather_ln(p, layer, lat_only); }
__global__ void __launch_bounds__(256) k_gemm_od_in(Params p) { SMEM_DECL; gemm_phase(p.A16, D, p.wt_od_in, 1024, 2560, RowMap{0}, EpiBf16{p.P, 2560, 2560}, smem); }
__global__ void __launch_bounds__(256) k_gemm_od_out(Params p) { SMEM_DECL; gemm_phase(p.P, 2560, p.wt_od_out, 1280, 1024, RowMap{1}, EpiResid{p.x, p.ctx, p.mod, p.H, 1}, smem); }

__global__ void __launch_bounds__(256, 2) k_mega(Params p) {
    SMEM_DECL;
    cg::grid_group grid = cg::this_grid();
    volatile LAS unsigned* xst = (volatile LAS unsigned*)(LAS unsigned char*)(smem + 65520);
    if (threadIdx.x == 0) { xst[0] = 0u; xst[1] = 0u; }
    if (blockIdx.x == 0) for (int i = threadIdx.x; i < XCD_BAR_WORDS; i += 256) p.bar[i] = 0u;
    ph_prologue(p, smem); grid.sync();
    const XcdBarrier xb = xcd_barrier_post(p.bar, xst);
    if (p.probe & 32) ph_modulate0(p);
    ph_modulate0(p); xcd_barrier(xb);
    gemm_phase(p.A16, D, p.wt_ev_in, 1024, EV_IN, RowMap{0}, EpiBf16{p.P, EV_IN, EV_IN}, smem); xcd_barrier(xb);
    if (p.probe & 32) ph_rowpost(p);
    if (p.probe & 128) ph_gla_a(p, smem);
    ph_rowpost(p); ph_gla_a(p, smem); xcd_barrier(xb);
    gemm_phase(p.P + C_CQ, EV_IN, p.wt_uq, 384, 768, RowMap{0}, EpiQ{p.Q16, p.rsq, p.rope_cos, p.rope_sin}, smem);
    gemm_phase(p.P + C_CKV, EV_IN, p.wt_ukv, 256, 1024, RowMap{0}, EpiKV{p.K16, p.V16, p.rsq + R}, smem); if (p.probe & 8) ph_gla_b(p, 1);
    ph_gla_b(p); xcd_barrier(xb);
    if (p.probe & 256) ph_gla_c(p, smem);
    if (p.probe & 512) ph_attn(p, smem, blockIdx.x, gridDim.x);
    ph_gla_c(p, smem); ph_attn(p, smem, blockIdx.x, gridDim.x); xcd_barrier(xb);
    gemm_phase(p.A16, D, p.wt_ev_out, 1024, 1024, RowMap{0}, EpiResid{p.x, p.ctx, p.mod, p.H, 0}, smem); xcd_barrier(xb);
    if (p.probe & 4) ph_ln_mod(p, 0, 0, 0, 1);
    ph_ln_mod(p, 0, 0, 0); xcd_barrier(xb);
    gemm_phase(p.A16, D, p.wt_pq, 1024, 2048, RowMap{0}, EpiBf16{p.P, 2048, 2048}, smem); ph_convert_uv(p, 0); xcd_barrier(xb);
    ph_scores(p, 0, 0, smem); xcd_barrier(xb);
    ph_combine(p, 0); xcd_barrier(xb);
    ph_gather_sliced(p, 0, 0, smem); xcd_barrier(xb);
    gemm_phase(p.A16, D, p.wt_od_in, 1024, 2560, RowMap{0}, EpiBf16{p.P, 2560, 2560}, smem); xcd_barrier(xb);
    if (p.probe & 64) ph_rg_a(p, smem);
    ph_rg_a(p, smem); xcd_barrier(xb);
    if (p.probe & 32) ph_rg_b(p);
    ph_rg_b(p); xcd_barrier(xb);
    if (p.probe & 16) ph_rg_c(p, smem, 1);
    ph_rg_c(p, smem); xcd_barrier(xb);
    gemm_phase(p.P, 2560, p.wt_od_out, 1280, 1024, RowMap{1}, EpiResid{p.x, p.ctx, p.mod, p.H, 1}, smem); xcd_barrier(xb);
    if (p.probe & 4) ph_ln_mod(p, 1, 0, 1, 1);
    ph_ln_mod(p, 1, 0, 1); xcd_barrier(xb);
    gemm_phase(p.A16, D, p.wt_pq + (size_t)2048 * 1024, 1024, 2048, RowMap{1}, EpiBf16{p.P, 2048, 2048}, smem); ph_convert_uv(p, 1); xcd_barrier(xb);
    ph_scores(p, 1, 1, smem); xcd_barrier(xb);
    ph_combine(p, 1); xcd_barrier(xb);
    ph_gather_sliced(p, 1, 1, smem);
}

extern "C" void kernel_launch(void* const* d_in, const int* in_sizes, int n_in, void* d_out, int out_size, void* d_ws, size_t ws_size, hipStream_t stream) {
    Params p{};
    const float** f = (const float**)d_in;
    p.x = f[0]; p.c = f[1]; p.ctx = f[2]; p.c_ctx = f[3]; p.mod_w = f[4]; p.mod_b = f[5]; p.ln_g = f[6]; p.ln_b = f[7];
    p.ev_w_in = f[8]; p.ev_q_norm = f[9]; p.ev_kv_norm = f[10]; p.ev_w_uq = f[11]; p.ev_w_ukv = f[12]; p.ev_gla_wa2 = f[13]; p.ev_gla_ba = f[14]; p.ev_gla_norm = f[15]; p.ev_w_out = f[16];
    p.od_w_in = f[17]; p.od_conv_w = f[18]; p.od_conv_b = f[19]; p.od_gate_w = f[20]; p.od_gate_b = f[21]; p.od_lambda = f[22]; p.od_w_out = f[23];
    p.peer_wq = f[24]; p.peer_k1 = f[25]; p.peer_k2 = f[26]; p.peer_u = f[27]; p.peer_v = f[28];
    p.out = (float*)d_out;
    unsigned char* w = (unsigned char*)d_ws; size_t off = 0;
    auto take = [&](size_t bytes) { unsigned char* r = w + off; off += (bytes + 255) & ~(size_t)255; return r; };
    p.wt_ev_in = (bf16_t*)take((size_t)EV_IN * 1024 * 2); p.wt_uq = (bf16_t*)take(768 * 384 * 2); p.wt_ukv = (bf16_t*)take(1024 * 256 * 2);
    p.wt_ev_out = (bf16_t*)take(1024 * 1024 * 2); p.wt_od_in = (bf16_t*)take(2560 * 1024 * 2); p.wt_gate = (bf16_t*)take(40 * 16384 * 2);
    p.wt_od_out = (bf16_t*)take(1024 * 1280 * 2); p.wt_pq = (bf16_t*)take((size_t)2 * 2048 * 1024 * 2); p.wt_k = (bf16_t*)take(4 * 16384 * 2);
    p.mod = (float*)take(2 * 9 * 6144 * 4); p.rope_cos = (float*)take(SEQ * 16 * 4); p.rope_sin = (float*)take(SEQ * 16 * 4); p.rsq = (float*)take((size_t)2 * R * 4);
    p.H = (float*)take((size_t)R * D * 4);
    p.Q16 = (bf16_t*)p.H; p.K16 = p.Q16 + (size_t)R * 768; p.V16 = p.K16 + (size_t)R * 768;
    p.A16 = (bf16_t*)take((size_t)R * D * 2);
    p.P = (bf16_t*)take((size_t)R * 2560 * 2);
    p.G = take((size_t)94371840);
    p.bar = (unsigned*)take(XCD_BAR_WORDS * 4);
    if (off > ws_size) { fprintf(stderr, "workspace too small: need %zu have %zu\n", off, ws_size); return; }
    static int grid_blocks = 0;
    if (!grid_blocks) {
        int dev = 0, cus = 0, per_cu = 0;
        (void)hipGetDevice(&dev);
        (void)hipDeviceGetAttribute(&cus, hipDeviceAttributeMultiprocessorCount, dev);
        (void)hipOccupancyMaxActiveBlocksPerMultiprocessor(&per_cu, k_mega, 256, 0);
        if (per_cu > 2) per_cu = 2;
        if (per_cu < 1) per_cu = 1;
        grid_blocks = cus * per_cu;
    }
    p.probe = PROBE_MASK; p.pad_ = 0;
    void* args[] = {&p};
    hipError_t e = hipLaunchCooperativeKernel((void*)k_mega, dim3(grid_blocks), dim3(256), args, 0, stream);
    if (e != hipSuccess) fprintf(stderr, "cooperative launch failed: %s (grid %d)\n", hipGetErrorString(e), grid_blocks);
}
__global__ void __launch_bounds__(256) k_gather2(Params p, int layer, int lat_only) { SMEM_DECL; ph_gather_mfma(p, layer, lat_only, smem); }
__global__ void __launch_bounds__(256) k_rga(Params p) { SMEM_DECL; ph_rg_a(p, smem); }
__global__ void __launch_bounds__(256) k_rgc(Params p) { SMEM_DECL; ph_rg_c(p, smem); }
__global__ void __launch_bounds__(256) k_glaa(Params p) { SMEM_DECL; ph_gla_a(p, smem); }
__global__ void __launch_bounds__(256) k_glac(Params p) { SMEM_DECL; ph_gla_c(p, smem); }
__global__ void __launch_bounds__(256) k_attn2(Params p) { SMEM_DECL; ph_attn(p, smem, blockIdx.x, gridDim.x); }
```

```cpp
#include <hip/hip_runtime.h>
#include <hip/hip_cooperative_groups.h>
#include <cstdio>
#include <cstdint>

namespace cg = cooperative_groups;
typedef unsigned short bf16_t;
typedef short bf16x8 __attribute__((ext_vector_type(8)));
typedef float f32x4 __attribute__((ext_vector_type(4)));
typedef float f32x16 __attribute__((ext_vector_type(16)));
typedef unsigned u32x4 __attribute__((ext_vector_type(4)));
typedef unsigned u32x2 __attribute__((ext_vector_type(2)));

constexpr int D = 1024, NB = 8, SEQ = 4096, CTX = 256, PB = SEQ + CTX  , R = NB * PB  ;
constexpr int EV_IN = 2240, RGW = 1280;
constexpr int C_CQ = 0, C_CKV = 384, C_KPE = 640, C_GQ = 672, C_GK = 928, C_GV = 1184, C_GG = 1696, C_GAF = 2208;
constexpr float LN_EPS = 1e-6f, ALPHA = 1.41421356237f, MLA_SCALE = 0.10206207261596577f  ;
constexpr int PEER_N = 16384;

#ifndef PROBE_MASK
#define PROBE_MASK 0
#endif
struct Params {
    const float *x, *c, *ctx, *c_ctx, *mod_w, *mod_b, *ln_g, *ln_b;
    const float *ev_w_in, *ev_q_norm, *ev_kv_norm, *ev_w_uq, *ev_w_ukv, *ev_gla_wa2, *ev_gla_ba, *ev_gla_norm, *ev_w_out;
    const float *od_w_in, *od_conv_w, *od_conv_b, *od_gate_w, *od_gate_b, *od_lambda, *od_w_out;
    const float *peer_wq, *peer_k1, *peer_k2, *peer_u, *peer_v;
    float* out;
    bf16_t *wt_ev_in, *wt_uq, *wt_ukv, *wt_ev_out, *wt_od_in, *wt_gate, *wt_od_out, *wq16, *wpt, *wt_k;
    float *mod, *rope_cos, *rope_sin, *rsq;
    float* H; bf16_t *Q16, *K16, *V16;
    bf16_t* A16; bf16_t* P; unsigned char* G;
    unsigned* bar;
    int probe, pad_;
};

__device__ __forceinline__ bf16_t f2bf(float f) { unsigned u = __float_as_uint(f); u += 0x7fffu + ((u >> 16) & 1u); return (bf16_t)(u >> 16); }
__device__ __forceinline__ float bf2f(bf16_t h) { return __uint_as_float(((unsigned)h) << 16); }
__device__ __forceinline__ unsigned pack2(float a, float b) { unsigned r; asm volatile("v_cvt_pk_bf16_f32 %0, %1, %2" : "=v"(r) : "v"(a), "v"(b)); return r; }
__device__ __forceinline__ float silu_f(float x) { return x / (1.0f + expf(-x)); }
__device__ __forceinline__ float sigmoid_f(float x) { return 1.0f / (1.0f + expf(-x)); }
__device__ __forceinline__ float gelu_f(float x) { return 0.5f * x * (1.0f + erff(x * 0.70710678118654752f)); }
__device__ __forceinline__ float wave_sum(float v) {
#pragma unroll
    for (int o = 32; o > 0; o >>= 1) v += __shfl_xor(v, o);
    return v;
}
__device__ __forceinline__ int otid() { int t = threadIdx.x; asm volatile("" : "+v"(t)); return t; }
__device__ __forceinline__ int mod_row(int r) { const int b = r / PB, p = r - b * PB; return p < CTX ? 8 : b; }
__device__ __forceinline__ const float* in_row(const Params& P_, int r) {
    const int b = r / PB, p = r - b * PB;
    return p < CTX ? P_.ctx + ((size_t)b * CTX + p) * D : P_.x + ((size_t)b * SEQ + (p - CTX)) * D;
}

__device__ __forceinline__ void tconv_tile(const float* __restrict__ W, int K, int N, bf16_t* __restrict__ Wt, const float* __restrict__ rowscale, int tile, float* sm) {
    const int ntn = N / 64, tk = tile / ntn, tn = tile % ntn, tid = threadIdx.x;
#pragma unroll
    for (int i = 0; i < 4; ++i) {
        const int k = (tid >> 4) + 16 * i;
        f32x4 v = *(const f32x4*)(W + (size_t)(tk * 64 + k) * N + tn * 64 + (tid & 15) * 4);
        const float s = rowscale ? rowscale[tk * 64 + k] : 1.0f;
#pragma unroll
        for (int q = 0; q < 4; ++q) sm[k * 65 + (tid & 15) * 4 + q] = v[q] * s;
    }
    __syncthreads();
    const int n = tid >> 2, kc = tid & 3;
    unsigned w[8];
#pragma unroll
    for (int kk = 0; kk < 8; ++kk) w[kk] = pack2(sm[(kc * 16 + 2 * kk) * 65 + n], sm[(kc * 16 + 2 * kk + 1) * 65 + n]);
    bf16_t* dst = Wt + (size_t)(tn * 64 + n) * K + tk * 64 + kc * 16;
    *(u32x4*)dst = (u32x4){w[0], w[1], w[2], w[3]};
    *(u32x4*)(dst + 8) = (u32x4){w[4], w[5], w[6], w[7]};
    __syncthreads();
}
__device__ __forceinline__ void tconv_all(const float* W, int K, int N, bf16_t* Wt, const float* rowscale, float* sm) {
    const int nt = (K / 64) * (N / 64);
    for (int t = blockIdx.x; t < nt; t += gridDim.x) tconv_tile(W, K, N, Wt, rowscale, t, sm);
}

__device__ __forceinline__ void ph_prologue(const Params& p, unsigned char* smem) {
    float* sm = (float*)smem;
    tconv_all(p.ev_w_in, 1024, EV_IN, p.wt_ev_in, nullptr, sm);
    tconv_all(p.ev_w_uq, 384, 768, p.wt_uq, p.ev_q_norm, sm);
    tconv_all(p.ev_w_ukv, 256, 1024, p.wt_ukv, p.ev_kv_norm, sm);
    tconv_all(p.ev_w_out, 1024, 1024, p.wt_ev_out, nullptr, sm);
    tconv_all(p.od_w_in, 1024, 2560, p.wt_od_in, nullptr, sm);
    for (int g = 0; g < 40; ++g) tconv_all(p.od_gate_w + (size_t)g * 16384, 128, 128, p.wt_gate + (size_t)g * 16384, nullptr, sm);
    tconv_all(p.od_w_out, 1280, 1024, p.wt_od_out, nullptr, sm);
    for (int i = blockIdx.x * 256 + threadIdx.x; i < 2 * 1024 * 2048 / 8; i += gridDim.x * 256) {
        const f32x4 a = *(const f32x4*)(p.peer_wq + (size_t)i * 8), b2 = *(const f32x4*)(p.peer_wq + (size_t)i * 8 + 4);
        *(u32x4*)(p.wq16 + (size_t)i * 8) = (u32x4){pack2(a[0], a[1]), pack2(a[2], a[3]), pack2(b2[0], b2[1]), pack2(b2[2], b2[3])};
    }
    for (int i = blockIdx.x * 256 + threadIdx.x; i < 2 * 2 * 16384; i += gridDim.x * 256) {
        const int l = i / 32768, h = (i / 16384) & 1, e = i & 16383;
        p.wt_k[i] = f2bf((h ? p.peer_k2 : p.peer_k1)[(size_t)l * 16384 + e]);
    }
    for (int i = blockIdx.x * 256 + threadIdx.x; i < SEQ * 16; i += gridDim.x * 256) {
        const int s = i >> 4, f = i & 15;
        const float pos = (float)(f < 8 ? (s >> 6) : (s & 63));
        const float inv = powf(10000.0f, -(float)(f & 7) / 8.0f);
        const float ang = pos * inv;
        p.rope_cos[i] = cosf(ang); p.rope_sin[i] = sinf(ang);
    }
    float* sc = sm;
    for (int u = blockIdx.x; u < 2 * 96; u += gridDim.x) {
        const int l = u / 96, c0 = (u % 96) * 64, tid = threadIdx.x;
        __syncthreads();
        for (int i = tid; i < 9 * 1024; i += 256) { const int rr = i >> 10, k = i & 1023; sc[i] = silu_f(rr < 8 ? p.c[rr * 1024 + k] : p.c_ctx[k]); }
        __syncthreads();
        const int col = c0 + (tid & 63), kq = tid >> 6;
        float acc[9];
#pragma unroll
        for (int rr = 0; rr < 9; ++rr) acc[rr] = 0.f;
        const float* w = p.mod_w + (size_t)l * 1024 * 6144 + col;
        for (int k = kq * 256; k < kq * 256 + 256; ++k) {
            const float wv = w[(size_t)k * 6144];
#pragma unroll
            for (int rr = 0; rr < 9; ++rr) acc[rr] += sc[rr * 1024 + k] * wv;
        }
        __syncthreads();
        float* red = sm + 9 * 1024;
#pragma unroll
        for (int rr = 0; rr < 9; ++rr) red[(kq * 9 + rr) * 64 + (tid & 63)] = acc[rr];
        __syncthreads();
        for (int i = tid; i < 9 * 64; i += 256) {
            const int rr = i >> 6, cc = i & 63;
            const float s = red[(0 * 9 + rr) * 64 + cc] + red[(1 * 9 + rr) * 64 + cc] + red[(2 * 9 + rr) * 64 + cc] + red[(3 * 9 + rr) * 64 + cc];
            p.mod[((size_t)l * 9 + rr) * 6144 + c0 + cc] = s + p.mod_b[l * 6144 + c0 + cc];
        }
    }
}

__device__ __forceinline__ void ph_modulate0(const Params& p) {
    const int tid_ = otid(), wid = tid_ >> 6, lane = tid_ & 63;
    for (int u = blockIdx.x; u < R / 4; u += gridDim.x) {
        const int r = u * 4 + wid;
        const float* src = in_row(p, r);
        const float* md = p.mod + (size_t)(0 * 9 + mod_row(r)) * 6144;
#pragma unroll
        for (int q = 0; q < 4; ++q) {
            const int c = q * 256 + lane * 4;
            const f32x4 h = *(const f32x4*)(src + c), sh = *(const f32x4*)(md + c), scl = *(const f32x4*)(md + 1024 + c);
            const f32x4 v = h * (1.0f + scl) + sh;
            *(u32x2*)(p.A16 + (size_t)r * D + c) = (u32x2){pack2(v[0], v[1]), pack2(v[2], v[3])};
        }
    }
}

constexpr int GBK = 64, GLDS = 64  ;
struct RowMap { int lat_only; __device__ __forceinline__ int ntiles() const { return lat_only ? 256 : 272; }
    __device__ __forceinline__ int row0(int t) const { return lat_only ? (t >> 5) * PB + CTX + (t & 31) * 128 : t * 128; } };

template <class Epi>
__device__ __forceinline__ void gemm_unit(const bf16_t* __restrict__ A, int lda, const bf16_t* __restrict__ Bt, int ldb, int K, int N, int m0, int n0, const Epi& epi, unsigned char* smem) {
    bf16_t* sA = (bf16_t*)smem; bf16_t* sB = sA + 128 * GLDS;
    const int tid = otid(), lane = tid & 63, wid = tid >> 6, wm = wid >> 1, wn = wid & 1, fr = lane & 15, fq = lane >> 4;
    const int nk = K / GBK;
    f32x4 acc[4][4];
#pragma unroll
    for (int i = 0; i < 4; ++i)
#pragma unroll
        for (int j = 0; j < 4; ++j) acc[i][j] = (f32x4){0.f, 0.f, 0.f, 0.f};
    u32x4 ra[4], rb[4];
    auto gload = [&](int kt) {
#pragma unroll
        for (int i = 0; i < 4; ++i) {
            const int id = tid + 256 * i, row = id >> 3, ch = id & 7;
            ra[i] = *(const u32x4*)(A + (size_t)(m0 + row) * lda + kt * GBK + ch * 8);
            int brow = n0 + row; brow = brow < N ? brow : N - 1;
            rb[i] = *(const u32x4*)(Bt + (size_t)brow * ldb + kt * GBK + ch * 8);
        }
    };
    auto lstore = [&]() {
#pragma unroll
        for (int i = 0; i < 4; ++i) {
            const int id = tid + 256 * i, row = id >> 3, ch = id & 7;
            *(u32x4*)(sA + row * GLDS + ((ch ^ (row & 7)) * 8)) = ra[i];
            *(u32x4*)(sB + row * GLDS + ((ch ^ (row & 7)) * 8)) = rb[i];
        }
    };
    gload(0);
    __syncthreads();
    lstore();
    __syncthreads();
    for (int kt = 0; kt < nk; ++kt) {
        if (kt + 1 < nk) gload(kt + 1);
#pragma unroll
        for (int ks = 0; ks < 2; ++ks) {
            bf16x8 af[4], bfr[4];
#pragma unroll
            for (int i = 0; i < 4; ++i) af[i] = *(const bf16x8*)(sA + (wm * 64 + i * 16 + fr) * GLDS + (((ks * 4 + fq) ^ (fr & 7)) * 8));
#pragma unroll
            for (int j = 0; j < 4; ++j) bfr[j] = *(const bf16x8*)(sB + (wn * 64 + j * 16 + fr) * GLDS + (((ks * 4 + fq) ^ (fr & 7)) * 8));
#pragma unroll
            for (int i = 0; i < 4; ++i)
#pragma unroll
                for (int j = 0; j < 4; ++j) acc[i][j] = __builtin_amdgcn_mfma_f32_16x16x32_bf16(bfr[j], af[i], acc[i][j], 0, 0, 0);
        }
        __syncthreads();
        if (kt + 1 < nk) { lstore(); __syncthreads(); }
    }
    epi(acc, m0 + wm * 64, n0 + wn * 64, fr, fq);
}
template <class Epi>
__device__ __forceinline__ void gemm_phase(const bf16_t* __restrict__ A, int lda, const bf16_t* __restrict__ Bt, int K, int N, RowMap rm, const Epi& epi, unsigned char* smem) {
    const int ntn = (N + 127) / 128, nunits = rm.ntiles() * ntn;
    for (int u = blockIdx.x; u < nunits; u += gridDim.x) gemm_unit(A, lda, Bt, K, K, N, rm.row0(u / ntn), (u % ntn) * 128, epi, smem);
}

struct EpiBf16 {
    bf16_t* C; int ldc, N;
    __device__ __forceinline__ void operator()(const f32x4 (&acc)[4][4], int mb, int nb, int fr, int fq) const {
#pragma unroll
        for (int i = 0; i < 4; ++i)
#pragma unroll
            for (int j = 0; j < 4; ++j) {
                const int m = mb + i * 16 + fr, n = nb + j * 16 + 4 * fq;
                if (n < N) *(u32x2*)(C + (size_t)m * ldc + n) = (u32x2){pack2(acc[i][j][0], acc[i][j][1]), pack2(acc[i][j][2], acc[i][j][3])};
            }
    }
};
struct EpiQ {
    bf16_t* Q; const float *rsq, *rc, *rs;
    __device__ __forceinline__ void operator()(const f32x4 (&acc)[4][4], int mb, int nb, int fr, int fq) const {
#pragma unroll
        for (int i = 0; i < 4; ++i) {
            const int m = mb + i * 16 + fr, b = m / PB, pp = m - b * PB;
            const float sc = rsq[m] * (MLA_SCALE * 1.4426950408889634f);
#pragma unroll
            for (int j = 0; j < 4; j += 2) {
                const int n = nb + j * 16 + 4 * fq;
                f32x4 v0 = acc[i][j] * sc, v1 = acc[i][j + 1] * sc;
                const int d = n % 96;
                if (d >= 64 && pp >= CTX) {
                    const int s = pp - CTX, f = (d - 64) + 0;
                    const f32x4 cs = *(const f32x4*)(rc + s * 16 + f), sn = *(const f32x4*)(rs + s * 16 + f);
                    const f32x4 o0 = v0 * cs - v1 * sn, o1 = v0 * sn + v1 * cs; v0 = o0; v1 = o1;
                }
                *(u32x2*)(Q + (size_t)m * 768 + n) = (u32x2){pack2(v0[0], v0[1]), pack2(v0[2], v0[3])};
                *(u32x2*)(Q + (size_t)m * 768 + n + 16) = (u32x2){pack2(v1[0], v1[1]), pack2(v1[2], v1[3])};
            }
        }
    }
};
struct EpiKV {
    bf16_t *Kd, *Vd; const float* rsq;
    __device__ __forceinline__ void operator()(const f32x4 (&acc)[4][4], int mb, int nb, int fr, int fq) const {
#pragma unroll
        for (int i = 0; i < 4; ++i) {
            const int m = mb + i * 16 + fr; const float sc = rsq[m];
#pragma unroll
            for (int j = 0; j < 4; ++j) {
                const int n = nb + j * 16 + 4 * fq, hd = n >> 7, d = n & 127;
                const f32x4 v = acc[i][j] * sc;
                bf16_t* dst = d < 64 ? Kd + (size_t)m * 768 + hd * 96 + d : Vd + (size_t)m * 512 + hd * 64 + (d - 64);
                *(u32x2*)dst = (u32x2){pack2(v[0], v[1]), pack2(v[2], v[3])};
            }
        }
    }
};
struct EpiResid {
    const float *x, *ctx, *mod; float* H; int layer;
    __device__ __forceinline__ void operator()(const f32x4 (&acc)[4][4], int mb, int nb, int fr, int fq) const {
#pragma unroll
        for (int i = 0; i < 4; ++i) {
            const int m = mb + i * 16 + fr, b = m / PB, pp = m - b * PB;
            const float* hin = layer == 0 ? (pp < CTX ? ctx + ((size_t)b * CTX + pp) * D : x + ((size_t)b * SEQ + (pp - CTX)) * D) : H + (size_t)m * D;
            const float* gate = mod + ((size_t)layer * 9 + (pp < CTX ? 8 : b)) * 6144 + 2 * 1024;
#pragma unroll
            for (int j = 0; j < 4; ++j) {
                const int n = nb + j * 16 + 4 * fq;
                const f32x4 h = *(const f32x4*)(hin + n), g = *(const f32x4*)(gate + n);
                *(f32x4*)(H + (size_t)m * D + n) = ALPHA * h + g * acc[i][j];
            }
        }
    }
};

__device__ __forceinline__ void ph_rowpost(const Params& p) {
    const int tid_ = otid(), wid = tid_ >> 6, lane = tid_ & 63;
    for (int u = blockIdx.x; u < R / 4; u += gridDim.x) {
        const int r = u * 4 + wid, b = r / PB, pp = r - b * PB;
        const bf16_t* row = p.P + (size_t)r * EV_IN;
        float sq = 0.f, skv = 0.f;
#pragma unroll
        for (int i = 0; i < 10; ++i) { const float v = bf2f(row[lane + 64 * i]); if (i < 6) sq += v * v; else skv += v * v; }
        sq = wave_sum(sq); skv = wave_sum(skv);
        if (lane == 0) { p.rsq[r] = rsqrtf(sq / 384.0f + LN_EPS); p.rsq[R + r] = rsqrtf(skv / 256.0f + LN_EPS); }
        if (lane < 16) {
            float x1 = bf2f(row[C_KPE + lane]), x2 = bf2f(row[C_KPE + 16 + lane]);
            if (pp >= CTX) { const int s = pp - CTX; const float cs = p.rope_cos[s * 16 + lane], sn = p.rope_sin[s * 16 + lane];
                const float o1 = x1 * cs - x2 * sn, o2 = x1 * sn + x2 * cs; x1 = o1; x2 = o2; }
            const bf16_t b1 = f2bf(x1), b2 = f2bf(x2);
#pragma unroll
            for (int hd = 0; hd < 8; ++hd) { p.K16[(size_t)r * 768 + hd * 96 + 64 + lane] = b1; p.K16[(size_t)r * 768 + hd * 96 + 80 + lane] = b2; }
        }
    }
}

constexpr int AT_KS = 104, AT_VS = 68, AT_BUF = 64 * AT_KS * 2 + 64 * AT_VS * 2;
__device__ __forceinline__ void ph_attn(const Params& p, unsigned char* smem, int bid, int nblk) {
    const int tid = otid(), wid = tid >> 6, lane = tid & 63, q = lane & 31, h = lane >> 5;
    for (int u = bid; u < 2048 + 128; u += nblk) {
        int b, hd, q0, nkeys;
        if (u < 2048) { b = u >> 8; hd = (u >> 5) & 7; q0 = CTX + (u & 31) * 128; nkeys = PB; }
        else { const int v = u - 2048; b = v >> 4; hd = (v >> 1) & 7; q0 = (v & 1) * 128; nkeys = CTX; }
        const size_t rq = (size_t)b * PB + q0 + wid * 32 + q;
        bf16x8 qf[6];
#pragma unroll
        for (int s = 0; s < 6; ++s) qf[s] = *(const bf16x8*)(p.Q16 + rq * 768 + hd * 96 + 16 * s + 8 * h);
        f32x16 o[2];
#pragma unroll
        for (int i = 0; i < 16; ++i) { o[0][i] = 0.f; o[1][i] = 0.f; }
        float m = -1e30f, l = 0.f;
        const int ntiles = nkeys / 64;
        const bf16_t* Kg = p.K16 + (size_t)b * PB * 768 + hd * 96;
        const bf16_t* Vg = p.V16 + (size_t)b * PB * 512 + hd * 64;
        u32x4 rk[3], rv[2];
        auto gload = [&](int t) {
#pragma unroll
            for (int i = 0; i < 3; ++i) { const int id = tid + 256 * i, key = id / 12, ch = id % 12; rk[i] = *(const u32x4*)(Kg + (size_t)(t * 64 + key) * 768 + ch * 8); }
#pragma unroll
            for (int i = 0; i < 2; ++i) { const int id = tid + 256 * i, key = id >> 3, dch = id & 7; rv[i] = *(const u32x4*)(Vg + (size_t)(t * 64 + key) * 512 + dch * 8); }
        };
        auto lstore = [&](int buf) {
            bf16_t* Ks = (bf16_t*)(smem + buf * AT_BUF); bf16_t* Vt = Ks + 64 * AT_KS;
#pragma unroll
            for (int i = 0; i < 3; ++i) { const int id = tid + 256 * i, key = id / 12, ch = id % 12; *(u32x4*)(Ks + key * AT_KS + ch * 8) = rk[i]; }
#pragma unroll
            for (int i = 0; i < 2; ++i) {
                const int id = tid + 256 * i, key = id >> 3, dch = id & 7;
#pragma unroll
                for (int e = 0; e < 4; ++e) { Vt[(dch * 8 + 2 * e) * AT_VS + key] = (bf16_t)(rv[i][e] & 0xffffu); Vt[(dch * 8 + 2 * e + 1) * AT_VS + key] = (bf16_t)(rv[i][e] >> 16); }
            }
        };
        __syncthreads();
        gload(0); lstore(0);
        __syncthreads();
        for (int t = 0; t < ntiles; ++t) {
            if (t + 1 < ntiles) gload(t + 1);
            const bf16_t* Ks = (const bf16_t*)(smem + (t & 1) * AT_BUF); const bf16_t* Vt = Ks + 64 * AT_KS;
            f32x16 sa[2];
#pragma unroll
            for (int kb = 0; kb < 2; ++kb) {
#pragma unroll
                for (int i = 0; i < 16; ++i) sa[kb][i] = 0.f;
#pragma unroll
                for (int s = 0; s < 6; ++s) {
                    const bf16x8 kf = *(const bf16x8*)(Ks + (kb * 32 + q) * AT_KS + 16 * s + 8 * h);
                    sa[kb] = __builtin_amdgcn_mfma_f32_32x32x16_bf16(kf, qf[s], sa[kb], 0, 0, 0);
                }
            }
            float mx = sa[0][0];
#pragma unroll
            for (int i = 1; i < 16; ++i) mx = fmaxf(mx, sa[0][i]);
#pragma unroll
            for (int i = 0; i < 16; ++i) mx = fmaxf(mx, sa[1][i]);
            mx = fmaxf(mx, __shfl_xor(mx, 32));
            const float mn = fmaxf(m, mx), al = __builtin_amdgcn_exp2f(m - mn);
            m = mn;
            float ps = 0.f;
#pragma unroll
            for (int kb = 0; kb < 2; ++kb)
#pragma unroll
                for (int i = 0; i < 16; ++i) { const float e = __builtin_amdgcn_exp2f(sa[kb][i] - mn); sa[kb][i] = e; ps += e; }
            l = l * al + ps;
#pragma unroll
            for (int i = 0; i < 16; ++i) { o[0][i] *= al; o[1][i] *= al; }
#pragma unroll
            for (int kb = 0; kb < 2; ++kb)
#pragma unroll
                for (int s2 = 0; s2 < 2; ++s2) {
                    u32x4 pw;
#pragma unroll
                    for (int e = 0; e < 4; ++e) pw[e] = pack2(sa[kb][8 * s2 + 2 * e], sa[kb][8 * s2 + 2 * e + 1]);
                    const bf16x8 pf = __builtin_bit_cast(bf16x8, pw);
                    const int base = kb * 32 + 16 * s2;
#pragma unroll
                    for (int db = 0; db < 2; ++db) {
                        const bf16_t* vp = Vt + (db * 32 + q) * AT_VS + base + 4 * h;
                        const u32x2 v0 = *(const u32x2*)vp, v1 = *(const u32x2*)(vp + 8);
                        const bf16x8 vf = __builtin_bit_cast(bf16x8, (u32x4){v0[0], v0[1], v1[0], v1[1]});
                        o[db] = __builtin_amdgcn_mfma_f32_32x32x16_bf16(vf, pf, o[db], 0, 0, 0);
                    }
                }
            if (t + 1 < ntiles) lstore((t + 1) & 1);
            __syncthreads();
        }
        l += __shfl_xor(l, 32);
        const float il = 1.0f / l;
#pragma unroll
        for (int db = 0; db < 2; ++db)
#pragma unroll
            for (int gq = 0; gq < 4; ++gq) {
                const int d = db * 32 + 8 * gq + 4 * h;
                *(u32x2*)(p.A16 + rq * D + hd * 64 + d) = (u32x2){pack2(o[db][4 * gq] * il, o[db][4 * gq + 1] * il), pack2(o[db][4 * gq + 2] * il, o[db][4 * gq + 3] * il)};
            }
    }
}

constexpr size_t GLA_KS_BYTES = (size_t)NB * 4 * 68 * 2 * 8192 * 2;
constexpr int GL_S = 72;
__device__ __forceinline__ void gla_cum(const Params& p, size_t row0, int hd, int dir, float* sga, float* spart, float (&c)[16], float& T) {
    const int tid = otid(), d = tid & 63, part = tid >> 6;
    {
        const int j = tid >> 2, g4 = tid & 3;
        const u32x2 w = *(const u32x2*)(p.P + (row0 + j) * EV_IN + C_GAF + dir * 16 + g4 * 4);
        sga[j * 16 + g4 * 4 + 0] = __uint_as_float(w[0] << 16); sga[j * 16 + g4 * 4 + 1] = __uint_as_float(w[0] & 0xffff0000u);
        sga[j * 16 + g4 * 4 + 2] = __uint_as_float(w[1] << 16); sga[j * 16 + g4 * 4 + 3] = __uint_as_float(w[1] & 0xffff0000u);
    }
    __syncthreads();
    float wc[16];
    const float* wa = p.ev_gla_wa2 + (size_t)dir * 16 * 256 + hd * 64 + d;
#pragma unroll
    for (int g = 0; g < 16; ++g) wc[g] = wa[g * 256];
    const float bias = p.ev_gla_ba[dir * 256 + hd * 64 + d];
    float lv[16]; float run = 0.f;
#pragma unroll
    for (int jj = 0; jj < 16; ++jj) {
        const int j = part * 16 + jj;
        float z = bias;
#pragma unroll
        for (int g = 0; g < 16; g += 4) { const f32x4 a = *(const f32x4*)(sga + j * 16 + g); z += a[0] * wc[g] + a[1] * wc[g + 1] + a[2] * wc[g + 2] + a[3] * wc[g + 3]; }
        const float ls = (fminf(z, 0.f) - log1pf(expf(-fabsf(z)))) * (1.0f / 16.0f);
        lv[jj] = ls; run += ls; c[jj] = run;
    }
    spart[part * 64 + d] = run;
    __syncthreads();
    float off = 0.f; T = 0.f;
#pragma unroll
    for (int pp = 0; pp < 4; ++pp) { const float v = spart[pp * 64 + d]; T += v; if (pp < part) off += v; }
#pragma unroll
    for (int jj = 0; jj < 16; ++jj) c[jj] = dir == 0 ? off + c[jj] : T - (off + c[jj]) + lv[jj];
}
__device__ __forceinline__ void gla_stage_vt(const Params& p, size_t row0, int hd, bf16_t* Vt) {
    const int tid = otid();
#pragma unroll
    for (int i = 0; i < 4; ++i) {
        const int id = tid + 256 * i, j = id >> 4, ech = id & 15;
        const u32x4 w = *(const u32x4*)(p.P + (row0 + j) * EV_IN + C_GV + hd * 128 + ech * 8);
#pragma unroll
        for (int e = 0; e < 4; ++e) { Vt[(ech * 8 + 2 * e) * GL_S + j] = (bf16_t)(w[e] & 0xffffu); Vt[(ech * 8 + 2 * e + 1) * GL_S + j] = (bf16_t)(w[e] >> 16); }
    }
}
__device__ __forceinline__ void ph_gla_a(const Params& p, unsigned char* smem) {
    bf16_t* kwT = (bf16_t*)smem; bf16_t* Vt = kwT + 64 * GL_S; float* sga = (float*)(Vt + 128 * GL_S); float* spart = sga + 1024;
    bf16_t* KS = (bf16_t*)p.G; float* DEC = (float*)(p.G + GLA_KS_BYTES);
    const int tid = otid(), lane = tid & 63, wid = tid >> 6, fr = lane & 15, fq = lane >> 4, d = tid & 63, part = tid >> 6;
    for (int u = blockIdx.x; u < NB * 4 * 68; u += gridDim.x) {
        const int b = u / 272, hd = (u / 68) & 3, ci = u % 68;
        const size_t row0 = (size_t)b * PB + ci * 64;
        __syncthreads();
        gla_stage_vt(p, row0, hd, Vt);
        for (int dir = 0; dir < 2; ++dir) {
            float c[16], T;
            gla_cum(p, row0, hd, dir, sga, spart, c, T);
            unsigned kw[8];
#pragma unroll
            for (int jj = 0; jj < 16; jj += 2) {
                const float k0 = bf2f(p.P[(row0 + part * 16 + jj) * EV_IN + C_GK + hd * 64 + d]), k1 = bf2f(p.P[(row0 + part * 16 + jj + 1) * EV_IN + C_GK + hd * 64 + d]);
                kw[jj >> 1] = pack2(k0 * expf(T - c[jj]), k1 * expf(T - c[jj + 1]));
            }
            *(u32x4*)(kwT + d * GL_S + part * 16) = (u32x4){kw[0], kw[1], kw[2], kw[3]};
            *(u32x4*)(kwT + d * GL_S + part * 16 + 8) = (u32x4){kw[4], kw[5], kw[6], kw[7]};
            if (part == 0) DEC[((size_t)u * 2 + dir) * 64 + d] = expf(T);
            __syncthreads();
            f32x4 acc[8];
#pragma unroll
            for (int et = 0; et < 8; ++et) acc[et] = (f32x4){0.f, 0.f, 0.f, 0.f};
#pragma unroll
            for (int s = 0; s < 2; ++s) {
                const bf16x8 a = *(const bf16x8*)(kwT + (16 * wid + fr) * GL_S + 32 * s + 8 * fq);
#pragma unroll
                for (int et = 0; et < 8; ++et) {
                    const bf16x8 bq = *(const bf16x8*)(Vt + (16 * et + fr) * GL_S + 32 * s + 8 * fq);
                    acc[et] = __builtin_amdgcn_mfma_f32_16x16x32_bf16(a, bq, acc[et], 0, 0, 0);
                }
            }
#pragma unroll
            for (int et = 0; et < 8; ++et)
                *(u32x2*)(KS + (((size_t)u * 2 + dir) * 128 + 16 * et + fr) * 64 + 16 * wid + 4 * fq) = (u32x2){pack2(acc[et][0], acc[et][1]), pack2(acc[et][2], acc[et][3])};
            __syncthreads();
        }
    }
}
__device__ __forceinline__ void ph_gla_b(const Params& p, int dry = 0) {
    unsigned* KS32 = (unsigned*)p.G; const float* DEC = (const float*)(p.G + GLA_KS_BYTES);
    for (int gid = blockIdx.x * 256 + threadIdx.x; gid < 64 * 4096; gid += gridDim.x * 256) {
        const int seq = gid >> 12, pi = gid & 4095, dir = seq & 1, bh = seq >> 1, d = (2 * pi) & 63;
        float s0 = 0.f, s1 = 0.f;
#pragma unroll 4
        for (int step = 0; step < 68; ++step) {
            const int ci = dir == 0 ? step : (step < 4 ? 3 - step : 71 - step);
            const size_t ud = ((size_t)bh * 68 + ci) * 2 + dir;
            const unsigned w = KS32[ud * 4096 + pi];
            const float dc0 = DEC[ud * 64 + d], dc1 = DEC[ud * 64 + d + 1];
            if (!dry) KS32[ud * 4096 + pi] = pack2(s0, s1);
            s0 = dc0 * s0 + __uint_as_float(w << 16); s1 = dc1 * s1 + __uint_as_float(w & 0xffff0000u);
        }
        if (dry) asm volatile("" :: "v"(s0), "v"(s1));
    }
}
__device__ __forceinline__ void ph_gla_c(const Params& p, unsigned char* smem) {
    bf16_t* qs = (bf16_t*)smem; bf16_t* ks = qs + 64 * GL_S; bf16_t* Vt = ks + 64 * GL_S; float* sga = (float*)(Vt + 128 * GL_S); float* spart = sga + 1024;
    const bf16_t* KS = (const bf16_t*)p.G;
    const int tid = otid(), lane = tid & 63, wid = tid >> 6, fr = lane & 15, fq = lane >> 4, d = tid & 63, part = tid >> 6;
    for (int u = blockIdx.x; u < NB * 4 * 68; u += gridDim.x) {
        const int b = u / 272, hd = (u / 68) & 3, ci = u % 68;
        const size_t row0 = (size_t)b * PB + ci * 64;
        const int i = 16 * wid + fr;
        __syncthreads();
        gla_stage_vt(p, row0, hd, Vt);
        f32x4 oacc[8], pt[4];
#pragma unroll
        for (int et = 0; et < 8; ++et) oacc[et] = (f32x4){0.f, 0.f, 0.f, 0.f};
#pragma unroll
        for (int jt = 0; jt < 4; ++jt) pt[jt] = (f32x4){0.f, 0.f, 0.f, 0.f};
        for (int dir = 0; dir < 2; ++dir) {
            float c[16], T;
            gla_cum(p, row0, hd, dir, sga, spart, c, T);
#pragma unroll
            for (int jj = 0; jj < 16; ++jj) {
                const size_t ro = (row0 + part * 16 + jj) * EV_IN + hd * 64 + d;
                qs[(part * 16 + jj) * GL_S + d] = f2bf(bf2f(p.P[ro + C_GQ]) * 0.125f * expf(c[jj]));
                ks[(part * 16 + jj) * GL_S + d] = f2bf(bf2f(p.P[ro + C_GK]) * expf(-c[jj]));
            }
            __syncthreads();
            bf16x8 qf[2];
#pragma unroll
            for (int s = 0; s < 2; ++s) qf[s] = *(const bf16x8*)(qs + i * GL_S + 32 * s + 8 * fq);
#pragma unroll
            for (int jt = 0; jt < 4; ++jt) {
                f32x4 t = (f32x4){0.f, 0.f, 0.f, 0.f};
#pragma unroll
                for (int s = 0; s < 2; ++s) { const bf16x8 a = *(const bf16x8*)(ks + (16 * jt + fr) * GL_S + 32 * s + 8 * fq); t = __builtin_amdgcn_mfma_f32_16x16x32_bf16(a, qf[s], t, 0, 0, 0); }
#pragma unroll
                for (int rg = 0; rg < 4; ++rg) { const int j = 16 * jt + 4 * fq + rg; const bool keep = dir == 0 ? (j <= i) : (j >= i); pt[jt][rg] += keep ? t[rg] : 0.f; }
            }
            const bf16_t* Sg = KS + ((size_t)u * 2 + dir) * 8192;
#pragma unroll
            for (int et = 0; et < 8; ++et) {
#pragma unroll
                for (int s = 0; s < 2; ++s) { const bf16x8 a = *(const bf16x8*)(Sg + (16 * et + fr) * 64 + 32 * s + 8 * fq); oacc[et] = __builtin_amdgcn_mfma_f32_16x16x32_bf16(a, qf[s], oacc[et], 0, 0, 0); }
                if ((et & 3) == 3) __builtin_amdgcn_sched_barrier(0);
            }
            __syncthreads();
        }
#pragma unroll
        for (int k2 = 0; k2 < 2; ++k2) {
            const u32x4 pw = (u32x4){pack2(pt[2 * k2][0], pt[2 * k2][1]), pack2(pt[2 * k2][2], pt[2 * k2][3]), pack2(pt[2 * k2 + 1][0], pt[2 * k2 + 1][1]), pack2(pt[2 * k2 + 1][2], pt[2 * k2 + 1][3])};
            const bf16x8 pf = __builtin_bit_cast(bf16x8, pw);
#pragma unroll
            for (int et = 0; et < 8; ++et) {
                const bf16_t* vp = Vt + (16 * et + fr) * GL_S + 32 * k2 + 4 * fq;
                const u32x2 v0 = *(const u32x2*)vp, v1 = *(const u32x2*)(vp + 16);
                const bf16x8 vf = __builtin_bit_cast(bf16x8, (u32x4){v0[0], v0[1], v1[0], v1[1]});
                oacc[et] = __builtin_amdgcn_mfma_f32_16x16x32_bf16(vf, pf, oacc[et], 0, 0, 0);
            }
        }
        float ss = 0.f;
#pragma unroll
        for (int et = 0; et < 8; ++et) ss += oacc[et][0] * oacc[et][0] + oacc[et][1] * oacc[et][1] + oacc[et][2] * oacc[et][2] + oacc[et][3] * oacc[et][3];
        ss += __shfl_xor(ss, 16); ss += __shfl_xor(ss, 32);
        const float rs = rsqrtf(ss * (1.0f / 128.0f) + LN_EPS);
        const size_t r = row0 + i;
#pragma unroll
        for (int et = 0; et < 8; ++et) {
            const int e = 16 * et + 4 * fq;
            const u32x2 gw = *(const u32x2*)(p.P + r * EV_IN + C_GG + hd * 128 + e);
            const f32x4 nr = *(const f32x4*)(p.ev_gla_norm + hd * 128 + e);
            const float g0 = __uint_as_float(gw[0] << 16), g1 = __uint_as_float(gw[0] & 0xffff0000u), g2 = __uint_as_float(gw[1] << 16), g3 = __uint_as_float(gw[1] & 0xffff0000u);
            *(u32x2*)(p.A16 + r * D + 512 + hd * 128 + e) = (u32x2){pack2(oacc[et][0] * rs * nr[0] * silu_f(g0), oacc[et][1] * rs * nr[1] * silu_f(g1)),
                                                                   pack2(oacc[et][2] * rs * nr[2] * silu_f(g2), oacc[et][3] * rs * nr[3] * silu_f(g3))};
        }
    }
}

__device__ __forceinline__ void ph_ln_mod(const Params& p, int layer, int lnidx, int lat_only, int dry = 0) {
    const int tid_ = otid(), wid = tid_ >> 6, lane = tid_ & 63;
    const int nrows = lat_only ? NB * SEQ : R;
    const float* g = p.ln_g + (size_t)(layer * 2 + lnidx) * D; const float* bb = p.ln_b + (size_t)(layer * 2 + lnidx) * D;
    for (int u = blockIdx.x; u < nrows / 4; u += gridDim.x) {
        const int rr = u * 4 + wid, r = lat_only ? (rr >> 12) * PB + CTX + (rr & 4095) : rr;
        float* hrow = p.H + (size_t)r * D;
        f32x4 v[4]; float s = 0.f;
#pragma unroll
        for (int q = 0; q < 4; ++q) { v[q] = *(const f32x4*)(hrow + q * 256 + lane * 4); s += v[q][0] + v[q][1] + v[q][2] + v[q][3]; }
        const float mu = wave_sum(s) * (1.0f / 1024.0f);
        float ss = 0.f;
#pragma unroll
        for (int q = 0; q < 4; ++q) { v[q] = v[q] - mu; ss += v[q][0] * v[q][0] + v[q][1] * v[q][1] + v[q][2] * v[q][2] + v[q][3] * v[q][3]; }
        const float rstd = rsqrtf(wave_sum(ss) * (1.0f / 1024.0f) + LN_EPS);
        const float* md = p.mod + ((size_t)layer * 9 + mod_row(r)) * 6144;
#pragma unroll
        for (int q = 0; q < 4; ++q) {
            const int c = q * 256 + lane * 4;
            const f32x4 h = v[q] * rstd * *(const f32x4*)(g + c) + *(const f32x4*)(bb + c);
            const f32x4 a = h * (1.0f + *(const f32x4*)(md + 4 * 1024 + c)) + *(const f32x4*)(md + 3 * 1024 + c);
            if (dry) { asm volatile("" :: "v"(a), "v"(h)); continue; }
            *(f32x4*)(hrow + c) = h;
            *(u32x2*)(p.A16 + (size_t)r * D + c) = (u32x2){pack2(a[0], a[1]), pack2(a[2], a[3])};
        }
    }
}

__device__ __forceinline__ void ph_wprime(const Params& p, unsigned char* smem) {
    for (int u = blockIdx.x; u < 256; u += gridDim.x) {
        const int layer = u >> 7, g16 = (u >> 3) & 15, tn = u & 7, half = g16 & 1, hd = g16 >> 1;
        bf16_t* C = p.wpt + ((size_t)layer * 2048 + g16 * 128) * 1024;
        gemm_unit(p.wt_k + ((size_t)layer * 2 + half) * 16384, 128, p.wq16 + (size_t)layer * 1024 * 2048 + hd * 256 + half * 128, 2048, 128, 1024, 0, tn * 128, EpiBf16{C, 1024, 1024}, smem);
    }
}
__device__ __forceinline__ void ph_gemm_scores(const Params& p, int layer, int lat_only, unsigned char* smem) {
    bf16_t* sA = (bf16_t*)smem; bf16_t* sB = sA + 128 * GLDS;
    float* T = (float*)p.G;
    const int tid = otid(), lane = tid & 63, wid = tid >> 6, q = lane & 31, h = lane >> 5;
    const RowMap rm{lat_only};
    const int nunits = rm.ntiles() * 16;
    for (int u = blockIdx.x; u < nunits; u += gridDim.x) {
        const int tile = u >> 4, g16 = u & 15, m0 = rm.row0(tile);
        const bf16_t* A = p.A16 + (size_t)m0 * D;
        const bf16_t* Bt = p.wpt + ((size_t)layer * 2048 + g16 * 128) * 1024;
        f32x16 sa[4];
#pragma unroll
        for (int kb = 0; kb < 4; ++kb)
#pragma unroll
            for (int i = 0; i < 16; ++i) sa[kb][i] = 0.f;
        u32x4 ra[4], rb[4];
        auto gload = [&](int kt) {
#pragma unroll
            for (int i = 0; i < 4; ++i) { const int id = tid + 256 * i, row = id >> 3, ch = id & 7; ra[i] = *(const u32x4*)(A + (size_t)row * D + kt * GBK + ch * 8); rb[i] = *(const u32x4*)(Bt + (size_t)row * 1024 + kt * GBK + ch * 8); }
        };
        auto lstore = [&]() {
#pragma unroll
            for (int i = 0; i < 4; ++i) { const int id = tid + 256 * i, row = id >> 3, ch = id & 7, sw = (ch ^ ((row >> 1) & 7)) * 8; *(u32x4*)(sA + row * GLDS + sw) = ra[i]; *(u32x4*)(sB + row * GLDS + sw) = rb[i]; }
        };
        gload(0);
        __syncthreads();
        lstore();
        __syncthreads();
        for (int kt = 0; kt < 1024 / GBK; ++kt) {
            if (kt + 1 < 1024 / GBK) gload(kt + 1);
#pragma unroll
            for (int s = 0; s < 4; ++s) {
                const int sw = ((2 * s + h) ^ ((q >> 1) & 7)) * 8;
                const bf16x8 tf = *(const bf16x8*)(sA + (32 * wid + q) * GLDS + sw);
#pragma unroll
                for (int kb = 0; kb < 4; ++kb) {
                    const bf16x8 kf = *(const bf16x8*)(sB + (32 * kb + q) * GLDS + sw);
                    sa[kb] = __builtin_amdgcn_mfma_f32_32x32x16_bf16(kf, tf, sa[kb], 0, 0, 0);
                }
            }
            __syncthreads();
            if (kt + 1 < 1024 / GBK) { lstore(); __syncthreads(); }
        }
        float top[16];
#pragma unroll
        for (int t = 0; t < 16; ++t) top[t] = -3.0e38f;
#pragma unroll
        for (int kb = 0; kb < 4; ++kb)
#pragma unroll
            for (int rg = 0; rg < 16; ++rg) {
                const unsigned key = (unsigned)(kb * 32 + (rg & 3) + 8 * (rg >> 2) + 4 * h);
                float xv = __uint_as_float((__float_as_uint(sa[kb][rg]) & ~127u) | key);
#pragma unroll
                for (int t = 0; t < 16; ++t) { const float hi = fmaxf(top[t], xv); xv = fminf(top[t], xv); top[t] = hi; }
            }
        float mrg[8];
#pragma unroll
        for (int i = 0; i < 8; ++i) mrg[i] = fmaxf(top[i], __shfl_xor(top[15 - i], 32));
        const size_t r = (size_t)m0 + 32 * wid + q;
        float* dst = T + (r * 16 + g16) * 16 + 8 * h;
        *(f32x4*)dst = (f32x4){mrg[0], mrg[1], mrg[2], mrg[3]}; *(f32x4*)(dst + 4) = (f32x4){mrg[4], mrg[5], mrg[6], mrg[7]};
    }
}

__device__ __forceinline__ void ph_combine(const Params& p, int lat_only) {
    const float* T = (const float*)p.G;
    int* EIDX = (int*)(p.G + (size_t)R * 8 * 2 * 16 * 4);
    float* EG = (float*)(p.G + (size_t)R * 8 * 2 * 16 * 4 + (size_t)R * 8 * 16 * 4);
    const int nrows = lat_only ? NB * SEQ : R;
    for (int g = blockIdx.x * 256 + threadIdx.x; g < nrows * 8; g += gridDim.x * 256) {
        const int rr = g >> 3, hd = g & 7, r = lat_only ? (rr >> 12) * PB + CTX + (rr & 4095) : rr;
        const float* t = T + ((size_t)r * 8 + hd) * 32;
        float t2[16];
#pragma unroll
        for (int i = 0; i < 16; ++i) t2[i] = __uint_as_float(__float_as_uint(t[16 + i]) & ~127u);
        float top[16];
#pragma unroll
        for (int k = 0; k < 16; ++k) top[k] = -3.0e38f;
        for (int i = 0; i < 16; ++i) {
            const float t1i = __uint_as_float(__float_as_uint(t[i]) & ~127u);
#pragma unroll
            for (int j = 0; j < 16; ++j) {
                float xv = __uint_as_float((__float_as_uint(t1i + t2[j]) & ~255u) | (unsigned)(i * 16 + j));
#pragma unroll
                for (int k = 0; k < 16; ++k) { const float hi = fmaxf(top[k], xv); xv = fminf(top[k], xv); top[k] = hi; }
            }
        }
        float e[16], sum = 0.f; const float mx = __uint_as_float(__float_as_uint(top[0]) & ~255u);
#pragma unroll
        for (int k = 0; k < 16; ++k) { e[k] = expf(__uint_as_float(__float_as_uint(top[k]) & ~255u) - mx); sum += e[k]; }
        const float inv = 1.0f / sum;
#pragma unroll
        for (int k = 0; k < 16; ++k) {
            const unsigned code = __float_as_uint(top[k]) & 255u, i = code >> 4, j = code & 15;
            const unsigned i1 = __float_as_uint(t[i]) & 127u, i2 = __float_as_uint(t[16 + j]) & 127u;
            EIDX[((size_t)r * 8 + hd) * 16 + k] = (int)(i1 * 128 + i2);
            EG[((size_t)r * 8 + hd) * 16 + k] = e[k] * inv;
        }
    }
}

__device__ __forceinline__ void ph_gather_ln(const Params& p, int layer, int lat_only) {
    const int tid_ = otid(), wid = tid_ >> 6, lane = tid_ & 63;
    const int* EIDX = (const int*)(p.G + (size_t)R * 8 * 2 * 16 * 4);
    const float* EG = (const float*)(p.G + (size_t)R * 8 * 2 * 16 * 4 + (size_t)R * 8 * 16 * 4);
    const float* U = p.peer_u + (size_t)layer * PEER_N * D; const float* V = p.peer_v + (size_t)layer * PEER_N * D;
    const float* g = p.ln_g + (size_t)(layer * 2 + 1) * D; const float* bb = p.ln_b + (size_t)(layer * 2 + 1) * D;
    const int nrows = lat_only ? NB * SEQ : R;
    for (int u = blockIdx.x; u < nrows / 4; u += gridDim.x) {
        const int rr = u * 4 + wid, r = lat_only ? (rr >> 12) * PB + CTX + (rr & 4095) : rr;
        f32x4 hm[4], acc[4];
#pragma unroll
        for (int q = 0; q < 4; ++q) {
            const u32x2 w = *(const u32x2*)(p.A16 + (size_t)r * D + q * 256 + lane * 4);
            hm[q] = (f32x4){__uint_as_float(w[0] << 16), __uint_as_float(w[0] & 0xffff0000u), __uint_as_float(w[1] << 16), __uint_as_float(w[1] & 0xffff0000u)};
            acc[q] = (f32x4){0.f, 0.f, 0.f, 0.f};
        }
        for (int e0 = 0; e0 < 128; e0 += 2) {
            const int ea = EIDX[(size_t)r * 128 + e0], eb = EIDX[(size_t)r * 128 + e0 + 1];
            const float ga = EG[(size_t)r * 128 + e0], gb = EG[(size_t)r * 128 + e0 + 1];
            f32x4 ua[4], ub[4];
#pragma unroll
            for (int q = 0; q < 4; ++q) { ua[q] = *(const f32x4*)(U + (size_t)ea * D + q * 256 + lane * 4); ub[q] = *(const f32x4*)(U + (size_t)eb * D + q * 256 + lane * 4); }
            float da = 0.f, db = 0.f;
#pragma unroll
            for (int q = 0; q < 4; ++q) { da += hm[q][0] * ua[q][0] + hm[q][1] * ua[q][1] + hm[q][2] * ua[q][2] + hm[q][3] * ua[q][3]; db += hm[q][0] * ub[q][0] + hm[q][1] * ub[q][1] + hm[q][2] * ub[q][2] + hm[q][3] * ub[q][3]; }
            da = wave_sum(da); db = wave_sum(db);
            const float wa = ga * gelu_f(da), wb = gb * gelu_f(db);
#pragma unroll
            for (int q = 0; q < 4; ++q) {
                acc[q] += wa * *(const f32x4*)(V + (size_t)ea * D + q * 256 + lane * 4);
                acc[q] += wb * *(const f32x4*)(V + (size_t)eb * D + q * 256 + lane * 4);
            }
        }
        const float* md = p.mod + ((size_t)layer * 9 + mod_row(r)) * 6144;
        float* hrow = p.H + (size_t)r * D;
        f32x4 v[4]; float s = 0.f;
#pragma unroll
        for (int q = 0; q < 4; ++q) { const int c = q * 256 + lane * 4; v[q] = ALPHA * *(const f32x4*)(hrow + c) + *(const f32x4*)(md + 5 * 1024 + c) * acc[q]; s += v[q][0] + v[q][1] + v[q][2] + v[q][3]; }
        const float mu = wave_sum(s) * (1.0f / 1024.0f);
        float ss = 0.f;
#pragma unroll
        for (int q = 0; q < 4; ++q) { v[q] = v[q] - mu; ss += v[q][0] * v[q][0] + v[q][1] * v[q][1] + v[q][2] * v[q][2] + v[q][3] * v[q][3]; }
        const float rstd = rsqrtf(wave_sum(ss) * (1.0f / 1024.0f) + LN_EPS);
        if (layer == 0) {
            const float* md1 = p.mod + ((size_t)1 * 9 + mod_row(r)) * 6144;
#pragma unroll
            for (int q = 0; q < 4; ++q) {
                const int c = q * 256 + lane * 4;
                const f32x4 h = v[q] * rstd * *(const f32x4*)(g + c) + *(const f32x4*)(bb + c);
                *(f32x4*)(hrow + c) = h;
                const f32x4 a = h * (1.0f + *(const f32x4*)(md1 + 1024 + c)) + *(const f32x4*)(md1 + c);
                *(u32x2*)(p.A16 + (size_t)r * D + c) = (u32x2){pack2(a[0], a[1]), pack2(a[2], a[3])};
            }
        } else {
            float* orow = p.out + (size_t)rr * D;
#pragma unroll
            for (int q = 0; q < 4; ++q) { const int c = q * 256 + lane * 4; *(f32x4*)(orow + c) = v[q] * rstd * *(const f32x4*)(g + c) + *(const f32x4*)(bb + c); }
        }
    }
}

__device__ __forceinline__ float gelu_fast(float v);
constexpr size_t UV8_BYTES = (size_t)PEER_N * D;
constexpr size_t UV8_OFF = (size_t)R * 2048 * 2;
__device__ __forceinline__ float wave_max(float v) {
#pragma unroll
    for (int o = 32; o > 0; o >>= 1) v = fmaxf(v, __shfl_xor(v, o));
    return v;
}
__device__ __forceinline__ unsigned cvt4_fp8(float a, float b, float c, float d) {
    int pk = __builtin_amdgcn_cvt_pk_fp8_f32(a, b, 0, false);
    pk = __builtin_amdgcn_cvt_pk_fp8_f32(c, d, pk, true);
    return (unsigned)pk;
}
__device__ __forceinline__ void ph_convert_uv(const Params& p, int layer) {
    const int tid = otid(), lane = tid & 63, gw = blockIdx.x * 4 + (tid >> 6), nw = gridDim.x * 4;
    unsigned char* T8 = (unsigned char*)p.P + UV8_OFF;
    float* sinv = (float*)(T8 + 2 * UV8_BYTES);
    for (int row = gw; row < 2 * PEER_N; row += nw) {
        const float* src = (row < PEER_N ? p.peer_u + ((size_t)layer * PEER_N + row) * D : p.peer_v + ((size_t)layer * PEER_N + (row - PEER_N)) * D) + lane * 16;
        f32x4 v[4]; float am = 0.f;
#pragma unroll
        for (int q = 0; q < 4; ++q) { v[q] = *(const f32x4*)(src + 4 * q); am = fmaxf(am, fmaxf(fmaxf(fabsf(v[q][0]), fabsf(v[q][1])), fmaxf(fabsf(v[q][2]), fabsf(v[q][3])))); }
        am = wave_max(am);
        const float sc = am > 0.f ? 224.0f / am : 1.0f;
        u32x4 w;
#pragma unroll
        for (int q = 0; q < 4; ++q) w[q] = cvt4_fp8(v[q][0] * sc, v[q][1] * sc, v[q][2] * sc, v[q][3] * sc);
        *(u32x4*)(T8 + (size_t)(row >= PEER_N) * UV8_BYTES + (size_t)(lane >> 3) * (PEER_N * 128) + (size_t)(row & (PEER_N - 1)) * 128 + (lane & 7) * 16) = w;
        if (lane == 0) sinv[row] = 1.0f / sc;
    }
}

__device__ __forceinline__ void ph_gather_mfma(const Params& p, int layer, int lat_only, unsigned char* smem) {
    const int tid = otid(), wid = tid >> 6, lane = tid & 63, c = lane & 15, g = lane >> 4;
    unsigned char* hs = smem + wid * 2048;
    int* se = (int*)(smem + wid * 2048 + 1024);
    float* sw = (float*)(smem + wid * 2048 + 1536);
    const int* EIDX = (const int*)(p.G + (size_t)R * 8 * 2 * 16 * 4);
    const float* EG = (const float*)(p.G + (size_t)R * 8 * 2 * 16 * 4 + (size_t)R * 8 * 16 * 4);
    const unsigned char* U8 = (const unsigned char*)p.P + UV8_OFF; const unsigned char* V8 = U8 + UV8_BYTES;
    const float* su_inv = (const float*)(U8 + 2 * UV8_BYTES); const float* sv_inv = su_inv + PEER_N;
    const float* gam = p.ln_g + (size_t)(layer * 2 + 1) * D; const float* bet = p.ln_b + (size_t)(layer * 2 + 1) * D;
    const int nrows = lat_only ? NB * SEQ : R;
    for (int u = blockIdx.x; u < nrows / 4; u += gridDim.x) {
        const int rr = u * 4 + wid, r = lat_only ? (rr >> 12) * PB + CTX + (rr & 4095) : rr;
        __syncthreads();
        float inv_sh;
        {
            const u32x4 w0 = *(const u32x4*)(p.A16 + (size_t)r * D + lane * 16), w1 = *(const u32x4*)(p.A16 + (size_t)r * D + lane * 16 + 8);
            float hv[16];
#pragma unroll
            for (int e = 0; e < 4; ++e) { hv[2 * e] = __uint_as_float(w0[e] << 16); hv[2 * e + 1] = __uint_as_float(w0[e] & 0xffff0000u); hv[8 + 2 * e] = __uint_as_float(w1[e] << 16); hv[8 + 2 * e + 1] = __uint_as_float(w1[e] & 0xffff0000u); }
            float am = 0.f;
#pragma unroll
            for (int e = 0; e < 16; ++e) am = fmaxf(am, fabsf(hv[e]));
            am = wave_max(am);
            const float sh = am > 0.f ? 224.0f / am : 1.0f; inv_sh = 1.0f / sh;
            *(u32x4*)(hs + lane * 16) = (u32x4){cvt4_fp8(hv[0] * sh, hv[1] * sh, hv[2] * sh, hv[3] * sh), cvt4_fp8(hv[4] * sh, hv[5] * sh, hv[6] * sh, hv[7] * sh),
                                                cvt4_fp8(hv[8] * sh, hv[9] * sh, hv[10] * sh, hv[11] * sh), cvt4_fp8(hv[12] * sh, hv[13] * sh, hv[14] * sh, hv[15] * sh)};
        }
        se[lane] = EIDX[(size_t)r * 128 + lane]; se[64 + lane] = EIDX[(size_t)r * 128 + 64 + lane];
        sw[lane] = EG[(size_t)r * 128 + lane]; sw[64 + lane] = EG[(size_t)r * 128 + 64 + lane];
        __syncthreads();
#pragma unroll 2
        for (int hd = 0; hd < 8; ++hd) {
            f32x4 dacc = (f32x4){0.f, 0.f, 0.f, 0.f};
            const int e = se[hd * 16 + c];
            const unsigned char* urow = U8 + (size_t)e * D + g * 16;
#pragma unroll
            for (int s2 = 0; s2 < 16; ++s2) {
                const u32x4 bq = *(const u32x4*)(urow + s2 * 64);
                const u32x4 aq = *(const u32x4*)(hs + s2 * 64 + g * 16);
                dacc = __builtin_amdgcn_mfma_f32_16x16x32_fp8_fp8((long)(((unsigned long long)aq[1] << 32) | aq[0]), (long)(((unsigned long long)bq[1] << 32) | bq[0]), dacc, 0, 0, 0);
                dacc = __builtin_amdgcn_mfma_f32_16x16x32_fp8_fp8((long)(((unsigned long long)aq[3] << 32) | aq[2]), (long)(((unsigned long long)bq[3] << 32) | bq[2]), dacc, 0, 0, 0);
            }
            const float wv = sw[hd * 16 + c] * gelu_fast(dacc[0] * inv_sh * su_inv[e]) * sv_inv[e];
            if (g == 0) sw[hd * 16 + c] = wv;
        }
        __syncthreads();
        const float wmax = wave_max(fmaxf(fabsf(sw[lane]), fabsf(sw[64 + lane])));
        const float wsc = wmax > 0.f ? 224.0f / wmax : 1.0f, inv_wsc = 1.0f / wsc;
        f32x4 oacc[8];
#pragma unroll
        for (int blk = 0; blk < 8; ++blk) oacc[blk] = (f32x4){0.f, 0.f, 0.f, 0.f};
#pragma unroll 4
        for (int it = 0; it < 32; ++it) {
            const int e = se[4 * it + g];
            const unsigned w8 = (unsigned)__builtin_amdgcn_cvt_pk_fp8_f32(sw[4 * it + g] * wsc, 0.f, 0, false) & 0xffu;
            const unsigned long long a64 = c < 8 ? ((unsigned long long)w8 << (8 * c)) : 0ull;
            const unsigned char* vrow = V8 + (size_t)e * D + c * 16;
#pragma unroll
            for (int b2 = 0; b2 < 4; ++b2) {
                const u32x4 bq = *(const u32x4*)(vrow + b2 * 256);
                oacc[2 * b2] = __builtin_amdgcn_mfma_f32_16x16x32_fp8_fp8((long)a64, (long)(((unsigned long long)bq[1] << 32) | bq[0]), oacc[2 * b2], 0, 0, 0);
                oacc[2 * b2 + 1] = __builtin_amdgcn_mfma_f32_16x16x32_fp8_fp8((long)a64, (long)(((unsigned long long)bq[3] << 32) | bq[2]), oacc[2 * b2 + 1], 0, 0, 0);
            }
        }
#pragma unroll
        for (int blk = 0; blk < 8; ++blk) oacc[blk] = oacc[blk] * inv_wsc;
        const float* md = p.mod + ((size_t)layer * 9 + mod_row(r)) * 6144;
        float* hrow = p.H + (size_t)r * D;
        const bool act = g < 2;
        f32x4 v[8]; float s = 0.f;
#pragma unroll
        for (int blk = 0; blk < 8; ++blk) {
            const int n = 256 * (blk >> 1) + 16 * c + 8 * (blk & 1) + 4 * (g & 1);
            v[blk] = ALPHA * *(const f32x4*)(hrow + n) + *(const f32x4*)(md + 5 * 1024 + n) * oacc[blk];
            if (!act) v[blk] = (f32x4){0.f, 0.f, 0.f, 0.f};
            s += v[blk][0] + v[blk][1] + v[blk][2] + v[blk][3];
        }
        const float mu = wave_sum(s) * (1.0f / 1024.0f);
        float ss = 0.f;
#pragma unroll
        for (int blk = 0; blk < 8; ++blk) { v[blk] = v[blk] - mu; if (act) ss += v[blk][0] * v[blk][0] + v[blk][1] * v[blk][1] + v[blk][2] * v[blk][2] + v[blk][3] * v[blk][3]; }
        const float rstd = rsqrtf(wave_sum(ss) * (1.0f / 1024.0f) + LN_EPS);
        if (act) {
            if (layer == 0) {
                const float* md1 = p.mod + ((size_t)1 * 9 + mod_row(r)) * 6144;
#pragma unroll
                for (int blk = 0; blk < 8; ++blk) {
                    const int n = 256 * (blk >> 1) + 16 * c + 8 * (blk & 1) + 4 * g;
                    const f32x4 h = v[blk] * rstd * *(const f32x4*)(gam + n) + *(const f32x4*)(bet + n);
                    *(f32x4*)(hrow + n) = h;
                    const f32x4 a = h * (1.0f + *(const f32x4*)(md1 + 1024 + n)) + *(const f32x4*)(md1 + n);
                    *(u32x2*)(p.A16 + (size_t)r * D + n) = (u32x2){pack2(a[0], a[1]), pack2(a[2], a[3])};
                }
            } else {
                float* orow = p.out + (size_t)rr * D;
#pragma unroll
                for (int blk = 0; blk < 8; ++blk) { const int n = 256 * (blk >> 1) + 16 * c + 8 * (blk & 1) + 4 * g; *(f32x4*)(orow + n) = v[blk] * rstd * *(const f32x4*)(gam + n) + *(const f32x4*)(bet + n); }
            }
        }
    }
}

constexpr int GT_TW = 17;
__device__ __forceinline__ long mk64(unsigned lo, unsigned hi) { return (long)(((unsigned long long)hi << 32) | lo); }
__device__ __forceinline__ void ph_gather_sliced(const Params& p, int layer, int lat_only, unsigned char* smem) {
    const int tid = otid(), wid = tid >> 6, lane = tid & 63, c = lane & 15, g = lane >> 4;
    float* part = (float*)smem + wid * (GT_TW * 128);
    float* tsc = (float*)smem + 4 * GT_TW * 128 + wid * (2 * GT_TW);
    unsigned short* sid = (unsigned short*)(smem + 4 * GT_TW * 128 * 4 + 4 * 2 * GT_TW * 4) + wid * (GT_TW * 128);
    const int* EIDX = (const int*)(p.G + (size_t)R * 8 * 2 * 16 * 4);
    const float* EG = (const float*)(p.G + (size_t)R * 8 * 2 * 16 * 4 + (size_t)R * 8 * 16 * 4);
    const unsigned char* U8 = (const unsigned char*)p.P + UV8_OFF; const unsigned char* V8 = U8 + UV8_BYTES;
    const float* su_inv = (const float*)(U8 + 2 * UV8_BYTES); const float* sv_inv = su_inv + PEER_N;
    const float* gam = p.ln_g + (size_t)(layer * 2 + 1) * D; const float* bet = p.ln_b + (size_t)(layer * 2 + 1) * D;
    const int ntok = lat_only ? NB * SEQ : R;
    const int per_round = gridDim.x * 4 * GT_TW;
    for (int base = 0; base < ntok; base += per_round) {
        const int t0 = base + (blockIdx.x * 4 + wid) * GT_TW;
        int nt = ntok - t0; nt = nt < 0 ? 0 : (nt > GT_TW ? GT_TW : nt);
        auto rowof = [&](int j) { const int rr = t0 + j; return lat_only ? (rr >> 12) * PB + CTX + (rr & 4095) : rr; };
        for (int j = 0; j < nt; ++j) {
            const size_t r = rowof(j);
            const u32x4 w0 = *(const u32x4*)(p.A16 + r * D + lane * 16), w1 = *(const u32x4*)(p.A16 + r * D + lane * 16 + 8);
            const int i0 = EIDX[r * 128 + lane], i1 = EIDX[r * 128 + 64 + lane];
            float hv[16];
#pragma unroll
            for (int e = 0; e < 4; ++e) { hv[2 * e] = __uint_as_float(w0[e] << 16); hv[2 * e + 1] = __uint_as_float(w0[e] & 0xffff0000u); hv[8 + 2 * e] = __uint_as_float(w1[e] << 16); hv[8 + 2 * e + 1] = __uint_as_float(w1[e] & 0xffff0000u); }
            float am = 0.f;
#pragma unroll
            for (int e = 0; e < 16; ++e) am = fmaxf(am, fabsf(hv[e]));
            am = wave_max(am);
            const float sh = am > 0.f ? 224.0f / am : 1.0f;
            if (lane == 0) tsc[j] = 1.0f / sh;
            *(u32x4*)((unsigned char*)(p.A16 + r * D) + lane * 16) = (u32x4){cvt4_fp8(hv[0] * sh, hv[1] * sh, hv[2] * sh, hv[3] * sh), cvt4_fp8(hv[4] * sh, hv[5] * sh, hv[6] * sh, hv[7] * sh),
                                                                             cvt4_fp8(hv[8] * sh, hv[9] * sh, hv[10] * sh, hv[11] * sh), cvt4_fp8(hv[12] * sh, hv[13] * sh, hv[14] * sh, hv[15] * sh)};
            part[j * 128 + lane] = 0.f; part[j * 128 + 64 + lane] = 0.f;
            sid[j * 128 + lane] = (unsigned short)i0; sid[j * 128 + 64 + lane] = (unsigned short)i1;
        }
        asm volatile("s_waitcnt vmcnt(0) lgkmcnt(0)" ::: "memory");
        for (int rep_ = (p.probe & 1) ? 2 : 1; rep_ > 0; --rep_) {
        if (p.probe & 1) { for (int j = 0; j < nt; ++j) { part[j * 128 + lane] = 0.f; part[j * 128 + 64 + lane] = 0.f; } asm volatile("s_waitcnt lgkmcnt(0)" ::: "memory"); }
        for (int sl = 0; sl < 8; ++sl) {
            u32x4 aA[2], bA[8], aB[2], bB[8];
            auto issue = [&](int q, u32x4 (&a)[2], u32x4 (&b)[8]) {
                const int j = q >> 1, h0 = (q & 1) * 4;
                const size_t r = rowof(j);
                const unsigned char* hrow = (const unsigned char*)(p.A16 + r * D) + sl * 128 + g * 16;
                a[0] = *(const u32x4*)hrow; a[1] = *(const u32x4*)(hrow + 64);
#pragma unroll
                for (int hh = 0; hh < 4; ++hh) { const unsigned char* ur = U8 + (size_t)sl * (PEER_N * 128) + (size_t)sid[j * 128 + (h0 + hh) * 16 + (lane >> 2)] * 128 + (lane & 3) * 16; b[2 * hh] = *(const u32x4*)ur; b[2 * hh + 1] = *(const u32x4*)(ur + 64); }
            };
            const int bsrc = (4 * c + g) * 4;
            auto compute = [&](int q, const u32x4 (&a)[2], const u32x4 (&b)[8]) {
                const int j = q >> 1, h0 = (q & 1) * 4;
#pragma unroll
                for (int hh = 0; hh < 4; ++hh) {
                    unsigned t[8];
#pragma unroll
                    for (int e = 0; e < 4; ++e) { t[e] = (unsigned)__builtin_amdgcn_ds_bpermute(bsrc, (int)b[2 * hh][e]); t[4 + e] = (unsigned)__builtin_amdgcn_ds_bpermute(bsrc, (int)b[2 * hh + 1][e]); }
                    f32x4 dacc = (f32x4){0.f, 0.f, 0.f, 0.f};
                    dacc = __builtin_amdgcn_mfma_f32_16x16x32_fp8_fp8(mk64(a[0][0], a[0][1]), mk64(t[0], t[1]), dacc, 0, 0, 0);
                    dacc = __builtin_amdgcn_mfma_f32_16x16x32_fp8_fp8(mk64(a[0][2], a[0][3]), mk64(t[2], t[3]), dacc, 0, 0, 0);
                    dacc = __builtin_amdgcn_mfma_f32_16x16x32_fp8_fp8(mk64(a[1][0], a[1][1]), mk64(t[4], t[5]), dacc, 0, 0, 0);
                    dacc = __builtin_amdgcn_mfma_f32_16x16x32_fp8_fp8(mk64(a[1][2], a[1][3]), mk64(t[6], t[7]), dacc, 0, 0, 0);
                    if (g == 0) part[j * 128 + (h0 + hh) * 16 + c] += dacc[0];
                }
            };
            const int nq = 2 * nt;
            if (nq > 0) issue(0, aA, bA);
            for (int q = 0; q < nq; q += 2) {
                issue(q + 1, aB, bB);
                compute(q, aA, bA);
                issue(q + 2 < nq ? q + 2 : q, aA, bA);
                compute(q + 1, aB, bB);
            }
        }
        }
        for (int j = 0; j < nt; ++j) {
            const size_t r = rowof(j);
            const float ish = tsc[j];
            float wv[2];
#pragma unroll
            for (int q = 0; q < 2; ++q) {
                const int x = q * 64 + lane, e = sid[j * 128 + x];
                wv[q] = EG[r * 128 + x] * gelu_fast(part[j * 128 + x] * ish * su_inv[e]) * sv_inv[e];
            }
            const float wm = wave_max(fmaxf(fabsf(wv[0]), fabsf(wv[1])));
            const float wsc = wm > 0.f ? 224.0f / wm : 1.0f;
            if (lane == 0) tsc[GT_TW + j] = 1.0f / wsc;
            unsigned char* w8b = (unsigned char*)(part + j * 128);
            w8b[lane] = (unsigned char)(__builtin_amdgcn_cvt_pk_fp8_f32(wv[0] * wsc, 0.f, 0, false) & 0xff);
            w8b[64 + lane] = (unsigned char)(__builtin_amdgcn_cvt_pk_fp8_f32(wv[1] * wsc, 0.f, 0, false) & 0xff);
        }
        asm volatile("s_waitcnt lgkmcnt(0)" ::: "memory");
        for (int rep_ = (p.probe & 2) ? 2 : 1; rep_ > 0; --rep_)
        for (int sl = 0; sl < 8; ++sl) {
            u32x2 vA[16], vB[16]; f32x4 hA; f32x4 oacc;
            auto issue = [&](int q, u32x2 (&v)[16]) {
                const int j = q >> 1, i0 = (q & 1) * 16;
#pragma unroll
                for (int it = 0; it < 16; ++it) v[it] = *(const u32x2*)(V8 + (size_t)sl * (PEER_N * 128) + (size_t)sid[j * 128 + 4 * (i0 + it) + g] * 128 + c * 8);
            };
            const unsigned shl = 8 * (c & 3), mlo = c < 4 ? 0xffffffffu : 0u, mhi = (c >= 4 && c < 8) ? 0xffffffffu : 0u;
            auto compute = [&](int q, const u32x2 (&v)[16]) {
                const int j = q >> 1, i0 = (q & 1) * 16;
                const unsigned char* w8b = (const unsigned char*)(part + j * 128);
                if (i0 == 0) oacc = (f32x4){0.f, 0.f, 0.f, 0.f};
#pragma unroll
                for (int it = 0; it < 16; ++it) {
                    const unsigned ws = (unsigned)w8b[4 * (i0 + it) + g] << shl;
                    oacc = __builtin_amdgcn_mfma_f32_16x16x32_fp8_fp8(mk64(ws & mlo, ws & mhi), mk64(v[it][0], v[it][1]), oacc, 0, 0, 0);
                }
            };
            auto finish = [&](int j) {
                const size_t r = rowof(j);
                const float iws = tsc[GT_TW + j];
                if (rep_ > 1) { asm volatile("" :: "v"(oacc), "v"(hA)); }
                else if (g < 2) {
                    const int n = sl * 128 + 8 * c + 4 * g;
                    const float* md = p.mod + ((size_t)layer * 9 + mod_row((int)r)) * 6144 + 5 * 1024;
                    *(f32x4*)(p.H + r * D + n) = ALPHA * hA + *(const f32x4*)(md + n) * (oacc * iws);
                }
            };
            const int nq = 2 * nt;
            if (nq > 0) issue(0, vA);
            for (int q = 0; q < nq; q += 2) {
                const int j = q >> 1;
                hA = *(const f32x4*)(p.H + (size_t)rowof(j) * D + sl * 128 + 8 * c + 4 * (g & 1));
                issue(q + 1, vB);
                compute(q, vA);
                issue(q + 2 < nq ? q + 2 : q, vA);
                compute(q + 1, vB);
                finish(j);
            }
        }
        asm volatile("s_waitcnt vmcnt(0)" ::: "memory");
        for (int j = 0; j < nt; ++j) {
            const size_t r = rowof(j);
            float* hrow = p.H + r * D;
            f32x4 v[4]; float s = 0.f;
#pragma unroll
            for (int q = 0; q < 4; ++q) { v[q] = *(const f32x4*)(hrow + q * 256 + lane * 4); s += v[q][0] + v[q][1] + v[q][2] + v[q][3]; }
            const float mu = wave_sum(s) * (1.0f / 1024.0f);
            float ss = 0.f;
#pragma unroll
            for (int q = 0; q < 4; ++q) { v[q] = v[q] - mu; ss += v[q][0] * v[q][0] + v[q][1] * v[q][1] + v[q][2] * v[q][2] + v[q][3] * v[q][3]; }
            const float rstd = rsqrtf(wave_sum(ss) * (1.0f / 1024.0f) + LN_EPS);
            if (layer == 0) {
                const float* md1 = p.mod + ((size_t)1 * 9 + mod_row((int)r)) * 6144;
#pragma unroll
                for (int q = 0; q < 4; ++q) {
                    const int n = q * 256 + lane * 4;
                    const f32x4 h = v[q] * rstd * *(const f32x4*)(gam + n) + *(const f32x4*)(bet + n);
                    *(f32x4*)(hrow + n) = h;
                    const f32x4 a = h * (1.0f + *(const f32x4*)(md1 + 1024 + n)) + *(const f32x4*)(md1 + n);
                    *(u32x2*)(p.A16 + r * D + n) = (u32x2){pack2(a[0], a[1]), pack2(a[2], a[3])};
                }
            } else {
                float* orow = p.out + (size_t)(t0 + j) * D;
#pragma unroll
                for (int q = 0; q < 4; ++q) { const int n = q * 256 + lane * 4; *(f32x4*)(orow + n) = v[q] * rstd * *(const f32x4*)(gam + n) + *(const f32x4*)(bet + n); }
            }
        }
    }
}

constexpr int RG_ZS = 136;
constexpr size_t RG_SUM_BYTES = (size_t)NB * 34 * 2 * RGW * 2 * 4;
__device__ __forceinline__ void rg_stage_z(const Params& p, int b, int c34, int n, bf16_t* zc) {
    const int tid = otid(), k2 = tid & 63, tq = tid >> 6, ch = n * 128 + 2 * k2;
    const int lo = c34 < 2 ? 0 : CTX, hi = c34 < 2 ? CTX : PB, p0 = c34 * 128 + 32 * tq;
    float w0[4], w1[4];
#pragma unroll
    for (int tap = 0; tap < 4; ++tap) { w0[tap] = p.od_conv_w[tap * RGW + ch]; w1[tap] = p.od_conv_w[tap * RGW + ch + 1]; }
    const float b0 = p.od_conv_b[ch], b1 = p.od_conv_b[ch + 1];
    const bf16_t* base = p.P + (size_t)b * PB * 2560 + RGW + ch;
    unsigned raw[35];
#pragma unroll
    for (int i = 0; i < 35; ++i) { const int pp = p0 - 2 + i; raw[i] = (pp >= lo && pp < hi) ? *(const unsigned*)(base + (size_t)pp * 2560) : 0u; }
#pragma unroll
    for (int t = 0; t < 32; ++t) {
        const float y0 = b0 + w0[0] * __uint_as_float(raw[t] << 16) + w0[1] * __uint_as_float(raw[t + 1] << 16) + w0[2] * __uint_as_float(raw[t + 2] << 16) + w0[3] * __uint_as_float(raw[t + 3] << 16);
        const float y1 = b1 + w1[0] * __uint_as_float(raw[t] & 0xffff0000u) + w1[1] * __uint_as_float(raw[t + 1] & 0xffff0000u) + w1[2] * __uint_as_float(raw[t + 2] & 0xffff0000u) + w1[3] * __uint_as_float(raw[t + 3] & 0xffff0000u);
        *(unsigned*)(zc + (32 * tq + t) * RG_ZS + 2 * k2) = pack2(y0, y1);
    }
}
__device__ __forceinline__ float gelu_fast(float v) {
    const float av = fabsf(v), t = __builtin_amdgcn_rcpf(av * 0.2316418882f + 1.0f);
    float q = t * 0.5307027145f + (-0.7265760135f); q = q * t + 0.7107068705f; q = q * t + (-0.142248368f); q = q * t + 0.127414796f; q = q * t;
    const float e = __builtin_amdgcn_exp2f(v * v * (-0.72134752044f));
    const float m = v * (q * e);
    return v < 0.f ? m : v - m;
}
struct RgCtx { bf16x8 wr[4], wi[4]; float br, bi, coef; };
__device__ __forceinline__ void rg_ctx_load(const Params& p, int n, int cl, int dir, RgCtx& c) {
    const int lane = otid() & 63, fr = lane & 15, fq = lane >> 4, ch = n * 128 + cl + fr;
    const bf16_t* gr = p.wt_gate + ((size_t)(dir * 2 + 0) * 10 + n) * 16384 + (size_t)(cl + fr) * 128 + 8 * fq;
    const bf16_t* gi = p.wt_gate + ((size_t)(dir * 2 + 1) * 10 + n) * 16384 + (size_t)(cl + fr) * 128 + 8 * fq;
#pragma unroll
    for (int s = 0; s < 4; ++s) { c.wr[s] = *(const bf16x8*)(gr + 32 * s); c.wi[s] = *(const bf16x8*)(gi + 32 * s); }
    c.br = p.od_gate_b[(dir * 2 + 0) * RGW + ch]; c.bi = p.od_gate_b[(dir * 2 + 1) * RGW + ch];
    const float lam = p.od_lambda[dir * RGW + ch];
    c.coef = -8.0f * (fmaxf(-lam, 0.f) + log1pf(expf(-fabsf(lam)))) * 1.4426950408889634f;
}
__device__ __forceinline__ void rg_tile(const bf16_t* zc, int mt, int cl, const RgCtx& c, f32x4& a4, f32x4& x4) {
    const int lane = otid() & 63, fr = lane & 15, fq = lane >> 4;
    f32x4 r = (f32x4){0.f, 0.f, 0.f, 0.f}, ig = (f32x4){0.f, 0.f, 0.f, 0.f};
#pragma unroll
    for (int s = 0; s < 4; ++s) {
        const bf16x8 a = *(const bf16x8*)(zc + (16 * mt + fr) * RG_ZS + 32 * s + 8 * fq);
        r = __builtin_amdgcn_mfma_f32_16x16x32_bf16(a, c.wr[s], r, 0, 0, 0);
        ig = __builtin_amdgcn_mfma_f32_16x16x32_bf16(a, c.wi[s], ig, 0, 0, 0);
    }
#pragma unroll
    for (int rg = 0; rg < 4; ++rg) {
        const float rr = __builtin_amdgcn_rcpf(1.0f + __builtin_amdgcn_exp2f(-1.4426950408889634f * (r[rg] + c.br)));
        const float ii = __builtin_amdgcn_rcpf(1.0f + __builtin_amdgcn_exp2f(-1.4426950408889634f * (ig[rg] + c.bi)));
        const float a = __builtin_amdgcn_exp2f(c.coef * rr);
        const float z = bf2f(zc[(16 * mt + 4 * fq + rg) * RG_ZS + cl + fr]);
        a4[rg] = a; x4[rg] = sqrtf((1.0f - a) * (1.0f + a)) * ii * z;
    }
}
template <int DIR> __device__ __forceinline__ void rg_sum_dir(const Params& p, const bf16_t* zc, int b, int c34, int n, int cl, float* SUM) {
    const int lane = otid() & 63, fr = lane & 15, fq = lane >> 4;
    RgCtx c; rg_ctx_load(p, n, cl, DIR, c);
    float h = 0.f, pt = 1.f;
#pragma unroll 2
    for (int m2 = 0; m2 < 8; ++m2) {
        const int mt = DIR == 0 ? m2 : 7 - m2;
        f32x4 a, x; rg_tile(zc, mt, cl, c, a, x);
        const float P4 = a[0] * a[1] * a[2] * a[3];
        const float B4 = DIR == 0 ? ((x[0] * a[1] + x[1]) * a[2] + x[2]) * a[3] + x[3] : ((x[3] * a[2] + x[2]) * a[1] + x[1]) * a[0] + x[0];
#pragma unroll
        for (int g2 = 0; g2 < 4; ++g2) {
            const int gs = DIR == 0 ? g2 : 3 - g2;
            const float Pg = __shfl(P4, 16 * gs + fr), Bg = __shfl(B4, 16 * gs + fr);
            h = Pg * h + Bg; pt *= Pg;
        }
    }
    if (fq == 0) { float* dst = SUM + ((((size_t)b * 34 + c34) * 2 + DIR) * RGW + n * 128 + cl + fr) * 2; dst[0] = pt; dst[1] = h; }
}
__device__ __forceinline__ void ph_rg_a(const Params& p, unsigned char* smem) {
    bf16_t* zc = (bf16_t*)smem;
    float* SUM = (float*)p.G;
    const int wid = otid() >> 6;
    for (int u = blockIdx.x; u < NB * 34 * 10; u += gridDim.x) {
        const int b = u / 340, c34 = (u / 10) % 34, n = u % 10;
        __syncthreads();
        rg_stage_z(p, b, c34, n, zc);
        __syncthreads();
        for (int nt = 0; nt < 2; ++nt) {
            const int cl = 32 * wid + 16 * nt;
            rg_sum_dir<0>(p, zc, b, c34, n, cl, SUM);
            rg_sum_dir<1>(p, zc, b, c34, n, cl, SUM);
        }
    }
}
__device__ __forceinline__ void ph_rg_b(const Params& p) {
    const float* SUM = (const float*)p.G; float* HIN = (float*)(p.G + RG_SUM_BYTES);
    for (int gid = blockIdx.x * 256 + threadIdx.x; gid < NB * 2 * RGW; gid += gridDim.x * 256) {
        const int ch = gid % RGW, dir = (gid / RGW) & 1, b = gid / (2 * RGW);
        float h = 0.f;
#pragma unroll 2
        for (int step = 0; step < 34; ++step) {
            const int c34 = dir == 0 ? step : (step < 2 ? 1 - step : 35 - step);
            const size_t o = (((size_t)b * 34 + c34) * 2 + dir) * RGW + ch;
            HIN[o] = h;
            h = SUM[o * 2] * h + SUM[o * 2 + 1];
        }
    }
}
template <int DIR> __device__ __forceinline__ void rg_apply_dir(const Params& p, const bf16_t* zc, bf16_t* yf, int b, int c34, int n, int cl, const float* HIN, int dry) {
    const int lane = otid() & 63, fr = lane & 15, fq = lane >> 4, ch = n * 128 + cl + fr;
    RgCtx c; rg_ctx_load(p, n, cl, DIR, c);
    float h = HIN[(((size_t)b * 34 + c34) * 2 + DIR) * RGW + ch];
    bf16_t* pbase = p.P + ((size_t)b * PB + c34 * 128 + 4 * fq) * 2560 + ch;
    bf16_t br_[32];
    if (DIR == 1) {
#pragma unroll
        for (int i = 0; i < 32; ++i) br_[i] = pbase[(size_t)(16 * (i >> 2) + (i & 3)) * 2560];
    }
#pragma unroll
    for (int m2 = 0; m2 < 8; ++m2) {
        const int mt = DIR == 0 ? m2 : 7 - m2;
        f32x4 a, x; rg_tile(zc, mt, cl, c, a, x);
        const float P4 = a[0] * a[1] * a[2] * a[3];
        const float B4 = DIR == 0 ? ((x[0] * a[1] + x[1]) * a[2] + x[2]) * a[3] + x[3] : ((x[3] * a[2] + x[2]) * a[1] + x[1]) * a[0] + x[0];
        float hin = 0.f;
#pragma unroll
        for (int g2 = 0; g2 < 4; ++g2) {
            const int gs = DIR == 0 ? g2 : 3 - g2;
            const float Pg = __shfl(P4, 16 * gs + fr), Bg = __shfl(B4, 16 * gs + fr);
            if (fq == gs) hin = h;
            h = Pg * h + Bg;
        }
        f32x4 y;
        if (DIR == 0) {
            y[0] = a[0] * hin + x[0]; y[1] = a[1] * y[0] + x[1]; y[2] = a[2] * y[1] + x[2]; y[3] = a[3] * y[2] + x[3];
#pragma unroll
            for (int rg = 0; rg < 4; ++rg) yf[(16 * mt + 4 * fq + rg) * 16 + fr] = f2bf(y[rg]);
        } else {
            y[3] = a[3] * hin + x[3]; y[2] = a[2] * y[3] + x[2]; y[1] = a[1] * y[2] + x[1]; y[0] = a[0] * y[1] + x[0];
#pragma unroll
            for (int rg = 0; rg < 4; ++rg) {
                bf16_t* pb = pbase + (size_t)(16 * mt + rg) * 2560;
                const bf16_t ov = f2bf(gelu_fast(bf2f(br_[4 * mt + rg])) * (y[rg] + bf2f(yf[(16 * mt + 4 * fq + rg) * 16 + fr])));
                if (!dry) *pb = ov; else asm volatile("" :: "v"(ov));
            }
        }
    }
}
__device__ __forceinline__ void ph_rg_c(const Params& p, unsigned char* smem, int dry = 0) {
    bf16_t* zc = (bf16_t*)smem;
    const float* HIN = (const float*)(p.G + RG_SUM_BYTES);
    const int wid = otid() >> 6;
    bf16_t* yf = (bf16_t*)(smem + 128 * RG_ZS * 2) + wid * 2048;
    for (int u = blockIdx.x; u < NB * 32 * 10; u += gridDim.x) {
        const int b = u / 320, c34 = 2 + (u / 10) % 32, n = u % 10;
        __syncthreads();
        rg_stage_z(p, b, c34, n, zc);
        __syncthreads();
        for (int nt = 0; nt < 2; ++nt) {
            const int cl = 32 * wid + 16 * nt;
            rg_apply_dir<0>(p, zc, yf, b, c34, n, cl, HIN, dry);
            rg_apply_dir<1>(p, zc, yf, b, c34, n, cl, HIN, dry);
        }
    }
}

#define XB_TMO      128
#define XB_XCNT(j)  (256  + 64 * (j))
#define XB_XSUB(j)  (1280 + 64 * (j))
#define XB_XGEN(j)  (2304 + 64 * (j))
#define XB_TOP      3328
#define XB_TOPGEN   3392
#define XCD_BAR_WORDS 3456
#define XB_SPIN_CAP (1u << 22)
#define LAS __attribute__((address_space(3)))
__device__ __forceinline__ unsigned xb_ld(unsigned* p) { return __hip_atomic_load(p, __ATOMIC_RELAXED, __HIP_MEMORY_SCOPE_AGENT); }
__device__ __forceinline__ unsigned xb_add(unsigned* p, unsigned v) { return __hip_atomic_fetch_add(p, v, __ATOMIC_RELAXED, __HIP_MEMORY_SCOPE_AGENT); }
__device__ __forceinline__ unsigned xb_xcc_id() { return (unsigned)__builtin_amdgcn_s_getreg((3 << 11) | 20) & 0xFu; }
#define XB_SPIN(cond, bar) do { unsigned _sp = 0; while (cond) { __builtin_amdgcn_s_sleep(1); \
    if ((++_sp & 255u) == 0u) { if (xb_ld(&(bar)[XB_TMO])) break; if (_sp > XB_SPIN_CAP) { atomicAdd(&(bar)[XB_TMO], 1u); break; } } } } while (0)
struct XcdBarrier { unsigned* bar; unsigned x; volatile LAS unsigned* st; };
__device__ __forceinline__ XcdBarrier xcd_barrier_post(unsigned* bar, volatile LAS unsigned* st) {
    XcdBarrier b; b.bar = bar; b.x = xb_xcc_id(); b.st = st;
    if (threadIdx.x == 0) (void)xb_add(&bar[XB_XCNT(b.x)], 1u);
    return b;
}
__device__ __forceinline__ void xcd_barrier_complete(unsigned* bar, unsigned x, unsigned& nloc, unsigned& nx) {
    const unsigned G = gridDim.x * gridDim.y * gridDim.z;
    unsigned sum, cnt, mine, sp = 0u;
    for (;;) {
        sum = 0u; cnt = 0u; mine = 0u;
#pragma unroll
        for (unsigned j = 0; j < 16; ++j) { const unsigned c = xb_ld(&bar[XB_XCNT(j)]); sum += c; cnt += (c > 0u) ? 1u : 0u; mine = (j == x) ? c : mine; }
        if (sum == G) break;
        __builtin_amdgcn_s_sleep(1);
        if ((++sp & 255u) == 0u) { if (xb_ld(&bar[XB_TMO])) break; if (sp > XB_SPIN_CAP) { atomicAdd(&bar[XB_TMO], 1u); break; } }
    }
    nloc = mine > 0u ? mine : 1u; nx = cnt > 0u ? cnt : 1u;
}
__device__ __forceinline__ void xcd_barrier(const XcdBarrier& b) {
    asm volatile("s_waitcnt vmcnt(0)" ::: "memory");
    __syncthreads();
    if (threadIdx.x == 0) {
        unsigned* bar = b.bar;
        __builtin_amdgcn_s_waitcnt(0);
        unsigned nloc = b.st[0], nx = b.st[1];
        if (nloc == 0u) { xcd_barrier_complete(bar, b.x, nloc, nx); b.st[0] = nloc; b.st[1] = nx; }
        const unsigned old = xb_add(&bar[XB_XSUB(b.x)], 1u);
        const unsigned gen = old / nloc;
        if (old + 1u == (gen + 1u) * nloc) {
            __builtin_amdgcn_fence(__ATOMIC_RELEASE, "agent");
            asm volatile("s_waitcnt vmcnt(0)" ::: "memory");
            const unsigned og = xb_add(&bar[XB_TOP], 1u);
            const unsigned tg = og / nx;
            if (og + 1u == (tg + 1u) * nx) xb_add(&bar[XB_TOPGEN], 1u);
            else XB_SPIN(xb_ld(&bar[XB_TOPGEN]) == tg, bar);
            __builtin_amdgcn_fence(__ATOMIC_ACQUIRE, "agent");
            xb_add(&bar[XB_XGEN(b.x)], 1u);
            asm volatile("s_waitcnt vmcnt(0)" ::: "memory");
        } else {
            XB_SPIN(xb_ld(&bar[XB_XGEN(b.x)]) == gen, bar);
            __builtin_amdgcn_fence(__ATOMIC_ACQUIRE, "agent");
            asm volatile("s_waitcnt vmcnt(0)" ::: "memory");
        }
    }
    __syncthreads();
}

#define SMEM_DECL __shared__ __attribute__((aligned(16))) unsigned char smem[65536]
__global__ void __launch_bounds__(256, 2) k_mega(Params p) {
    SMEM_DECL;
    cg::grid_group grid = cg::this_grid();
    volatile LAS unsigned* xst = (volatile LAS unsigned*)(LAS unsigned char*)(smem + 65520);
    if (threadIdx.x == 0) { xst[0] = 0u; xst[1] = 0u; }
    if (blockIdx.x == 0) for (int i = threadIdx.x; i < XCD_BAR_WORDS; i += 256) p.bar[i] = 0u;
    ph_prologue(p, smem); grid.sync();
    const XcdBarrier xb = xcd_barrier_post(p.bar, xst);
    if (p.probe & 32) ph_modulate0(p);
    ph_modulate0(p); xcd_barrier(xb);
    ph_wprime(p, smem); gemm_phase(p.A16, D, p.wt_ev_in, 1024, EV_IN, RowMap{0}, EpiBf16{p.P, EV_IN, EV_IN}, smem); xcd_barrier(xb);
    if (p.probe & 32) ph_rowpost(p);
    if (p.probe & 128) ph_gla_a(p, smem);
    ph_rowpost(p); ph_gla_a(p, smem); xcd_barrier(xb);
    gemm_phase(p.P + C_CQ, EV_IN, p.wt_uq, 384, 768, RowMap{0}, EpiQ{p.Q16, p.rsq, p.rope_cos, p.rope_sin}, smem);
    gemm_phase(p.P + C_CKV, EV_IN, p.wt_ukv, 256, 1024, RowMap{0}, EpiKV{p.K16, p.V16, p.rsq + R}, smem); if (p.probe & 8) ph_gla_b(p, 1);
    ph_gla_b(p); xcd_barrier(xb);
    if (p.probe & 256) ph_gla_c(p, smem);
    if (p.probe & 512) ph_attn(p, smem, blockIdx.x, gridDim.x);
    ph_gla_c(p, smem); ph_attn(p, smem, blockIdx.x, gridDim.x); xcd_barrier(xb);
    gemm_phase(p.A16, D, p.wt_ev_out, 1024, 1024, RowMap{0}, EpiResid{p.x, p.ctx, p.mod, p.H, 0}, smem); xcd_barrier(xb);
    if (p.probe & 4) ph_ln_mod(p, 0, 0, 0, 1);
    ph_ln_mod(p, 0, 0, 0); xcd_barrier(xb);
    ph_gemm_scores(p, 0, 0, smem); ph_convert_uv(p, 0); xcd_barrier(xb);
    ph_combine(p, 0); xcd_barrier(xb);
    ph_gather_sliced(p, 0, 0, smem); xcd_barrier(xb);
    gemm_phase(p.A16, D, p.wt_od_in, 1024, 2560, RowMap{0}, EpiBf16{p.P, 2560, 2560}, smem); xcd_barrier(xb);
    if (p.probe & 64) ph_rg_a(p, smem);
    ph_rg_a(p, smem); xcd_barrier(xb);
    if (p.probe & 32) ph_rg_b(p);
    ph_rg_b(p); xcd_barrier(xb);
    if (p.probe & 16) ph_rg_c(p, smem, 1);
    ph_rg_c(p, smem); xcd_barrier(xb);
    gemm_phase(p.P, 2560, p.wt_od_out, 1280, 1024, RowMap{1}, EpiResid{p.x, p.ctx, p.mod, p.H, 1}, smem); xcd_barrier(xb);
    if (p.probe & 4) ph_ln_mod(p, 1, 0, 1, 1);
    ph_ln_mod(p, 1, 0, 1); xcd_barrier(xb);
    ph_gemm_scores(p, 1, 1, smem); ph_convert_uv(p, 1); xcd_barrier(xb);
    ph_combine(p, 1); xcd_barrier(xb);
    ph_gather_sliced(p, 1, 1, smem);
}

extern "C" void kernel_launch(void* const* d_in, const int* in_sizes, int n_in, void* d_out, int out_size, void* d_ws, size_t ws_size, hipStream_t stream) {
    Params p{};
    const float** f = (const float**)d_in;
    p.x = f[0]; p.c = f[1]; p.ctx = f[2]; p.c_ctx = f[3]; p.mod_w = f[4]; p.mod_b = f[5]; p.ln_g = f[6]; p.ln_b = f[7];
    p.ev_w_in = f[8]; p.ev_q_norm = f[9]; p.ev_kv_norm = f[10]; p.ev_w_uq = f[11]; p.ev_w_ukv = f[12]; p.ev_gla_wa2 = f[13]; p.ev_gla_ba = f[14]; p.ev_gla_norm = f[15]; p.ev_w_out = f[16];
    p.od_w_in = f[17]; p.od_conv_w = f[18]; p.od_conv_b = f[19]; p.od_gate_w = f[20]; p.od_gate_b = f[21]; p.od_lambda = f[22]; p.od_w_out = f[23];
    p.peer_wq = f[24]; p.peer_k1 = f[25]; p.peer_k2 = f[26]; p.peer_u = f[27]; p.peer_v = f[28];
    p.out = (float*)d_out;
    unsigned char* w = (unsigned char*)d_ws; size_t off = 0;
    auto take = [&](size_t bytes) { unsigned char* r = w + off; off += (bytes + 255) & ~(size_t)255; return r; };
    p.wt_ev_in = (bf16_t*)take((size_t)EV_IN * 1024 * 2); p.wt_uq = (bf16_t*)take(768 * 384 * 2); p.wt_ukv = (bf16_t*)take(1024 * 256 * 2);
    p.wt_ev_out = (bf16_t*)take(1024 * 1024 * 2); p.wt_od_in = (bf16_t*)take(2560 * 1024 * 2); p.wt_gate = (bf16_t*)take(40 * 16384 * 2);
    p.wt_od_out = (bf16_t*)take(1024 * 1280 * 2); p.wq16 = (bf16_t*)take((size_t)2 * 2048 * 1024 * 2); p.wpt = (bf16_t*)take((size_t)2 * 2048 * 1024 * 2); p.wt_k = (bf16_t*)take(4 * 16384 * 2);
    p.mod = (float*)take(2 * 9 * 6144 * 4); p.rope_cos = (float*)take(SEQ * 16 * 4); p.rope_sin = (float*)take(SEQ * 16 * 4); p.rsq = (float*)take((size_t)2 * R * 4);
    p.H = (float*)take((size_t)R * D * 4);
    p.Q16 = (bf16_t*)p.H; p.K16 = p.Q16 + (size_t)R * 768; p.V16 = p.K16 + (size_t)R * 768;
    p.A16 = (bf16_t*)take((size_t)R * D * 2);
    p.P = (bf16_t*)take((size_t)R * 2560 * 2);
    p.G = take((size_t)94371840);
    p.bar = (unsigned*)take(XCD_BAR_WORDS * 4);
    if (off > ws_size) { fprintf(stderr, "workspace too small: need %zu have %zu\n", off, ws_size); return; }
    static int grid_blocks = 0;
    if (!grid_blocks) {
        int dev = 0, cus = 0, per_cu = 0;
        (void)hipGetDevice(&dev);
        (void)hipDeviceGetAttribute(&cus, hipDeviceAttributeMultiprocessorCount, dev);
        (void)hipOccupancyMaxActiveBlocksPerMultiprocessor(&per_cu, k_mega, 256, 0);
        if (per_cu > 2) per_cu = 2;
        if (per_cu < 1) per_cu = 1;
        grid_blocks = cus * per_cu;
    }
    p.probe = PROBE_MASK; p.pad_ = 0;
    void* args[] = {&p};
    hipError_t e = hipLaunchCooperativeKernel((void*)k_mega, dim3(grid_blocks), dim3(256), args, 0, stream);
    if (e != hipSuccess) fprintf(stderr, "cooperative launch failed: %s (grid %d)\n", hipGetErrorString(e), grid_blocks);
}
```

```cpp
#include <hip/hip_runtime.h>
#include <hip/hip_cooperative_groups.h>
#include <cstdio>
#include <cstdint>

namespace cg = cooperative_groups;
#define LAS __attribute__((address_space(3)))
typedef unsigned short bf16_t;
typedef short bf16x8 __attribute__((ext_vector_type(8)));
typedef float f32x4 __attribute__((ext_vector_type(4)));
typedef float f32x16 __attribute__((ext_vector_type(16)));
typedef unsigned u32x4 __attribute__((ext_vector_type(4)));
typedef unsigned u32x2 __attribute__((ext_vector_type(2)));

constexpr int D = 1024, NB = 8, SEQ = 4096, CTX = 256, PB = SEQ + CTX  , R = NB * PB  ;
constexpr int EV_IN = 2240, RGW = 1280;
constexpr int C_CQ = 0, C_CKV = 384, C_KPE = 640, C_GQ = 672, C_GK = 928, C_GV = 1184, C_GG = 1696, C_GAF = 2208;
constexpr float LN_EPS = 1e-6f, ALPHA = 1.41421356237f, MLA_SCALE = 0.10206207261596577f  ;
constexpr int PEER_N = 16384;

#ifndef PROBE_MASK
#define PROBE_MASK 0
#endif
struct Params {
    const float *x, *c, *ctx, *c_ctx, *mod_w, *mod_b, *ln_g, *ln_b;
    const float *ev_w_in, *ev_q_norm, *ev_kv_norm, *ev_w_uq, *ev_w_ukv, *ev_gla_wa2, *ev_gla_ba, *ev_gla_norm, *ev_w_out;
    const float *od_w_in, *od_conv_w, *od_conv_b, *od_gate_w, *od_gate_b, *od_lambda, *od_w_out;
    const float *peer_wq, *peer_k1, *peer_k2, *peer_u, *peer_v;
    float* out;
    bf16_t *wt_ev_in, *wt_uq, *wt_ukv, *wt_ev_out, *wt_od_in, *wt_gate, *wt_od_out, *wq16, *wpt, *wt_k;
    float *mod, *rope_cos, *rope_sin, *rsq;
    float* H; bf16_t *Q16, *K16, *V16;
    bf16_t* A16; bf16_t* P; unsigned char* G;
    unsigned* bar;
    int probe, pad_;
};

__device__ __forceinline__ bf16_t f2bf(float f) { unsigned u = __float_as_uint(f); u += 0x7fffu + ((u >> 16) & 1u); return (bf16_t)(u >> 16); }
__device__ __forceinline__ float bf2f(bf16_t h) { return __uint_as_float(((unsigned)h) << 16); }
__device__ __forceinline__ unsigned pack2(float a, float b) { unsigned r; asm volatile("v_cvt_pk_bf16_f32 %0, %1, %2" : "=v"(r) : "v"(a), "v"(b)); return r; }
__device__ __forceinline__ float silu_f(float x) { return x / (1.0f + expf(-x)); }
__device__ __forceinline__ float sigmoid_f(float x) { return 1.0f / (1.0f + expf(-x)); }
__device__ __forceinline__ float gelu_f(float x) { return 0.5f * x * (1.0f + erff(x * 0.70710678118654752f)); }
__device__ __forceinline__ float wave_sum(float v) {
#pragma unroll
    for (int o = 32; o > 0; o >>= 1) v += __shfl_xor(v, o);
    return v;
}
__device__ __forceinline__ int otid() { int t = threadIdx.x; asm volatile("" : "+v"(t)); return t; }
__device__ __forceinline__ int mod_row(int r) { const int b = r / PB, p = r - b * PB; return p < CTX ? 8 : b; }
__device__ __forceinline__ const float* in_row(const Params& P_, int r) {
    const int b = r / PB, p = r - b * PB;
    return p < CTX ? P_.ctx + ((size_t)b * CTX + p) * D : P_.x + ((size_t)b * SEQ + (p - CTX)) * D;
}

__device__ __forceinline__ void tconv_tile(const float* __restrict__ W, int K, int N, bf16_t* __restrict__ Wt, const float* __restrict__ rowscale, int tile, float* sm) {
    const int ntn = N / 64, tk = tile / ntn, tn = tile % ntn, tid = threadIdx.x;
#pragma unroll
    for (int i = 0; i < 4; ++i) {
        const int k = (tid >> 4) + 16 * i;
        f32x4 v = *(const f32x4*)(W + (size_t)(tk * 64 + k) * N + tn * 64 + (tid & 15) * 4);
        const float s = rowscale ? rowscale[tk * 64 + k] : 1.0f;
#pragma unroll
        for (int q = 0; q < 4; ++q) sm[k * 65 + (tid & 15) * 4 + q] = v[q] * s;
    }
    __syncthreads();
    const int n = tid >> 2, kc = tid & 3;
    unsigned w[8];
#pragma unroll
    for (int kk = 0; kk < 8; ++kk) w[kk] = pack2(sm[(kc * 16 + 2 * kk) * 65 + n], sm[(kc * 16 + 2 * kk + 1) * 65 + n]);
    bf16_t* dst = Wt + (size_t)(tn * 64 + n) * K + tk * 64 + kc * 16;
    *(u32x4*)dst = (u32x4){w[0], w[1], w[2], w[3]};
    *(u32x4*)(dst + 8) = (u32x4){w[4], w[5], w[6], w[7]};
    __syncthreads();
}
__device__ __forceinline__ void tconv_all(const float* W, int K, int N, bf16_t* Wt, const float* rowscale, float* sm) {
    const int nt = (K / 64) * (N / 64);
    for (int t = blockIdx.x; t < nt; t += gridDim.x) tconv_tile(W, K, N, Wt, rowscale, t, sm);
}

__device__ __forceinline__ void ph_prologue(const Params& p, unsigned char* smem) {
    float* sm = (float*)smem;
    tconv_all(p.ev_w_in, 1024, EV_IN, p.wt_ev_in, nullptr, sm);
    tconv_all(p.ev_w_uq, 384, 768, p.wt_uq, p.ev_q_norm, sm);
    tconv_all(p.ev_w_ukv, 256, 1024, p.wt_ukv, p.ev_kv_norm, sm);
    tconv_all(p.ev_w_out, 1024, 1024, p.wt_ev_out, nullptr, sm);
    tconv_all(p.od_w_in, 1024, 2560, p.wt_od_in, nullptr, sm);
    for (int g = 0; g < 40; ++g) tconv_all(p.od_gate_w + (size_t)g * 16384, 128, 128, p.wt_gate + (size_t)g * 16384, nullptr, sm);
    tconv_all(p.od_w_out, 1280, 1024, p.wt_od_out, nullptr, sm);
    for (int i = blockIdx.x * 256 + threadIdx.x; i < 2 * 1024 * 2048 / 8; i += gridDim.x * 256) {
        const f32x4 a = *(const f32x4*)(p.peer_wq + (size_t)i * 8), b2 = *(const f32x4*)(p.peer_wq + (size_t)i * 8 + 4);
        *(u32x4*)(p.wq16 + (size_t)i * 8) = (u32x4){pack2(a[0], a[1]), pack2(a[2], a[3]), pack2(b2[0], b2[1]), pack2(b2[2], b2[3])};
    }
    for (int i = blockIdx.x * 256 + threadIdx.x; i < 2 * 2 * 16384; i += gridDim.x * 256) {
        const int l = i / 32768, h = (i / 16384) & 1, e = i & 16383;
        p.wt_k[i] = f2bf((h ? p.peer_k2 : p.peer_k1)[(size_t)l * 16384 + e]);
    }
    for (int i = blockIdx.x * 256 + threadIdx.x; i < SEQ * 16; i += gridDim.x * 256) {
        const int s = i >> 4, f = i & 15;
        const float pos = (float)(f < 8 ? (s >> 6) : (s & 63));
        const float inv = powf(10000.0f, -(float)(f & 7) / 8.0f);
        const float ang = pos * inv;
        p.rope_cos[i] = cosf(ang); p.rope_sin[i] = sinf(ang);
    }
    float* sc = sm;
    for (int u = blockIdx.x; u < 2 * 96; u += gridDim.x) {
        const int l = u / 96, c0 = (u % 96) * 64, tid = threadIdx.x;
        __syncthreads();
        for (int i = tid; i < 9 * 1024; i += 256) { const int rr = i >> 10, k = i & 1023; sc[i] = silu_f(rr < 8 ? p.c[rr * 1024 + k] : p.c_ctx[k]); }
        __syncthreads();
        const int col = c0 + (tid & 63), kq = tid >> 6;
        float acc[9];
#pragma unroll
        for (int rr = 0; rr < 9; ++rr) acc[rr] = 0.f;
        const float* w = p.mod_w + (size_t)l * 1024 * 6144 + col;
        for (int k = kq * 256; k < kq * 256 + 256; ++k) {
            const float wv = w[(size_t)k * 6144];
#pragma unroll
            for (int rr = 0; rr < 9; ++rr) acc[rr] += sc[rr * 1024 + k] * wv;
        }
        __syncthreads();
        float* red = sm + 9 * 1024;
#pragma unroll
        for (int rr = 0; rr < 9; ++rr) red[(kq * 9 + rr) * 64 + (tid & 63)] = acc[rr];
        __syncthreads();
        for (int i = tid; i < 9 * 64; i += 256) {
            const int rr = i >> 6, cc = i & 63;
            const float s = red[(0 * 9 + rr) * 64 + cc] + red[(1 * 9 + rr) * 64 + cc] + red[(2 * 9 + rr) * 64 + cc] + red[(3 * 9 + rr) * 64 + cc];
            p.mod[((size_t)l * 9 + rr) * 6144 + c0 + cc] = s + p.mod_b[l * 6144 + c0 + cc];
        }
    }
}

__device__ __forceinline__ void ph_modulate0(const Params& p) {
    const int tid_ = otid(), wid = tid_ >> 6, lane = tid_ & 63;
    for (int u = blockIdx.x; u < R / 4; u += gridDim.x) {
        const int r = u * 4 + wid;
        const float* src = in_row(p, r);
        const float* md = p.mod + (size_t)(0 * 9 + mod_row(r)) * 6144;
#pragma unroll
        for (int q = 0; q < 4; ++q) {
            const int c = q * 256 + lane * 4;
            const f32x4 h = *(const f32x4*)(src + c), sh = *(const f32x4*)(md + c), scl = *(const f32x4*)(md + 1024 + c);
            const f32x4 v = h * (1.0f + scl) + sh;
            *(u32x2*)(p.A16 + (size_t)r * D + c) = (u32x2){pack2(v[0], v[1]), pack2(v[2], v[3])};
        }
    }
}

constexpr int GBK = 64, GLDS = 64  ;
struct RowMap { int lat_only; __device__ __forceinline__ int ntiles() const { return lat_only ? 256 : 272; }
    __device__ __forceinline__ int row0(int t) const { return lat_only ? (t >> 5) * PB + CTX + (t & 31) * 128 : t * 128; } };

template <class Epi>
__device__ __forceinline__ void gemm_unit(const bf16_t* __restrict__ A, int lda, const bf16_t* __restrict__ Bt, int ldb, int K, int N, int m0, int n0, const Epi& epi, unsigned char* smem) {
    bf16_t* sA = (bf16_t*)smem; bf16_t* sB = sA + 128 * GLDS;
    const int tid = otid(), lane = tid & 63, wid = tid >> 6, wm = wid >> 1, wn = wid & 1, fr = lane & 15, fq = lane >> 4;
    const int nk = K / GBK;
    f32x4 acc[4][4];
#pragma unroll
    for (int i = 0; i < 4; ++i)
#pragma unroll
        for (int j = 0; j < 4; ++j) acc[i][j] = (f32x4){0.f, 0.f, 0.f, 0.f};
    u32x4 ra[4], rb[4];
    auto gload = [&](int kt) {
#pragma unroll
        for (int i = 0; i < 4; ++i) {
            const int id = tid + 256 * i, row = id >> 3, ch = id & 7;
            ra[i] = *(const u32x4*)(A + (size_t)(m0 + row) * lda + kt * GBK + ch * 8);
            int brow = n0 + row; brow = brow < N ? brow : N - 1;
            rb[i] = *(const u32x4*)(Bt + (size_t)brow * ldb + kt * GBK + ch * 8);
        }
    };
    auto lstore = [&]() {
#pragma unroll
        for (int i = 0; i < 4; ++i) {
            const int id = tid + 256 * i, row = id >> 3, ch = id & 7;
            *(u32x4*)(sA + row * GLDS + ((ch ^ (row & 7)) * 8)) = ra[i];
            *(u32x4*)(sB + row * GLDS + ((ch ^ (row & 7)) * 8)) = rb[i];
        }
    };
    gload(0);
    __syncthreads();
    lstore();
    __syncthreads();
    for (int kt = 0; kt < nk; ++kt) {
        if (kt + 1 < nk) gload(kt + 1);
#pragma unroll
        for (int ks = 0; ks < 2; ++ks) {
            bf16x8 af[4], bfr[4];
#pragma unroll
            for (int i = 0; i < 4; ++i) af[i] = *(const bf16x8*)(sA + (wm * 64 + i * 16 + fr) * GLDS + (((ks * 4 + fq) ^ (fr & 7)) * 8));
#pragma unroll
            for (int j = 0; j < 4; ++j) bfr[j] = *(const bf16x8*)(sB + (wn * 64 + j * 16 + fr) * GLDS + (((ks * 4 + fq) ^ (fr & 7)) * 8));
#pragma unroll
            for (int i = 0; i < 4; ++i)
#pragma unroll
                for (int j = 0; j < 4; ++j) acc[i][j] = __builtin_amdgcn_mfma_f32_16x16x32_bf16(bfr[j], af[i], acc[i][j], 0, 0, 0);
        }
        __syncthreads();
        if (kt + 1 < nk) { lstore(); __syncthreads(); }
    }
    epi(acc, m0 + wm * 64, n0 + wn * 64, fr, fq);
}
template <class Epi>
__device__ __forceinline__ void gemm_phase(const bf16_t* __restrict__ A, int lda, const bf16_t* __restrict__ Bt, int K, int N, RowMap rm, const Epi& epi, unsigned char* smem) {
    const int ntn = (N + 127) / 128, nunits = rm.ntiles() * ntn;
    for (int u = blockIdx.x; u < nunits; u += gridDim.x) gemm_unit(A, lda, Bt, K, K, N, rm.row0(u / ntn), (u % ntn) * 128, epi, smem);
}

struct EpiBf16 {
    bf16_t* C; int ldc, N;
    __device__ __forceinline__ void operator()(const f32x4 (&acc)[4][4], int mb, int nb, int fr, int fq) const {
#pragma unroll
        for (int i = 0; i < 4; ++i)
#pragma unroll
            for (int j = 0; j < 4; ++j) {
                const int m = mb + i * 16 + fr, n = nb + j * 16 + 4 * fq;
                if (n < N) *(u32x2*)(C + (size_t)m * ldc + n) = (u32x2){pack2(acc[i][j][0], acc[i][j][1]), pack2(acc[i][j][2], acc[i][j][3])};
            }
    }
};
struct EpiQ {
    bf16_t* Q; const float *rsq, *rc, *rs;
    __device__ __forceinline__ void operator()(const f32x4 (&acc)[4][4], int mb, int nb, int fr, int fq) const {
#pragma unroll
        for (int i = 0; i < 4; ++i) {
            const int m = mb + i * 16 + fr, b = m / PB, pp = m - b * PB;
            const float sc = rsq[m] * (MLA_SCALE * 1.4426950408889634f);
#pragma unroll
            for (int j = 0; j < 4; j += 2) {
                const int n = nb + j * 16 + 4 * fq;
                f32x4 v0 = acc[i][j] * sc, v1 = acc[i][j + 1] * sc;
                const int d = n % 96;
                if (d >= 64 && pp >= CTX) {
                    const int s = pp - CTX, f = (d - 64) + 0;
                    const f32x4 cs = *(const f32x4*)(rc + s * 16 + f), sn = *(const f32x4*)(rs + s * 16 + f);
                    const f32x4 o0 = v0 * cs - v1 * sn, o1 = v0 * sn + v1 * cs; v0 = o0; v1 = o1;
                }
                *(u32x2*)(Q + (size_t)m * 768 + n) = (u32x2){pack2(v0[0], v0[1]), pack2(v0[2], v0[3])};
                *(u32x2*)(Q + (size_t)m * 768 + n + 16) = (u32x2){pack2(v1[0], v1[1]), pack2(v1[2], v1[3])};
            }
        }
    }
};
struct EpiKV {
    bf16_t *Kd, *Vd; const float* rsq;
    __device__ __forceinline__ void operator()(const f32x4 (&acc)[4][4], int mb, int nb, int fr, int fq) const {
#pragma unroll
        for (int i = 0; i < 4; ++i) {
            const int m = mb + i * 16 + fr; const float sc = rsq[m];
#pragma unroll
            for (int j = 0; j < 4; ++j) {
                const int n = nb + j * 16 + 4 * fq, hd = n >> 7, d = n & 127;
                const f32x4 v = acc[i][j] * sc;
                bf16_t* dst = d < 64 ? Kd + (size_t)m * 768 + hd * 96 + d : Vd + (size_t)m * 512 + hd * 64 + (d - 64);
                *(u32x2*)dst = (u32x2){pack2(v[0], v[1]), pack2(v[2], v[3])};
            }
        }
    }
};
struct EpiResid {
    const float *x, *ctx, *mod; float* H; int layer;
    __device__ __forceinline__ void operator()(const f32x4 (&acc)[4][4], int mb, int nb, int fr, int fq) const {
#pragma unroll
        for (int i = 0; i < 4; ++i) {
            const int m = mb + i * 16 + fr, b = m / PB, pp = m - b * PB;
            const float* hin = layer == 0 ? (pp < CTX ? ctx + ((size_t)b * CTX + pp) * D : x + ((size_t)b * SEQ + (pp - CTX)) * D) : H + (size_t)m * D;
            const float* gate = mod + ((size_t)layer * 9 + (pp < CTX ? 8 : b)) * 6144 + 2 * 1024;
#pragma unroll
            for (int j = 0; j < 4; ++j) {
                const int n = nb + j * 16 + 4 * fq;
                const f32x4 h = *(const f32x4*)(hin + n), g = *(const f32x4*)(gate + n);
                *(f32x4*)(H + (size_t)m * D + n) = ALPHA * h + g * acc[i][j];
            }
        }
    }
};

__device__ __forceinline__ void ph_rowpost(const Params& p) {
    const int tid_ = otid(), wid = tid_ >> 6, lane = tid_ & 63;
    for (int u = blockIdx.x; u < R / 4; u += gridDim.x) {
        const int r = u * 4 + wid, b = r / PB, pp = r - b * PB;
        const bf16_t* row = p.P + (size_t)r * EV_IN;
        float sq = 0.f, skv = 0.f;
#pragma unroll
        for (int i = 0; i < 10; ++i) { const float v = bf2f(row[lane + 64 * i]); if (i < 6) sq += v * v; else skv += v * v; }
        sq = wave_sum(sq); skv = wave_sum(skv);
        if (lane == 0) { p.rsq[r] = rsqrtf(sq / 384.0f + LN_EPS); p.rsq[R + r] = rsqrtf(skv / 256.0f + LN_EPS); }
        if (lane < 16) {
            float x1 = bf2f(row[C_KPE + lane]), x2 = bf2f(row[C_KPE + 16 + lane]);
            if (pp >= CTX) { const int s = pp - CTX; const float cs = p.rope_cos[s * 16 + lane], sn = p.rope_sin[s * 16 + lane];
                const float o1 = x1 * cs - x2 * sn, o2 = x1 * sn + x2 * cs; x1 = o1; x2 = o2; }
            const bf16_t b1 = f2bf(x1), b2 = f2bf(x2);
#pragma unroll
            for (int hd = 0; hd < 8; ++hd) { p.K16[(size_t)r * 768 + hd * 96 + 64 + lane] = b1; p.K16[(size_t)r * 768 + hd * 96 + 80 + lane] = b2; }
        }
    }
}

constexpr int AT_KS = 104  , AT_VSB = 192  , AT_BUF = 64 * AT_KS * 2 + 64 * AT_VSB;
template <int OFF> __device__ __forceinline__ u32x2 at_tr_read(unsigned addr) {
    u32x2 r; asm volatile("ds_read_b64_tr_b16 %0, %1 offset:%2" : "=&v"(r) : "v"(addr), "i"(OFF) : "memory"); return r;
}
__device__ __forceinline__ void ph_attn(const Params& p, unsigned char* smem, int bid, int nblk) {
    const int tid = otid(), wid = tid >> 6, lane = tid & 63, q = lane & 31, h = lane >> 5;
    const unsigned vlane = (unsigned)((4 * h + ((lane & 15) >> 2)) * AT_VSB + (16 * ((lane >> 4) & 1) + 4 * (lane & 3)) * 2);
    for (int u = bid; u < 2048 + 128; u += nblk) {
        int b, hd, q0, nkeys;
        if (u < 2048) { b = u >> 8; hd = (u >> 5) & 7; q0 = CTX + (u & 31) * 128; nkeys = PB; }
        else { const int v = u - 2048; b = v >> 4; hd = (v >> 1) & 7; q0 = (v & 1) * 128; nkeys = CTX; }
        const size_t rq = (size_t)b * PB + q0 + wid * 32 + q;
        bf16x8 qf[6];
#pragma unroll
        for (int s = 0; s < 6; ++s) qf[s] = *(const bf16x8*)(p.Q16 + rq * 768 + hd * 96 + 16 * s + 8 * h);
        f32x16 o[2];
#pragma unroll
        for (int i = 0; i < 16; ++i) { o[0][i] = 0.f; o[1][i] = 0.f; }
        float m = -1e30f, l = 0.f;
        const int ntiles = nkeys / 64;
        const bf16_t* Kg = p.K16 + (size_t)b * PB * 768 + hd * 96;
        const bf16_t* Vg = p.V16 + (size_t)b * PB * 512 + hd * 64;
        u32x4 rk[3], rv[2];
        auto gload = [&](int t) {
#pragma unroll
            for (int i = 0; i < 3; ++i) { const int id = tid + 256 * i, key = id / 12, ch = id % 12; rk[i] = *(const u32x4*)(Kg + (size_t)(t * 64 + key) * 768 + ch * 8); }
#pragma unroll
            for (int i = 0; i < 2; ++i) { const int id = tid + 256 * i, key = id >> 3, dch = id & 7; rv[i] = *(const u32x4*)(Vg + (size_t)(t * 64 + key) * 512 + dch * 8); }
        };
        auto lstore = [&](int buf) {
            bf16_t* Ks = (bf16_t*)(smem + buf * AT_BUF); unsigned char* Vs = (unsigned char*)(Ks + 64 * AT_KS);
#pragma unroll
            for (int i = 0; i < 3; ++i) { const int id = tid + 256 * i, key = id / 12, ch = id % 12; *(u32x4*)(Ks + key * AT_KS + ch * 8) = rk[i]; }
#pragma unroll
            for (int i = 0; i < 2; ++i) { const int id = tid + 256 * i, key = id >> 3, dch = id & 7; *(u32x4*)(Vs + key * AT_VSB + dch * 16) = rv[i]; }
        };
        __syncthreads();
        gload(0); lstore(0);
        __syncthreads();
        for (int t = 0; t < ntiles; ++t) {
            if (t + 1 < ntiles) gload(t + 1);
            const bf16_t* Ks = (const bf16_t*)(smem + (t & 1) * AT_BUF);
            const unsigned vb = (unsigned)(size_t)((LAS unsigned char*)(smem + (t & 1) * AT_BUF + 64 * AT_KS * 2)) + vlane;
            f32x16 sa[2];
#pragma unroll
            for (int kb = 0; kb < 2; ++kb) {
#pragma unroll
                for (int i = 0; i < 16; ++i) sa[kb][i] = 0.f;
#pragma unroll
                for (int s = 0; s < 6; ++s) {
                    const bf16x8 kf = *(const bf16x8*)(Ks + (kb * 32 + q) * AT_KS + 16 * s + 8 * h);
                    sa[kb] = __builtin_amdgcn_mfma_f32_32x32x16_bf16(kf, qf[s], sa[kb], 0, 0, 0);
                }
            }
            u32x2 vt[4][2][2];
#define AT_TR(st, db) vt[st][db][0] = at_tr_read<(16 * st) * AT_VSB + db * 64>(vb); vt[st][db][1] = at_tr_read<(16 * st + 8) * AT_VSB + db * 64>(vb);
            AT_TR(0, 0) AT_TR(0, 1) AT_TR(1, 0) AT_TR(1, 1) AT_TR(2, 0) AT_TR(2, 1) AT_TR(3, 0) AT_TR(3, 1)
#undef AT_TR
            float mx = sa[0][0];
#pragma unroll
            for (int i = 1; i < 16; ++i) mx = fmaxf(mx, sa[0][i]);
#pragma unroll
            for (int i = 0; i < 16; ++i) mx = fmaxf(mx, sa[1][i]);
            { auto rr = __builtin_amdgcn_permlane32_swap(__float_as_uint(mx), __float_as_uint(mx), false, false); mx = fmaxf(__uint_as_float(rr[0]), __uint_as_float(rr[1])); }
            if (!__all(mx - m <= 8.0f)) {
                const float mn = fmaxf(m, mx), al = __builtin_amdgcn_exp2f(m - mn);
                m = mn; l *= al;
#pragma unroll
                for (int i = 0; i < 16; ++i) { o[0][i] *= al; o[1][i] *= al; }
            }
            float ps = 0.f;
#pragma unroll
            for (int kb = 0; kb < 2; ++kb)
#pragma unroll
                for (int i = 0; i < 16; ++i) { const float e = __builtin_amdgcn_exp2f(sa[kb][i] - m); sa[kb][i] = e; ps += e; }
            l += ps;
            bf16x8 pf[4];
#pragma unroll
            for (int st = 0; st < 4; ++st) {
                u32x4 pw;
#pragma unroll
                for (int e = 0; e < 4; ++e) pw[e] = pack2(sa[st >> 1][8 * (st & 1) + 2 * e], sa[st >> 1][8 * (st & 1) + 2 * e + 1]);
                pf[st] = __builtin_bit_cast(bf16x8, pw);
            }
            asm volatile("s_waitcnt lgkmcnt(0)" ::: "memory"); __builtin_amdgcn_sched_barrier(0);
#pragma unroll
            for (int st = 0; st < 4; ++st)
#pragma unroll
                for (int db = 0; db < 2; ++db) {
                    const bf16x8 vf = __builtin_bit_cast(bf16x8, (u32x4){vt[st][db][0][0], vt[st][db][0][1], vt[st][db][1][0], vt[st][db][1][1]});
                    o[db] = __builtin_amdgcn_mfma_f32_32x32x16_bf16(vf, pf[st], o[db], 0, 0, 0);
                }
            if (t + 1 < ntiles) lstore((t + 1) & 1);
            __syncthreads();
        }
        l += __shfl_xor(l, 32);
        const float il = 1.0f / l;
#pragma unroll
        for (int db = 0; db < 2; ++db)
#pragma unroll
            for (int gq = 0; gq < 4; ++gq) {
                const int d = db * 32 + 8 * gq + 4 * h;
                *(u32x2*)(p.A16 + rq * D + hd * 64 + d) = (u32x2){pack2(o[db][4 * gq] * il, o[db][4 * gq + 1] * il), pack2(o[db][4 * gq + 2] * il, o[db][4 * gq + 3] * il)};
            }
    }
}

constexpr size_t GLA_KS_BYTES = (size_t)NB * 4 * 68 * 2 * 8192 * 2;
constexpr int GL_S = 72;
__device__ __forceinline__ void gla_cum(const Params& p, size_t row0, int hd, int dir, float* sga, float* spart, float (&c)[16], float& T) {
    const int tid = otid(), d = tid & 63, part = tid >> 6;
    {
        const int j = tid >> 2, g4 = tid & 3;
        const u32x2 w = *(const u32x2*)(p.P + (row0 + j) * EV_IN + C_GAF + dir * 16 + g4 * 4);
        sga[j * 16 + g4 * 4 + 0] = __uint_as_float(w[0] << 16); sga[j * 16 + g4 * 4 + 1] = __uint_as_float(w[0] & 0xffff0000u);
        sga[j * 16 + g4 * 4 + 2] = __uint_as_float(w[1] << 16); sga[j * 16 + g4 * 4 + 3] = __uint_as_float(w[1] & 0xffff0000u);
    }
    __syncthreads();
    float wc[16];
    const float* wa = p.ev_gla_wa2 + (size_t)dir * 16 * 256 + hd * 64 + d;
#pragma unroll
    for (int g = 0; g < 16; ++g) wc[g] = wa[g * 256];
    const float bias = p.ev_gla_ba[dir * 256 + hd * 64 + d];
    float lv[16]; float run = 0.f;
#pragma unroll
    for (int jj = 0; jj < 16; ++jj) {
        const int j = part * 16 + jj;
        float z = bias;
#pragma unroll
        for (int g = 0; g < 16; g += 4) { const f32x4 a = *(const f32x4*)(sga + j * 16 + g); z += a[0] * wc[g] + a[1] * wc[g + 1] + a[2] * wc[g + 2] + a[3] * wc[g + 3]; }
        const float ls = (fminf(z, 0.f) - log1pf(expf(-fabsf(z)))) * (1.0f / 16.0f);
        lv[jj] = ls; run += ls; c[jj] = run;
    }
    spart[part * 64 + d] = run;
    __syncthreads();
    float off = 0.f; T = 0.f;
#pragma unroll
    for (int pp = 0; pp < 4; ++pp) { const float v = spart[pp * 64 + d]; T += v; if (pp < part) off += v; }
#pragma unroll
    for (int jj = 0; jj < 16; ++jj) c[jj] = dir == 0 ? off + c[jj] : T - (off + c[jj]) + lv[jj];
}
__device__ __forceinline__ void gla_stage_vt(const Params& p, size_t row0, int hd, bf16_t* Vt) {
    const int tid = otid();
#pragma unroll
    for (int i = 0; i < 4; ++i) {
        const int id = tid + 256 * i, j = id >> 4, ech = id & 15;
        const u32x4 w = *(const u32x4*)(p.P + (row0 + j) * EV_IN + C_GV + hd * 128 + ech * 8);
#pragma unroll
        for (int e = 0; e < 4; ++e) { Vt[(ech * 8 + 2 * e) * GL_S + j] = (bf16_t)(w[e] & 0xffffu); Vt[(ech * 8 + 2 * e + 1) * GL_S + j] = (bf16_t)(w[e] >> 16); }
    }
}
__device__ __forceinline__ void ph_gla_a(const Params& p, unsigned char* smem) {
    bf16_t* kwT = (bf16_t*)smem; bf16_t* Vt = kwT + 64 * GL_S; float* sga = (float*)(Vt + 128 * GL_S); float* spart = sga + 1024;
    bf16_t* KS = (bf16_t*)p.G; float* DEC = (float*)(p.G + GLA_KS_BYTES);
    const int tid = otid(), lane = tid & 63, wid = tid >> 6, fr = lane & 15, fq = lane >> 4, d = tid & 63, part = tid >> 6;
    for (int u = blockIdx.x; u < NB * 4 * 68; u += gridDim.x) {
        const int b = u / 272, hd = (u / 68) & 3, ci = u % 68;
        const size_t row0 = (size_t)b * PB + ci * 64;
        __syncthreads();
        gla_stage_vt(p, row0, hd, Vt);
        for (int dir = 0; dir < 2; ++dir) {
            float c[16], T;
            gla_cum(p, row0, hd, dir, sga, spart, c, T);
            unsigned kw[8];
#pragma unroll
            for (int jj = 0; jj < 16; jj += 2) {
                const float k0 = bf2f(p.P[(row0 + part * 16 + jj) * EV_IN + C_GK + hd * 64 + d]), k1 = bf2f(p.P[(row0 + part * 16 + jj + 1) * EV_IN + C_GK + hd * 64 + d]);
                kw[jj >> 1] = pack2(k0 * expf(T - c[jj]), k1 * expf(T - c[jj + 1]));
            }
            *(u32x4*)(kwT + d * GL_S + part * 16) = (u32x4){kw[0], kw[1], kw[2], kw[3]};
            *(u32x4*)(kwT + d * GL_S + part * 16 + 8) = (u32x4){kw[4], kw[5], kw[6], kw[7]};
            if (part == 0) DEC[((size_t)u * 2 + dir) * 64 + d] = expf(T);
            __syncthreads();
            f32x4 acc[8];
#pragma unroll
            for (int et = 0; et < 8; ++et) acc[et] = (f32x4){0.f, 0.f, 0.f, 0.f};
#pragma unroll
            for (int s = 0; s < 2; ++s) {
                const bf16x8 a = *(const bf16x8*)(kwT + (16 * wid + fr) * GL_S + 32 * s + 8 * fq);
#pragma unroll
                for (int et = 0; et < 8; ++et) {
                    const bf16x8 bq = *(const bf16x8*)(Vt + (16 * et + fr) * GL_S + 32 * s + 8 * fq);
                    acc[et] = __builtin_amdgcn_mfma_f32_16x16x32_bf16(a, bq, acc[et], 0, 0, 0);
                }
            }
#pragma unroll
            for (int et = 0; et < 8; ++et)
                *(u32x2*)(KS + (((size_t)u * 2 + dir) * 128 + 16 * et + fr) * 64 + 16 * wid + 4 * fq) = (u32x2){pack2(acc[et][0], acc[et][1]), pack2(acc[et][2], acc[et][3])};
            __syncthreads();
        }
    }
}
__device__ __forceinline__ void ph_gla_b(const Params& p, int dry = 0) {
    unsigned* KS32 = (unsigned*)p.G; const float* DEC = (const float*)(p.G + GLA_KS_BYTES);
    for (int gid = blockIdx.x * 256 + threadIdx.x; gid < 64 * 4096; gid += gridDim.x * 256) {
        const int seq = gid >> 12, pi = gid & 4095, dir = seq & 1, bh = seq >> 1, d = (2 * pi) & 63;
        float s0 = 0.f, s1 = 0.f;
#pragma unroll 4
        for (int step = 0; step < 68; ++step) {
            const int ci = dir == 0 ? step : (step < 4 ? 3 - step : 71 - step);
            const size_t ud = ((size_t)bh * 68 + ci) * 2 + dir;
            const unsigned w = KS32[ud * 4096 + pi];
            const float dc0 = DEC[ud * 64 + d], dc1 = DEC[ud * 64 + d + 1];
            if (!dry) KS32[ud * 4096 + pi] = pack2(s0, s1);
            s0 = dc0 * s0 + __uint_as_float(w << 16); s1 = dc1 * s1 + __uint_as_float(w & 0xffff0000u);
        }
        if (dry) asm volatile("" :: "v"(s0), "v"(s1));
    }
}
__device__ __forceinline__ void ph_gla_c(const Params& p, unsigned char* smem) {
    bf16_t* qs = (bf16_t*)smem; bf16_t* ks = qs + 64 * GL_S; bf16_t* Vt = ks + 64 * GL_S; float* sga = (float*)(Vt + 128 * GL_S); float* spart = sga + 1024;
    const bf16_t* KS = (const bf16_t*)p.G;
    const int tid = otid(), lane = tid & 63, wid = tid >> 6, fr = lane & 15, fq = lane >> 4, d = tid & 63, part = tid >> 6;
    for (int u = blockIdx.x; u < NB * 4 * 68; u += gridDim.x) {
        const int b = u / 272, hd = (u / 68) & 3, ci = u % 68;
        const size_t row0 = (size_t)b * PB + ci * 64;
        const int i = 16 * wid + fr;
        __syncthreads();
        gla_stage_vt(p, row0, hd, Vt);
        f32x4 oacc[8], pt[4];
#pragma unroll
        for (int et = 0; et < 8; ++et) oacc[et] = (f32x4){0.f, 0.f, 0.f, 0.f};
#pragma unroll
        for (int jt = 0; jt < 4; ++jt) pt[jt] = (f32x4){0.f, 0.f, 0.f, 0.f};
        for (int dir = 0; dir < 2; ++dir) {
            float c[16], T;
            gla_cum(p, row0, hd, dir, sga, spart, c, T);
#pragma unroll
            for (int jj = 0; jj < 16; ++jj) {
                const size_t ro = (row0 + part * 16 + jj) * EV_IN + hd * 64 + d;
                qs[(part * 16 + jj) * GL_S + d] = f2bf(bf2f(p.P[ro + C_GQ]) * 0.125f * expf(c[jj]));
                ks[(part * 16 + jj) * GL_S + d] = f2bf(bf2f(p.P[ro + C_GK]) * expf(-c[jj]));
            }
            __syncthreads();
            bf16x8 qf[2];
#pragma unroll
            for (int s = 0; s < 2; ++s) qf[s] = *(const bf16x8*)(qs + i * GL_S + 32 * s + 8 * fq);
#pragma unroll
            for (int jt = 0; jt < 4; ++jt) {
                f32x4 t = (f32x4){0.f, 0.f, 0.f, 0.f};
#pragma unroll
                for (int s = 0; s < 2; ++s) { const bf16x8 a = *(const bf16x8*)(ks + (16 * jt + fr) * GL_S + 32 * s + 8 * fq); t = __builtin_amdgcn_mfma_f32_16x16x32_bf16(a, qf[s], t, 0, 0, 0); }
#pragma unroll
                for (int rg = 0; rg < 4; ++rg) { const int j = 16 * jt + 4 * fq + rg; const bool keep = dir == 0 ? (j <= i) : (j >= i); pt[jt][rg] += keep ? t[rg] : 0.f; }
            }
            const bf16_t* Sg = KS + ((size_t)u * 2 + dir) * 8192;
#pragma unroll
            for (int et = 0; et < 8; ++et) {
#pragma unroll
                for (int s = 0; s < 2; ++s) { const bf16x8 a = *(const bf16x8*)(Sg + (16 * et + fr) * 64 + 32 * s + 8 * fq); oacc[et] = __builtin_amdgcn_mfma_f32_16x16x32_bf16(a, qf[s], oacc[et], 0, 0, 0); }
                if ((et & 3) == 3) __builtin_amdgcn_sched_barrier(0);
            }
            __syncthreads();
        }
#pragma unroll
        for (int k2 = 0; k2 < 2; ++k2) {
            const u32x4 pw = (u32x4){pack2(pt[2 * k2][0], pt[2 * k2][1]), pack2(pt[2 * k2][2], pt[2 * k2][3]), pack2(pt[2 * k2 + 1][0], pt[2 * k2 + 1][1]), pack2(pt[2 * k2 + 1][2], pt[2 * k2 + 1][3])};
            const bf16x8 pf = __builtin_bit_cast(bf16x8, pw);
#pragma unroll
            for (int et = 0; et < 8; ++et) {
                const bf16_t* vp = Vt + (16 * et + fr) * GL_S + 32 * k2 + 4 * fq;
                const u32x2 v0 = *(const u32x2*)vp, v1 = *(const u32x2*)(vp + 16);
                const bf16x8 vf = __builtin_bit_cast(bf16x8, (u32x4){v0[0], v0[1], v1[0], v1[1]});
                oacc[et] = __builtin_amdgcn_mfma_f32_16x16x32_bf16(vf, pf, oacc[et], 0, 0, 0);
            }
        }
        float ss = 0.f;
#pragma unroll
        for (int et = 0; et < 8; ++et) ss += oacc[et][0] * oacc[et][0] + oacc[et][1] * oacc[et][1] + oacc[et][2] * oacc[et][2] + oacc[et][3] * oacc[et][3];
        ss += __shfl_xor(ss, 16); ss += __shfl_xor(ss, 32);
        const float rs = rsqrtf(ss * (1.0f / 128.0f) + LN_EPS);
        const size_t r = row0 + i;
#pragma unroll
        for (int et = 0; et < 8; ++et) {
            const int e = 16 * et + 4 * fq;
            const u32x2 gw = *(const u32x2*)(p.P + r * EV_IN + C_GG + hd * 128 + e);
            const f32x4 nr = *(const f32x4*)(p.ev_gla_norm + hd * 128 + e);
            const float g0 = __uint_as_float(gw[0] << 16), g1 = __uint_as_float(gw[0] & 0xffff0000u), g2 = __uint_as_float(gw[1] << 16), g3 = __uint_as_float(gw[1] & 0xffff0000u);
            *(u32x2*)(p.A16 + r * D + 512 + hd * 128 + e) = (u32x2){pack2(oacc[et][0] * rs * nr[0] * silu_f(g0), oacc[et][1] * rs * nr[1] * silu_f(g1)),
                                                                   pack2(oacc[et][2] * rs * nr[2] * silu_f(g2), oacc[et][3] * rs * nr[3] * silu_f(g3))};
        }
    }
}

__device__ __forceinline__ void ph_ln_mod(const Params& p, int layer, int lnidx, int lat_only, int dry = 0) {
    const int tid_ = otid(), wid = tid_ >> 6, lane = tid_ & 63;
    const int nrows = lat_only ? NB * SEQ : R;
    const float* g = p.ln_g + (size_t)(layer * 2 + lnidx) * D; const float* bb = p.ln_b + (size_t)(layer * 2 + lnidx) * D;
    for (int u = blockIdx.x; u < nrows / 4; u += gridDim.x) {
        const int rr = u * 4 + wid, r = lat_only ? (rr >> 12) * PB + CTX + (rr & 4095) : rr;
        float* hrow = p.H + (size_t)r * D;
        f32x4 v[4]; float s = 0.f;
#pragma unroll
        for (int q = 0; q < 4; ++q) { v[q] = *(const f32x4*)(hrow + q * 256 + lane * 4); s += v[q][0] + v[q][1] + v[q][2] + v[q][3]; }
        const float mu = wave_sum(s) * (1.0f / 1024.0f);
        float ss = 0.f;
#pragma unroll
        for (int q = 0; q < 4; ++q) { v[q] = v[q] - mu; ss += v[q][0] * v[q][0] + v[q][1] * v[q][1] + v[q][2] * v[q][2] + v[q][3] * v[q][3]; }
        const float rstd = rsqrtf(wave_sum(ss) * (1.0f / 1024.0f) + LN_EPS);
        const float* md = p.mod + ((size_t)layer * 9 + mod_row(r)) * 6144;
#pragma unroll
        for (int q = 0; q < 4; ++q) {
            const int c = q * 256 + lane * 4;
            const f32x4 h = v[q] * rstd * *(const f32x4*)(g + c) + *(const f32x4*)(bb + c);
            const f32x4 a = h * (1.0f + *(const f32x4*)(md + 4 * 1024 + c)) + *(const f32x4*)(md + 3 * 1024 + c);
            if (dry) { asm volatile("" :: "v"(a), "v"(h)); continue; }
            *(f32x4*)(hrow + c) = h;
            *(u32x2*)(p.A16 + (size_t)r * D + c) = (u32x2){pack2(a[0], a[1]), pack2(a[2], a[3])};
        }
    }
}

__device__ __forceinline__ void ph_wprime(const Params& p, unsigned char* smem) {
    for (int u = blockIdx.x; u < 256; u += gridDim.x) {
        const int layer = u >> 7, g16 = (u >> 3) & 15, tn = u & 7, half = g16 & 1, hd = g16 >> 1;
        bf16_t* C = p.wpt + ((size_t)layer * 2048 + g16 * 128) * 1024;
        gemm_unit(p.wt_k + ((size_t)layer * 2 + half) * 16384, 128, p.wq16 + (size_t)layer * 1024 * 2048 + hd * 256 + half * 128, 2048, 128, 1024, 0, tn * 128, EpiBf16{C, 1024, 1024}, smem);
    }
}
__device__ __forceinline__ void ph_gemm_scores(const Params& p, int layer, int lat_only, unsigned char* smem) {
    bf16_t* sA = (bf16_t*)smem; bf16_t* sB = sA + 128 * GLDS;
    float* T = (float*)p.G;
    const int tid = otid(), lane = tid & 63, wid = tid >> 6, q = lane & 31, h = lane >> 5;
    const RowMap rm{lat_only};
    const int nunits = rm.ntiles() * 16;
    for (int u = blockIdx.x; u < nunits; u += gridDim.x) {
        const int tile = u >> 4, g16 = u & 15, m0 = rm.row0(tile);
        const bf16_t* A = p.A16 + (size_t)m0 * D;
        const bf16_t* Bt = p.wpt + ((size_t)layer * 2048 + g16 * 128) * 1024;
        f32x16 sa[4];
#pragma unroll
        for (int kb = 0; kb < 4; ++kb)
#pragma unroll
            for (int i = 0; i < 16; ++i) sa[kb][i] = 0.f;
        u32x4 ra[4], rb[4];
        auto gload = [&](int kt) {
#pragma unroll
            for (int i = 0; i < 4; ++i) { const int id = tid + 256 * i, row = id >> 3, ch = id & 7; ra[i] = *(const u32x4*)(A + (size_t)row * D + kt * GBK + ch * 8); rb[i] = *(const u32x4*)(Bt + (size_t)row * 1024 + kt * GBK + ch * 8); }
        };
        auto lstore = [&]() {
#pragma unroll
            for (int i = 0; i < 4; ++i) { const int id = tid + 256 * i, row = id >> 3, ch = id & 7, sw = (ch ^ ((row >> 1) & 7)) * 8; *(u32x4*)(sA + row * GLDS + sw) = ra[i]; *(u32x4*)(sB + row * GLDS + sw) = rb[i]; }
        };
        gload(0);
        __syncthreads();
        lstore();
        __syncthreads();
        for (int kt = 0; kt < 1024 / GBK; ++kt) {
            if (kt + 1 < 1024 / GBK) gload(kt + 1);
#pragma unroll
            for (int s = 0; s < 4; ++s) {
                const int sw = ((2 * s + h) ^ ((q >> 1) & 7)) * 8;
                const bf16x8 tf = *(const bf16x8*)(sA + (32 * wid + q) * GLDS + sw);
#pragma unroll
                for (int kb = 0; kb < 4; ++kb) {
                    const bf16x8 kf = *(const bf16x8*)(sB + (32 * kb + q) * GLDS + sw);
                    sa[kb] = __builtin_amdgcn_mfma_f32_32x32x16_bf16(kf, tf, sa[kb], 0, 0, 0);
                }
            }
            __syncthreads();
            if (kt + 1 < 1024 / GBK) { lstore(); __syncthreads(); }
        }
        float top[16];
#pragma unroll
        for (int t = 0; t < 16; ++t) top[t] = -3.0e38f;
#pragma unroll
        for (int kb = 0; kb < 4; ++kb)
#pragma unroll
            for (int rg = 0; rg < 16; ++rg) {
                const unsigned key = (unsigned)(kb * 32 + (rg & 3) + 8 * (rg >> 2) + 4 * h);
                float xv = __uint_as_float((__float_as_uint(sa[kb][rg]) & ~127u) | key);
#pragma unroll
                for (int t = 0; t < 16; ++t) { const float hi = fmaxf(top[t], xv); xv = fminf(top[t], xv); top[t] = hi; }
            }
        float mrg[8];
#pragma unroll
        for (int i = 0; i < 8; ++i) mrg[i] = fmaxf(top[i], __shfl_xor(top[15 - i], 32));
        const size_t r = (size_t)m0 + 32 * wid + q;
        float* dst = T + (r * 16 + g16) * 16 + 8 * h;
        *(f32x4*)dst = (f32x4){mrg[0], mrg[1], mrg[2], mrg[3]}; *(f32x4*)(dst + 4) = (f32x4){mrg[4], mrg[5], mrg[6], mrg[7]};
    }
}

__device__ __forceinline__ void ph_combine(const Params& p, int lat_only) {
    const float* T = (const float*)p.G;
    int* EIDX = (int*)(p.G + (size_t)R * 8 * 2 * 16 * 4);
    float* EG = (float*)(p.G + (size_t)R * 8 * 2 * 16 * 4 + (size_t)R * 8 * 16 * 4);
    const int nrows = lat_only ? NB * SEQ : R;
    for (int g = blockIdx.x * 256 + threadIdx.x; g < nrows * 8; g += gridDim.x * 256) {
        const int rr = g >> 3, hd = g & 7, r = lat_only ? (rr >> 12) * PB + CTX + (rr & 4095) : rr;
        const float* t = T + ((size_t)r * 8 + hd) * 32;
        float t2[16];
#pragma unroll
        for (int i = 0; i < 16; ++i) t2[i] = __uint_as_float(__float_as_uint(t[16 + i]) & ~127u);
        float top[16];
#pragma unroll
        for (int k = 0; k < 16; ++k) top[k] = -3.0e38f;
        for (int i = 0; i < 16; ++i) {
            const float t1i = __uint_as_float(__float_as_uint(t[i]) & ~127u);
#pragma unroll
            for (int j = 0; j < 16; ++j) {
                float xv = __uint_as_float((__float_as_uint(t1i + t2[j]) & ~255u) | (unsigned)(i * 16 + j));
#pragma unroll
                for (int k = 0; k < 16; ++k) { const float hi = fmaxf(top[k], xv); xv = fminf(top[k], xv); top[k] = hi; }
            }
        }
        float e[16], sum = 0.f; const float mx = __uint_as_float(__float_as_uint(top[0]) & ~255u);
#pragma unroll
        for (int k = 0; k < 16; ++k) { e[k] = expf(__uint_as_float(__float_as_uint(top[k]) & ~255u) - mx); sum += e[k]; }
        const float inv = 1.0f / sum;
#pragma unroll
        for (int k = 0; k < 16; ++k) {
            const unsigned code = __float_as_uint(top[k]) & 255u, i = code >> 4, j = code & 15;
            const unsigned i1 = __float_as_uint(t[i]) & 127u, i2 = __float_as_uint(t[16 + j]) & 127u;
            EIDX[((size_t)r * 8 + hd) * 16 + k] = (int)(i1 * 128 + i2);
            EG[((size_t)r * 8 + hd) * 16 + k] = e[k] * inv;
        }
    }
}

__device__ __forceinline__ void ph_gather_ln(const Params& p, int layer, int lat_only) {
    const int tid_ = otid(), wid = tid_ >> 6, lane = tid_ & 63;
    const int* EIDX = (const int*)(p.G + (size_t)R * 8 * 2 * 16 * 4);
    const float* EG = (const float*)(p.G + (size_t)R * 8 * 2 * 16 * 4 + (size_t)R * 8 * 16 * 4);
    const float* U = p.peer_u + (size_t)layer * PEER_N * D; const float* V = p.peer_v + (size_t)layer * PEER_N * D;
    const float* g = p.ln_g + (size_t)(layer * 2 + 1) * D; const float* bb = p.ln_b + (size_t)(layer * 2 + 1) * D;
    const int nrows = lat_only ? NB * SEQ : R;
    for (int u = blockIdx.x; u < nrows / 4; u += gridDim.x) {
        const int rr = u * 4 + wid, r = lat_only ? (rr >> 12) * PB + CTX + (rr & 4095) : rr;
        f32x4 hm[4], acc[4];
#pragma unroll
        for (int q = 0; q < 4; ++q) {
            const u32x2 w = *(const u32x2*)(p.A16 + (size_t)r * D + q * 256 + lane * 4);
            hm[q] = (f32x4){__uint_as_float(w[0] << 16), __uint_as_float(w[0] & 0xffff0000u), __uint_as_float(w[1] << 16), __uint_as_float(w[1] & 0xffff0000u)};
            acc[q] = (f32x4){0.f, 0.f, 0.f, 0.f};
        }
        for (int e0 = 0; e0 < 128; e0 += 2) {
            const int ea = EIDX[(size_t)r * 128 + e0], eb = EIDX[(size_t)r * 128 + e0 + 1];
            const float ga = EG[(size_t)r * 128 + e0], gb = EG[(size_t)r * 128 + e0 + 1];
            f32x4 ua[4], ub[4];
#pragma unroll
            for (int q = 0; q < 4; ++q) { ua[q] = *(const f32x4*)(U + (size_t)ea * D + q * 256 + lane * 4); ub[q] = *(const f32x4*)(U + (size_t)eb * D + q * 256 + lane * 4); }
            float da = 0.f, db = 0.f;
#pragma unroll
            for (int q = 0; q < 4; ++q) { da += hm[q][0] * ua[q][0] + hm[q][1] * ua[q][1] + hm[q][2] * ua[q][2] + hm[q][3] * ua[q][3]; db += hm[q][0] * ub[q][0] + hm[q][1] * ub[q][1] + hm[q][2] * ub[q][2] + hm[q][3] * ub[q][3]; }
            da = wave_sum(da); db = wave_sum(db);
            const float wa = ga * gelu_f(da), wb = gb * gelu_f(db);
#pragma unroll
            for (int q = 0; q < 4; ++q) {
                acc[q] += wa * *(const f32x4*)(V + (size_t)ea * D + q * 256 + lane * 4);
                acc[q] += wb * *(const f32x4*)(V + (size_t)eb * D + q * 256 + lane * 4);
            }
        }
        const float* md = p.mod + ((size_t)layer * 9 + mod_row(r)) * 6144;
        float* hrow = p.H + (size_t)r * D;
        f32x4 v[4]; float s = 0.f;
#pragma unroll
        for (int q = 0; q < 4; ++q) { const int c = q * 256 + lane * 4; v[q] = ALPHA * *(const f32x4*)(hrow + c) + *(const f32x4*)(md + 5 * 1024 + c) * acc[q]; s += v[q][0] + v[q][1] + v[q][2] + v[q][3]; }
        const float mu = wave_sum(s) * (1.0f / 1024.0f);
        float ss = 0.f;
#pragma unroll
        for (int q = 0; q < 4; ++q) { v[q] = v[q] - mu; ss += v[q][0] * v[q][0] + v[q][1] * v[q][1] + v[q][2] * v[q][2] + v[q][3] * v[q][3]; }
        const float rstd = rsqrtf(wave_sum(ss) * (1.0f / 1024.0f) + LN_EPS);
        if (layer == 0) {
            const float* md1 = p.mod + ((size_t)1 * 9 + mod_row(r)) * 6144;
#pragma unroll
            for (int q = 0; q < 4; ++q) {
                const int c = q * 256 + lane * 4;
                const f32x4 h = v[q] * rstd * *(const f32x4*)(g + c) + *(const f32x4*)(bb + c);
                *(f32x4*)(hrow + c) = h;
                const f32x4 a = h * (1.0f + *(const f32x4*)(md1 + 1024 + c)) + *(const f32x4*)(md1 + c);
                *(u32x2*)(p.A16 + (size_t)r * D + c) = (u32x2){pack2(a[0], a[1]), pack2(a[2], a[3])};
            }
        } else {
            float* orow = p.out + (size_t)rr * D;
#pragma unroll
            for (int q = 0; q < 4; ++q) { const int c = q * 256 + lane * 4; *(f32x4*)(orow + c) = v[q] * rstd * *(const f32x4*)(g + c) + *(const f32x4*)(bb + c); }
        }
    }
}

__device__ __forceinline__ float gelu_fast(float v);
constexpr size_t UV8_BYTES = (size_t)PEER_N * D;
constexpr size_t UV8_OFF = (size_t)R * 2048 * 2;
__device__ __forceinline__ float wave_max(float v) {
#pragma unroll
    for (int o = 32; o > 0; o >>= 1) v = fmaxf(v, __shfl_xor(v, o));
    return v;
}
__device__ __forceinline__ unsigned cvt4_fp8(float a, float b, float c, float d) {
    int pk = __builtin_amdgcn_cvt_pk_fp8_f32(a, b, 0, false);
    pk = __builtin_amdgcn_cvt_pk_fp8_f32(c, d, pk, true);
    return (unsigned)pk;
}
__device__ __forceinline__ void ph_convert_uv(const Params& p, int layer) {
    const int tid = otid(), lane = tid & 63, gw = blockIdx.x * 4 + (tid >> 6), nw = gridDim.x * 4;
    unsigned char* T8 = (unsigned char*)p.P + UV8_OFF;
    float* sinv = (float*)(T8 + 2 * UV8_BYTES);
    for (int row = gw; row < 2 * PEER_N; row += nw) {
        const float* src = (row < PEER_N ? p.peer_u + ((size_t)layer * PEER_N + row) * D : p.peer_v + ((size_t)layer * PEER_N + (row - PEER_N)) * D) + lane * 16;
        f32x4 v[4]; float am = 0.f;
#pragma unroll
        for (int q = 0; q < 4; ++q) { v[q] = *(const f32x4*)(src + 4 * q); am = fmaxf(am, fmaxf(fmaxf(fabsf(v[q][0]), fabsf(v[q][1])), fmaxf(fabsf(v[q][2]), fabsf(v[q][3])))); }
        am = wave_max(am);
        const float sc = am > 0.f ? 224.0f / am : 1.0f;
        u32x4 w;
#pragma unroll
        for (int q = 0; q < 4; ++q) w[q] = cvt4_fp8(v[q][0] * sc, v[q][1] * sc, v[q][2] * sc, v[q][3] * sc);
        *(u32x4*)(T8 + (size_t)(row >= PEER_N) * UV8_BYTES + (size_t)(lane >> 3) * (PEER_N * 128) + (size_t)(row & (PEER_N - 1)) * 128 + (lane & 7) * 16) = w;
        if (lane == 0) sinv[row] = 1.0f / sc;
    }
}

__device__ __forceinline__ void ph_gather_mfma(const Params& p, int layer, int lat_only, unsigned char* smem) {
    const int tid = otid(), wid = tid >> 6, lane = tid & 63, c = lane & 15, g = lane >> 4;
    unsigned char* hs = smem + wid * 2048;
    int* se = (int*)(smem + wid * 2048 + 1024);
    float* sw = (float*)(smem + wid * 2048 + 1536);
    const int* EIDX = (const int*)(p.G + (size_t)R * 8 * 2 * 16 * 4);
    const float* EG = (const float*)(p.G + (size_t)R * 8 * 2 * 16 * 4 + (size_t)R * 8 * 16 * 4);
    const unsigned char* U8 = (const unsigned char*)p.P + UV8_OFF; const unsigned char* V8 = U8 + UV8_BYTES;
    const float* su_inv = (const float*)(U8 + 2 * UV8_BYTES); const float* sv_inv = su_inv + PEER_N;
    const float* gam = p.ln_g + (size_t)(layer * 2 + 1) * D; const float* bet = p.ln_b + (size_t)(layer * 2 + 1) * D;
    const int nrows = lat_only ? NB * SEQ : R;
    for (int u = blockIdx.x; u < nrows / 4; u += gridDim.x) {
        const int rr = u * 4 + wid, r = lat_only ? (rr >> 12) * PB + CTX + (rr & 4095) : rr;
        __syncthreads();
        float inv_sh;
        {
            const u32x4 w0 = *(const u32x4*)(p.A16 + (size_t)r * D + lane * 16), w1 = *(const u32x4*)(p.A16 + (size_t)r * D + lane * 16 + 8);
            float hv[16];
#pragma unroll
            for (int e = 0; e < 4; ++e) { hv[2 * e] = __uint_as_float(w0[e] << 16); hv[2 * e + 1] = __uint_as_float(w0[e] & 0xffff0000u); hv[8 + 2 * e] = __uint_as_float(w1[e] << 16); hv[8 + 2 * e + 1] = __uint_as_float(w1[e] & 0xffff0000u); }
            float am = 0.f;
#pragma unroll
            for (int e = 0; e < 16; ++e) am = fmaxf(am, fabsf(hv[e]));
            am = wave_max(am);
            const float sh = am > 0.f ? 224.0f / am : 1.0f; inv_sh = 1.0f / sh;
            *(u32x4*)(hs + lane * 16) = (u32x4){cvt4_fp8(hv[0] * sh, hv[1] * sh, hv[2] * sh, hv[3] * sh), cvt4_fp8(hv[4] * sh, hv[5] * sh, hv[6] * sh, hv[7] * sh),
                                                cvt4_fp8(hv[8] * sh, hv[9] * sh, hv[10] * sh, hv[11] * sh), cvt4_fp8(hv[12] * sh, hv[13] * sh, hv[14] * sh, hv[15] * sh)};
        }
        se[lane] = EIDX[(size_t)r * 128 + lane]; se[64 + lane] = EIDX[(size_t)r * 128 + 64 + lane];
        sw[lane] = EG[(size_t)r * 128 + lane]; sw[64 + lane] = EG[(size_t)r * 128 + 64 + lane];
        __syncthreads();
#pragma unroll 2
        for (int hd = 0; hd < 8; ++hd) {
            f32x4 dacc = (f32x4){0.f, 0.f, 0.f, 0.f};
            const int e = se[hd * 16 + c];
            const unsigned char* urow = U8 + (size_t)e * D + g * 16;
#pragma unroll
            for (int s2 = 0; s2 < 16; ++s2) {
                const u32x4 bq = *(const u32x4*)(urow + s2 * 64);
                const u32x4 aq = *(const u32x4*)(hs + s2 * 64 + g * 16);
                dacc = __builtin_amdgcn_mfma_f32_16x16x32_fp8_fp8((long)(((unsigned long long)aq[1] << 32) | aq[0]), (long)(((unsigned long long)bq[1] << 32) | bq[0]), dacc, 0, 0, 0);
                dacc = __builtin_amdgcn_mfma_f32_16x16x32_fp8_fp8((long)(((unsigned long long)aq[3] << 32) | aq[2]), (long)(((unsigned long long)bq[3] << 32) | bq[2]), dacc, 0, 0, 0);
            }
            const float wv = sw[hd * 16 + c] * gelu_fast(dacc[0] * inv_sh * su_inv[e]) * sv_inv[e];
            if (g == 0) sw[hd * 16 + c] = wv;
        }
        __syncthreads();
        const float wmax = wave_max(fmaxf(fabsf(sw[lane]), fabsf(sw[64 + lane])));
        const float wsc = wmax > 0.f ? 224.0f / wmax : 1.0f, inv_wsc = 1.0f / wsc;
        f32x4 oacc[8];
#pragma unroll
        for (int blk = 0; blk < 8; ++blk) oacc[blk] = (f32x4){0.f, 0.f, 0.f, 0.f};
#pragma unroll 4
        for (int it = 0; it < 32; ++it) {
            const int e = se[4 * it + g];
            const unsigned w8 = (unsigned)__builtin_amdgcn_cvt_pk_fp8_f32(sw[4 * it + g] * wsc, 0.f, 0, false) & 0xffu;
            const unsigned long long a64 = c < 8 ? ((unsigned long long)w8 << (8 * c)) : 0ull;
            const unsigned char* vrow = V8 + (size_t)e * D + c * 16;
#pragma unroll
            for (int b2 = 0; b2 < 4; ++b2) {
                const u32x4 bq = *(const u32x4*)(vrow + b2 * 256);
                oacc[2 * b2] = __builtin_amdgcn_mfma_f32_16x16x32_fp8_fp8((long)a64, (long)(((unsigned long long)bq[1] << 32) | bq[0]), oacc[2 * b2], 0, 0, 0);
                oacc[2 * b2 + 1] = __builtin_amdgcn_mfma_f32_16x16x32_fp8_fp8((long)a64, (long)(((unsigned long long)bq[3] << 32) | bq[2]), oacc[2 * b2 + 1], 0, 0, 0);
            }
        }
#pragma unroll
        for (int blk = 0; blk < 8; ++blk) oacc[blk] = oacc[blk] * inv_wsc;
        const float* md = p.mod + ((size_t)layer * 9 + mod_row(r)) * 6144;
        float* hrow = p.H + (size_t)r * D;
        const bool act = g < 2;
        f32x4 v[8]; float s = 0.f;
#pragma unroll
        for (int blk = 0; blk < 8; ++blk) {
            const int n = 256 * (blk >> 1) + 16 * c + 8 * (blk & 1) + 4 * (g & 1);
            v[blk] = ALPHA * *(const f32x4*)(hrow + n) + *(const f32x4*)(md + 5 * 1024 + n) * oacc[blk];
            if (!act) v[blk] = (f32x4){0.f, 0.f, 0.f, 0.f};
            s += v[blk][0] + v[blk][1] + v[blk][2] + v[blk][3];
        }
        const float mu = wave_sum(s) * (1.0f / 1024.0f);
        float ss = 0.f;
#pragma unroll
        for (int blk = 0; blk < 8; ++blk) { v[blk] = v[blk] - mu; if (act) ss += v[blk][0] * v[blk][0] + v[blk][1] * v[blk][1] + v[blk][2] * v[blk][2] + v[blk][3] * v[blk][3]; }
        const float rstd = rsqrtf(wave_sum(ss) * (1.0f / 1024.0f) + LN_EPS);
        if (act) {
            if (layer == 0) {
                const float* md1 = p.mod + ((size_t)1 * 9 + mod_row(r)) * 6144;
#pragma unroll
                for (int blk = 0; blk < 8; ++blk) {
                    const int n = 256 * (blk >> 1) + 16 * c + 8 * (blk & 1) + 4 * g;
                    const f32x4 h = v[blk] * rstd * *(const f32x4*)(gam + n) + *(const f32x4*)(bet + n);
                    *(f32x4*)(hrow + n) = h;
                    const f32x4 a = h * (1.0f + *(const f32x4*)(md1 + 1024 + n)) + *(const f32x4*)(md1 + n);
                    *(u32x2*)(p.A16 + (size_t)r * D + n) = (u32x2){pack2(a[0], a[1]), pack2(a[2], a[3])};
                }
            } else {
                float* orow = p.out + (size_t)rr * D;
#pragma unroll
                for (int blk = 0; blk < 8; ++blk) { const int n = 256 * (blk >> 1) + 16 * c + 8 * (blk & 1) + 4 * g; *(f32x4*)(orow + n) = v[blk] * rstd * *(const f32x4*)(gam + n) + *(const f32x4*)(bet + n); }
            }
        }
    }
}

constexpr int GT_TW = 17;
__device__ __forceinline__ long mk64(unsigned lo, unsigned hi) { return (long)(((unsigned long long)hi << 32) | lo); }
__device__ __forceinline__ void ph_gather_sliced(const Params& p, int layer, int lat_only, unsigned char* smem) {
    const int tid = otid(), wid = tid >> 6, lane = tid & 63, c = lane & 15, g = lane >> 4;
    float* part = (float*)smem + wid * (GT_TW * 128);
    float* tsc = (float*)smem + 4 * GT_TW * 128 + wid * (2 * GT_TW);
    unsigned short* sid = (unsigned short*)(smem + 4 * GT_TW * 128 * 4 + 4 * 2 * GT_TW * 4) + wid * (GT_TW * 128);
    const int* EIDX = (const int*)(p.G + (size_t)R * 8 * 2 * 16 * 4);
    const float* EG = (const float*)(p.G + (size_t)R * 8 * 2 * 16 * 4 + (size_t)R * 8 * 16 * 4);
    const unsigned char* U8 = (const unsigned char*)p.P + UV8_OFF; const unsigned char* V8 = U8 + UV8_BYTES;
    const float* su_inv = (const float*)(U8 + 2 * UV8_BYTES); const float* sv_inv = su_inv + PEER_N;
    const float* gam = p.ln_g + (size_t)(layer * 2 + 1) * D; const float* bet = p.ln_b + (size_t)(layer * 2 + 1) * D;
    const int ntok = lat_only ? NB * SEQ : R;
    const int per_round = gridDim.x * 4 * GT_TW;
    for (int base = 0; base < ntok; base += per_round) {
        const int t0 = base + (blockIdx.x * 4 + wid) * GT_TW;
        int nt = ntok - t0; nt = nt < 0 ? 0 : (nt > GT_TW ? GT_TW : nt);
        auto rowof = [&](int j) { const int rr = t0 + j; return lat_only ? (rr >> 12) * PB + CTX + (rr & 4095) : rr; };
        for (int j = 0; j < nt; ++j) {
            const size_t r = rowof(j);
            const u32x4 w0 = *(const u32x4*)(p.A16 + r * D + lane * 16), w1 = *(const u32x4*)(p.A16 + r * D + lane * 16 + 8);
            const int i0 = EIDX[r * 128 + lane], i1 = EIDX[r * 128 + 64 + lane];
            float hv[16];
#pragma unroll
            for (int e = 0; e < 4; ++e) { hv[2 * e] = __uint_as_float(w0[e] << 16); hv[2 * e + 1] = __uint_as_float(w0[e] & 0xffff0000u); hv[8 + 2 * e] = __uint_as_float(w1[e] << 16); hv[8 + 2 * e + 1] = __uint_as_float(w1[e] & 0xffff0000u); }
            float am = 0.f;
#pragma unroll
            for (int e = 0; e < 16; ++e) am = fmaxf(am, fabsf(hv[e]));
            am = wave_max(am);
            const float sh = am > 0.f ? 224.0f / am : 1.0f;
            if (lane == 0) tsc[j] = 1.0f / sh;
            *(u32x4*)((unsigned char*)(p.A16 + r * D) + lane * 16) = (u32x4){cvt4_fp8(hv[0] * sh, hv[1] * sh, hv[2] * sh, hv[3] * sh), cvt4_fp8(hv[4] * sh, hv[5] * sh, hv[6] * sh, hv[7] * sh),
                                                                             cvt4_fp8(hv[8] * sh, hv[9] * sh, hv[10] * sh, hv[11] * sh), cvt4_fp8(hv[12] * sh, hv[13] * sh, hv[14] * sh, hv[15] * sh)};
            part[j * 128 + lane] = 0.f; part[j * 128 + 64 + lane] = 0.f;
            sid[j * 128 + lane] = (unsigned short)i0; sid[j * 128 + 64 + lane] = (unsigned short)i1;
        }
        asm volatile("s_waitcnt vmcnt(0) lgkmcnt(0)" ::: "memory");
        for (int rep_ = (p.probe & 1) ? 2 : 1; rep_ > 0; --rep_) {
        if (p.probe & 1) { for (int j = 0; j < nt; ++j) { part[j * 128 + lane] = 0.f; part[j * 128 + 64 + lane] = 0.f; } asm volatile("s_waitcnt lgkmcnt(0)" ::: "memory"); }
        for (int sl = 0; sl < 8; ++sl) {
            u32x4 aA[2], bA[8], aB[2], bB[8];
            auto issue = [&](int q, u32x4 (&a)[2], u32x4 (&b)[8]) {
                const int j = q >> 1, h0 = (q & 1) * 4;
                const size_t r = rowof(j);
                const unsigned char* hrow = (const unsigned char*)(p.A16 + r * D) + sl * 128 + g * 16;
                a[0] = *(const u32x4*)hrow; a[1] = *(const u32x4*)(hrow + 64);
#pragma unroll
                for (int hh = 0; hh < 4; ++hh) { const unsigned char* ur = U8 + (size_t)sl * (PEER_N * 128) + (size_t)sid[j * 128 + (h0 + hh) * 16 + (lane >> 2)] * 128 + (lane & 3) * 16; b[2 * hh] = *(const u32x4*)ur; b[2 * hh + 1] = *(const u32x4*)(ur + 64); }
            };
            const int bsrc = (4 * c + g) * 4;
            auto compute = [&](int q, const u32x4 (&a)[2], const u32x4 (&b)[8]) {
                const int j = q >> 1, h0 = (q & 1) * 4;
#pragma unroll
                for (int hh = 0; hh < 4; ++hh) {
                    unsigned t[8];
#pragma unroll
                    for (int e = 0; e < 4; ++e) { t[e] = (unsigned)__builtin_amdgcn_ds_bpermute(bsrc, (int)b[2 * hh][e]); t[4 + e] = (unsigned)__builtin_amdgcn_ds_bpermute(bsrc, (int)b[2 * hh + 1][e]); }
                    f32x4 dacc = (f32x4){0.f, 0.f, 0.f, 0.f};
                    dacc = __builtin_amdgcn_mfma_f32_16x16x32_fp8_fp8(mk64(a[0][0], a[0][1]), mk64(t[0], t[1]), dacc, 0, 0, 0);
                    dacc = __builtin_amdgcn_mfma_f32_16x16x32_fp8_fp8(mk64(a[0][2], a[0][3]), mk64(t[2], t[3]), dacc, 0, 0, 0);
                    dacc = __builtin_amdgcn_mfma_f32_16x16x32_fp8_fp8(mk64(a[1][0], a[1][1]), mk64(t[4], t[5]), dacc, 0, 0, 0);
                    dacc = __builtin_amdgcn_mfma_f32_16x16x32_fp8_fp8(mk64(a[1][2], a[1][3]), mk64(t[6], t[7]), dacc, 0, 0, 0);
                    if (g == 0) part[j * 128 + (h0 + hh) * 16 + c] += dacc[0];
                }
            };
            const int nq = 2 * nt;
            if (nq > 0) issue(0, aA, bA);
            for (int q = 0; q < nq; q += 2) {
                issue(q + 1, aB, bB);
                compute(q, aA, bA);
                issue(q + 2 < nq ? q + 2 : q, aA, bA);
                compute(q + 1, aB, bB);
            }
        }
        }
        for (int j = 0; j < nt; ++j) {
            const size_t r = rowof(j);
            const float ish = tsc[j];
            float wv[2];
#pragma unroll
            for (int q = 0; q < 2; ++q) {
                const int x = q * 64 + lane, e = sid[j * 128 + x];
                wv[q] = EG[r * 128 + x] * gelu_fast(part[j * 128 + x] * ish * su_inv[e]) * sv_inv[e];
            }
            const float wm = wave_max(fmaxf(fabsf(wv[0]), fabsf(wv[1])));
            const float wsc = wm > 0.f ? 224.0f / wm : 1.0f;
            if (lane == 0) tsc[GT_TW + j] = 1.0f / wsc;
            unsigned char* w8b = (unsigned char*)(part + j * 128);
            w8b[lane] = (unsigned char)(__builtin_amdgcn_cvt_pk_fp8_f32(wv[0] * wsc, 0.f, 0, false) & 0xff);
            w8b[64 + lane] = (unsigned char)(__builtin_amdgcn_cvt_pk_fp8_f32(wv[1] * wsc, 0.f, 0, false) & 0xff);
        }
        asm volatile("s_waitcnt lgkmcnt(0)" ::: "memory");
        for (int rep_ = (p.probe & 2) ? 2 : 1; rep_ > 0; --rep_)
        for (int sl = 0; sl < 8; ++sl) {
            u32x2 vA[16], vB[16]; f32x4 hA; f32x4 oacc;
            auto issue = [&](int q, u32x2 (&v)[16]) {
                const int j = q >> 1, i0 = (q & 1) * 16;
#pragma unroll
                for (int it = 0; it < 16; ++it) v[it] = *(const u32x2*)(V8 + (size_t)sl * (PEER_N * 128) + (size_t)sid[j * 128 + 4 * (i0 + it) + g] * 128 + c * 8);
            };
            const unsigned shl = 8 * (c & 3), mlo = c < 4 ? 0xffffffffu : 0u, mhi = (c >= 4 && c < 8) ? 0xffffffffu : 0u;
            auto compute = [&](int q, const u32x2 (&v)[16]) {
                const int j = q >> 1, i0 = (q & 1) * 16;
                const unsigned char* w8b = (const unsigned char*)(part + j * 128);
                if (i0 == 0) oacc = (f32x4){0.f, 0.f, 0.f, 0.f};
#pragma unroll
                for (int it = 0; it < 16; ++it) {
                    const unsigned ws = (unsigned)w8b[4 * (i0 + it) + g] << shl;
                    oacc = __builtin_amdgcn_mfma_f32_16x16x32_fp8_fp8(mk64(ws & mlo, ws & mhi), mk64(v[it][0], v[it][1]), oacc, 0, 0, 0);
                }
            };
            auto finish = [&](int j) {
                const size_t r = rowof(j);
                const float iws = tsc[GT_TW + j];
                if (rep_ > 1) { asm volatile("" :: "v"(oacc), "v"(hA)); }
                else if (g < 2) {
                    const int n = sl * 128 + 8 * c + 4 * g;
                    const float* md = p.mod + ((size_t)layer * 9 + mod_row((int)r)) * 6144 + 5 * 1024;
                    *(f32x4*)(p.H + r * D + n) = ALPHA * hA + *(const f32x4*)(md + n) * (oacc * iws);
                }
            };
            const int nq = 2 * nt;
            if (nq > 0) issue(0, vA);
            for (int q = 0; q < nq; q += 2) {
                const int j = q >> 1;
                hA = *(const f32x4*)(p.H + (size_t)rowof(j) * D + sl * 128 + 8 * c + 4 * (g & 1));
                issue(q + 1, vB);
                compute(q, vA);
                issue(q + 2 < nq ? q + 2 : q, vA);
                compute(q + 1, vB);
                finish(j);
            }
        }
        asm volatile("s_waitcnt vmcnt(0)" ::: "memory");
        for (int j = 0; j < nt; ++j) {
            const size_t r = rowof(j);
            float* hrow = p.H + r * D;
            f32x4 v[4]; float s = 0.f;
#pragma unroll
            for (int q = 0; q < 4; ++q) { v[q] = *(const f32x4*)(hrow + q * 256 + lane * 4); s += v[q][0] + v[q][1] + v[q][2] + v[q][3]; }
            const float mu = wave_sum(s) * (1.0f / 1024.0f);
            float ss = 0.f;
#pragma unroll
            for (int q = 0; q < 4; ++q) { v[q] = v[q] - mu; ss += v[q][0] * v[q][0] + v[q][1] * v[q][1] + v[q][2] * v[q][2] + v[q][3] * v[q][3]; }
            const float rstd = rsqrtf(wave_sum(ss) * (1.0f / 1024.0f) + LN_EPS);
            if (layer == 0) {
                const float* md1 = p.mod + ((size_t)1 * 9 + mod_row((int)r)) * 6144;
#pragma unroll
                for (int q = 0; q < 4; ++q) {
                    const int n = q * 256 + lane * 4;
                    const f32x4 h = v[q] * rstd * *(const f32x4*)(gam + n) + *(const f32x4*)(bet + n);
                    *(f32x4*)(hrow + n) = h;
                    const f32x4 a = h * (1.0f + *(const f32x4*)(md1 + 1024 + n)) + *(const f32x4*)(md1 + n);
                    *(u32x2*)(p.A16 + r * D + n) = (u32x2){pack2(a[0], a[1]), pack2(a[2], a[3])};
                }
            } else {
                float* orow = p.out + (size_t)(t0 + j) * D;
#pragma unroll
                for (int q = 0; q < 4; ++q) { const int n = q * 256 + lane * 4; *(f32x4*)(orow + n) = v[q] * rstd * *(const f32x4*)(gam + n) + *(const f32x4*)(bet + n); }
            }
        }
    }
}

constexpr int RG_ZS = 136;
constexpr size_t RG_SUM_BYTES = (size_t)NB * 34 * 2 * RGW * 2 * 4;
__device__ __forceinline__ void rg_stage_z(const Params& p, int b, int c34, int n, bf16_t* zc) {
    const int tid = otid(), k2 = tid & 63, tq = tid >> 6, ch = n * 128 + 2 * k2;
    const int lo = c34 < 2 ? 0 : CTX, hi = c34 < 2 ? CTX : PB, p0 = c34 * 128 + 32 * tq;
    float w0[4], w1[4];
#pragma unroll
    for (int tap = 0; tap < 4; ++tap) { w0[tap] = p.od_conv_w[tap * RGW + ch]; w1[tap] = p.od_conv_w[tap * RGW + ch + 1]; }
    const float b0 = p.od_conv_b[ch], b1 = p.od_conv_b[ch + 1];
    const bf16_t* base = p.P + (size_t)b * PB * 2560 + RGW + ch;
    unsigned raw[35];
#pragma unroll
    for (int i = 0; i < 35; ++i) { const int pp = p0 - 2 + i; raw[i] = (pp >= lo && pp < hi) ? *(const unsigned*)(base + (size_t)pp * 2560) : 0u; }
#pragma unroll
    for (int t = 0; t < 32; ++t) {
        const float y0 = b0 + w0[0] * __uint_as_float(raw[t] << 16) + w0[1] * __uint_as_float(raw[t + 1] << 16) + w0[2] * __uint_as_float(raw[t + 2] << 16) + w0[3] * __uint_as_float(raw[t + 3] << 16);
        const float y1 = b1 + w1[0] * __uint_as_float(raw[t] & 0xffff0000u) + w1[1] * __uint_as_float(raw[t + 1] & 0xffff0000u) + w1[2] * __uint_as_float(raw[t + 2] & 0xffff0000u) + w1[3] * __uint_as_float(raw[t + 3] & 0xffff0000u);
        *(unsigned*)(zc + (32 * tq + t) * RG_ZS + 2 * k2) = pack2(y0, y1);
    }
}
__device__ __forceinline__ float gelu_fast(float v) {
    const float av = fabsf(v), t = __builtin_amdgcn_rcpf(av * 0.2316418882f + 1.0f);
    float q = t * 0.5307027145f + (-0.7265760135f); q = q * t + 0.7107068705f; q = q * t + (-0.142248368f); q = q * t + 0.127414796f; q = q * t;
    const float e = __builtin_amdgcn_exp2f(v * v * (-0.72134752044f));
    const float m = v * (q * e);
    return v < 0.f ? m : v - m;
}
struct RgCtx { bf16x8 wr[4], wi[4]; float br, bi, coef; };
__device__ __forceinline__ void rg_ctx_load(const Params& p, int n, int cl, int dir, RgCtx& c) {
    const int lane = otid() & 63, fr = lane & 15, fq = lane >> 4, ch = n * 128 + cl + fr;
    const bf16_t* gr = p.wt_gate + ((size_t)(dir * 2 + 0) * 10 + n) * 16384 + (size_t)(cl + fr) * 128 + 8 * fq;
    const bf16_t* gi = p.wt_gate + ((size_t)(dir * 2 + 1) * 10 + n) * 16384 + (size_t)(cl + fr) * 128 + 8 * fq;
#pragma unroll
    for (int s = 0; s < 4; ++s) { c.wr[s] = *(const bf16x8*)(gr + 32 * s); c.wi[s] = *(const bf16x8*)(gi + 32 * s); }
    c.br = p.od_gate_b[(dir * 2 + 0) * RGW + ch]; c.bi = p.od_gate_b[(dir * 2 + 1) * RGW + ch];
    const float lam = p.od_lambda[dir * RGW + ch];
    c.coef = -8.0f * (fmaxf(-lam, 0.f) + log1pf(expf(-fabsf(lam)))) * 1.4426950408889634f;
}
__device__ __forceinline__ void rg_tile(const bf16_t* zc, int mt, int cl, const RgCtx& c, f32x4& a4, f32x4& x4) {
    const int lane = otid() & 63, fr = lane & 15, fq = lane >> 4;
    f32x4 r = (f32x4){0.f, 0.f, 0.f, 0.f}, ig = (f32x4){0.f, 0.f, 0.f, 0.f};
#pragma unroll
    for (int s = 0; s < 4; ++s) {
        const bf16x8 a = *(const bf16x8*)(zc + (16 * mt + fr) * RG_ZS + 32 * s + 8 * fq);
        r = __builtin_amdgcn_mfma_f32_16x16x32_bf16(a, c.wr[s], r, 0, 0, 0);
        ig = __builtin_amdgcn_mfma_f32_16x16x32_bf16(a, c.wi[s], ig, 0, 0, 0);
    }
#pragma unroll
    for (int rg = 0; rg < 4; ++rg) {
        const float rr = __builtin_amdgcn_rcpf(1.0f + __builtin_amdgcn_exp2f(-1.4426950408889634f * (r[rg] + c.br)));
        const float ii = __builtin_amdgcn_rcpf(1.0f + __builtin_amdgcn_exp2f(-1.4426950408889634f * (ig[rg] + c.bi)));
        const float a = __builtin_amdgcn_exp2f(c.coef * rr);
        const float z = bf2f(zc[(16 * mt + 4 * fq + rg) * RG_ZS + cl + fr]);
        a4[rg] = a; x4[rg] = sqrtf((1.0f - a) * (1.0f + a)) * ii * z;
    }
}
template <int DIR> __device__ __forceinline__ void rg_sum_dir(const Params& p, const bf16_t* zc, int b, int c34, int n, int cl, float* SUM) {
    const int lane = otid() & 63, fr = lane & 15, fq = lane >> 4;
    RgCtx c; rg_ctx_load(p, n, cl, DIR, c);
    float h = 0.f, pt = 1.f;
#pragma unroll 2
    for (int m2 = 0; m2 < 8; ++m2) {
        const int mt = DIR == 0 ? m2 : 7 - m2;
        f32x4 a, x; rg_tile(zc, mt, cl, c, a, x);
        const float P4 = a[0] * a[1] * a[2] * a[3];
        const float B4 = DIR == 0 ? ((x[0] * a[1] + x[1]) * a[2] + x[2]) * a[3] + x[3] : ((x[3] * a[2] + x[2]) * a[1] + x[1]) * a[0] + x[0];
#pragma unroll
        for (int g2 = 0; g2 < 4; ++g2) {
            const int gs = DIR == 0 ? g2 : 3 - g2;
            const float Pg = __shfl(P4, 16 * gs + fr), Bg = __shfl(B4, 16 * gs + fr);
            h = Pg * h + Bg; pt *= Pg;
        }
    }
    if (fq == 0) { float* dst = SUM + ((((size_t)b * 34 + c34) * 2 + DIR) * RGW + n * 128 + cl + fr) * 2; dst[0] = pt; dst[1] = h; }
}
__device__ __forceinline__ void ph_rg_a(const Params& p, unsigned char* smem) {
    bf16_t* zc = (bf16_t*)smem;
    float* SUM = (float*)p.G;
    const int wid = otid() >> 6;
    for (int u = blockIdx.x; u < NB * 34 * 10; u += gridDim.x) {
        const int b = u / 340, c34 = (u / 10) % 34, n = u % 10;
        __syncthreads();
        rg_stage_z(p, b, c34, n, zc);
        __syncthreads();
        for (int nt = 0; nt < 2; ++nt) {
            const int cl = 32 * wid + 16 * nt;
            rg_sum_dir<0>(p, zc, b, c34, n, cl, SUM);
            rg_sum_dir<1>(p, zc, b, c34, n, cl, SUM);
        }
    }
}
__device__ __forceinline__ void ph_rg_b(const Params& p) {
    const float* SUM = (const float*)p.G; float* HIN = (float*)(p.G + RG_SUM_BYTES);
    for (int gid = blockIdx.x * 256 + threadIdx.x; gid < NB * 2 * RGW; gid += gridDim.x * 256) {
        const int ch = gid % RGW, dir = (gid / RGW) & 1, b = gid / (2 * RGW);
        float h = 0.f;
#pragma unroll 2
        for (int step = 0; step < 34; ++step) {
            const int c34 = dir == 0 ? step : (step < 2 ? 1 - step : 35 - step);
            const size_t o = (((size_t)b * 34 + c34) * 2 + dir) * RGW + ch;
            HIN[o] = h;
            h = SUM[o * 2] * h + SUM[o * 2 + 1];
        }
    }
}
template <int DIR> __device__ __forceinline__ void rg_apply_dir(const Params& p, const bf16_t* zc, bf16_t* yf, int b, int c34, int n, int cl, const float* HIN, int dry) {
    const int lane = otid() & 63, fr = lane & 15, fq = lane >> 4, ch = n * 128 + cl + fr;
    RgCtx c; rg_ctx_load(p, n, cl, DIR, c);
    float h = HIN[(((size_t)b * 34 + c34) * 2 + DIR) * RGW + ch];
    bf16_t* pbase = p.P + ((size_t)b * PB + c34 * 128 + 4 * fq) * 2560 + ch;
    bf16_t br_[32];
    if (DIR == 1) {
#pragma unroll
        for (int i = 0; i < 32; ++i) br_[i] = pbase[(size_t)(16 * (i >> 2) + (i & 3)) * 2560];
    }
#pragma unroll
    for (int m2 = 0; m2 < 8; ++m2) {
        const int mt = DIR == 0 ? m2 : 7 - m2;
        f32x4 a, x; rg_tile(zc, mt, cl, c, a, x);
        const float P4 = a[0] * a[1] * a[2] * a[3];
        const float B4 = DIR == 0 ? ((x[0] * a[1] + x[1]) * a[2] + x[2]) * a[3] + x[3] : ((x[3] * a[2] + x[2]) * a[1] + x[1]) * a[0] + x[0];
        float hin = 0.f;
#pragma unroll
        for (int g2 = 0; g2 < 4; ++g2) {
            const int gs = DIR == 0 ? g2 : 3 - g2;
            const float Pg = __shfl(P4, 16 * gs + fr), Bg = __shfl(B4, 16 * gs + fr);
            if (fq == gs) hin = h;
            h = Pg * h + Bg;
        }
        f32x4 y;
        if (DIR == 0) {
            y[0] = a[0] * hin + x[0]; y[1] = a[1] * y[0] + x[1]; y[2] = a[2] * y[1] + x[2]; y[3] = a[3] * y[2] + x[3];
#pragma unroll
            for (int rg = 0; rg < 4; ++rg) yf[(16 * mt + 4 * fq + rg) * 16 + fr] = f2bf(y[rg]);
        } else {
            y[3] = a[3] * hin + x[3]; y[2] = a[2] * y[3] + x[2]; y[1] = a[1] * y[2] + x[1]; y[0] = a[0] * y[1] + x[0];
#pragma unroll
            for (int rg = 0; rg < 4; ++rg) {
                bf16_t* pb = pbase + (size_t)(16 * mt + rg) * 2560;
                const bf16_t ov = f2bf(gelu_fast(bf2f(br_[4 * mt + rg])) * (y[rg] + bf2f(yf[(16 * mt + 4 * fq + rg) * 16 + fr])));
                if (!dry) *pb = ov; else asm volatile("" :: "v"(ov));
            }
        }
    }
}
__device__ __forceinline__ void ph_rg_c(const Params& p, unsigned char* smem, int dry = 0) {
    bf16_t* zc = (bf16_t*)smem;
    const float* HIN = (const float*)(p.G + RG_SUM_BYTES);
    const int wid = otid() >> 6;
    bf16_t* yf = (bf16_t*)(smem + 128 * RG_ZS * 2) + wid * 2048;
    for (int u = blockIdx.x; u < NB * 32 * 10; u += gridDim.x) {
        const int b = u / 320, c34 = 2 + (u / 10) % 32, n = u % 10;
        __syncthreads();
        rg_stage_z(p, b, c34, n, zc);
        __syncthreads();
        for (int nt = 0; nt < 2; ++nt) {
            const int cl = 32 * wid + 16 * nt;
            rg_apply_dir<0>(p, zc, yf, b, c34, n, cl, HIN, dry);
            rg_apply_dir<1>(p, zc, yf, b, c34, n, cl, HIN, dry);
        }
    }
}

#define XB_TMO      128
#define XB_XCNT(j)  (256  + 64 * (j))
#define XB_XSUB(j)  (1280 + 64 * (j))
#define XB_XGEN(j)  (2304 + 64 * (j))
#define XB_TOP      3328
#define XB_TOPGEN   3392
#define XCD_BAR_WORDS 3456
#define XB_SPIN_CAP (1u << 22)
__device__ __forceinline__ unsigned xb_ld(unsigned* p) { return __hip_atomic_load(p, __ATOMIC_RELAXED, __HIP_MEMORY_SCOPE_AGENT); }
__device__ __forceinline__ unsigned xb_add(unsigned* p, unsigned v) { return __hip_atomic_fetch_add(p, v, __ATOMIC_RELAXED, __HIP_MEMORY_SCOPE_AGENT); }
__device__ __forceinline__ unsigned xb_xcc_id() { return (unsigned)__builtin_amdgcn_s_getreg((3 << 11) | 20) & 0xFu; }
#define XB_SPIN(cond, bar) do { unsigned _sp = 0; while (cond) { __builtin_amdgcn_s_sleep(1); \
    if ((++_sp & 255u) == 0u) { if (xb_ld(&(bar)[XB_TMO])) break; if (_sp > XB_SPIN_CAP) { atomicAdd(&(bar)[XB_TMO], 1u); break; } } } } while (0)
struct XcdBarrier { unsigned* bar; unsigned x; volatile LAS unsigned* st; };
__device__ __forceinline__ XcdBarrier xcd_barrier_post(unsigned* bar, volatile LAS unsigned* st) {
    XcdBarrier b; b.bar = bar; b.x = xb_xcc_id(); b.st = st;
    if (threadIdx.x == 0) (void)xb_add(&bar[XB_XCNT(b.x)], 1u);
    return b;
}
__device__ __forceinline__ void xcd_barrier_complete(unsigned* bar, unsigned x, unsigned& nloc, unsigned& nx) {
    const unsigned G = gridDim.x * gridDim.y * gridDim.z;
    unsigned sum, cnt, mine, sp = 0u;
    for (;;) {
        sum = 0u; cnt = 0u; mine = 0u;
#pragma unroll
        for (unsigned j = 0; j < 16; ++j) { const unsigned c = xb_ld(&bar[XB_XCNT(j)]); sum += c; cnt += (c > 0u) ? 1u : 0u; mine = (j == x) ? c : mine; }
        if (sum == G) break;
        __builtin_amdgcn_s_sleep(1);
        if ((++sp & 255u) == 0u) { if (xb_ld(&bar[XB_TMO])) break; if (sp > XB_SPIN_CAP) { atomicAdd(&bar[XB_TMO], 1u); break; } }
    }
    nloc = mine > 0u ? mine : 1u; nx = cnt > 0u ? cnt : 1u;
}
__device__ __forceinline__ void xcd_barrier(const XcdBarrier& b) {
    asm volatile("s_waitcnt vmcnt(0)" ::: "memory");
    __syncthreads();
    if (threadIdx.x == 0) {
        unsigned* bar = b.bar;
        __builtin_amdgcn_s_waitcnt(0);
        unsigned nloc = b.st[0], nx = b.st[1];
        if (nloc == 0u) { xcd_barrier_complete(bar, b.x, nloc, nx); b.st[0] = nloc; b.st[1] = nx; }
        const unsigned old = xb_add(&bar[XB_XSUB(b.x)], 1u);
        const unsigned gen = old / nloc;
        if (old + 1u == (gen + 1u) * nloc) {
            __builtin_amdgcn_fence(__ATOMIC_RELEASE, "agent");
            asm volatile("s_waitcnt vmcnt(0)" ::: "memory");
            const unsigned og = xb_add(&bar[XB_TOP], 1u);
            const unsigned tg = og / nx;
            if (og + 1u == (tg + 1u) * nx) xb_add(&bar[XB_TOPGEN], 1u);
            else XB_SPIN(xb_ld(&bar[XB_TOPGEN]) == tg, bar);
            __builtin_amdgcn_fence(__ATOMIC_ACQUIRE, "agent");
            xb_add(&bar[XB_XGEN(b.x)], 1u);
            asm volatile("s_waitcnt vmcnt(0)" ::: "memory");
        } else {
            XB_SPIN(xb_ld(&bar[XB_XGEN(b.x)]) == gen, bar);
            __builtin_amdgcn_fence(__ATOMIC_ACQUIRE, "agent");
            asm volatile("s_waitcnt vmcnt(0)" ::: "memory");
        }
    }
    __syncthreads();
}

#define SMEM_DECL __shared__ __attribute__((aligned(16))) unsigned char smem[65536]
__global__ void __launch_bounds__(256, 2) k_mega(Params p) {
    SMEM_DECL;
    cg::grid_group grid = cg::this_grid();
    volatile LAS unsigned* xst = (volatile LAS unsigned*)(LAS unsigned char*)(smem + 65520);
    if (threadIdx.x == 0) { xst[0] = 0u; xst[1] = 0u; }
    if (blockIdx.x == 0) for (int i = threadIdx.x; i < XCD_BAR_WORDS; i += 256) p.bar[i] = 0u;
    ph_prologue(p, smem); grid.sync();
    const XcdBarrier xb = xcd_barrier_post(p.bar, xst);
    if (p.probe & 32) ph_modulate0(p);
    ph_modulate0(p); xcd_barrier(xb);
    ph_wprime(p, smem); gemm_phase(p.A16, D, p.wt_ev_in, 1024, EV_IN, RowMap{0}, EpiBf16{p.P, EV_IN, EV_IN}, smem); xcd_barrier(xb);
    if (p.probe & 32) ph_rowpost(p);
    if (p.probe & 128) ph_gla_a(p, smem);
    ph_rowpost(p); ph_gla_a(p, smem); xcd_barrier(xb);
    gemm_phase(p.P + C_CQ, EV_IN, p.wt_uq, 384, 768, RowMap{0}, EpiQ{p.Q16, p.rsq, p.rope_cos, p.rope_sin}, smem);
    gemm_phase(p.P + C_CKV, EV_IN, p.wt_ukv, 256, 1024, RowMap{0}, EpiKV{p.K16, p.V16, p.rsq + R}, smem); if (p.probe & 8) ph_gla_b(p, 1);
    ph_gla_b(p); xcd_barrier(xb);
    if (p.probe & 256) ph_gla_c(p, smem);
    if (p.probe & 512) ph_attn(p, smem, blockIdx.x, gridDim.x);
    ph_gla_c(p, smem); ph_attn(p, smem, blockIdx.x, gridDim.x); xcd_barrier(xb);
    gemm_phase(p.A16, D, p.wt_ev_out, 1024, 1024, RowMap{0}, EpiResid{p.x, p.ctx, p.mod, p.H, 0}, smem); xcd_barrier(xb);
    if (p.probe & 4) ph_ln_mod(p, 0, 0, 0, 1);
    ph_ln_mod(p, 0, 0, 0); xcd_barrier(xb);
    ph_gemm_scores(p, 0, 0, smem); ph_convert_uv(p, 0); xcd_barrier(xb);
    ph_combine(p, 0); xcd_barrier(xb);
    ph_gather_sliced(p, 0, 0, smem); xcd_barrier(xb);
    gemm_phase(p.A16, D, p.wt_od_in, 1024, 2560, RowMap{0}, EpiBf16{p.P, 2560, 2560}, smem); xcd_barrier(xb);
    if (p.probe & 64) ph_rg_a(p, smem);
    ph_rg_a(p, smem); xcd_barrier(xb);
    if (p.probe & 32) ph_rg_b(p);
    ph_rg_b(p); xcd_barrier(xb);
    if (p.probe & 16) ph_rg_c(p, smem, 1);
    ph_rg_c(p, smem); xcd_barrier(xb);
    gemm_phase(p.P, 2560, p.wt_od_out, 1280, 1024, RowMap{1}, EpiResid{p.x, p.ctx, p.mod, p.H, 1}, smem); xcd_barrier(xb);
    if (p.probe & 4) ph_ln_mod(p, 1, 0, 1, 1);
    ph_ln_mod(p, 1, 0, 1); xcd_barrier(xb);
    ph_gemm_scores(p, 1, 1, smem); ph_convert_uv(p, 1); xcd_barrier(xb);
    ph_combine(p, 1); xcd_barrier(xb);
    ph_gather_sliced(p, 1, 1, smem);
}

extern "C" void kernel_launch(void* const* d_in, const int* in_sizes, int n_in, void* d_out, int out_size, void* d_ws, size_t ws_size, hipStream_t stream) {
    Params p{};
    const float** f = (const float**)d_in;
    p.x = f[0]; p.c = f[1]; p.ctx = f[2]; p.c_ctx = f[3]; p.mod_w = f[4]; p.mod_b = f[5]; p.ln_g = f[6]; p.ln_b = f[7];
    p.ev_w_in = f[8]; p.ev_q_norm = f[9]; p.ev_kv_norm = f[10]; p.ev_w_uq = f[11]; p.ev_w_ukv = f[12]; p.ev_gla_wa2 = f[13]; p.ev_gla_ba = f[14]; p.ev_gla_norm = f[15]; p.ev_w_out = f[16];
    p.od_w_in = f[17]; p.od_conv_w = f[18]; p.od_conv_b = f[19]; p.od_gate_w = f[20]; p.od_gate_b = f[21]; p.od_lambda = f[22]; p.od_w_out = f[23];
    p.peer_wq = f[24]; p.peer_k1 = f[25]; p.peer_k2 = f[26]; p.peer_u = f[27]; p.peer_v = f[28];
    p.out = (float*)d_out;
    unsigned char* w = (unsigned char*)d_ws; size_t off = 0;
    auto take = [&](size_t bytes) { unsigned char* r = w + off; off += (bytes + 255) & ~(size_t)255; return r; };
    p.wt_ev_in = (bf16_t*)take((size_t)EV_IN * 1024 * 2); p.wt_uq = (bf16_t*)take(768 * 384 * 2); p.wt_ukv = (bf16_t*)take(1024 * 256 * 2);
    p.wt_ev_out = (bf16_t*)take(1024 * 1024 * 2); p.wt_od_in = (bf16_t*)take(2560 * 1024 * 2); p.wt_gate = (bf16_t*)take(40 * 16384 * 2);
    p.wt_od_out = (bf16_t*)take(1024 * 1280 * 2); p.wq16 = (bf16_t*)take((size_t)2 * 2048 * 1024 * 2); p.wpt = (bf16_t*)take((size_t)2 * 2048 * 1024 * 2); p.wt_k = (bf16_t*)take(4 * 16384 * 2);
    p.mod = (float*)take(2 * 9 * 6144 * 4); p.rope_cos = (float*)take(SEQ * 16 * 4); p.rope_sin = (float*)take(SEQ * 16 * 4); p.rsq = (float*)take((size_t)2 * R * 4);
    p.H = (float*)take((size_t)R * D * 4);
    p.Q16 = (bf16_t*)p.H; p.K16 = p.Q16 + (size_t)R * 768; p.V16 = p.K16 + (size_t)R * 768;
    p.A16 = (bf16_t*)take((size_t)R * D * 2);
    p.P = (bf16_t*)take((size_t)R * 2560 * 2);
    p.G = take((size_t)94371840);
    p.bar = (unsigned*)take(XCD_BAR_WORDS * 4);
    if (off > ws_size) { fprintf(stderr, "workspace too small: need %zu have %zu\n", off, ws_size); return; }
    static int grid_blocks = 0;
    if (!grid_blocks) {
        int dev = 0, cus = 0, per_cu = 0;
        (void)hipGetDevice(&dev);
        (void)hipDeviceGetAttribute(&cus, hipDeviceAttributeMultiprocessorCount, dev);
        (void)hipOccupancyMaxActiveBlocksPerMultiprocessor(&per_cu, k_mega, 256, 0);
        if (per_cu > 2) per_cu = 2;
        if (per_cu < 1) per_cu = 1;
        grid_blocks = cus * per_cu;
    }
    p.probe = PROBE_MASK; p.pad_ = 0;
    void* args[] = {&p};
    hipError_t e = hipLaunchCooperativeKernel((void*)k_mega, dim3(grid_blocks), dim3(256), args, 0, stream);
    if (e != hipSuccess) fprintf(stderr, "cooperative launch failed: %s (grid %d)\n", hipGetErrorString(e), grid_blocks);
}
```
